# Optimizing an MI355X kernel written in HIP

```python
import math
import jax, jax.numpy as jnp
from jax import lax
import numpy as np

D_MODEL = 4096
BATCH = 1
SEQ = 8192
DEPTH = 1
DEC_BATCH = 2
DEC_SEQ = 8192
PAST_LEN = 128

D_RG = D_MODEL // 2
D_HY = D_MODEL - D_RG
D_MIX = D_RG + D_HY
RG_HEAD_DIM = 128
N_RG_HEADS = D_RG // RG_HEAD_DIM
RG_CONV = 4
RG_CONV_LEFT = 2
RG_C = 8.0
HY_ORDER = 2
HY_CONV = 3
HY_EMB = 33
HY_BANDS = (HY_EMB - 1) // 2
HY_FILTER_WIDTH = 64
HY_FAST_DECAY = 0.3
HY_SLOW_DECAY = 1.5
HY_TARGET = 1e-2
D_FF = 11008
FFN_CONV = 3
EPS = 1e-6
N_IN = 2 * D_RG + (HY_ORDER + 1) * D_HY

kernel_name = "hymba_rglru_hyena_encoder"

F32 = jnp.float32


def rms_norm(x, g):
    xf = x.astype(F32)
    y = xf * lax.rsqrt(jnp.mean(xf * xf, axis=-1, keepdims=True) + EPS)
    return (y * g.astype(F32)).astype(x.dtype)


def dw_conv(x, w, b, left):
    k_w = w.shape[0]
    L = x.shape[1]
    xp = jnp.pad(x, ((0, 0), (left, k_w - 1 - left), (0, 0)))
    y = xp[:, 0:L, :] * w[0] + b
    for k in range(1, k_w):
        y = y + xp[:, k:k + L, :] * w[k]
    return y


def block_diag(x, w, b):
    B, L, _ = x.shape
    xh = x.reshape(B, L, N_RG_HEADS, RG_HEAD_DIM)
    return jnp.einsum("blhi,hij->blhj", xh, w).reshape(B, L, D_RG) + b


def _linear_combine(left, right):
    a1, b1 = left
    a2, b2 = right
    return a1 * a2, a2 * b1 + b2


def rg_lru(xc, wa, ba, wx, bx, lam, reverse):
    xf = xc.astype(F32)
    r = jax.nn.sigmoid(block_diag(xf, wa.astype(F32), ba.astype(F32)))
    i = jax.nn.sigmoid(block_diag(xf, wx.astype(F32), bx.astype(F32)))
    log_a = -RG_C * r * jax.nn.softplus(-lam.astype(F32))
    a = jnp.exp(log_a)
    b = jnp.sqrt(-jnp.expm1(2.0 * log_a)) * (i * xf)
    _, h = lax.associative_scan(_linear_combine, (a, b), axis=1, reverse=reverse)
    return h


def hyena_filters(L, w1, b1, w2, b2, w3, b3, w4, freq):
    t = jnp.linspace(0.0, 1.0, L, dtype=F32)[:, None]
    n = jnp.arange(L, dtype=F32)[:, None]
    bands = jnp.linspace(1e-4, HY_BANDS - 1, HY_BANDS, dtype=F32)
    ang = (2.0 * math.pi / L) * n * bands
    z = jnp.concatenate([t, jnp.cos(ang), -jnp.sin(ang)], axis=-1)
    fr = freq.astype(F32)
    h = jnp.sin(fr * (z @ w1.astype(F32) + b1.astype(F32)))
    h = jnp.sin(fr * (h @ w2.astype(F32) + b2.astype(F32)))
    h = jnp.sin(fr * (h @ w3.astype(F32) + b3.astype(F32)))
    h = (h @ w4.astype(F32)).reshape(L, HY_ORDER, 2, D_HY)
    max_decay = math.log(HY_TARGET) / HY_FAST_DECAY
    min_decay = math.log(HY_TARGET) / HY_SLOW_DECAY
    deltas = jnp.linspace(min_decay, max_decay, D_HY, dtype=F32)
    decay = jnp.exp(-t * jnp.abs(deltas))
    h = h * decay[:, None, None, :]
    h_fwd = h[:, :, 0, :]
    h_bwd = h[1:, :, 1, :][::-1]
    k = jnp.concatenate([h_fwd, jnp.zeros((1, HY_ORDER, D_HY), F32), h_bwd], axis=0)
    return jnp.fft.rfft(k, axis=0)


def long_conv(u, k_spec, bias):
    L = u.shape[1]
    U = jnp.fft.rfft(u, n=2 * L, axis=1)
    y = jnp.fft.irfft(U * k_spec[None], n=2 * L, axis=1)[:, :L]
    return y + u * bias.astype(F32)


def encoder_layer(x, pre_mix_norm, w_in, rg_conv_w, rg_conv_b, rg_a_w, rg_a_b, rg_x_w, rg_x_b,
                  rg_lambda, hy_conv_w, hy_conv_b, hy_w1, hy_b1, hy_w2, hy_b2, hy_w3, hy_b3,
                  hy_w4, hy_sin_freq, hy_bias, rg_out_norm, hy_out_norm, w_out, post_mix_norm,
                  pre_ffn_norm, w_ffn_in, ffn_conv_w, ffn_conv_b, w_ffn_out, post_ffn_norm):
    dt = x.dtype
    L = x.shape[1]
    hn = rms_norm(x, pre_mix_norm)
    proj = hn @ w_in
    rg_x = proj[..., :D_RG]
    rg_g = proj[..., D_RG:2 * D_RG]
    hy_u = proj[..., 2 * D_RG:]
    xc = dw_conv(rg_x, rg_conv_w, rg_conv_b, RG_CONV_LEFT)
    h_f = rg_lru(xc, rg_a_w[0], rg_a_b[0], rg_x_w[0], rg_x_b[0], rg_lambda[0], False)
    h_b = rg_lru(xc, rg_a_w[1], rg_a_b[1], rg_x_w[1], rg_x_b[1], rg_lambda[1], True)
    rg_y = ((h_f + h_b) * jax.nn.gelu(rg_g.astype(F32))).astype(dt)
    hu = dw_conv(hy_u, hy_conv_w, hy_conv_b, (HY_CONV - 1) // 2).astype(F32)
    streams = jnp.split(hu, HY_ORDER + 1, axis=-1)
    k_spec = hyena_filters(L, hy_w1, hy_b1, hy_w2, hy_b2, hy_w3, hy_b3, hy_w4, hy_sin_freq)
    z = streams[0]
    for o in range(HY_ORDER):
        z = streams[o + 1] * long_conv(z, k_spec[:, o], hy_bias[o])
    hy_y = z.astype(dt)
    mix = jnp.concatenate([rms_norm(rg_y, rg_out_norm), rms_norm(hy_y, hy_out_norm)], axis=-1)
    x = x + rms_norm(mix @ w_out, post_mix_norm)
    hn = rms_norm(x, pre_ffn_norm)
    gu = hn @ w_ffn_in
    g = dw_conv(gu[..., :D_FF], ffn_conv_w, ffn_conv_b, (FFN_CONV - 1) // 2)
    f = (jax.nn.gelu(g) * gu[..., D_FF:]) @ w_ffn_out
    return x + rms_norm(f, post_ffn_norm)


def run_trunk(x, params):
    for l in range(DEPTH):
        x = encoder_layer(x, *[p[l] for p in params])
    return x


def setup_inputs(seed: int = 0) -> dict:
    key = jax.random.key(seed)
    ks = iter(jax.random.split(key, 48))
    nrm = lambda shape, scale: scale * jax.random.normal(next(ks), shape, F32)
    gain = lambda shape: 1.0 + 0.05 * jax.random.normal(next(ks), shape, F32)
    u = jax.random.uniform(next(ks), (DEPTH, 2, D_RG), F32, minval=0.9, maxval=0.999)
    base = u ** (1.0 / RG_C)
    rg_lambda = jnp.log(base) - jnp.log1p(-base)
    return {
        "x_prompt": nrm((BATCH, SEQ, D_MODEL), 1.0),
        "x_sample": nrm((DEC_BATCH, DEC_SEQ, D_MODEL), 1.0),
        "pre_mix_norm": gain((DEPTH, D_MODEL)),
        "w_in": nrm((DEPTH, D_MODEL, N_IN), D_MODEL ** -0.5),
        "rg_conv_w": nrm((DEPTH, RG_CONV, D_RG), RG_CONV ** -0.5),
        "rg_conv_b": nrm((DEPTH, D_RG), 0.02),
        "rg_a_w": nrm((DEPTH, 2, N_RG_HEADS, RG_HEAD_DIM, RG_HEAD_DIM), RG_HEAD_DIM ** -0.5),
        "rg_a_b": nrm((DEPTH, 2, D_RG), 0.02),
        "rg_x_w": nrm((DEPTH, 2, N_RG_HEADS, RG_HEAD_DIM, RG_HEAD_DIM), RG_HEAD_DIM ** -0.5),
        "rg_x_b": nrm((DEPTH, 2, D_RG), 0.02),
        "rg_lambda": rg_lambda,
        "hy_conv_w": nrm((DEPTH, HY_CONV, (HY_ORDER + 1) * D_HY), HY_CONV ** -0.5),
        "hy_conv_b": nrm((DEPTH, (HY_ORDER + 1) * D_HY), 0.02),
        "hy_w1": nrm((DEPTH, HY_EMB, HY_FILTER_WIDTH), HY_EMB ** -0.5),
        "hy_b1": nrm((DEPTH, HY_FILTER_WIDTH), 0.02),
        "hy_w2": nrm((DEPTH, HY_FILTER_WIDTH, HY_FILTER_WIDTH), HY_FILTER_WIDTH ** -0.5),
        "hy_b2": nrm((DEPTH, HY_FILTER_WIDTH), 0.02),
        "hy_w3": nrm((DEPTH, HY_FILTER_WIDTH, HY_FILTER_WIDTH), HY_FILTER_WIDTH ** -0.5),
        "hy_b3": nrm((DEPTH, HY_FILTER_WIDTH), 0.02),
        "hy_w4": nrm((DEPTH, HY_FILTER_WIDTH, HY_ORDER * 2 * D_HY), HY_FILTER_WIDTH ** -0.5),
        "hy_sin_freq": gain((DEPTH, HY_FILTER_WIDTH)),
        "hy_bias": nrm((DEPTH, HY_ORDER, D_HY), 1.0),
        "rg_out_norm": gain((DEPTH, D_RG)),
        "hy_out_norm": gain((DEPTH, D_HY)),
        "w_out": nrm((DEPTH, D_MIX, D_MODEL), D_MIX ** -0.5),
        "post_mix_norm": gain((DEPTH, D_MODEL)),
        "pre_ffn_norm": gain((DEPTH, D_MODEL)),
        "w_ffn_in": nrm((DEPTH, D_MODEL, 2 * D_FF), D_MODEL ** -0.5),
        "ffn_conv_w": nrm((DEPTH, FFN_CONV, D_FF), FFN_CONV ** -0.5),
        "ffn_conv_b": nrm((DEPTH, D_FF), 0.02),
        "w_ffn_out": nrm((DEPTH, D_FF, D_MODEL), D_FF ** -0.5),
        "post_ffn_norm": gain((DEPTH, D_MODEL)),
    }


def reference(x_prompt, x_sample, pre_mix_norm, w_in, rg_conv_w, rg_conv_b, rg_a_w, rg_a_b,
              rg_x_w, rg_x_b, rg_lambda, hy_conv_w, hy_conv_b, hy_w1, hy_b1, hy_w2, hy_b2,
              hy_w3, hy_b3, hy_w4, hy_sin_freq, hy_bias, rg_out_norm, hy_out_norm, w_out,
              post_mix_norm, pre_ffn_norm, w_ffn_in, ffn_conv_w, ffn_conv_b, w_ffn_out,
              post_ffn_norm):
    params = (pre_mix_norm, w_in, rg_conv_w, rg_conv_b, rg_a_w, rg_a_b, rg_x_w, rg_x_b,
              rg_lambda, hy_conv_w, hy_conv_b, hy_w1, hy_b1, hy_w2, hy_b2, hy_w3, hy_b3,
              hy_w4, hy_sin_freq, hy_bias, rg_out_norm, hy_out_norm, w_out, post_mix_norm,
              pre_ffn_norm, w_ffn_in, ffn_conv_w, ffn_conv_b, w_ffn_out, post_ffn_norm)
    y_prompt = run_trunk(x_prompt, params)
    y_sample = run_trunk(x_sample, params)
    return (y_prompt, y_sample)
```

```cpp
#include <hip/hip_runtime.h>
#include <cstdio>
#include <cstdint>
namespace pg8 {
#define PG8_LAS __attribute__((address_space(3)))
typedef unsigned short bf16_t;
typedef short bf16x8 __attribute__((ext_vector_type(8)));
typedef float f32x4 __attribute__((ext_vector_type(4)));
typedef unsigned u32x4 __attribute__((ext_vector_type(4)));
constexpr int BM = 256, BK = 64, HALF = 128, HTB = HALF * BK * 2  , STAGE_BYTES = 8 * HTB, NXCD = 8, WGM = 8;

__host__ __device__ __forceinline__ int lds_byte(int r, int c) { const int st = (r >> 4) * 2 + (c >> 5), rr = r & 15, cc = c & 31, ob = rr * 64 + cc * 2; return st * 1024 + (ob ^ (((ob >> 9) & 1) << 5)); }
__host__ __device__ __forceinline__ void stage_rc(int b, int& R, int& C) { const int st = b / 1024, sb = b % 1024, swz = sb ^ (((sb >> 9) & 1) << 5); R = (st >> 1) * 16 + swz / 64; C = (st & 1) * 32 + (swz % 64) / 2; }
__host__ __device__ __forceinline__ int perm32(int rho) { const int n = rho >> 4, i = rho & 15; return 8 * (i >> 2) + 4 * n + (i & 3); }

struct Unit { int pm, pn; };
struct Gemm { const bf16_t* A; const bf16_t* Bt; int M, N, K; };

struct StaticOrder {
    int nM, nN, nwg, G, c;
    __host__ __device__ void init(int M, int N, int G_, int c_) { nM = M / BM; nN = N / BM; nwg = nM * nN; G = G_; c = c_; }
    __host__ __device__ bool next(int i, Unit& u) const {
        const long L = (long)i * G + c; if (L >= nwg) return false;
        int wgid = (int)L; { const int q = nwg / NXCD, r = nwg % NXCD, xcd = wgid % NXCD, off = wgid / NXCD; wgid = (xcd < r ? xcd * (q + 1) : r * (q + 1) + (xcd - r) * q) + off; }
        const int nig = WGM * nN, gid = wgid / nig, fm = gid * WGM, gsz = (nM - fm) < WGM ? (nM - fm) : WGM;
        u.pm = fm + ((wgid % nig) % gsz); u.pn = (wgid % nig) / gsz; return true;
    }
    __device__ __forceinline__ void a_ready(const Unit&) const {}
    __device__ __forceinline__ void done(const Unit&) const {}
};

__device__ __forceinline__ unsigned cvt_pk_bf16(float lo, float hi) { unsigned r; asm volatile("v_cvt_pk_bf16_f32 %0, %1, %2" : "=v"(r) : "v"(lo), "v"(hi)); return r; }
typedef float f32x2 __attribute__((ext_vector_type(2)));
__device__ __forceinline__ f32x2 gelu_pk(f32x2 v) {
    const f32x2 av = __builtin_elementwise_abs(v), d = av * 0.2316418882f + 1.0f;
    f32x2 t; t.x = __builtin_amdgcn_rcpf(d.x); t.y = __builtin_amdgcn_rcpf(d.y);
    f32x2 q = t * 0.5307027145f + (-0.7265760135f); q = q * t + 0.7107068705f; q = q * t + (-0.142248368f); q = q * t + 0.127414796f; q = q * t;
    const f32x2 s = (v * v) * (-0.72134752044f);
    f32x2 e; e.x = __builtin_amdgcn_exp2f(s.x); e.y = __builtin_amdgcn_exp2f(s.y);
    const f32x2 m = v * (q * e), r = v - m;
    f32x2 o; o.x = v.x < 0.f ? m.x : r.x; o.y = v.y < 0.f ? m.y : r.y; return o;
}

template <int ACT  > struct EpiBf16 {
    static constexpr bool PERM = true, AFTER_DRAIN = false; static_assert(ACT == 0 || ACT == 1, "EpiBf16: ACT is 0 (none) or 1 (gelu_pk)");
    bf16_t* O; int ldc; const float* bias; int split_cols; size_t split_stride; float scale0;
    __device__ __forceinline__ void operator()(const f32x4 (&acc)[2][2][4][2], const Unit& u, int wr, int wc, int fr, int fq) const {
        const int row0 = u.pm * BM + wr * 64 + fr; int colt = u.pn * BM; bf16_t* base = O;
        float sc = 1.f; if (split_cols) { const int t = colt / split_cols; base += (size_t)t * split_stride; colt -= t * split_cols; if (t == 0) sc = scale0; }
        const int col0 = colt + wc * 32 + 8 * fq, bcol0 = u.pn * BM + wc * 32 + 8 * fq;
        f32x4 bv[2][2];
#pragma unroll
        for (int bj = 0; bj < 2; ++bj)
#pragma unroll
            for (int n = 0; n < 2; ++n) bv[bj][n] = bias ? *(const f32x4*)(bias + bcol0 + bj * HALF + 4 * n) : (f32x4){0.f, 0.f, 0.f, 0.f};
#pragma unroll
        for (int ai = 0; ai < 2; ++ai)
#pragma unroll
            for (int m = 0; m < 4; ++m) { bf16_t* rowp = base + (size_t)(row0 + ai * HALF + m * 16) * ldc + col0;
#pragma unroll
                for (int bj = 0; bj < 2; ++bj) { f32x4 v0 = acc[ai][bj][m][0] + bv[bj][0], v1 = acc[ai][bj][m][1] + bv[bj][1];
                    if (ACT == 1) { f32x2 a = gelu_pk((f32x2){v0[0], v0[1]}), b = gelu_pk((f32x2){v0[2], v0[3]}), c = gelu_pk((f32x2){v1[0], v1[1]}), d = gelu_pk((f32x2){v1[2], v1[3]});
                        v0 = (f32x4){a.x, a.y, b.x, b.y}; v1 = (f32x4){c.x, c.y, d.x, d.y}; }
                    v0 = v0 * sc; v1 = v1 * sc; u32x4 w; w.x = cvt_pk_bf16(v0[0], v0[1]); w.y = cvt_pk_bf16(v0[2], v0[3]); w.z = cvt_pk_bf16(v1[0], v1[1]); w.w = cvt_pk_bf16(v1[2], v1[3]);
                    *(u32x4*)(rowp + bj * HALF) = w; } }
    }
};
template <class Epi, class Sched, bool ALIGN_EPI = false, bool SP2 = false>
__device__ __forceinline__ void gemm_phase(PG8_LAS unsigned char* lds, const Gemm g, const Sched& S, const Epi& E) {
    const int tid = threadIdx.x, wid = __builtin_amdgcn_readfirstlane(tid >> 6), lane = tid & 63, wr = wid >> 2, wc = wid & 3, fr = lane & 15, fq = lane >> 4;
    const int K = g.K, nt = K / BK;
    unsigned voffA[2], voffB[2];
#pragma unroll
    for (int i = 0; i < 2; ++i) { int R, C; stage_rc(tid * 16 + i * 8192, R, C); const int Rb = Epi::PERM ? ((R & ~31) + perm32(R & 31)) : R;
        voffA[i] = (unsigned)(R * K + C) * 2u; voffB[i] = (unsigned)(Rb * K + C) * 2u; }
    const size_t kstep = (size_t)(BK * 2);
    const size_t hstep = (size_t)HALF * K * 2;
    const size_t tstep = 2 * hstep;
    const unsigned ldsw = (unsigned)wid * 1024u;
    const int aoff = lds_byte(wr * 64 + fr, fq * 8), boff = lds_byte(wc * 32 + fr, fq * 8);
#define PG8_SA(b, h) (((b) * 2 + (h)) * HTB)
#define PG8_SB(b, h) ((4 + (b) * 2 + (h)) * HTB)
#define PG8_STAGE(bufoff, gbase, voff) do { _Pragma("unroll") for (int _i = 0; _i < 2; ++_i) \
        __builtin_amdgcn_global_load_lds((const unsigned*)((const char*)(gbase) + (voff)[_i]), (PG8_LAS unsigned*)(lds + (bufoff) + ldsw + _i * 8192), 16, 0, 0); } while (0)
#define PG8_LDA(dst, b, h) do { _Pragma("unroll") for (int m = 0; m < 4; ++m) _Pragma("unroll") for (int k = 0; k < 2; ++k) dst[m][k] = *(const PG8_LAS bf16x8*)(lds + PG8_SA(b, h) + aoff + m * 2048 + k * 1024); } while (0)
#define PG8_LDB(dst, b, h) do { _Pragma("unroll") for (int n = 0; n < 2; ++n) _Pragma("unroll") for (int k = 0; k < 2; ++k) dst[n][k] = *(const PG8_LAS bf16x8*)(lds + PG8_SB(b, h) + boff + n * 2048 + k * 1024); } while (0)
#define PG8_MMA(ai, bj, At, Bt) do { __builtin_amdgcn_s_setprio(1); _Pragma("unroll") for (int m = 0; m < 4; ++m) _Pragma("unroll") for (int n = 0; n < 2; ++n) _Pragma("unroll") for (int k = 0; k < 2; ++k) \
        acc[ai][bj][m][n] = __builtin_amdgcn_mfma_f32_16x16x32_bf16(Bt[n][k], At[m][k], acc[ai][bj][m][n], 0, 0, 0); __builtin_amdgcn_s_setprio(0); } while (0)
#define PG8_WAIT_V(n) asm volatile("s_waitcnt vmcnt(" #n ")" ::: "memory")
#define PG8_WAIT_L(n) asm volatile("s_waitcnt lgkmcnt(" #n ")" ::: "memory")
#define PG8_BAR __builtin_amdgcn_s_barrier()
#define PG8_SCHED __builtin_amdgcn_sched_barrier(0)
    Unit cur, nxt; int ui = 0;
    if (!S.next(0, cur)) return;
    f32x4 acc[2][2][4][2];
#pragma unroll
    for (int a = 0; a < 2; ++a)
#pragma unroll
        for (int b = 0; b < 2; ++b)
#pragma unroll
            for (int m = 0; m < 4; ++m)
#pragma unroll
                for (int n = 0; n < 2; ++n) acc[a][b][m][n] = (f32x4){0.f, 0.f, 0.f, 0.f};
    bf16x8 At[4][2], B0[2][2], B1[2][2];
    const char* cA = (const char*)g.A + (size_t)cur.pm * tstep; const char* cB = (const char*)g.Bt + (size_t)cur.pn * tstep;
    S.a_ready(cur);
    if constexpr (SP2) {
        PG8_STAGE(PG8_SB(0, 0), cB, voffB); PG8_STAGE(PG8_SB(0, 1), cB + hstep, voffB); PG8_STAGE(PG8_SA(0, 0), cA, voffA); PG8_STAGE(PG8_SA(0, 1), cA + hstep, voffA);
        if (wr == 1) PG8_BAR;
        PG8_WAIT_V(2); PG8_BAR;
        PG8_STAGE(PG8_SB(1, 0), cB + kstep, voffB); PG8_STAGE(PG8_SA(1, 0), cA + kstep, voffA); PG8_STAGE(PG8_SB(1, 1), cB + hstep + kstep, voffB);
        PG8_WAIT_V(6); PG8_BAR;
    } else {
        PG8_STAGE(PG8_SB(0, 0), cB, voffB); PG8_STAGE(PG8_SA(0, 0), cA, voffA); PG8_STAGE(PG8_SB(0, 1), cB + hstep, voffB); PG8_STAGE(PG8_SA(0, 1), cA + hstep, voffA);
        if (wr == 1) PG8_BAR;
        PG8_WAIT_V(4); PG8_BAR;
        PG8_STAGE(PG8_SB(1, 0), cB + kstep, voffB); PG8_STAGE(PG8_SA(1, 0), cA + kstep, voffA); PG8_STAGE(PG8_SB(1, 1), cB + hstep + kstep, voffB);
        PG8_WAIT_V(6); PG8_BAR;
    }
    for (;;) {
        const bool has_next = S.next(ui + 1, nxt);
        const char* nA = has_next ? (const char*)g.A + (size_t)nxt.pm * tstep : cA; const char* nB = has_next ? (const char*)g.Bt + (size_t)nxt.pn * tstep : cB;
        for (int t = 0; t < nt; t += 2) {
            const bool last = (t == nt - 2);
            const char* a1 = cA + (size_t)(t + 1) * kstep;
            const char* a2 = last ? nA : cA + (size_t)(t + 2) * kstep; const char* b2 = last ? nB : cB + (size_t)(t + 2) * kstep;
            const char* a3 = a2 + kstep; const char* b3 = b2 + kstep;
            if (last && has_next) S.a_ready(nxt);
            if constexpr (SP2) {
            PG8_LDB(B0, 0, 0); PG8_LDB(B1, 0, 1); PG8_SCHED; PG8_LDA(At, 0, 0); PG8_STAGE(PG8_SA(1, 1), a1 + hstep, voffA);
            PG8_WAIT_V(8); PG8_WAIT_L(0); PG8_BAR; PG8_MMA(0, 0, At, B0); PG8_MMA(0, 1, At, B1); PG8_BAR; PG8_SCHED;
            PG8_LDA(At, 0, 1); PG8_STAGE(PG8_SB(0, 0), b2, voffB); PG8_STAGE(PG8_SB(0, 1), b2 + hstep, voffB); PG8_STAGE(PG8_SA(0, 0), a2, voffA);
            PG8_WAIT_V(8); PG8_WAIT_L(0); PG8_BAR; PG8_MMA(1, 0, At, B0); PG8_MMA(1, 1, At, B1); PG8_BAR; PG8_SCHED;
            PG8_LDB(B0, 1, 0); PG8_LDB(B1, 1, 1); PG8_SCHED; PG8_LDA(At, 1, 0); PG8_STAGE(PG8_SA(0, 1), a2 + hstep, voffA);
            PG8_WAIT_V(8); PG8_WAIT_L(0); PG8_BAR; PG8_MMA(0, 0, At, B0); PG8_MMA(0, 1, At, B1); PG8_BAR; PG8_SCHED;
            PG8_LDA(At, 1, 1); PG8_STAGE(PG8_SB(1, 0), b3, voffB); PG8_STAGE(PG8_SB(1, 1), b3 + hstep, voffB); PG8_STAGE(PG8_SA(1, 0), a3, voffA);
            PG8_WAIT_V(8); PG8_WAIT_L(0); PG8_BAR; PG8_MMA(1, 0, At, B0); PG8_MMA(1, 1, At, B1); PG8_BAR; PG8_SCHED;
            } else {
            PG8_LDB(B0, 0, 0); PG8_SCHED; PG8_LDA(At, 0, 0); PG8_STAGE(PG8_SA(1, 1), a1 + hstep, voffA);
            PG8_WAIT_L(8); PG8_BAR; PG8_WAIT_L(0); PG8_MMA(0, 0, At, B0); PG8_BAR; PG8_SCHED;
            PG8_LDB(B1, 0, 1); PG8_STAGE(PG8_SB(0, 0), b2, voffB);
            PG8_BAR; PG8_WAIT_L(0); PG8_MMA(0, 1, At, B1); PG8_BAR;
            PG8_LDA(At, 0, 1); PG8_STAGE(PG8_SA(0, 0), a2, voffA);
            PG8_BAR; PG8_WAIT_L(0); PG8_MMA(1, 0, At, B0); PG8_BAR; PG8_SCHED;
            PG8_STAGE(PG8_SB(0, 1), b2 + hstep, voffB);
            PG8_WAIT_V(6); PG8_BAR; PG8_MMA(1, 1, At, B1); PG8_BAR;
            PG8_LDB(B0, 1, 0); PG8_SCHED; PG8_LDA(At, 1, 0); PG8_STAGE(PG8_SA(0, 1), a2 + hstep, voffA);
            PG8_WAIT_L(8); PG8_BAR; PG8_WAIT_L(0); PG8_MMA(0, 0, At, B0); PG8_BAR; PG8_SCHED;
            PG8_LDB(B1, 1, 1); PG8_STAGE(PG8_SB(1, 0), b3, voffB);
            PG8_BAR; PG8_WAIT_L(0); PG8_MMA(0, 1, At, B1); PG8_BAR;
            PG8_LDA(At, 1, 1); PG8_STAGE(PG8_SA(1, 0), a3, voffA);
            PG8_BAR; PG8_WAIT_L(0); PG8_MMA(1, 0, At, B0); PG8_BAR; PG8_SCHED;
            PG8_STAGE(PG8_SB(1, 1), b3 + hstep, voffB);
            PG8_WAIT_V(6); PG8_BAR; PG8_MMA(1, 1, At, B1); PG8_BAR;
            }
        }
        if constexpr (ALIGN_EPI) { if (wr == 0) PG8_BAR; }
        if constexpr (!Epi::AFTER_DRAIN) { E(acc, cur, wr, wc, fr, fq); S.done(cur); }
        if (!has_next) break;
#pragma unroll
        for (int a = 0; a < 2; ++a)
#pragma unroll
            for (int b = 0; b < 2; ++b)
#pragma unroll
                for (int m = 0; m < 4; ++m)
#pragma unroll
                    for (int n = 0; n < 2; ++n) acc[a][b][m][n] = (f32x4){0.f, 0.f, 0.f, 0.f};
        cur = nxt; cA = nA; cB = nB; ++ui;
        if constexpr (ALIGN_EPI) { if (wr == 1) PG8_BAR; }
    }
    PG8_WAIT_V(0);
    if constexpr (!ALIGN_EPI) { if (wr == 0) PG8_BAR; }
    PG8_BAR;
    if constexpr (Epi::AFTER_DRAIN) { E.fused(acc, cur, wr, wc, fr, fq, lds, wid, lane); S.done(cur); }
#undef PG8_SA
#undef PG8_SB
#undef PG8_STAGE
#undef PG8_LDA
#undef PG8_LDB
#undef PG8_MMA
#undef PG8_WAIT_V
#undef PG8_WAIT_L
#undef PG8_BAR
#undef PG8_SCHED
}
}
constexpr int SEQL = 8192, NSEQ = 3, NTOK = NSEQ * SEQL;
constexpr int DM = 4096, DRG = 2048, DHY = 2048, NIN = 10240, DFF = 11008;
constexpr int NHEAD = 16, HDIM = 128;
constexpr float EPSN = 1e-6f;
constexpr int FFT_N = 16384;

#define GAS __attribute__((address_space(1)))
#define LAS __attribute__((address_space(3)))
typedef unsigned short bf16;
typedef unsigned v4u __attribute__((ext_vector_type(4)));
typedef unsigned v2u __attribute__((ext_vector_type(2)));
typedef float f32x4 __attribute__((ext_vector_type(4)));
typedef float f32x2 __attribute__((ext_vector_type(2)));
typedef short bf16x8 __attribute__((ext_vector_type(8)));

__device__ __forceinline__ unsigned f2bf(float f) { unsigned u = __builtin_bit_cast(unsigned, f); return (u + 0x7fffu + ((u >> 16) & 1u)) >> 16; }
__device__ __forceinline__ unsigned pk2(float lo, float hi) { return f2bf(lo) | (f2bf(hi) << 16); }
__device__ __forceinline__ float bf2f(unsigned b) { return __builtin_bit_cast(float, b << 16); }
__device__ __forceinline__ float bflo(unsigned w) { return __builtin_bit_cast(float, w << 16); }
__device__ __forceinline__ float bfhi(unsigned w) { return __builtin_bit_cast(float, w & 0xffff0000u); }
__device__ __forceinline__ float wave_sum(float v) {
#pragma unroll
    for (int o = 1; o < 64; o <<= 1) v += __shfl_xor(v, o);
    return v;
}
__device__ __forceinline__ float sigmoidf_(float x) { return 1.0f / (1.0f + __expf(-x)); }
__device__ __forceinline__ float gelu_tanh(float x) { const float u = 1.5957691216057308f * (x + 0.044715f * x * x * x); return x / (1.0f + __expf(-u)); }

constexpr size_t MiB = 1u << 20;
constexpr size_t WS_CTL = 0;
constexpr size_t WS_TW = 1 * MiB;
constexpr size_t WS_H3 = 2 * MiB;
constexpr size_t WS_RGW = 4 * MiB;
constexpr size_t WS_SUMM = 6 * MiB;
constexpr size_t WS_WIN = 16 * MiB;
constexpr size_t WS_WOUT = 96 * MiB;
constexpr size_t WS_WFI = 128 * MiB;
constexpr size_t WS_WFO = 300 * MiB;
constexpr size_t WS_XN = 386 * MiB;
constexpr size_t WS_PRG = 578 * MiB;
constexpr size_t WS_PHY = 770 * MiB;
constexpr size_t WS_HYY = 1058 * MiB;
constexpr size_t WS_RGY = 1154 * MiB;
constexpr size_t WS_ZK = 1250 * MiB;
constexpr size_t WS_END = 1314 * MiB;
constexpr size_t WS_MIX = WS_PHY;
constexpr size_t WS_Y = WS_PRG;
constexpr size_t WS_F = WS_PRG;
__device__ __forceinline__ void p0_transpose_item(const float* W, int K, int N, bf16* WT, int k0, int n0, int drow0, LAS float* scr, int lane) {
#pragma unroll 8
    for (int i = 0; i < 32; ++i) { const int kk = 2 * i + (lane >> 5); scr[kk * 33 + (lane & 31)] = W[(size_t)(k0 + kk) * N + n0 + (lane & 31)]; }
    asm volatile("s_waitcnt lgkmcnt(0)" ::: "memory");
    const int c = lane & 7;
#pragma unroll
    for (int j = 0; j < 4; ++j) { const int n = (lane >> 3) + 8 * j; const LAS float* s = scr + (8 * c) * 33 + n;
        v4u o; o.x = pk2(s[0 * 33], s[1 * 33]); o.y = pk2(s[2 * 33], s[3 * 33]); o.z = pk2(s[4 * 33], s[5 * 33]); o.w = pk2(s[6 * 33], s[7 * 33]);
        *(v4u*)(WT + (size_t)(drow0 + n) * K + k0 + 8 * c) = o; }
    asm volatile("s_waitcnt lgkmcnt(0)" ::: "memory");
}
template <bool INTER> __device__ __forceinline__ int ffi_drow(int n) {
    if (!INTER) return n;
    const int up = n >= DFF ? 1 : 0, c = n - up * DFF; return (c >> 7) * 256 + up * 128 + (c & 127);
}
struct ProArgs {
    const float *xp, *xs, *g_premix;
    const float *w_in, *w_out, *w_ffi, *w_ffo;
    const float *rg_a_w, *rg_x_w;
    const float *hy_w1, *hy_b1, *hy_w2, *hy_b2, *hy_w3, *hy_b3, *hy_freq;
    unsigned char* ws;
};
__device__ __forceinline__ const float* xrow_ptr(const float* xp, const float* xs, int m) { return m < SEQL ? xp + (size_t)m * DM : xs + (size_t)(m - SEQL) * DM; }

template <bool INTER> __device__ __forceinline__ void p0_prologue(const ProArgs& a, LAS unsigned char* lds, int gw, int NGW, int wave, int lane) {
    bf16* WIN = (bf16*)(a.ws + WS_WIN); bf16* WOUT = (bf16*)(a.ws + WS_WOUT); bf16* WFI = (bf16*)(a.ws + WS_WFI); bf16* WFO = (bf16*)(a.ws + WS_WFO);
    LAS float* scr = (LAS float*)(lds + wave * 16384);
    constexpr int I_IN = (DM / 64) * (NIN / 32), I_OUT = (DM / 64) * (DM / 32), I_FI = (DM / 64) * (2 * DFF / 32), I_FO = (DFF / 64) * (DM / 32);
    constexpr int NITEMS = I_IN + I_OUT + I_FI + I_FO;
    for (int it = gw; it < NITEMS; it += NGW) {
        int r = it;
        if (r < I_IN) { const int nb = NIN / 32, kb = r / nb, n0 = (r % nb) * 32; p0_transpose_item(a.w_in, DM, NIN, WIN, kb * 64, n0, n0, scr, lane); continue; } r -= I_IN;
        if (r < I_OUT) { const int nb = DM / 32, kb = r / nb, n0 = (r % nb) * 32; p0_transpose_item(a.w_out, DM, DM, WOUT, kb * 64, n0, n0, scr, lane); continue; } r -= I_OUT;
        if (r < I_FI) { const int nb = 2 * DFF / 32, kb = r / nb, n0 = (r % nb) * 32; p0_transpose_item(a.w_ffi, DM, 2 * DFF, WFI, kb * 64, n0, ffi_drow<INTER>(n0), scr, lane); continue; } r -= I_FI;
        { const int nb = DM / 32, kb = r / nb, n0 = (r % nb) * 32; p0_transpose_item(a.w_ffo, DFF, DM, WFO, kb * 64, n0, n0, scr, lane); }
    }
    bf16* XN = (bf16*)(a.ws + WS_XN);
    for (int m = gw; m < NTOK; m += NGW) {
        const float* xr = xrow_ptr(a.xp, a.xs, m);
        f32x4 v[16]; float s = 0.f;
#pragma unroll
        for (int j = 0; j < 8; ++j) { const f32x4* p = (const f32x4*)(xr + (j * 64 + lane) * 8); v[2 * j] = p[0]; v[2 * j + 1] = p[1];
            s += (v[2 * j].x * v[2 * j].x + v[2 * j].y * v[2 * j].y) + (v[2 * j].z * v[2 * j].z + v[2 * j].w * v[2 * j].w);
            s += (v[2 * j + 1].x * v[2 * j + 1].x + v[2 * j + 1].y * v[2 * j + 1].y) + (v[2 * j + 1].z * v[2 * j + 1].z + v[2 * j + 1].w * v[2 * j + 1].w); }
        const float rs = 1.0f / sqrtf(wave_sum(s) * (1.0f / DM) + EPSN);
#pragma unroll
        for (int j = 0; j < 8; ++j) { const int c0 = (j * 64 + lane) * 8; const f32x4 g0 = *(const f32x4*)(a.g_premix + c0), g1 = *(const f32x4*)(a.g_premix + c0 + 4);
            const f32x4 a0 = v[2 * j] * rs * g0, a1 = v[2 * j + 1] * rs * g1;
            v4u o; o.x = pk2(a0.x, a0.y); o.y = pk2(a0.z, a0.w); o.z = pk2(a1.x, a1.y); o.w = pk2(a1.z, a1.w);
            *(v4u*)(XN + (size_t)m * DM + c0) = o; }
    }
    bf16* RGW = (bf16*)(a.ws + WS_RGW);
    for (int idx = gw * 64 + lane; idx < 2 * 2 * NHEAD * HDIM * HDIM; idx += NGW * 64) {
        const int i = idx & 127, j = (idx >> 7) & 127, h = (idx >> 14) & 15, gate = (idx >> 18) & 1, dir = idx >> 19;
        const float* W = gate ? a.rg_x_w : a.rg_a_w;
        RGW[idx] = (bf16)f2bf(W[(((size_t)dir * NHEAD + h) * HDIM + i) * HDIM + j]);
    }
    f32x2* TW = (f32x2*)(a.ws + WS_TW);
    for (int k = gw * 64 + lane; k < FFT_N; k += NGW * 64) { float sn, cs; sincospif((float)k * (1.0f / 8192.0f), &sn, &cs); TW[k] = (f32x2){cs, -sn}; }
    float* H3 = (float*)(a.ws + WS_H3);
    const float fr = a.hy_freq[lane], b1 = a.hy_b1[lane], b2 = a.hy_b2[lane], b3 = a.hy_b3[lane];
    for (int n = gw; n < SEQL; n += NGW) {
        float zv = 0.f;
        if (lane == 0) zv = (float)n * (1.0f / (float)(SEQL - 1));
        else if (lane < 33) { const int k = (lane - 1) & 15; const float band = 1e-4f + (float)k * ((15.0f - 1e-4f) / 15.0f);
            const float ang = (6.283185307179586f / (float)SEQL) * (float)n * band; zv = lane < 17 ? cosf(ang) : -sinf(ang); }
        float acc = b1;
        for (int e = 0; e < 33; ++e) acc += __shfl(zv, e) * a.hy_w1[e * 64 + lane];
        float h = sinf(fr * acc);
        acc = b2;
        for (int e = 0; e < 64; ++e) acc += __shfl(h, e) * a.hy_w2[e * 64 + lane];
        h = sinf(fr * acc);
        acc = b3;
        for (int e = 0; e < 64; ++e) acc += __shfl(h, e) * a.hy_w3[e * 64 + lane];
        h = sinf(fr * acc);
        H3[n * 64 + lane] = h;
    }
}
constexpr int FFT_LDS_BYTES = (FFT_N + FFT_N / 32) * 8;
constexpr int HY_W4_OFF = FFT_LDS_BYTES;
constexpr int HY_PRM_OFF = FFT_LDS_BYTES + 1024;
constexpr int HY_LDS_BYTES = FFT_LDS_BYTES + 1024 + 256;
__device__ __forceinline__ int PH(int i) { return i + (i >> 5); }
__device__ __forceinline__ f32x2 cmul(f32x2 a, f32x2 b) { return (f32x2){a.x * b.x - a.y * b.y, a.x * b.y + a.y * b.x}; }
__device__ __forceinline__ constexpr int bitrev_c(int r, int bits) { int o = 0; for (int i = 0; i < bits; ++i) o |= ((r >> i) & 1) << (bits - 1 - i); return o; }

__device__ __forceinline__ f32x2 mul_w32(f32x2 d, int idx) {
    constexpr float C[16] = {1.0f, 0.98078528040323043f, 0.92387953251128674f, 0.83146961230254524f, 0.70710678118654752f, 0.55557023301960218f, 0.38268343236508977f, 0.19509032201612825f,
                             0.0f, -0.19509032201612825f, -0.38268343236508977f, -0.55557023301960218f, -0.70710678118654752f, -0.83146961230254524f, -0.92387953251128674f, -0.98078528040323043f};
    constexpr float S[16] = {0.0f, 0.19509032201612825f, 0.38268343236508977f, 0.55557023301960218f, 0.70710678118654752f, 0.83146961230254524f, 0.92387953251128674f, 0.98078528040323043f,
                             1.0f, 0.98078528040323043f, 0.92387953251128674f, 0.83146961230254524f, 0.70710678118654752f, 0.55557023301960218f, 0.38268343236508977f, 0.19509032201612825f};
    if (idx == 0) return d;
    if (idx == 8) return (f32x2){d.y, -d.x};
    const float c = C[idx], s = S[idx];
    return (f32x2){d.x * c + d.y * s, d.y * c - d.x * s};
}
template <int R> __device__ __forceinline__ void dft_inreg(f32x2 (&a)[R]) {
    constexpr int LOGR = (R == 32) ? 5 : 4;
#pragma unroll
    for (int t = 0; t < LOGR; ++t) {
        const int half = R >> (t + 1);
#pragma unroll
        for (int g = 0; g < R; g += 2 * half)
#pragma unroll
            for (int i = 0; i < half; ++i) {
                const f32x2 u = a[g + i], v = a[g + i + half];
                a[g + i] = u + v;
                a[g + i + half] = mul_w32(u - v, i * (16 / half));
            }
    }
}
template <int R, int S, bool TW> __device__ __forceinline__ void fft_pass(LAS f32x2* lds, const f32x2* tw, int tid) {
    constexpr int NB = FFT_N / R, PER = NB / 512, LOGR = (R == 32) ? 5 : 4;
    constexpr int RSTEP = NB + NB / 32;
    constexpr int WSTEP = (S == 1) ? 1 : (S + S / 32);
    f32x2 a[PER][R];
#pragma unroll
    for (int b = 0; b < PER; ++b) { const LAS f32x2* rp = lds + PH(tid + 512 * b);
#pragma unroll
        for (int k = 0; k < R; ++k) a[b][k] = rp[k * RSTEP]; }
    __syncthreads();
#pragma unroll
    for (int b = 0; b < PER; ++b) {
        const int beta = tid + 512 * b, q = beta & (S - 1), p = beta / S, base = q + R * S * p;
        dft_inreg<R>(a[b]);
        f32x2 w1 = (f32x2){1.f, 0.f}, wj = (f32x2){1.f, 0.f};
        if (TW) { w1 = tw[p * S]; wj = w1; }
        LAS f32x2* wp = lds + PH(base);
        wp[0] = a[b][0];
#pragma unroll
        for (int j = 1; j < R; ++j) {
            f32x2 v = a[b][bitrev_c(j, LOGR)];
            if (TW) { v = cmul(v, wj); wj = cmul(wj, w1); }
            wp[j * WSTEP] = v;
        }
    }
    __syncthreads();
}
__device__ __forceinline__ void fft16k(LAS f32x2* lds, const f32x2* tw, int tid) {
    asm volatile("" : "+v"(tid));
    fft_pass<32, 1, true>(lds, tw, tid);
    fft_pass<32, 32, true>(lds, tw, tid);
    fft_pass<16, 1024, false>(lds, tw, tid);
}
__device__ __forceinline__ void spec_pair(LAS f32x2* lds, const f32x2* ZK, int p) {
    const int f = p, f2 = (FFT_N - p) & (FFT_N - 1);
    const f32x2 A = ZK[f], A2 = ZK[f2], Z = lds[PH(f)], Z2 = lds[PH(f2)];
    const float kcx = 0.5f * (A.x + A2.x), kcy = 0.5f * (A.y - A2.y);
    const float dx = 0.5f * (A.x - A2.x), dy = 0.5f * (A.y + A2.y);
    const float k1x = dy, k1y = -dx;
    const float px = 0.5f * (kcx + k1x), py = 0.5f * (kcy + k1y), qx = 0.5f * (kcx - k1x), qy = 0.5f * (kcy - k1y);
    const float wx = Z.x * px - Z.y * py + (Z2.x * qx + Z2.y * qy);
    const float wy = Z.x * py + Z.y * px + (Z2.x * qy - Z2.y * qx);
    const float w2x = Z2.x * px + Z2.y * py + (Z.x * qx - Z.y * qy);
    const float w2y = Z2.y * px - Z2.x * py - (Z.x * qy + Z.y * qx);
    lds[PH(f)] = (f32x2){wx, -wy}; lds[PH(f2)] = (f32x2){w2x, -w2y};
}
__device__ __forceinline__ void spec_mul(LAS f32x2* lds, const f32x2* ZK, int tid) {
    asm volatile("" : "+v"(tid));
#pragma unroll 4
    for (int i = 0; i < 16; ++i) spec_pair(lds, ZK, tid + 512 * i);
    if (tid == 0) spec_pair(lds, ZK, 8192);
    __syncthreads();
}
struct HyArgs {
    const bf16* phy;
    const float *conv_w, *conv_b;
    const float* w4;
    const float* hy_bias;
    const float* h3;
    const f32x2* tw;
    f32x2* zk;
    bf16* hyy;
};
__device__ __forceinline__ void load_conv3_16(const bf16* row, int t0, float w0, float w1, float w2, float bias, float (&out)[16]) {
    const v4u r0 = *(const v4u*)(row + t0), r1 = *(const v4u*)(row + t0 + 8);
    float u[18];
    u[0] = t0 > 0 ? bf2f(row[t0 - 1]) : 0.f;
    u[17] = (t0 + 16 < SEQL) ? bf2f(row[t0 + 16]) : 0.f;
    u[1] = bflo(r0.x); u[2] = bfhi(r0.x); u[3] = bflo(r0.y); u[4] = bfhi(r0.y); u[5] = bflo(r0.z); u[6] = bfhi(r0.z); u[7] = bflo(r0.w); u[8] = bfhi(r0.w);
    u[9] = bflo(r1.x); u[10] = bfhi(r1.x); u[11] = bflo(r1.y); u[12] = bfhi(r1.y); u[13] = bflo(r1.z); u[14] = bfhi(r1.z); u[15] = bflo(r1.w); u[16] = bfhi(r1.w);
#pragma unroll
    for (int e = 0; e < 16; ++e) out[e] = bias + w0 * u[e] + w1 * u[e + 1] + w2 * u[e + 2];
}
__device__ __forceinline__ void store16_bf16(bf16* dst, const float (&v)[16]) {
    v4u o0, o1; o0.x = pk2(v[0], v[1]); o0.y = pk2(v[2], v[3]); o0.z = pk2(v[4], v[5]); o0.w = pk2(v[6], v[7]);
    o1.x = pk2(v[8], v[9]); o1.y = pk2(v[10], v[11]); o1.z = pk2(v[12], v[13]); o1.w = pk2(v[14], v[15]);
    *(v4u*)dst = o0; *(v4u*)(dst + 8) = o1;
}
__device__ __forceinline__ void hyena_unit(const HyArgs& a, LAS unsigned char* ldsb_, int cp, int wgslot, int tid) {
    unsigned lzero; asm volatile("v_mov_b32 %0, 0" : "=v"(lzero));
    LAS unsigned char* ldsb = ldsb_ + lzero;
    LAS f32x2* lds = (LAS f32x2*)ldsb;
    LAS f32x4* w4s = (LAS f32x4*)(ldsb + HY_W4_OFF);
    const int c0 = 2 * cp, c1 = c0 + 1;
    f32x2* zk = a.zk + (size_t)wgslot * 2 * FFT_N;
    constexpr float MIN_DECAY = -3.0701134573253945f, MAX_DECAY = -15.350567286626973f;
    const float ad0 = fabsf(MIN_DECAY + (float)c0 * ((MAX_DECAY - MIN_DECAY) / (float)(DHY - 1)));
    const float ad1 = fabsf(MIN_DECAY + (float)c1 * ((MAX_DECAY - MIN_DECAY) / (float)(DHY - 1)));
    LAS float* prm = (LAS float*)(ldsb + HY_PRM_OFF);
    __syncthreads();
    if (tid < 24) { const int k = tid & 3, sc = tid >> 2, st = sc >> 1, chn = st * DHY + c0 + (sc & 1); prm[tid] = k < 3 ? a.conv_w[k * 6144 + chn] : a.conv_b[chn]; }
    if (tid >= 32 && tid < 36) { const int j = tid - 32; prm[tid] = a.hy_bias[(j >> 1) * DHY + c0 + (j & 1)]; }
#pragma unroll 1
    for (int o = 0; o < 2; ++o) {
        int tq = tid; asm volatile("" : "+v"(tq)); const int t0 = 16 * tq;
        __syncthreads();
        if (tq < 64) w4s[tq] = (f32x4){a.w4[(size_t)tq * 8192 + o * 4096 + c0], a.w4[(size_t)tq * 8192 + o * 4096 + c1],
                                         a.w4[(size_t)tq * 8192 + o * 4096 + 2048 + c0], a.w4[(size_t)tq * 8192 + o * 4096 + 2048 + c1]};
        __syncthreads();
        {
            f32x4 acc[16];
#pragma unroll
            for (int e = 0; e < 16; ++e) acc[e] = (f32x4){0.f, 0.f, 0.f, 0.f};
            const f32x4* hr = (const f32x4*)(a.h3 + (size_t)t0 * 64);
#pragma unroll 1
            for (int j4 = 0; j4 < 16; ++j4) {
                const f32x4 wA = w4s[4 * j4 + 0], wB = w4s[4 * j4 + 1], wC = w4s[4 * j4 + 2], wD = w4s[4 * j4 + 3];
#pragma unroll
                for (int e = 0; e < 16; ++e) { const f32x4 hv = hr[e * 16 + j4]; acc[e] += hv.x * wA; acc[e] += hv.y * wB; acc[e] += hv.z * wC; acc[e] += hv.w * wD; }
            }
#pragma unroll
            for (int e = 0; e < 16; ++e) {
                const int n = t0 + e;
                const float tn = (float)n * (1.0f / (float)(SEQL - 1));
                const float d0 = __expf(-tn * ad0), d1 = __expf(-tn * ad1);
                lds[PH(n)] = (f32x2){acc[e].x * d0, acc[e].y * d1};
                if (n >= 1) lds[PH(FFT_N - n)] = (f32x2){acc[e].z * d0, acc[e].w * d1};
                else lds[PH(SEQL)] = (f32x2){0.f, 0.f};
            }
        }
        __syncthreads();
        fft16k(lds, a.tw, tid);
#pragma unroll 4
        for (int i = 0; i < 32; ++i) zk[(size_t)o * FFT_N + tq + 512 * i] = lds[PH(tq + 512 * i)];
    }
    const float inv_n = 1.0f / (float)FFT_N;
    asm volatile("s_waitcnt vmcnt(0)" ::: "memory");
    __syncthreads();
#pragma unroll 1
    for (int s = 0; s < NSEQ; ++s) {
        const size_t m0 = (size_t)s * SEQL;
        int tq = tid; asm volatile("" : "+v"(tq)); const int t0 = 16 * tq;
        {
            float v0[16], v1[16];
            load_conv3_16(a.phy + (size_t)(0 * DHY + c0) * NTOK + m0, t0, prm[0], prm[1], prm[2], prm[3], v0);
            load_conv3_16(a.phy + (size_t)(0 * DHY + c1) * NTOK + m0, t0, prm[4], prm[5], prm[6], prm[7], v1);
            __syncthreads();
#pragma unroll
            for (int e = 0; e < 16; ++e) { lds[PH(t0 + e)] = (f32x2){v0[e], v1[e]}; lds[PH(SEQL + t0 + e)] = (f32x2){0.f, 0.f}; }
        }
        __syncthreads();
        fft16k(lds, a.tw, tid);
        spec_mul(lds, zk, tid);
        fft16k(lds, a.tw, tid);
        float z0[16], z1[16];
        {
            float x0[16], x1[16];
            load_conv3_16(a.phy + (size_t)(0 * DHY + c0) * NTOK + m0, t0, prm[0], prm[1], prm[2], prm[3], x0);
            load_conv3_16(a.phy + (size_t)(0 * DHY + c1) * NTOK + m0, t0, prm[4], prm[5], prm[6], prm[7], x1);
#pragma unroll
            for (int e = 0; e < 16; ++e) { const f32x2 r = lds[PH(t0 + e)]; z0[e] = r.x * inv_n + prm[32] * x0[e]; z1[e] = -r.y * inv_n + prm[33] * x1[e]; }
            load_conv3_16(a.phy + (size_t)(1 * DHY + c0) * NTOK + m0, t0, prm[8], prm[9], prm[10], prm[11], x0);
            load_conv3_16(a.phy + (size_t)(1 * DHY + c1) * NTOK + m0, t0, prm[12], prm[13], prm[14], prm[15], x1);
#pragma unroll
            for (int e = 0; e < 16; ++e) { z0[e] *= x0[e]; z1[e] *= x1[e]; }
        }
#pragma unroll
        for (int e = 0; e < 16; ++e) { lds[PH(t0 + e)] = (f32x2){z0[e], z1[e]}; lds[PH(SEQL + t0 + e)] = (f32x2){0.f, 0.f}; }
        __syncthreads();
        fft16k(lds, a.tw, tid);
        spec_mul(lds, zk + FFT_N, tid);
        fft16k(lds, a.tw, tid);
        {
            float x0[16], x1[16];
            load_conv3_16(a.phy + (size_t)(2 * DHY + c0) * NTOK + m0, t0, prm[16], prm[17], prm[18], prm[19], x0);
            load_conv3_16(a.phy + (size_t)(2 * DHY + c1) * NTOK + m0, t0, prm[20], prm[21], prm[22], prm[23], x1);
#pragma unroll
            for (int e = 0; e < 16; ++e) { const f32x2 r = lds[PH(t0 + e)];
                x0[e] = x0[e] * (r.x * inv_n + prm[34] * z0[e]); x1[e] = x1[e] * (-r.y * inv_n + prm[35] * z1[e]); }
            store16_bf16(a.hyy + (size_t)c0 * NTOK + m0 + t0, x0);
            store16_bf16(a.hyy + (size_t)c1 * NTOK + m0 + t0, x1);
        }
    }
}
constexpr int RG_T = 128, RG_NT = SEQL / RG_T;
constexpr int RG_XC_STRIDE = 272;
constexpr int RG_HF_OFF = RG_T * RG_XC_STRIDE;
constexpr int RG_LDS_BYTES = RG_HF_OFF + (RG_T / 4) * 512 * 4;
constexpr int RG_UNITS = NSEQ * RG_NT * NHEAD;
struct RgArgs {
    const bf16* prg;
    const float *conv_w, *conv_b;
    const bf16* rgw;
    const float *a_b, *x_b;
    const float* lam;
    f32x2* summ;
    bf16* rgy;
};
template <int PASS> __device__ __forceinline__ void rg_unit(const RgArgs& a, LAS unsigned char* lds, int unit, int tid) {
    const int wave = tid >> 6, lane = tid & 63, fr = lane & 15, fq = lane >> 4;
    const int h = unit % NHEAD, tt = (unit / NHEAD) % RG_NT, s = unit / (NHEAD * RG_NT);
    const int tok0 = tt * RG_T;
    const size_t mrow0 = (size_t)s * SEQL;
    __syncthreads();
    {
        const int cg = h * HDIM + 2 * lane;
        float w0[4], w1[4];
#pragma unroll
        for (int k = 0; k < 4; ++k) { w0[k] = a.conv_w[k * DRG + cg]; w1[k] = a.conv_w[k * DRG + cg + 1]; }
        const float cb0 = a.conv_b[cg], cb1 = a.conv_b[cg + 1];
        float x0[4], x1[4];
        const int tb = tok0 + 16 * wave;
#pragma unroll
        for (int k = 0; k < 3; ++k) { const int t = tb - 2 + k; unsigned u = 0u; if (t >= 0 && t < SEQL) u = *(const unsigned*)(a.prg + (mrow0 + t) * DM + cg); x0[k] = bflo(u); x1[k] = bfhi(u); }
#pragma unroll
        for (int i = 0; i < 16; ++i) {
            const int t = tb + i + 1; unsigned u = 0u; if (t < SEQL) u = *(const unsigned*)(a.prg + (mrow0 + t) * DM + cg);
            x0[3] = bflo(u); x1[3] = bfhi(u);
            const float y0 = cb0 + w0[0] * x0[0] + w0[1] * x0[1] + w0[2] * x0[2] + w0[3] * x0[3];
            const float y1 = cb1 + w1[0] * x1[0] + w1[1] * x1[1] + w1[2] * x1[2] + w1[3] * x1[3];
            *(LAS unsigned*)(lds + (16 * wave + i) * RG_XC_STRIDE + lane * 4) = pk2(y0, y1);
            x0[0] = x0[1]; x0[1] = x0[2]; x0[2] = x0[3]; x1[0] = x1[1]; x1[1] = x1[2]; x1[2] = x1[3];
        }
    }
    __syncthreads();
    const int ch = h * HDIM + 16 * wave + fr;
    LAS float* hfl = (LAS float*)(lds + RG_HF_OFF) + tid;
#pragma unroll
    for (int dir = 0; dir < 2; ++dir) {
        bf16x8 Br[4], Bi[4];
#pragma unroll
        for (int kk = 0; kk < 4; ++kk) {
            Br[kk] = *(const bf16x8*)(a.rgw + ((((size_t)dir * 2 + 0) * NHEAD + h) * HDIM + 16 * wave + fr) * HDIM + 32 * kk + 8 * fq);
            Bi[kk] = *(const bf16x8*)(a.rgw + ((((size_t)dir * 2 + 1) * NHEAD + h) * HDIM + 16 * wave + fr) * HDIM + 32 * kk + 8 * fq);
        }
        const float ba = a.a_b[dir * DRG + ch], bx = a.x_b[dir * DRG + ch];
        const float sp = log1pf(expf(-a.lam[dir * DRG + ch]));
        float carry = 0.f, ptot = 1.f;
        if (PASS == 2) {
            const f32x2* sm = a.summ + ((size_t)dir * NSEQ + s) * RG_NT * DRG + ch;
            if (dir == 0) { for (int j = 0; j < tt; ++j) { const f32x2 pb = sm[(size_t)j * DRG]; carry = pb.x * carry + pb.y; } }
            else { for (int j = RG_NT - 1; j > tt; --j) { const f32x2 pb = sm[(size_t)j * DRG]; carry = pb.x * carry + pb.y; } }
        }
        for (int bi = 0; bi < RG_T / 16; ++bi) {
            const int blk = dir == 0 ? bi : (RG_T / 16 - 1 - bi);
            f32x4 accR = (f32x4){0.f, 0.f, 0.f, 0.f}, accI = (f32x4){0.f, 0.f, 0.f, 0.f};
#pragma unroll
            for (int kk = 0; kk < 4; ++kk) {
                const bf16x8 af = *(const LAS bf16x8*)(lds + (16 * blk + fr) * RG_XC_STRIDE + (32 * kk + 8 * fq) * 2);
                accR = __builtin_amdgcn_mfma_f32_16x16x32_bf16(af, Br[kk], accR, 0, 0, 0);
                accI = __builtin_amdgcn_mfma_f32_16x16x32_bf16(af, Bi[kk], accI, 0, 0, 0);
            }
            float av[4], bv[4];
#pragma unroll
            for (int e = 0; e < 4; ++e) {
                const float r = sigmoidf_(accR[e] + ba), ig = sigmoidf_(accI[e] + bx);
                const float log_a = -8.0f * r * sp;
                av[e] = __expf(log_a);
                const float mult = sqrtf(fmaxf(-expm1f(2.0f * log_a), 0.f));
                const float xcv = bf2f(*(const LAS unsigned short*)(lds + (16 * blk + 4 * fq + e) * RG_XC_STRIDE + (16 * wave + fr) * 2));
                bv[e] = mult * ig * xcv;
            }
            float A = 1.f, B = 0.f;
            if (dir == 0) {
#pragma unroll
                for (int e = 0; e < 4; ++e) { B = av[e] * B + bv[e]; A *= av[e]; }
            } else {
#pragma unroll
                for (int e = 3; e >= 0; --e) { B = av[e] * B + bv[e]; A *= av[e]; }
            }
            float hin;
            if (dir == 0) {
                float Ap = __shfl_up(A, 16), Bp = __shfl_up(B, 16);
                if (fq >= 1) { B = A * Bp + B; A = Ap * A; }
                Ap = __shfl_up(A, 32); Bp = __shfl_up(B, 32);
                if (fq >= 2) { B = A * Bp + B; A = Ap * A; }
                const float hend = A * carry + B;
                const float hprev = __shfl_up(hend, 16);
                hin = fq == 0 ? carry : hprev;
                carry = __shfl(hend, 48 + fr);
                if (PASS == 1) ptot *= __shfl(A, 48 + fr);
            } else {
                float Ap = __shfl_down(A, 16), Bp = __shfl_down(B, 16);
                if (fq <= 2) { B = A * Bp + B; A = Ap * A; }
                Ap = __shfl_down(A, 32); Bp = __shfl_down(B, 32);
                if (fq <= 1) { B = A * Bp + B; A = Ap * A; }
                const float hend = A * carry + B;
                const float hprev = __shfl_down(hend, 16);
                hin = fq == 3 ? carry : hprev;
                carry = __shfl(hend, fr);
                if (PASS == 1) ptot *= __shfl(A, fr);
            }
            if (PASS == 2) {
                if (dir == 0) {
                    float hh = hin;
#pragma unroll
                    for (int e = 0; e < 4; ++e) { hh = av[e] * hh + bv[e]; hfl[(blk * 4 + e) * 512] = hh; }
                } else {
                    float hh = hin, hb[4];
#pragma unroll
                    for (int e = 3; e >= 0; --e) { hh = av[e] * hh + bv[e]; hb[e] = hh; }
#pragma unroll
                    for (int e = 0; e < 4; ++e) {
                        const size_t m = mrow0 + tok0 + 16 * blk + 4 * fq + e;
                        const float g = bf2f(a.prg[m * DM + DRG + ch]);
                        a.rgy[m * DRG + ch] = (bf16)f2bf((hfl[(blk * 4 + e) * 512] + hb[e]) * gelu_tanh(g));
                    }
                }
            }
        }
        if (PASS == 1 && fq == 0) a.summ[(((size_t)dir * NSEQ + s) * RG_NT + tt) * DRG + ch] = (f32x2){ptot, carry};
    }
}
__device__ __forceinline__ void mixnorm_rg_row(const bf16* rgy, const float* g_rg, bf16* mix, int m, int lane) {
    v4u r[4]; float s = 0.f;
#pragma unroll
    for (int j = 0; j < 4; ++j) { r[j] = *(const v4u*)(rgy + (size_t)m * DRG + (j * 64 + lane) * 8);
        const float a0 = bflo(r[j].x), a1 = bfhi(r[j].x), a2 = bflo(r[j].y), a3 = bfhi(r[j].y), a4 = bflo(r[j].z), a5 = bfhi(r[j].z), a6 = bflo(r[j].w), a7 = bfhi(r[j].w);
        s += (a0 * a0 + a1 * a1) + (a2 * a2 + a3 * a3) + (a4 * a4 + a5 * a5) + (a6 * a6 + a7 * a7); }
    const float rs = 1.0f / sqrtf(wave_sum(s) * (1.0f / DRG) + EPSN);
#pragma unroll
    for (int j = 0; j < 4; ++j) { const int c0 = (j * 64 + lane) * 8; const f32x4 g0 = *(const f32x4*)(g_rg + c0), g1 = *(const f32x4*)(g_rg + c0 + 4);
        v4u o; o.x = pk2(bflo(r[j].x) * rs * g0.x, bfhi(r[j].x) * rs * g0.y); o.y = pk2(bflo(r[j].y) * rs * g0.z, bfhi(r[j].y) * rs * g0.w);
        o.z = pk2(bflo(r[j].z) * rs * g1.x, bfhi(r[j].z) * rs * g1.y); o.w = pk2(bflo(r[j].w) * rs * g1.z, bfhi(r[j].w) * rs * g1.w);
        *(v4u*)(mix + (size_t)m * DM + c0) = o; }
}
constexpr int MN_TILE_STRIDE = 66;
constexpr int MN_LDS_BYTES = 8 * 64 * MN_TILE_STRIDE * 2 + 8 * 64 * 4 + 64 * 4;
__device__ __forceinline__ void mixnorm_hy_tile(const bf16* hyy, const float* g_hy, bf16* mix, LAS unsigned char* lds, int tile, int tid) {
    const int wave = tid >> 6, lane = tid & 63, m0 = tile * 64;
    LAS unsigned short* tl = (LAS unsigned short*)(lds + wave * 64 * MN_TILE_STRIDE * 2);
    LAS float* part = (LAS float*)(lds + 8 * 64 * MN_TILE_STRIDE * 2);
    LAS float* scl = part + 8 * 64;
    __syncthreads();
    float s = 0.f;
    for (int c = wave * 256; c < wave * 256 + 256; ++c) { const float v = bf2f(hyy[(size_t)c * NTOK + m0 + lane]); s += v * v; }
    part[wave * 64 + lane] = s;
    __syncthreads();
    if (tid < 64) { float t = 0.f;
#pragma unroll
        for (int w = 0; w < 8; ++w) t += part[w * 64 + tid];
        scl[tid] = 1.0f / sqrtf(t * (1.0f / DHY) + EPSN); }
    __syncthreads();
    for (int cb = wave; cb < DHY / 64; cb += 8) {
        for (int ci = 0; ci < 64; ++ci) tl[ci * MN_TILE_STRIDE + lane] = hyy[(size_t)(cb * 64 + ci) * NTOK + m0 + lane];
        asm volatile("s_waitcnt lgkmcnt(0)" ::: "memory");
        const float g = g_hy[cb * 64 + lane];
        for (int tk = 0; tk < 64; ++tk) mix[(size_t)(m0 + tk) * DM + DRG + cb * 64 + lane] = (bf16)f2bf(bf2f(tl[lane * MN_TILE_STRIDE + tk]) * scl[tk] * g);
        asm volatile("s_waitcnt lgkmcnt(0)" ::: "memory");
    }
}
__device__ __forceinline__ void rowpass1(const float* xr, const bf16* yr, const float* g_post, const float* g_pre, float* outr, bf16* xnr, int lane) {
    float v[64]; float s = 0.f;
#pragma unroll
    for (int j = 0; j < 8; ++j) { const v4u r = *(const v4u*)(yr + (j * 64 + lane) * 8);
        v[8 * j + 0] = bflo(r.x); v[8 * j + 1] = bfhi(r.x); v[8 * j + 2] = bflo(r.y); v[8 * j + 3] = bfhi(r.y); v[8 * j + 4] = bflo(r.z); v[8 * j + 5] = bfhi(r.z); v[8 * j + 6] = bflo(r.w); v[8 * j + 7] = bfhi(r.w);
#pragma unroll
        for (int e = 0; e < 8; ++e) s += v[8 * j + e] * v[8 * j + e]; }
    const float rs = 1.0f / sqrtf(wave_sum(s) * (1.0f / DM) + EPSN);
    float s2 = 0.f;
#pragma unroll
    for (int j = 0; j < 8; ++j) { const int c0 = (j * 64 + lane) * 8;
        const f32x4 x0 = *(const f32x4*)(xr + c0), x1 = *(const f32x4*)(xr + c0 + 4), g0 = *(const f32x4*)(g_post + c0), g1 = *(const f32x4*)(g_post + c0 + 4);
        f32x4 o0, o1;
        o0.x = x0.x + v[8 * j + 0] * rs * g0.x; o0.y = x0.y + v[8 * j + 1] * rs * g0.y; o0.z = x0.z + v[8 * j + 2] * rs * g0.z; o0.w = x0.w + v[8 * j + 3] * rs * g0.w;
        o1.x = x1.x + v[8 * j + 4] * rs * g1.x; o1.y = x1.y + v[8 * j + 5] * rs * g1.y; o1.z = x1.z + v[8 * j + 6] * rs * g1.z; o1.w = x1.w + v[8 * j + 7] * rs * g1.w;
        *(f32x4*)(outr + c0) = o0; *(f32x4*)(outr + c0 + 4) = o1;
        v[8 * j + 0] = o0.x; v[8 * j + 1] = o0.y; v[8 * j + 2] = o0.z; v[8 * j + 3] = o0.w; v[8 * j + 4] = o1.x; v[8 * j + 5] = o1.y; v[8 * j + 6] = o1.z; v[8 * j + 7] = o1.w;
        s2 += (o0.x * o0.x + o0.y * o0.y) + (o0.z * o0.z + o0.w * o0.w) + (o1.x * o1.x + o1.y * o1.y) + (o1.z * o1.z + o1.w * o1.w); }
    const float rs2 = 1.0f / sqrtf(wave_sum(s2) * (1.0f / DM) + EPSN);
#pragma unroll
    for (int j = 0; j < 8; ++j) { const int c0 = (j * 64 + lane) * 8; const f32x4 g0 = *(const f32x4*)(g_pre + c0), g1 = *(const f32x4*)(g_pre + c0 + 4);
        v4u o; o.x = pk2(v[8 * j + 0] * rs2 * g0.x, v[8 * j + 1] * rs2 * g0.y); o.y = pk2(v[8 * j + 2] * rs2 * g0.z, v[8 * j + 3] * rs2 * g0.w);
        o.z = pk2(v[8 * j + 4] * rs2 * g1.x, v[8 * j + 5] * rs2 * g1.y); o.w = pk2(v[8 * j + 6] * rs2 * g1.z, v[8 * j + 7] * rs2 * g1.w);
        *(v4u*)(xnr + c0) = o; }
}
__device__ __forceinline__ void rowpass2(const bf16* fr_, const float* g, float* outr, int lane) {
    float v[64]; float s = 0.f;
#pragma unroll
    for (int j = 0; j < 8; ++j) { const v4u r = *(const v4u*)(fr_ + (j * 64 + lane) * 8);
        v[8 * j + 0] = bflo(r.x); v[8 * j + 1] = bfhi(r.x); v[8 * j + 2] = bflo(r.y); v[8 * j + 3] = bfhi(r.y); v[8 * j + 4] = bflo(r.z); v[8 * j + 5] = bfhi(r.z); v[8 * j + 6] = bflo(r.w); v[8 * j + 7] = bfhi(r.w);
#pragma unroll
        for (int e = 0; e < 8; ++e) s += v[8 * j + e] * v[8 * j + e]; }
    const float rs = 1.0f / sqrtf(wave_sum(s) * (1.0f / DM) + EPSN);
#pragma unroll
    for (int j = 0; j < 8; ++j) { const int c0 = (j * 64 + lane) * 8;
        const f32x4 x0 = *(const f32x4*)(outr + c0), x1 = *(const f32x4*)(outr + c0 + 4), g0 = *(const f32x4*)(g + c0), g1 = *(const f32x4*)(g + c0 + 4);
        f32x4 o0, o1;
        o0.x = x0.x + v[8 * j + 0] * rs * g0.x; o0.y = x0.y + v[8 * j + 1] * rs * g0.y; o0.z = x0.z + v[8 * j + 2] * rs * g0.z; o0.w = x0.w + v[8 * j + 3] * rs * g0.w;
        o1.x = x1.x + v[8 * j + 4] * rs * g1.x; o1.y = x1.y + v[8 * j + 5] * rs * g1.y; o1.z = x1.z + v[8 * j + 6] * rs * g1.z; o1.w = x1.w + v[8 * j + 7] * rs * g1.w;
        *(f32x4*)(outr + c0) = o0; *(f32x4*)(outr + c0 + 4) = o1; }
}
constexpr int GEMM_LDS = pg8::STAGE_BYTES;
template <class Epi> __global__ void __launch_bounds__(512, 2) k_gemm(pg8::Gemm g, Epi E) {
    extern __shared__ __attribute__((aligned(16))) unsigned char lds[];
    pg8::StaticOrder S; S.init(g.M, g.N, (int)gridDim.x, (int)blockIdx.x);
    pg8::gemm_phase<Epi, pg8::StaticOrder, true, true>((PG8_LAS unsigned char*)lds, g, S, E);
}
__global__ void __launch_bounds__(512, 2) k_prologue(ProArgs a) {
    extern __shared__ __attribute__((aligned(16))) unsigned char lds[];
    const int tid = threadIdx.x, wave = __builtin_amdgcn_readfirstlane(tid >> 6), lane = tid & 63;
    p0_prologue<false>(a, (LAS unsigned char*)lds, blockIdx.x * 8 + wave, gridDim.x * 8, wave, lane);
}
__global__ void __launch_bounds__(512, 2) k_hyena(HyArgs a) {
    extern __shared__ __attribute__((aligned(16))) unsigned char lds[];
    for (int cp = blockIdx.x; cp < DHY / 2; cp += gridDim.x) hyena_unit(a, (LAS unsigned char*)lds, cp, blockIdx.x, threadIdx.x);
}
template <int PASS> __global__ void __launch_bounds__(512, 2) k_rg(RgArgs a) {
    extern __shared__ __attribute__((aligned(16))) unsigned char lds[];
    for (int u = blockIdx.x; u < RG_UNITS; u += gridDim.x) rg_unit<PASS>(a, (LAS unsigned char*)lds, u, threadIdx.x);
}
__global__ void __launch_bounds__(512, 2) k_mixnorm(const bf16* rgy, const bf16* hyy, const float* g_rg, const float* g_hy, bf16* mix) {
    extern __shared__ __attribute__((aligned(16))) unsigned char lds[];
    const int tid = threadIdx.x, wave = tid >> 6, lane = tid & 63;
    for (int m = blockIdx.x * 8 + wave; m < NTOK; m += gridDim.x * 8) mixnorm_rg_row(rgy, g_rg, mix, m, lane);
    for (int t = blockIdx.x; t < NTOK / 64; t += gridDim.x) mixnorm_hy_tile(hyy, g_hy, mix, (LAS unsigned char*)lds, t, tid);
}
__global__ void __launch_bounds__(512, 2) k_rowpass1(const float* xp, const float* xs, const bf16* y, const float* g_post, const float* g_pre, float* out, bf16* xn) {
    const int tid = threadIdx.x, wave = tid >> 6, lane = tid & 63;
    for (int m = blockIdx.x * 8 + wave; m < NTOK; m += gridDim.x * 8) rowpass1(xrow_ptr(xp, xs, m), y + (size_t)m * DM, g_post, g_pre, out + (size_t)m * DM, xn + (size_t)m * DM, lane);
}
__global__ void __launch_bounds__(512, 2) k_rowpass2(const bf16* f, const float* g, float* out) {
    const int tid = threadIdx.x, wave = tid >> 6, lane = tid & 63;
    for (int m = blockIdx.x * 8 + wave; m < NTOK; m += gridDim.x * 8) rowpass2(f + (size_t)m * DM, g, out + (size_t)m * DM, lane);
}
__global__ void __launch_bounds__(512, 2) k_gate_seq(const bf16* gu, const float* cw, const float* cb, bf16* h) {
    constexpr int CG = DFF / 8;
    for (int idx = blockIdx.x * 512 + threadIdx.x; idx < SEQL * CG; idx += gridDim.x * 512) {
        const int m = idx / CG, c0 = (idx % CG) * 8;
        const v4u z = (v4u){0u, 0u, 0u, 0u};
        const v4u gm = m > 0 ? *(const v4u*)(gu + (size_t)(m - 1) * 2 * DFF + c0) : z;
        const v4u g0 = *(const v4u*)(gu + (size_t)m * 2 * DFF + c0);
        const v4u gp = m < SEQL - 1 ? *(const v4u*)(gu + (size_t)(m + 1) * 2 * DFF + c0) : z;
        const v4u uu = *(const v4u*)(gu + (size_t)m * 2 * DFF + DFF + c0);
        float r[8];
#pragma unroll
        for (int e = 0; e < 8; ++e) {
            const unsigned wm = e < 2 ? gm.x : e < 4 ? gm.y : e < 6 ? gm.z : gm.w, w0 = e < 2 ? g0.x : e < 4 ? g0.y : e < 6 ? g0.z : g0.w, wp = e < 2 ? gp.x : e < 4 ? gp.y : e < 6 ? gp.z : gp.w, wu = e < 2 ? uu.x : e < 4 ? uu.y : e < 6 ? uu.z : uu.w;
            const float a = (e & 1) ? bfhi(wm) : bflo(wm), b = (e & 1) ? bfhi(w0) : bflo(w0), c = (e & 1) ? bfhi(wp) : bflo(wp), u = (e & 1) ? bfhi(wu) : bflo(wu);
            const float pre = cb[c0 + e] + cw[c0 + e] * a + cw[DFF + c0 + e] * b + cw[2 * DFF + c0 + e] * c;
            r[e] = gelu_tanh(pre) * u;
        }
        v4u o; o.x = pk2(r[0], r[1]); o.y = pk2(r[2], r[3]); o.z = pk2(r[4], r[5]); o.w = pk2(r[6], r[7]);
        *(v4u*)(h + (size_t)m * DFF + c0) = o;
    }
}

#include <cstring>
static pg8::Gemm mk_gemm(const bf16* A, const bf16* Bt, int M, int N, int K) { pg8::Gemm g; memset(&g, 0, sizeof g); g.A = A; g.Bt = Bt; g.M = M; g.N = N; g.K = K; return g; }
static pg8::EpiBf16<0> mk_epi(bf16* O, int ldc) { pg8::EpiBf16<0> e; memset(&e, 0, sizeof e); e.O = O; e.ldc = ldc; e.bias = nullptr; e.split_cols = 0; e.split_stride = 0; e.scale0 = 1.f; return e; }
extern "C" void kernel_launch(void* const* d_in, const int* in_sizes, int n_in, void* d_out, int out_size, void* d_ws, size_t ws_size, hipStream_t stream) {
    static int ok = 0;
    if (ok == 0) {
        ok = 1;
        if (n_in != 32 || out_size != NTOK * DM || ws_size < WS_END) { fprintf(stderr, "kernel_launch: unexpected sizes n_in %d out %d ws %zu (need %zu)\n", n_in, out_size, ws_size, (size_t)WS_END); ok = -1; }
        if (hipFuncSetAttribute((const void*)k_gemm<pg8::EpiBf16<0>>, hipFuncAttributeMaxDynamicSharedMemorySize, GEMM_LDS) != hipSuccess) ok = -1;
        if (hipFuncSetAttribute((const void*)k_hyena, hipFuncAttributeMaxDynamicSharedMemorySize, HY_LDS_BYTES) != hipSuccess) ok = -1;
        if (hipFuncSetAttribute((const void*)k_prologue, hipFuncAttributeMaxDynamicSharedMemorySize, 131072) != hipSuccess) ok = -1;
        if (hipFuncSetAttribute((const void*)k_rg<1>, hipFuncAttributeMaxDynamicSharedMemorySize, RG_LDS_BYTES) != hipSuccess) ok = -1;
        if (hipFuncSetAttribute((const void*)k_rg<2>, hipFuncAttributeMaxDynamicSharedMemorySize, RG_LDS_BYTES) != hipSuccess) ok = -1;
        if (hipFuncSetAttribute((const void*)k_mixnorm, hipFuncAttributeMaxDynamicSharedMemorySize, MN_LDS_BYTES) != hipSuccess) ok = -1;
        if (ok < 0) fprintf(stderr, "kernel_launch: set-up failed; nothing launched\n");
    }
    if (ok < 0) return;
    unsigned char* ws = (unsigned char*)d_ws;
    const float* const* in = (const float* const*)d_in;
    const int G = 256;
    ProArgs pa{}; pa.xp = in[0]; pa.xs = in[1]; pa.g_premix = in[2]; pa.w_in = in[3]; pa.w_out = in[24]; pa.w_ffi = in[27]; pa.w_ffo = in[30]; pa.rg_a_w = in[6]; pa.rg_x_w = in[8];
    pa.hy_w1 = in[13]; pa.hy_b1 = in[14]; pa.hy_w2 = in[15]; pa.hy_b2 = in[16]; pa.hy_w3 = in[17]; pa.hy_b3 = in[18]; pa.hy_freq = in[20]; pa.ws = ws;
    hipLaunchKernelGGL(k_prologue, dim3(G), dim3(512), 131072, stream, pa);
    bf16* XN = (bf16*)(ws + WS_XN); bf16* WIN = (bf16*)(ws + WS_WIN);
    { pg8::Gemm g = mk_gemm(XN, WIN, NTOK, 2 * DRG, DM); pg8::EpiBf16<0> E = mk_epi((bf16*)(ws + WS_PRG), 2 * DRG);
      hipLaunchKernelGGL(k_gemm<pg8::EpiBf16<0>>, dim3(G), dim3(512), GEMM_LDS, stream, g, E); }
    { pg8::Gemm g = mk_gemm(WIN + (size_t)2 * DRG * DM, XN, 3 * DHY, NTOK, DM); pg8::EpiBf16<0> E = mk_epi((bf16*)(ws + WS_PHY), NTOK);
      hipLaunchKernelGGL(k_gemm<pg8::EpiBf16<0>>, dim3(G), dim3(512), GEMM_LDS, stream, g, E); }
    { HyArgs a{}; a.phy = (const bf16*)(ws + WS_PHY); a.conv_w = in[11]; a.conv_b = in[12]; a.w4 = in[19]; a.hy_bias = in[21]; a.h3 = (const float*)(ws + WS_H3); a.tw = (const f32x2*)(ws + WS_TW);
      a.zk = (f32x2*)(ws + WS_ZK); a.hyy = (bf16*)(ws + WS_HYY);
      hipLaunchKernelGGL(k_hyena, dim3(G), dim3(512), HY_LDS_BYTES, stream, a); }
    { RgArgs a{}; a.prg = (const bf16*)(ws + WS_PRG); a.conv_w = in[4]; a.conv_b = in[5]; a.rgw = (const bf16*)(ws + WS_RGW); a.a_b = in[7]; a.x_b = in[9]; a.lam = in[10];
      a.summ = (f32x2*)(ws + WS_SUMM); a.rgy = (bf16*)(ws + WS_RGY);
      hipLaunchKernelGGL(k_rg<1>, dim3(G), dim3(512), RG_LDS_BYTES, stream, a);
      hipLaunchKernelGGL(k_rg<2>, dim3(G), dim3(512), RG_LDS_BYTES, stream, a); }
    hipLaunchKernelGGL(k_mixnorm, dim3(G), dim3(512), MN_LDS_BYTES, stream, (const bf16*)(ws + WS_RGY), (const bf16*)(ws + WS_HYY), in[22], in[23], (bf16*)(ws + WS_MIX));
    { pg8::Gemm g = mk_gemm((bf16*)(ws + WS_MIX), (bf16*)(ws + WS_WOUT), NTOK, DM, DM); pg8::EpiBf16<0> E = mk_epi((bf16*)(ws + WS_Y), DM);
      hipLaunchKernelGGL(k_gemm<pg8::EpiBf16<0>>, dim3(G), dim3(512), GEMM_LDS, stream, g, E); }
    hipLaunchKernelGGL(k_rowpass1, dim3(G), dim3(512), 0, stream, in[0], in[1], (const bf16*)(ws + WS_Y), in[25], in[26], (float*)d_out, XN);
    bf16* GU = (bf16*)(ws + WS_PHY);
    bf16* HS = (bf16*)(ws + WS_PHY + (size_t)344 * MiB);
    for (int s = 0; s < NSEQ; ++s) {
        { pg8::Gemm g = mk_gemm(XN + (size_t)s * SEQL * DM, (bf16*)(ws + WS_WFI), SEQL, 2 * DFF, DM); pg8::EpiBf16<0> E = mk_epi(GU, 2 * DFF);
          hipLaunchKernelGGL(k_gemm<pg8::EpiBf16<0>>, dim3(G), dim3(512), GEMM_LDS, stream, g, E); }
        hipLaunchKernelGGL(k_gate_seq, dim3(G * 8), dim3(512), 0, stream, (const bf16*)GU, in[28], in[29], HS);
        { pg8::Gemm g = mk_gemm(HS, (bf16*)(ws + WS_WFO), SEQL, DM, DFF); pg8::EpiBf16<0> E = mk_epi((bf16*)(ws + WS_F) + (size_t)s * SEQL * DM, DM);
          hipLaunchKernelGGL(k_gemm<pg8::EpiBf16<0>>, dim3(G), dim3(512), GEMM_LDS, stream, g, E); }
    }
    hipLaunchKernelGGL(k_rowpass2, dim3(G), dim3(512), 0, stream, (const bf16*)(ws + WS_F), in[31], (float*)d_out);
}
```

```cpp
#include <cstring>
#include <hip/hip_runtime.h>
#include <cstdio>
#include <cstdint>
namespace pg8 {
#define PG8_LAS __attribute__((address_space(3)))
typedef unsigned short bf16_t;
typedef short bf16x8 __attribute__((ext_vector_type(8)));
typedef float f32x4 __attribute__((ext_vector_type(4)));
typedef unsigned u32x4 __attribute__((ext_vector_type(4)));
constexpr int BM = 256, BK = 64, HALF = 128, HTB = HALF * BK * 2  , STAGE_BYTES = 8 * HTB, NXCD = 8, WGM = 8;

__host__ __device__ __forceinline__ int lds_byte(int r, int c) { const int st = (r >> 4) * 2 + (c >> 5), rr = r & 15, cc = c & 31, ob = rr * 64 + cc * 2; return st * 1024 + (ob ^ (((ob >> 9) & 1) << 5)); }
__host__ __device__ __forceinline__ void stage_rc(int b, int& R, int& C) { const int st = b / 1024, sb = b % 1024, swz = sb ^ (((sb >> 9) & 1) << 5); R = (st >> 1) * 16 + swz / 64; C = (st & 1) * 32 + (swz % 64) / 2; }
__host__ __device__ __forceinline__ int perm32(int rho) { const int n = rho >> 4, i = rho & 15; return 8 * (i >> 2) + 4 * n + (i & 3); }

struct Unit { int pm, pn; };
struct Gemm { const bf16_t* A; const bf16_t* Bt; int M, N, K; };

struct StaticOrder {
    int nM, nN, nwg, G, c;
    __host__ __device__ void init(int M, int N, int G_, int c_) { nM = M / BM; nN = N / BM; nwg = nM * nN; G = G_; c = c_; }
    __host__ __device__ bool next(int i, Unit& u) const {
        const long L = (long)i * G + c; if (L >= nwg) return false;
        int wgid = (int)L; { const int q = nwg / NXCD, r = nwg % NXCD, xcd = wgid % NXCD, off = wgid / NXCD; wgid = (xcd < r ? xcd * (q + 1) : r * (q + 1) + (xcd - r) * q) + off; }
        const int nig = WGM * nN, gid = wgid / nig, fm = gid * WGM, gsz = (nM - fm) < WGM ? (nM - fm) : WGM;
        u.pm = fm + ((wgid % nig) % gsz); u.pn = (wgid % nig) / gsz; return true;
    }
    __device__ __forceinline__ void a_ready(const Unit&) const {}
    __device__ __forceinline__ void done(const Unit&) const {}
};

__device__ __forceinline__ unsigned cvt_pk_bf16(float lo, float hi) { unsigned r; asm volatile("v_cvt_pk_bf16_f32 %0, %1, %2" : "=v"(r) : "v"(lo), "v"(hi)); return r; }
typedef float f32x2 __attribute__((ext_vector_type(2)));
__device__ __forceinline__ f32x2 gelu_pk(f32x2 v) {
    const f32x2 av = __builtin_elementwise_abs(v), d = av * 0.2316418882f + 1.0f;
    f32x2 t; t.x = __builtin_amdgcn_rcpf(d.x); t.y = __builtin_amdgcn_rcpf(d.y);
    f32x2 q = t * 0.5307027145f + (-0.7265760135f); q = q * t + 0.7107068705f; q = q * t + (-0.142248368f); q = q * t + 0.127414796f; q = q * t;
    const f32x2 s = (v * v) * (-0.72134752044f);
    f32x2 e; e.x = __builtin_amdgcn_exp2f(s.x); e.y = __builtin_amdgcn_exp2f(s.y);
    const f32x2 m = v * (q * e), r = v - m;
    f32x2 o; o.x = v.x < 0.f ? m.x : r.x; o.y = v.y < 0.f ? m.y : r.y; return o;
}

template <int ACT  > struct EpiBf16 {
    static constexpr bool PERM = true, AFTER_DRAIN = false; static_assert(ACT == 0 || ACT == 1, "EpiBf16: ACT is 0 (none) or 1 (gelu_pk)");
    bf16_t* O; int ldc; const float* bias; int split_cols; size_t split_stride; float scale0;
    __device__ __forceinline__ void operator()(const f32x4 (&acc)[2][2][4][2], const Unit& u, int wr, int wc, int fr, int fq) const {
        const int row0 = u.pm * BM + wr * 64 + fr; int colt = u.pn * BM; bf16_t* base = O;
        float sc = 1.f; if (split_cols) { const int t = colt / split_cols; base += (size_t)t * split_stride; colt -= t * split_cols; if (t == 0) sc = scale0; }
        const int col0 = colt + wc * 32 + 8 * fq, bcol0 = u.pn * BM + wc * 32 + 8 * fq;
        f32x4 bv[2][2];
#pragma unroll
        for (int bj = 0; bj < 2; ++bj)
#pragma unroll
            for (int n = 0; n < 2; ++n) bv[bj][n] = bias ? *(const f32x4*)(bias + bcol0 + bj * HALF + 4 * n) : (f32x4){0.f, 0.f, 0.f, 0.f};
#pragma unroll
        for (int ai = 0; ai < 2; ++ai)
#pragma unroll
            for (int m = 0; m < 4; ++m) { bf16_t* rowp = base + (size_t)(row0 + ai * HALF + m * 16) * ldc + col0;
#pragma unroll
                for (int bj = 0; bj < 2; ++bj) { f32x4 v0 = acc[ai][bj][m][0] + bv[bj][0], v1 = acc[ai][bj][m][1] + bv[bj][1];
                    if (ACT == 1) { f32x2 a = gelu_pk((f32x2){v0[0], v0[1]}), b = gelu_pk((f32x2){v0[2], v0[3]}), c = gelu_pk((f32x2){v1[0], v1[1]}), d = gelu_pk((f32x2){v1[2], v1[3]});
                        v0 = (f32x4){a.x, a.y, b.x, b.y}; v1 = (f32x4){c.x, c.y, d.x, d.y}; }
                    v0 = v0 * sc; v1 = v1 * sc; u32x4 w; w.x = cvt_pk_bf16(v0[0], v0[1]); w.y = cvt_pk_bf16(v0[2], v0[3]); w.z = cvt_pk_bf16(v1[0], v1[1]); w.w = cvt_pk_bf16(v1[2], v1[3]);
                    *(u32x4*)(rowp + bj * HALF) = w; } }
    }
};
template <class Epi, class Sched, bool ALIGN_EPI = false, bool SP2 = false>
__device__ __forceinline__ void gemm_phase(PG8_LAS unsigned char* lds, const Gemm g, const Sched& S, const Epi& E) {
    int tid_ = threadIdx.x; asm volatile("" : "+v"(tid_));
    const int tid = tid_, wid = __builtin_amdgcn_readfirstlane(tid >> 6), lane = tid & 63, wr = wid >> 2, wc = wid & 3, fr = lane & 15, fq = lane >> 4;
    const int K = g.K, nt = K / BK;
    unsigned voffA[2], voffB[2];
#pragma unroll
    for (int i = 0; i < 2; ++i) { int R, C; stage_rc(tid * 16 + i * 8192, R, C); const int Rb = Epi::PERM ? ((R & ~31) + perm32(R & 31)) : R;
        voffA[i] = (unsigned)(R * K + C) * 2u; voffB[i] = (unsigned)(Rb * K + C) * 2u; }
    const size_t kstep = (size_t)(BK * 2);
    const size_t hstep = (size_t)HALF * K * 2;
    const size_t tstep = 2 * hstep;
    const unsigned ldsw = (unsigned)wid * 1024u;
    const int aoff = lds_byte(wr * 64 + fr, fq * 8), boff = lds_byte(wc * 32 + fr, fq * 8);
#define PG8_SA(b, h) (((b) * 2 + (h)) * HTB)
#define PG8_SB(b, h) ((4 + (b) * 2 + (h)) * HTB)
#define PG8_STAGE(bufoff, gbase, voff) do { _Pragma("unroll") for (int _i = 0; _i < 2; ++_i) \
        __builtin_amdgcn_global_load_lds((const unsigned*)((const char*)(gbase) + (voff)[_i]), (PG8_LAS unsigned*)(lds + (bufoff) + ldsw + _i * 8192), 16, 0, 0); } while (0)
#define PG8_LDA(dst, b, h) do { _Pragma("unroll") for (int m = 0; m < 4; ++m) _Pragma("unroll") for (int k = 0; k < 2; ++k) dst[m][k] = *(const PG8_LAS bf16x8*)(lds + PG8_SA(b, h) + aoff + m * 2048 + k * 1024); } while (0)
#define PG8_LDB(dst, b, h) do { _Pragma("unroll") for (int n = 0; n < 2; ++n) _Pragma("unroll") for (int k = 0; k < 2; ++k) dst[n][k] = *(const PG8_LAS bf16x8*)(lds + PG8_SB(b, h) + boff + n * 2048 + k * 1024); } while (0)
#define PG8_MMA(ai, bj, At, Bt) do { __builtin_amdgcn_s_setprio(1); _Pragma("unroll") for (int m = 0; m < 4; ++m) _Pragma("unroll") for (int n = 0; n < 2; ++n) _Pragma("unroll") for (int k = 0; k < 2; ++k) \
        acc[ai][bj][m][n] = __builtin_amdgcn_mfma_f32_16x16x32_bf16(Bt[n][k], At[m][k], acc[ai][bj][m][n], 0, 0, 0); __builtin_amdgcn_s_setprio(0); } while (0)
#define PG8_WAIT_V(n) asm volatile("s_waitcnt vmcnt(" #n ")" ::: "memory")
#define PG8_WAIT_L(n) asm volatile("s_waitcnt lgkmcnt(" #n ")" ::: "memory")
#define PG8_BAR __builtin_amdgcn_s_barrier()
#define PG8_SCHED __builtin_amdgcn_sched_barrier(0)
    Unit cur, nxt; int ui = 0;
    if (!S.next(0, cur)) return;
    f32x4 acc[2][2][4][2];
#pragma unroll
    for (int a = 0; a < 2; ++a)
#pragma unroll
        for (int b = 0; b < 2; ++b)
#pragma unroll
            for (int m = 0; m < 4; ++m)
#pragma unroll
                for (int n = 0; n < 2; ++n) acc[a][b][m][n] = (f32x4){0.f, 0.f, 0.f, 0.f};
    bf16x8 At[4][2], B0[2][2], B1[2][2];
    const char* cA = (const char*)g.A + (size_t)cur.pm * tstep; const char* cB = (const char*)g.Bt + (size_t)cur.pn * tstep;
    S.a_ready(cur);
    if constexpr (SP2) {
        PG8_STAGE(PG8_SB(0, 0), cB, voffB); PG8_STAGE(PG8_SB(0, 1), cB + hstep, voffB); PG8_STAGE(PG8_SA(0, 0), cA, voffA); PG8_STAGE(PG8_SA(0, 1), cA + hstep, voffA);
        if (wr == 1) PG8_BAR;
        PG8_WAIT_V(2); PG8_BAR;
        PG8_STAGE(PG8_SB(1, 0), cB + kstep, voffB); PG8_STAGE(PG8_SA(1, 0), cA + kstep, voffA); PG8_STAGE(PG8_SB(1, 1), cB + hstep + kstep, voffB);
        PG8_WAIT_V(6); PG8_BAR;
    } else {
        PG8_STAGE(PG8_SB(0, 0), cB, voffB); PG8_STAGE(PG8_SA(0, 0), cA, voffA); PG8_STAGE(PG8_SB(0, 1), cB + hstep, voffB); PG8_STAGE(PG8_SA(0, 1), cA + hstep, voffA);
        if (wr == 1) PG8_BAR;
        PG8_WAIT_V(4); PG8_BAR;
        PG8_STAGE(PG8_SB(1, 0), cB + kstep, voffB); PG8_STAGE(PG8_SA(1, 0), cA + kstep, voffA); PG8_STAGE(PG8_SB(1, 1), cB + hstep + kstep, voffB);
        PG8_WAIT_V(6); PG8_BAR;
    }
    for (;;) {
        const bool has_next = S.next(ui + 1, nxt);
        const char* nA = has_next ? (const char*)g.A + (size_t)nxt.pm * tstep : cA; const char* nB = has_next ? (const char*)g.Bt + (size_t)nxt.pn * tstep : cB;
        for (int t = 0; t < nt; t += 2) {
            const bool last = (t == nt - 2);
            const char* a1 = cA + (size_t)(t + 1) * kstep;
            const char* a2 = last ? nA : cA + (size_t)(t + 2) * kstep; const char* b2 = last ? nB : cB + (size_t)(t + 2) * kstep;
            const char* a3 = a2 + kstep; const char* b3 = b2 + kstep;
            if (last && has_next) S.a_ready(nxt);
            if constexpr (SP2) {
            PG8_LDB(B0, 0, 0); PG8_LDB(B1, 0, 1); PG8_SCHED; PG8_LDA(At, 0, 0); PG8_STAGE(PG8_SA(1, 1), a1 + hstep, voffA);
            PG8_WAIT_V(8); PG8_WAIT_L(0); PG8_BAR; PG8_MMA(0, 0, At, B0); PG8_MMA(0, 1, At, B1); PG8_BAR; PG8_SCHED;
            PG8_LDA(At, 0, 1); PG8_STAGE(PG8_SB(0, 0), b2, voffB); PG8_STAGE(PG8_SB(0, 1), b2 + hstep, voffB); PG8_STAGE(PG8_SA(0, 0), a2, voffA);
            PG8_WAIT_V(8); PG8_WAIT_L(0); PG8_BAR; PG8_MMA(1, 0, At, B0); PG8_MMA(1, 1, At, B1); PG8_BAR; PG8_SCHED;
            PG8_LDB(B0, 1, 0); PG8_LDB(B1, 1, 1); PG8_SCHED; PG8_LDA(At, 1, 0); PG8_STAGE(PG8_SA(0, 1), a2 + hstep, voffA);
            PG8_WAIT_V(8); PG8_WAIT_L(0); PG8_BAR; PG8_MMA(0, 0, At, B0); PG8_MMA(0, 1, At, B1); PG8_BAR; PG8_SCHED;
            PG8_LDA(At, 1, 1); PG8_STAGE(PG8_SB(1, 0), b3, voffB); PG8_STAGE(PG8_SB(1, 1), b3 + hstep, voffB); PG8_STAGE(PG8_SA(1, 0), a3, voffA);
            PG8_WAIT_V(8); PG8_WAIT_L(0); PG8_BAR; PG8_MMA(1, 0, At, B0); PG8_MMA(1, 1, At, B1); PG8_BAR; PG8_SCHED;
            } else {
            PG8_LDB(B0, 0, 0); PG8_SCHED; PG8_LDA(At, 0, 0); PG8_STAGE(PG8_SA(1, 1), a1 + hstep, voffA);
            PG8_WAIT_L(8); PG8_BAR; PG8_WAIT_L(0); PG8_MMA(0, 0, At, B0); PG8_BAR; PG8_SCHED;
            PG8_LDB(B1, 0, 1); PG8_STAGE(PG8_SB(0, 0), b2, voffB);
            PG8_BAR; PG8_WAIT_L(0); PG8_MMA(0, 1, At, B1); PG8_BAR;
            PG8_LDA(At, 0, 1); PG8_STAGE(PG8_SA(0, 0), a2, voffA);
            PG8_BAR; PG8_WAIT_L(0); PG8_MMA(1, 0, At, B0); PG8_BAR; PG8_SCHED;
            PG8_STAGE(PG8_SB(0, 1), b2 + hstep, voffB);
            PG8_WAIT_V(6); PG8_BAR; PG8_MMA(1, 1, At, B1); PG8_BAR;
            PG8_LDB(B0, 1, 0); PG8_SCHED; PG8_LDA(At, 1, 0); PG8_STAGE(PG8_SA(0, 1), a2 + hstep, voffA);
            PG8_WAIT_L(8); PG8_BAR; PG8_WAIT_L(0); PG8_MMA(0, 0, At, B0); PG8_BAR; PG8_SCHED;
            PG8_LDB(B1, 1, 1); PG8_STAGE(PG8_SB(1, 0), b3, voffB);
            PG8_BAR; PG8_WAIT_L(0); PG8_MMA(0, 1, At, B1); PG8_BAR;
            PG8_LDA(At, 1, 1); PG8_STAGE(PG8_SA(1, 0), a3, voffA);
            PG8_BAR; PG8_WAIT_L(0); PG8_MMA(1, 0, At, B0); PG8_BAR; PG8_SCHED;
            PG8_STAGE(PG8_SB(1, 1), b3 + hstep, voffB);
            PG8_WAIT_V(6); PG8_BAR; PG8_MMA(1, 1, At, B1); PG8_BAR;
            }
        }
        if constexpr (ALIGN_EPI) { if (wr == 0) PG8_BAR; }
        if constexpr (!Epi::AFTER_DRAIN) { E(acc, cur, wr, wc, fr, fq); S.done(cur); }
        if (!has_next) break;
#pragma unroll
        for (int a = 0; a < 2; ++a)
#pragma unroll
            for (int b = 0; b < 2; ++b)
#pragma unroll
                for (int m = 0; m < 4; ++m)
#pragma unroll
                    for (int n = 0; n < 2; ++n) acc[a][b][m][n] = (f32x4){0.f, 0.f, 0.f, 0.f};
        cur = nxt; cA = nA; cB = nB; ++ui;
        if constexpr (ALIGN_EPI) { if (wr == 1) PG8_BAR; }
    }
    PG8_WAIT_V(0);
    if constexpr (!ALIGN_EPI) { if (wr == 0) PG8_BAR; }
    PG8_BAR;
    if constexpr (Epi::AFTER_DRAIN) { E.fused(acc, cur, wr, wc, fr, fq, lds, wid, lane); S.done(cur); }
#undef PG8_SA
#undef PG8_SB
#undef PG8_STAGE
#undef PG8_LDA
#undef PG8_LDB
#undef PG8_MMA
#undef PG8_WAIT_V
#undef PG8_WAIT_L
#undef PG8_BAR
#undef PG8_SCHED
}
}
constexpr int SEQL = 8192, NSEQ = 3, NTOK = NSEQ * SEQL;
constexpr int DM = 4096, DRG = 2048, DHY = 2048, NIN = 10240, DFF = 11008;
constexpr int NHEAD = 16, HDIM = 128;
constexpr float EPSN = 1e-6f;
constexpr int FFT_N = 16384;

#define GAS __attribute__((address_space(1)))
#define LAS __attribute__((address_space(3)))
typedef unsigned short bf16;
typedef unsigned v4u __attribute__((ext_vector_type(4)));
typedef unsigned v2u __attribute__((ext_vector_type(2)));
typedef float f32x4 __attribute__((ext_vector_type(4)));
typedef float f32x2 __attribute__((ext_vector_type(2)));
typedef short bf16x8 __attribute__((ext_vector_type(8)));

__device__ __forceinline__ unsigned f2bf(float f) { unsigned u = __builtin_bit_cast(unsigned, f); return (u + 0x7fffu + ((u >> 16) & 1u)) >> 16; }
__device__ __forceinline__ unsigned pk2(float lo, float hi) { return f2bf(lo) | (f2bf(hi) << 16); }
__device__ __forceinline__ float bf2f(unsigned b) { return __builtin_bit_cast(float, b << 16); }
__device__ __forceinline__ float bflo(unsigned w) { return __builtin_bit_cast(float, w << 16); }
__device__ __forceinline__ float bfhi(unsigned w) { return __builtin_bit_cast(float, w & 0xffff0000u); }
__device__ __forceinline__ float wave_sum(float v) {
#pragma unroll
    for (int o = 1; o < 64; o <<= 1) v += __shfl_xor(v, o);
    return v;
}
__device__ __forceinline__ float sigmoidf_(float x) { return 1.0f / (1.0f + __expf(-x)); }
__device__ __forceinline__ float gelu_tanh(float x) { const float u = 1.5957691216057308f * (x + 0.044715f * x * x * x); return x / (1.0f + __expf(-u)); }

constexpr size_t MiB = 1u << 20;
constexpr size_t WS_CTL = 0;
constexpr size_t WS_TW = 1 * MiB;
constexpr size_t WS_H3 = 2 * MiB;
constexpr size_t WS_RGW = 4 * MiB;
constexpr size_t WS_SUMM = 6 * MiB;
constexpr size_t WS_WIN = 16 * MiB;
constexpr size_t WS_WOUT = 96 * MiB;
constexpr size_t WS_WFI = 128 * MiB;
constexpr size_t WS_WFO = 300 * MiB;
constexpr size_t WS_XN = 386 * MiB;
constexpr size_t WS_PRG = 578 * MiB;
constexpr size_t WS_PHY = 770 * MiB;
constexpr size_t WS_HYY = 1058 * MiB;
constexpr size_t WS_RGY = 1154 * MiB;
constexpr size_t WS_ZK = 1250 * MiB;
constexpr size_t WS_END = 1314 * MiB;
constexpr size_t WS_MIX = WS_PHY;
constexpr size_t WS_Y = WS_PRG;
constexpr size_t WS_F = WS_PRG;
#define XB_TMO      128
#define XB_XCNT(j)  (256  + 64 * (j))
#define XB_XSUB(j)  (1280 + 64 * (j))
#define XB_XGEN(j)  (2304 + 64 * (j))
#define XB_TOP      3328
#define XB_TOPGEN   3392
#define XCD_BAR_WORDS 3456
#define XB_SPIN_CAP (1u << 18)

__device__ __forceinline__ unsigned xb_ld(unsigned* p)              { return __hip_atomic_load(p, __ATOMIC_RELAXED, __HIP_MEMORY_SCOPE_AGENT); }
__device__ __forceinline__ unsigned xb_add(unsigned* p, unsigned v) { return __hip_atomic_fetch_add(p, v, __ATOMIC_RELAXED, __HIP_MEMORY_SCOPE_AGENT); }
__device__ __forceinline__ unsigned xb_xcc_id() { return (unsigned)__builtin_amdgcn_s_getreg((3 << 11) | 20) & 0xFu; }
#define XB_SPIN(cond, bar) do { unsigned _sp = 0; while (cond) { __builtin_amdgcn_s_sleep(1); \
    if ((++_sp & 255u) == 0u) { if (xb_ld(&(bar)[XB_TMO])) break; if (_sp > XB_SPIN_CAP) { atomicAdd(&(bar)[XB_TMO], 1u); break; } } } } while (0)

struct XcdBarrier {
    unsigned* bar; unsigned x;
    volatile LAS unsigned* st;
};

__device__ __forceinline__ XcdBarrier xcd_barrier_post(unsigned* bar, volatile LAS unsigned* st) {
    XcdBarrier b; b.bar = bar; b.x = xb_xcc_id(); b.st = st;
    if (threadIdx.x == 0) (void)xb_add(&bar[XB_XCNT(b.x)], 1u);
    return b;
}
__device__ __forceinline__ void xcd_barrier_complete(unsigned* bar, unsigned x, unsigned& nloc, unsigned& nx) {
    const unsigned G = gridDim.x * gridDim.y * gridDim.z;
    unsigned sum, cnt, mine, sp = 0u;
    for (;;) {
        sum = 0u; cnt = 0u; mine = 0u;
#pragma unroll
        for (unsigned j = 0; j < 16; ++j) { const unsigned c = xb_ld(&bar[XB_XCNT(j)]); sum += c; cnt += (c > 0u) ? 1u : 0u; mine = (j == x) ? c : mine; }
        if (sum == G) break;
        __builtin_amdgcn_s_sleep(1);
        if ((++sp & 255u) == 0u) { if (xb_ld(&bar[XB_TMO])) break; if (sp > XB_SPIN_CAP) { atomicAdd(&bar[XB_TMO], 1u); break; } }
    }
    nloc = mine > 0u ? mine : 1u; nx = cnt > 0u ? cnt : 1u;
}

__device__ __forceinline__ void xcd_barrier(const XcdBarrier& b) {
    asm volatile("s_waitcnt vmcnt(0)" ::: "memory");
    __syncthreads();
    if (threadIdx.x == 0) {
        unsigned* bar = b.bar;
        __builtin_amdgcn_s_waitcnt(0);
        unsigned nloc = b.st[0], nx = b.st[1];
        if (nloc == 0u) { xcd_barrier_complete(bar, b.x, nloc, nx); b.st[0] = nloc; b.st[1] = nx; }
        const unsigned old = xb_add(&bar[XB_XSUB(b.x)], 1u);
        const unsigned gen = old / nloc;
        if (old + 1u == (gen + 1u) * nloc) {
            __builtin_amdgcn_fence(__ATOMIC_RELEASE, "agent");
            asm volatile("s_waitcnt vmcnt(0)" ::: "memory");
            const unsigned og = xb_add(&bar[XB_TOP], 1u);
            const unsigned tg = og / nx;
            if (og + 1u == (tg + 1u) * nx) xb_add(&bar[XB_TOPGEN], 1u);
            else XB_SPIN(xb_ld(&bar[XB_TOPGEN]) == tg, bar);
            __builtin_amdgcn_fence(__ATOMIC_ACQUIRE, "agent");
            xb_add(&bar[XB_XGEN(b.x)], 1u);
            asm volatile("s_waitcnt vmcnt(0)" ::: "memory");
        } else {
            XB_SPIN(xb_ld(&bar[XB_XGEN(b.x)]) == gen, bar);
            __builtin_amdgcn_fence(__ATOMIC_ACQUIRE, "agent");
            asm volatile("s_waitcnt vmcnt(0)" ::: "memory");
        }
    }
    __syncthreads();
}
__device__ __forceinline__ void p0_transpose_item(const float* W, int K, int N, bf16* WT, int k0, int n0, int drow0, LAS float* scr, int lane) {
#pragma unroll 8
    for (int i = 0; i < 32; ++i) { const int kk = 2 * i + (lane >> 5); scr[kk * 33 + (lane & 31)] = W[(size_t)(k0 + kk) * N + n0 + (lane & 31)]; }
    asm volatile("s_waitcnt lgkmcnt(0)" ::: "memory");
    const int c = lane & 7;
#pragma unroll
    for (int j = 0; j < 4; ++j) { const int n = (lane >> 3) + 8 * j; const LAS float* s = scr + (8 * c) * 33 + n;
        v4u o; o.x = pk2(s[0 * 33], s[1 * 33]); o.y = pk2(s[2 * 33], s[3 * 33]); o.z = pk2(s[4 * 33], s[5 * 33]); o.w = pk2(s[6 * 33], s[7 * 33]);
        *(v4u*)(WT + (size_t)(drow0 + n) * K + k0 + 8 * c) = o; }
    asm volatile("s_waitcnt lgkmcnt(0)" ::: "memory");
}
template <bool INTER> __device__ __forceinline__ int ffi_drow(int n) {
    if (!INTER) return n;
    const int up = n >= DFF ? 1 : 0, c = n - up * DFF; return (c >> 7) * 256 + up * 128 + (c & 127);
}
struct ProArgs {
    const float *xp, *xs, *g_premix;
    const float *w_in, *w_out, *w_ffi, *w_ffo;
    const float *rg_a_w, *rg_x_w;
    const float *hy_w1, *hy_b1, *hy_w2, *hy_b2, *hy_w3, *hy_b3, *hy_freq;
    unsigned char* ws;
};
__device__ __forceinline__ const float* xrow_ptr(const float* xp, const float* xs, int m) { return m < SEQL ? xp + (size_t)m * DM : xs + (size_t)(m - SEQL) * DM; }

template <bool INTER> __device__ __forceinline__ void p0_prologue(const ProArgs& a, LAS unsigned char* lds, int gw, int NGW, int wave, int lane) {
    bf16* WIN = (bf16*)(a.ws + WS_WIN); bf16* WOUT = (bf16*)(a.ws + WS_WOUT); bf16* WFI = (bf16*)(a.ws + WS_WFI); bf16* WFO = (bf16*)(a.ws + WS_WFO);
    LAS float* scr = (LAS float*)(lds + wave * 16384);
    constexpr int I_IN = (DM / 64) * (NIN / 32), I_OUT = (DM / 64) * (DM / 32), I_FI = (DM / 64) * (2 * DFF / 32), I_FO = (DFF / 64) * (DM / 32);
    constexpr int NITEMS = I_IN + I_OUT + I_FI + I_FO;
    for (int it = gw; it < NITEMS; it += NGW) {
        int r = it;
        if (r < I_IN) { const int nb = NIN / 32, kb = r / nb, n0 = (r % nb) * 32; p0_transpose_item(a.w_in, DM, NIN, WIN, kb * 64, n0, n0, scr, lane); continue; } r -= I_IN;
        if (r < I_OUT) { const int nb = DM / 32, kb = r / nb, n0 = (r % nb) * 32; p0_transpose_item(a.w_out, DM, DM, WOUT, kb * 64, n0, n0, scr, lane); continue; } r -= I_OUT;
        if (r < I_FI) { const int nb = 2 * DFF / 32, kb = r / nb, n0 = (r % nb) * 32; p0_transpose_item(a.w_ffi, DM, 2 * DFF, WFI, kb * 64, n0, ffi_drow<INTER>(n0), scr, lane); continue; } r -= I_FI;
        { const int nb = DM / 32, kb = r / nb, n0 = (r % nb) * 32; p0_transpose_item(a.w_ffo, DFF, DM, WFO, kb * 64, n0, n0, scr, lane); }
    }
    bf16* XN = (bf16*)(a.ws + WS_XN);
    for (int m = gw; m < NTOK; m += NGW) {
        const float* xr = xrow_ptr(a.xp, a.xs, m);
        f32x4 v[16]; float s = 0.f;
#pragma unroll
        for (int j = 0; j < 8; ++j) { const f32x4* p = (const f32x4*)(xr + (j * 64 + lane) * 8); v[2 * j] = p[0]; v[2 * j + 1] = p[1];
            s += (v[2 * j].x * v[2 * j].x + v[2 * j].y * v[2 * j].y) + (v[2 * j].z * v[2 * j].z + v[2 * j].w * v[2 * j].w);
            s += (v[2 * j + 1].x * v[2 * j + 1].x + v[2 * j + 1].y * v[2 * j + 1].y) + (v[2 * j + 1].z * v[2 * j + 1].z + v[2 * j + 1].w * v[2 * j + 1].w); }
        const float rs = 1.0f / sqrtf(wave_sum(s) * (1.0f / DM) + EPSN);
#pragma unroll
        for (int j = 0; j < 8; ++j) { const int c0 = (j * 64 + lane) * 8; const f32x4 g0 = *(const f32x4*)(a.g_premix + c0), g1 = *(const f32x4*)(a.g_premix + c0 + 4);
            const f32x4 a0 = v[2 * j] * rs * g0, a1 = v[2 * j + 1] * rs * g1;
            v4u o; o.x = pk2(a0.x, a0.y); o.y = pk2(a0.z, a0.w); o.z = pk2(a1.x, a1.y); o.w = pk2(a1.z, a1.w);
            *(v4u*)(XN + (size_t)m * DM + c0) = o; }
    }
    bf16* RGW = (bf16*)(a.ws + WS_RGW);
    for (int idx = gw * 64 + lane; idx < 2 * 2 * NHEAD * HDIM * HDIM; idx += NGW * 64) {
        const int i = idx & 127, j = (idx >> 7) & 127, h = (idx >> 14) & 15, gate = (idx >> 18) & 1, dir = idx >> 19;
        const float* W = gate ? a.rg_x_w : a.rg_a_w;
        RGW[idx] = (bf16)f2bf(W[(((size_t)dir * NHEAD + h) * HDIM + i) * HDIM + j]);
    }
    f32x2* TW = (f32x2*)(a.ws + WS_TW);
    for (int k = gw * 64 + lane; k < FFT_N; k += NGW * 64) { float sn, cs; sincospif((float)k * (1.0f / 8192.0f), &sn, &cs); TW[k] = (f32x2){cs, -sn}; }
    float* H3 = (float*)(a.ws + WS_H3);
    const float fr = a.hy_freq[lane], b1 = a.hy_b1[lane], b2 = a.hy_b2[lane], b3 = a.hy_b3[lane];
    for (int n = gw; n < SEQL; n += NGW) {
        float zv = 0.f;
        if (lane == 0) zv = (float)n * (1.0f / (float)(SEQL - 1));
        else if (lane < 33) { const int k = (lane - 1) & 15; const float band = 1e-4f + (float)k * ((15.0f - 1e-4f) / 15.0f);
            const float ang = (6.283185307179586f / (float)SEQL) * (float)n * band; zv = lane < 17 ? cosf(ang) : -sinf(ang); }
        float acc = b1;
        for (int e = 0; e < 33; ++e) acc += __shfl(zv, e) * a.hy_w1[e * 64 + lane];
        float h = sinf(fr * acc);
        acc = b2;
        for (int e = 0; e < 64; ++e) acc += __shfl(h, e) * a.hy_w2[e * 64 + lane];
        h = sinf(fr * acc);
        acc = b3;
        for (int e = 0; e < 64; ++e) acc += __shfl(h, e) * a.hy_w3[e * 64 + lane];
        h = sinf(fr * acc);
        H3[n * 64 + lane] = h;
    }
}
constexpr int FFT_LDS_BYTES = (FFT_N + FFT_N / 32) * 8;
constexpr int HY_W4_OFF = FFT_LDS_BYTES;
constexpr int HY_PRM_OFF = FFT_LDS_BYTES + 1024;
constexpr int HY_LDS_BYTES = FFT_LDS_BYTES + 1024 + 256;
__device__ __forceinline__ int PH(int i) { return i + (i >> 5); }
__device__ __forceinline__ f32x2 cmul(f32x2 a, f32x2 b) { return (f32x2){a.x * b.x - a.y * b.y, a.x * b.y + a.y * b.x}; }
__device__ __forceinline__ constexpr int bitrev_c(int r, int bits) { int o = 0; for (int i = 0; i < bits; ++i) o |= ((r >> i) & 1) << (bits - 1 - i); return o; }

__device__ __forceinline__ f32x2 mul_w32(f32x2 d, int idx) {
    constexpr float C[16] = {1.0f, 0.98078528040323043f, 0.92387953251128674f, 0.83146961230254524f, 0.70710678118654752f, 0.55557023301960218f, 0.38268343236508977f, 0.19509032201612825f,
                             0.0f, -0.19509032201612825f, -0.38268343236508977f, -0.55557023301960218f, -0.70710678118654752f, -0.83146961230254524f, -0.92387953251128674f, -0.98078528040323043f};
    constexpr float S[16] = {0.0f, 0.19509032201612825f, 0.38268343236508977f, 0.55557023301960218f, 0.70710678118654752f, 0.83146961230254524f, 0.92387953251128674f, 0.98078528040323043f,
                             1.0f, 0.98078528040323043f, 0.92387953251128674f, 0.83146961230254524f, 0.70710678118654752f, 0.55557023301960218f, 0.38268343236508977f, 0.19509032201612825f};
    if (idx == 0) return d;
    if (idx == 8) return (f32x2){d.y, -d.x};
    const float c = C[idx], s = S[idx];
    return (f32x2){d.x * c + d.y * s, d.y * c - d.x * s};
}
template <int R> __device__ __forceinline__ void dft_inreg(f32x2 (&a)[R]) {
    constexpr int LOGR = (R == 32) ? 5 : 4;
#pragma unroll
    for (int t = 0; t < LOGR; ++t) {
        const int half = R >> (t + 1);
#pragma unroll
        for (int g = 0; g < R; g += 2 * half)
#pragma unroll
            for (int i = 0; i < half; ++i) {
                const f32x2 u = a[g + i], v = a[g + i + half];
                a[g + i] = u + v;
                a[g + i + half] = mul_w32(u - v, i * (16 / half));
            }
    }
}
template <int R, int S, bool TW> __device__ __forceinline__ void fft_pass(LAS f32x2* lds, const f32x2* tw, int tid) {
    constexpr int NB = FFT_N / R, PER = NB / 512, LOGR = (R == 32) ? 5 : 4;
    constexpr int RSTEP = NB + NB / 32;
    constexpr int WSTEP = (S == 1) ? 1 : (S + S / 32);
    f32x2 a[PER][R];
#pragma unroll
    for (int b = 0; b < PER; ++b) { const LAS f32x2* rp = lds + PH(tid + 512 * b);
#pragma unroll
        for (int k = 0; k < R; ++k) a[b][k] = rp[k * RSTEP]; }
    __syncthreads();
#pragma unroll
    for (int b = 0; b < PER; ++b) {
        const int beta = tid + 512 * b, q = beta & (S - 1), p = beta / S, base = q + R * S * p;
        dft_inreg<R>(a[b]);
        f32x2 w1 = (f32x2){1.f, 0.f}, wj = (f32x2){1.f, 0.f};
        if (TW) { w1 = tw[p * S]; wj = w1; }
        LAS f32x2* wp = lds + PH(base);
        wp[0] = a[b][0];
#pragma unroll
        for (int j = 1; j < R; ++j) {
            f32x2 v = a[b][bitrev_c(j, LOGR)];
            if (TW) { v = cmul(v, wj); wj = cmul(wj, w1); }
            wp[j * WSTEP] = v;
        }
    }
    __syncthreads();
}
__device__ __forceinline__ void fft16k(LAS f32x2* lds, const f32x2* tw, int tid) {
    asm volatile("" : "+v"(tid));
    fft_pass<32, 1, true>(lds, tw, tid);
    fft_pass<32, 32, true>(lds, tw, tid);
    fft_pass<16, 1024, false>(lds, tw, tid);
}
__device__ __forceinline__ void spec_pair(LAS f32x2* lds, const f32x2* ZK, int p) {
    const int f = p, f2 = (FFT_N - p) & (FFT_N - 1);
    const f32x2 A = ZK[f], A2 = ZK[f2], Z = lds[PH(f)], Z2 = lds[PH(f2)];
    const float kcx = 0.5f * (A.x + A2.x), kcy = 0.5f * (A.y - A2.y);
    const float dx = 0.5f * (A.x - A2.x), dy = 0.5f * (A.y + A2.y);
    const float k1x = dy, k1y = -dx;
    const float px = 0.5f * (kcx + k1x), py = 0.5f * (kcy + k1y), qx = 0.5f * (kcx - k1x), qy = 0.5f * (kcy - k1y);
    const float wx = Z.x * px - Z.y * py + (Z2.x * qx + Z2.y * qy);
    const float wy = Z.x * py + Z.y * px + (Z2.x * qy - Z2.y * qx);
    const float w2x = Z2.x * px + Z2.y * py + (Z.x * qx - Z.y * qy);
    const float w2y = Z2.y * px - Z2.x * py - (Z.x * qy + Z.y * qx);
    lds[PH(f)] = (f32x2){wx, -wy}; lds[PH(f2)] = (f32x2){w2x, -w2y};
}
__device__ __forceinline__ void spec_mul(LAS f32x2* lds, const f32x2* ZK, int tid) {
    asm volatile("" : "+v"(tid));
#pragma unroll 4
    for (int i = 0; i < 16; ++i) spec_pair(lds, ZK, tid + 512 * i);
    if (tid == 0) spec_pair(lds, ZK, 8192);
    __syncthreads();
}
struct HyArgs {
    const bf16* phy;
    const float *conv_w, *conv_b;
    const float* w4;
    const float* hy_bias;
    const float* h3;
    const f32x2* tw;
    f32x2* zk;
    bf16* hyy;
};
__device__ __forceinline__ void load_conv3_16(const bf16* row, int t0, float w0, float w1, float w2, float bias, float (&out)[16]) {
    const v4u r0 = *(const v4u*)(row + t0), r1 = *(const v4u*)(row + t0 + 8);
    float u[18];
    u[0] = t0 > 0 ? bf2f(row[t0 - 1]) : 0.f;
    u[17] = (t0 + 16 < SEQL) ? bf2f(row[t0 + 16]) : 0.f;
    u[1] = bflo(r0.x); u[2] = bfhi(r0.x); u[3] = bflo(r0.y); u[4] = bfhi(r0.y); u[5] = bflo(r0.z); u[6] = bfhi(r0.z); u[7] = bflo(r0.w); u[8] = bfhi(r0.w);
    u[9] = bflo(r1.x); u[10] = bfhi(r1.x); u[11] = bflo(r1.y); u[12] = bfhi(r1.y); u[13] = bflo(r1.z); u[14] = bfhi(r1.z); u[15] = bflo(r1.w); u[16] = bfhi(r1.w);
#pragma unroll
    for (int e = 0; e < 16; ++e) out[e] = bias + w0 * u[e] + w1 * u[e + 1] + w2 * u[e + 2];
}
__device__ __forceinline__ void store16_bf16(bf16* dst, const float (&v)[16]) {
    v4u o0, o1; o0.x = pk2(v[0], v[1]); o0.y = pk2(v[2], v[3]); o0.z = pk2(v[4], v[5]); o0.w = pk2(v[6], v[7]);
    o1.x = pk2(v[8], v[9]); o1.y = pk2(v[10], v[11]); o1.z = pk2(v[12], v[13]); o1.w = pk2(v[14], v[15]);
    *(v4u*)dst = o0; *(v4u*)(dst + 8) = o1;
}
__device__ __forceinline__ void hyena_unit(const HyArgs& a, LAS unsigned char* ldsb_, int cp, int wgslot, int tid) {
    unsigned lzero; asm volatile("v_mov_b32 %0, 0" : "=v"(lzero));
    LAS unsigned char* ldsb = ldsb_ + lzero;
    LAS f32x2* lds = (LAS f32x2*)ldsb;
    LAS f32x4* w4s = (LAS f32x4*)(ldsb + HY_W4_OFF);
    const int c0 = 2 * cp, c1 = c0 + 1;
    f32x2* zk = a.zk + (size_t)wgslot * 2 * FFT_N;
    constexpr float MIN_DECAY = -3.0701134573253945f, MAX_DECAY = -15.350567286626973f;
    const float ad0 = fabsf(MIN_DECAY + (float)c0 * ((MAX_DECAY - MIN_DECAY) / (float)(DHY - 1)));
    const float ad1 = fabsf(MIN_DECAY + (float)c1 * ((MAX_DECAY - MIN_DECAY) / (float)(DHY - 1)));
    LAS float* prm = (LAS float*)(ldsb + HY_PRM_OFF);
    __syncthreads();
    if (tid < 24) { const int k = tid & 3, sc = tid >> 2, st = sc >> 1, chn = st * DHY + c0 + (sc & 1); prm[tid] = k < 3 ? a.conv_w[k * 6144 + chn] : a.conv_b[chn]; }
    if (tid >= 32 && tid < 36) { const int j = tid - 32; prm[tid] = a.hy_bias[(j >> 1) * DHY + c0 + (j & 1)]; }
#pragma unroll 1
    for (int o = 0; o < 2; ++o) {
        int tq = tid; asm volatile("" : "+v"(tq)); const int t0 = 16 * tq;
        __syncthreads();
        if (tq < 64) w4s[tq] = (f32x4){a.w4[(size_t)tq * 8192 + o * 4096 + c0], a.w4[(size_t)tq * 8192 + o * 4096 + c1],
                                         a.w4[(size_t)tq * 8192 + o * 4096 + 2048 + c0], a.w4[(size_t)tq * 8192 + o * 4096 + 2048 + c1]};
        __syncthreads();
        {
            f32x4 acc[16];
#pragma unroll
            for (int e = 0; e < 16; ++e) acc[e] = (f32x4){0.f, 0.f, 0.f, 0.f};
            const f32x4* hr = (const f32x4*)(a.h3 + (size_t)t0 * 64);
#pragma unroll 1
            for (int j4 = 0; j4 < 16; ++j4) {
                const f32x4 wA = w4s[4 * j4 + 0], wB = w4s[4 * j4 + 1], wC = w4s[4 * j4 + 2], wD = w4s[4 * j4 + 3];
#pragma unroll
                for (int e = 0; e < 16; ++e) { const f32x4 hv = hr[e * 16 + j4]; acc[e] += hv.x * wA; acc[e] += hv.y * wB; acc[e] += hv.z * wC; acc[e] += hv.w * wD; }
            }
#pragma unroll
            for (int e = 0; e < 16; ++e) {
                const int n = t0 + e;
                const float tn = (float)n * (1.0f / (float)(SEQL - 1));
                const float d0 = __expf(-tn * ad0), d1 = __expf(-tn * ad1);
                lds[PH(n)] = (f32x2){acc[e].x * d0, acc[e].y * d1};
                if (n >= 1) lds[PH(FFT_N - n)] = (f32x2){acc[e].z * d0, acc[e].w * d1};
                else lds[PH(SEQL)] = (f32x2){0.f, 0.f};
            }
        }
        __syncthreads();
        fft16k(lds, a.tw, tid);
#pragma unroll 4
        for (int i = 0; i < 32; ++i) zk[(size_t)o * FFT_N + tq + 512 * i] = lds[PH(tq + 512 * i)];
    }
    const float inv_n = 1.0f / (float)FFT_N;
    asm volatile("s_waitcnt vmcnt(0)" ::: "memory");
    __syncthreads();
#pragma unroll 1
    for (int s = 0; s < NSEQ; ++s) {
        const size_t m0 = (size_t)s * SEQL;
        int tq = tid; asm volatile("" : "+v"(tq)); const int t0 = 16 * tq;
        {
            float v0[16], v1[16];
            load_conv3_16(a.phy + (size_t)(0 * DHY + c0) * NTOK + m0, t0, prm[0], prm[1], prm[2], prm[3], v0);
            load_conv3_16(a.phy + (size_t)(0 * DHY + c1) * NTOK + m0, t0, prm[4], prm[5], prm[6], prm[7], v1);
            __syncthreads();
#pragma unroll
            for (int e = 0; e < 16; ++e) { lds[PH(t0 + e)] = (f32x2){v0[e], v1[e]}; lds[PH(SEQL + t0 + e)] = (f32x2){0.f, 0.f}; }
        }
        __syncthreads();
        fft16k(lds, a.tw, tid);
        spec_mul(lds, zk, tid);
        fft16k(lds, a.tw, tid);
        float z0[16], z1[16];
        {
            float x0[16], x1[16];
            load_conv3_16(a.phy + (size_t)(0 * DHY + c0) * NTOK + m0, t0, prm[0], prm[1], prm[2], prm[3], x0);
            load_conv3_16(a.phy + (size_t)(0 * DHY + c1) * NTOK + m0, t0, prm[4], prm[5], prm[6], prm[7], x1);
#pragma unroll
            for (int e = 0; e < 16; ++e) { const f32x2 r = lds[PH(t0 + e)]; z0[e] = r.x * inv_n + prm[32] * x0[e]; z1[e] = -r.y * inv_n + prm[33] * x1[e]; }
            load_conv3_16(a.phy + (size_t)(1 * DHY + c0) * NTOK + m0, t0, prm[8], prm[9], prm[10], prm[11], x0);
            load_conv3_16(a.phy + (size_t)(1 * DHY + c1) * NTOK + m0, t0, prm[12], prm[13], prm[14], prm[15], x1);
#pragma unroll
            for (int e = 0; e < 16; ++e) { z0[e] *= x0[e]; z1[e] *= x1[e]; }
        }
#pragma unroll
        for (int e = 0; e < 16; ++e) { lds[PH(t0 + e)] = (f32x2){z0[e], z1[e]}; lds[PH(SEQL + t0 + e)] = (f32x2){0.f, 0.f}; }
        __syncthreads();
        fft16k(lds, a.tw, tid);
        spec_mul(lds, zk + FFT_N, tid);
        fft16k(lds, a.tw, tid);
        {
            float x0[16], x1[16];
            load_conv3_16(a.phy + (size_t)(2 * DHY + c0) * NTOK + m0, t0, prm[16], prm[17], prm[18], prm[19], x0);
            load_conv3_16(a.phy + (size_t)(2 * DHY + c1) * NTOK + m0, t0, prm[20], prm[21], prm[22], prm[23], x1);
#pragma unroll
            for (int e = 0; e < 16; ++e) { const f32x2 r = lds[PH(t0 + e)];
                x0[e] = x0[e] * (r.x * inv_n + prm[34] * z0[e]); x1[e] = x1[e] * (-r.y * inv_n + prm[35] * z1[e]); }
            store16_bf16(a.hyy + (size_t)c0 * NTOK + m0 + t0, x0);
            store16_bf16(a.hyy + (size_t)c1 * NTOK + m0 + t0, x1);
        }
    }
}
constexpr int RG_T = 128, RG_NT = SEQL / RG_T;
constexpr int RG_XC_STRIDE = 272;
constexpr int RG_HF_OFF = RG_T * RG_XC_STRIDE;
constexpr int RG_LDS_BYTES = RG_HF_OFF + (RG_T / 4) * 512 * 4;
constexpr int RG_UNITS = NSEQ * RG_NT * NHEAD;
struct RgArgs {
    const bf16* prg;
    const float *conv_w, *conv_b;
    const bf16* rgw;
    const float *a_b, *x_b;
    const float* lam;
    f32x2* summ;
    bf16* rgy;
};
template <int PASS> __device__ __forceinline__ void rg_unit(const RgArgs& a, LAS unsigned char* lds, int unit, int tid) {
    const int wave = tid >> 6, lane = tid & 63, fr = lane & 15, fq = lane >> 4;
    const int h = unit % NHEAD, tt = (unit / NHEAD) % RG_NT, s = unit / (NHEAD * RG_NT);
    const int tok0 = tt * RG_T;
    const size_t mrow0 = (size_t)s * SEQL;
    __syncthreads();
    {
        const int cg = h * HDIM + 2 * lane;
        float w0[4], w1[4];
#pragma unroll
        for (int k = 0; k < 4; ++k) { w0[k] = a.conv_w[k * DRG + cg]; w1[k] = a.conv_w[k * DRG + cg + 1]; }
        const float cb0 = a.conv_b[cg], cb1 = a.conv_b[cg + 1];
        float x0[4], x1[4];
        const int tb = tok0 + 16 * wave;
#pragma unroll
        for (int k = 0; k < 3; ++k) { const int t = tb - 2 + k; unsigned u = 0u; if (t >= 0 && t < SEQL) u = *(const unsigned*)(a.prg + (mrow0 + t) * DM + cg); x0[k] = bflo(u); x1[k] = bfhi(u); }
#pragma unroll
        for (int i = 0; i < 16; ++i) {
            const int t = tb + i + 1; unsigned u = 0u; if (t < SEQL) u = *(const unsigned*)(a.prg + (mrow0 + t) * DM + cg);
            x0[3] = bflo(u); x1[3] = bfhi(u);
            const float y0 = cb0 + w0[0] * x0[0] + w0[1] * x0[1] + w0[2] * x0[2] + w0[3] * x0[3];
            const float y1 = cb1 + w1[0] * x1[0] + w1[1] * x1[1] + w1[2] * x1[2] + w1[3] * x1[3];
            *(LAS unsigned*)(lds + (16 * wave + i) * RG_XC_STRIDE + lane * 4) = pk2(y0, y1);
            x0[0] = x0[1]; x0[1] = x0[2]; x0[2] = x0[3]; x1[0] = x1[1]; x1[1] = x1[2]; x1[2] = x1[3];
        }
    }
    __syncthreads();
    const int ch = h * HDIM + 16 * wave + fr;
    LAS float* hfl = (LAS float*)(lds + RG_HF_OFF) + tid;
#pragma unroll
    for (int dir = 0; dir < 2; ++dir) {
        bf16x8 Br[4], Bi[4];
#pragma unroll
        for (int kk = 0; kk < 4; ++kk) {
            Br[kk] = *(const bf16x8*)(a.rgw + ((((size_t)dir * 2 + 0) * NHEAD + h) * HDIM + 16 * wave + fr) * HDIM + 32 * kk + 8 * fq);
            Bi[kk] = *(const bf16x8*)(a.rgw + ((((size_t)dir * 2 + 1) * NHEAD + h) * HDIM + 16 * wave + fr) * HDIM + 32 * kk + 8 * fq);
        }
        const float ba = a.a_b[dir * DRG + ch], bx = a.x_b[dir * DRG + ch];
        const float sp = log1pf(expf(-a.lam[dir * DRG + ch]));
        float carry = 0.f, ptot = 1.f;
        if (PASS == 2) {
            const f32x2* sm = a.summ + ((size_t)dir * NSEQ + s) * RG_NT * DRG + ch;
            if (dir == 0) { for (int j = 0; j < tt; ++j) { const f32x2 pb = sm[(size_t)j * DRG]; carry = pb.x * carry + pb.y; } }
            else { for (int j = RG_NT - 1; j > tt; --j) { const f32x2 pb = sm[(size_t)j * DRG]; carry = pb.x * carry + pb.y; } }
        }
        for (int bi = 0; bi < RG_T / 16; ++bi) {
            const int blk = dir == 0 ? bi : (RG_T / 16 - 1 - bi);
            f32x4 accR = (f32x4){0.f, 0.f, 0.f, 0.f}, accI = (f32x4){0.f, 0.f, 0.f, 0.f};
#pragma unroll
            for (int kk = 0; kk < 4; ++kk) {
                const bf16x8 af = *(const LAS bf16x8*)(lds + (16 * blk + fr) * RG_XC_STRIDE + (32 * kk + 8 * fq) * 2);
                accR = __builtin_amdgcn_mfma_f32_16x16x32_bf16(af, Br[kk], accR, 0, 0, 0);
                accI = __builtin_amdgcn_mfma_f32_16x16x32_bf16(af, Bi[kk], accI, 0, 0, 0);
            }
            float av[4], bv[4];
#pragma unroll
            for (int e = 0; e < 4; ++e) {
                const float r = sigmoidf_(accR[e] + ba), ig = sigmoidf_(accI[e] + bx);
                const float log_a = -8.0f * r * sp;
                av[e] = __expf(log_a);
                const float mult = sqrtf(fmaxf(-expm1f(2.0f * log_a), 0.f));
                const float xcv = bf2f(*(const LAS unsigned short*)(lds + (16 * blk + 4 * fq + e) * RG_XC_STRIDE + (16 * wave + fr) * 2));
                bv[e] = mult * ig * xcv;
            }
            float A = 1.f, B = 0.f;
            if (dir == 0) {
#pragma unroll
                for (int e = 0; e < 4; ++e) { B = av[e] * B + bv[e]; A *= av[e]; }
            } else {
#pragma unroll
                for (int e = 3; e >= 0; --e) { B = av[e] * B + bv[e]; A *= av[e]; }
            }
            float hin;
            if (dir == 0) {
                float Ap = __shfl_up(A, 16), Bp = __shfl_up(B, 16);
                if (fq >= 1) { B = A * Bp + B; A = Ap * A; }
                Ap = __shfl_up(A, 32); Bp = __shfl_up(B, 32);
                if (fq >= 2) { B = A * Bp + B; A = Ap * A; }
                const float hend = A * carry + B;
                const float hprev = __shfl_up(hend, 16);
                hin = fq == 0 ? carry : hprev;
                carry = __shfl(hend, 48 + fr);
                if (PASS == 1) ptot *= __shfl(A, 48 + fr);
            } else {
                float Ap = __shfl_down(A, 16), Bp = __shfl_down(B, 16);
                if (fq <= 2) { B = A * Bp + B; A = Ap * A; }
                Ap = __shfl_down(A, 32); Bp = __shfl_down(B, 32);
                if (fq <= 1) { B = A * Bp + B; A = Ap * A; }
                const float hend = A * carry + B;
                const float hprev = __shfl_down(hend, 16);
                hin = fq == 3 ? carry : hprev;
                carry = __shfl(hend, fr);
                if (PASS == 1) ptot *= __shfl(A, fr);
            }
            if (PASS == 2) {
                if (dir == 0) {
                    float hh = hin;
#pragma unroll
                    for (int e = 0; e < 4; ++e) { hh = av[e] * hh + bv[e]; hfl[(blk * 4 + e) * 512] = hh; }
                } else {
                    float hh = hin, hb[4];
#pragma unroll
                    for (int e = 3; e >= 0; --e) { hh = av[e] * hh + bv[e]; hb[e] = hh; }
#pragma unroll
                    for (int e = 0; e < 4; ++e) {
                        const size_t m = mrow0 + tok0 + 16 * blk + 4 * fq + e;
                        const float g = bf2f(a.prg[m * DM + DRG + ch]);
                        a.rgy[m * DRG + ch] = (bf16)f2bf((hfl[(blk * 4 + e) * 512] + hb[e]) * gelu_tanh(g));
                    }
                }
            }
        }
        if (PASS == 1 && fq == 0) a.summ[(((size_t)dir * NSEQ + s) * RG_NT + tt) * DRG + ch] = (f32x2){ptot, carry};
    }
}
__device__ __forceinline__ void mixnorm_rg_row(const bf16* rgy, const float* g_rg, bf16* mix, int m, int lane) {
    v4u r[4]; float s = 0.f;
#pragma unroll
    for (int j = 0; j < 4; ++j) { r[j] = *(const v4u*)(rgy + (size_t)m * DRG + (j * 64 + lane) * 8);
        const float a0 = bflo(r[j].x), a1 = bfhi(r[j].x), a2 = bflo(r[j].y), a3 = bfhi(r[j].y), a4 = bflo(r[j].z), a5 = bfhi(r[j].z), a6 = bflo(r[j].w), a7 = bfhi(r[j].w);
        s += (a0 * a0 + a1 * a1) + (a2 * a2 + a3 * a3) + (a4 * a4 + a5 * a5) + (a6 * a6 + a7 * a7); }
    const float rs = 1.0f / sqrtf(wave_sum(s) * (1.0f / DRG) + EPSN);
#pragma unroll
    for (int j = 0; j < 4; ++j) { const int c0 = (j * 64 + lane) * 8; const f32x4 g0 = *(const f32x4*)(g_rg + c0), g1 = *(const f32x4*)(g_rg + c0 + 4);
        v4u o; o.x = pk2(bflo(r[j].x) * rs * g0.x, bfhi(r[j].x) * rs * g0.y); o.y = pk2(bflo(r[j].y) * rs * g0.z, bfhi(r[j].y) * rs * g0.w);
        o.z = pk2(bflo(r[j].z) * rs * g1.x, bfhi(r[j].z) * rs * g1.y); o.w = pk2(bflo(r[j].w) * rs * g1.z, bfhi(r[j].w) * rs * g1.w);
        *(v4u*)(mix + (size_t)m * DM + c0) = o; }
}
constexpr int MN_TILE_STRIDE = 66;
constexpr int MN_LDS_BYTES = 8 * 64 * MN_TILE_STRIDE * 2 + 8 * 64 * 4 + 64 * 4;
__device__ __forceinline__ void mixnorm_hy_tile(const bf16* hyy, const float* g_hy, bf16* mix, LAS unsigned char* lds, int tile, int tid) {
    const int wave = tid >> 6, lane = tid & 63, m0 = tile * 64;
    LAS unsigned short* tl = (LAS unsigned short*)(lds + wave * 64 * MN_TILE_STRIDE * 2);
    LAS float* part = (LAS float*)(lds + 8 * 64 * MN_TILE_STRIDE * 2);
    LAS float* scl = part + 8 * 64;
    __syncthreads();
    float s = 0.f;
    for (int c = wave * 256; c < wave * 256 + 256; ++c) { const float v = bf2f(hyy[(size_t)c * NTOK + m0 + lane]); s += v * v; }
    part[wave * 64 + lane] = s;
    __syncthreads();
    if (tid < 64) { float t = 0.f;
#pragma unroll
        for (int w = 0; w < 8; ++w) t += part[w * 64 + tid];
        scl[tid] = 1.0f / sqrtf(t * (1.0f / DHY) + EPSN); }
    __syncthreads();
    for (int cb = wave; cb < DHY / 64; cb += 8) {
        for (int ci = 0; ci < 64; ++ci) tl[ci * MN_TILE_STRIDE + lane] = hyy[(size_t)(cb * 64 + ci) * NTOK + m0 + lane];
        asm volatile("s_waitcnt lgkmcnt(0)" ::: "memory");
        const float g = g_hy[cb * 64 + lane];
        for (int tk = 0; tk < 64; ++tk) mix[(size_t)(m0 + tk) * DM + DRG + cb * 64 + lane] = (bf16)f2bf(bf2f(tl[lane * MN_TILE_STRIDE + tk]) * scl[tk] * g);
        asm volatile("s_waitcnt lgkmcnt(0)" ::: "memory");
    }
}
__device__ __forceinline__ void rowpass1(const float* xr, const bf16* yr, const float* g_post, const float* g_pre, float* outr, bf16* xnr, int lane) {
    float v[64]; float s = 0.f;
#pragma unroll
    for (int j = 0; j < 8; ++j) { const v4u r = *(const v4u*)(yr + (j * 64 + lane) * 8);
        v[8 * j + 0] = bflo(r.x); v[8 * j + 1] = bfhi(r.x); v[8 * j + 2] = bflo(r.y); v[8 * j + 3] = bfhi(r.y); v[8 * j + 4] = bflo(r.z); v[8 * j + 5] = bfhi(r.z); v[8 * j + 6] = bflo(r.w); v[8 * j + 7] = bfhi(r.w);
#pragma unroll
        for (int e = 0; e < 8; ++e) s += v[8 * j + e] * v[8 * j + e]; }
    const float rs = 1.0f / sqrtf(wave_sum(s) * (1.0f / DM) + EPSN);
    float s2 = 0.f;
#pragma unroll
    for (int j = 0; j < 8; ++j) { const int c0 = (j * 64 + lane) * 8;
        const f32x4 x0 = *(const f32x4*)(xr + c0), x1 = *(const f32x4*)(xr + c0 + 4), g0 = *(const f32x4*)(g_post + c0), g1 = *(const f32x4*)(g_post + c0 + 4);
        f32x4 o0, o1;
        o0.x = x0.x + v[8 * j + 0] * rs * g0.x; o0.y = x0.y + v[8 * j + 1] * rs * g0.y; o0.z = x0.z + v[8 * j + 2] * rs * g0.z; o0.w = x0.w + v[8 * j + 3] * rs * g0.w;
        o1.x = x1.x + v[8 * j + 4] * rs * g1.x; o1.y = x1.y + v[8 * j + 5] * rs * g1.y; o1.z = x1.z + v[8 * j + 6] * rs * g1.z; o1.w = x1.w + v[8 * j + 7] * rs * g1.w;
        *(f32x4*)(outr + c0) = o0; *(f32x4*)(outr + c0 + 4) = o1;
        v[8 * j + 0] = o0.x; v[8 * j + 1] = o0.y; v[8 * j + 2] = o0.z; v[8 * j + 3] = o0.w; v[8 * j + 4] = o1.x; v[8 * j + 5] = o1.y; v[8 * j + 6] = o1.z; v[8 * j + 7] = o1.w;
        s2 += (o0.x * o0.x + o0.y * o0.y) + (o0.z * o0.z + o0.w * o0.w) + (o1.x * o1.x + o1.y * o1.y) + (o1.z * o1.z + o1.w * o1.w); }
    const float rs2 = 1.0f / sqrtf(wave_sum(s2) * (1.0f / DM) + EPSN);
#pragma unroll
    for (int j = 0; j < 8; ++j) { const int c0 = (j * 64 + lane) * 8; const f32x4 g0 = *(const f32x4*)(g_pre + c0), g1 = *(const f32x4*)(g_pre + c0 + 4);
        v4u o; o.x = pk2(v[8 * j + 0] * rs2 * g0.x, v[8 * j + 1] * rs2 * g0.y); o.y = pk2(v[8 * j + 2] * rs2 * g0.z, v[8 * j + 3] * rs2 * g0.w);
        o.z = pk2(v[8 * j + 4] * rs2 * g1.x, v[8 * j + 5] * rs2 * g1.y); o.w = pk2(v[8 * j + 6] * rs2 * g1.z, v[8 * j + 7] * rs2 * g1.w);
        *(v4u*)(xnr + c0) = o; }
}
__device__ __forceinline__ void rowpass2(const bf16* fr_, const float* g, float* outr, int lane) {
    float v[64]; float s = 0.f;
#pragma unroll
    for (int j = 0; j < 8; ++j) { const v4u r = *(const v4u*)(fr_ + (j * 64 + lane) * 8);
        v[8 * j + 0] = bflo(r.x); v[8 * j + 1] = bfhi(r.x); v[8 * j + 2] = bflo(r.y); v[8 * j + 3] = bfhi(r.y); v[8 * j + 4] = bflo(r.z); v[8 * j + 5] = bfhi(r.z); v[8 * j + 6] = bflo(r.w); v[8 * j + 7] = bfhi(r.w);
#pragma unroll
        for (int e = 0; e < 8; ++e) s += v[8 * j + e] * v[8 * j + e]; }
    const float rs = 1.0f / sqrtf(wave_sum(s) * (1.0f / DM) + EPSN);
#pragma unroll
    for (int j = 0; j < 8; ++j) { const int c0 = (j * 64 + lane) * 8;
        const f32x4 x0 = *(const f32x4*)(outr + c0), x1 = *(const f32x4*)(outr + c0 + 4), g0 = *(const f32x4*)(g + c0), g1 = *(const f32x4*)(g + c0 + 4);
        f32x4 o0, o1;
        o0.x = x0.x + v[8 * j + 0] * rs * g0.x; o0.y = x0.y + v[8 * j + 1] * rs * g0.y; o0.z = x0.z + v[8 * j + 2] * rs * g0.z; o0.w = x0.w + v[8 * j + 3] * rs * g0.w;
        o1.x = x1.x + v[8 * j + 4] * rs * g1.x; o1.y = x1.y + v[8 * j + 5] * rs * g1.y; o1.z = x1.z + v[8 * j + 6] * rs * g1.z; o1.w = x1.w + v[8 * j + 7] * rs * g1.w;
        *(f32x4*)(outr + c0) = o0; *(f32x4*)(outr + c0 + 4) = o1; }
}
constexpr int LDS_PHASE_BYTES = 143360;
constexpr int LDSCTL_OFF = LDS_PHASE_BYTES, LDS_BYTES = 147456;
constexpr int CW_BAR = 4096;
constexpr size_t CTL_ZERO_BYTES = 64 * 1024;
static_assert(HY_LDS_BYTES <= LDS_PHASE_BYTES && RG_LDS_BYTES <= LDS_PHASE_BYTES && MN_LDS_BYTES <= LDS_PHASE_BYTES && pg8::STAGE_BYTES <= LDS_PHASE_BYTES, "LDS map");
static_assert((CW_BAR + XCD_BAR_WORDS) * 4 <= (int)CTL_ZERO_BYTES, "control words inside the memset region");

struct MkArgs { const float* in[32]; float* out; unsigned char* ws; };
__device__ __forceinline__ pg8::Gemm dgemm(const bf16* A, const bf16* Bt, int M, int N, int K) { pg8::Gemm g; g.A = A; g.Bt = Bt; g.M = M; g.N = N; g.K = K; return g; }
__device__ __forceinline__ pg8::EpiBf16<0> depi(bf16* O, int ldc) { pg8::EpiBf16<0> e; e.O = O; e.ldc = ldc; e.bias = nullptr; e.split_cols = 0; e.split_stride = 0; e.scale0 = 1.f; return e; }

__device__ __forceinline__ void gate_seq(const bf16* gu, const float* cw, const float* cb, bf16* h, int gtid, int nthreads) {
    constexpr int CG = DFF / 8;
    for (int idx = gtid; idx < SEQL * CG; idx += nthreads) {
        const int m = idx / CG, c0 = (idx % CG) * 8;
        const v4u z = (v4u){0u, 0u, 0u, 0u};
        const v4u gm = m > 0 ? *(const v4u*)(gu + (size_t)(m - 1) * 2 * DFF + c0) : z;
        const v4u g0 = *(const v4u*)(gu + (size_t)m * 2 * DFF + c0);
        const v4u gp = m < SEQL - 1 ? *(const v4u*)(gu + (size_t)(m + 1) * 2 * DFF + c0) : z;
        const v4u uu = *(const v4u*)(gu + (size_t)m * 2 * DFF + DFF + c0);
        float r[8];
#pragma unroll
        for (int e = 0; e < 8; ++e) {
            const unsigned wm = e < 2 ? gm.x : e < 4 ? gm.y : e < 6 ? gm.z : gm.w, w0 = e < 2 ? g0.x : e < 4 ? g0.y : e < 6 ? g0.z : g0.w, wp = e < 2 ? gp.x : e < 4 ? gp.y : e < 6 ? gp.z : gp.w, wu = e < 2 ? uu.x : e < 4 ? uu.y : e < 6 ? uu.z : uu.w;
            const float a = (e & 1) ? bfhi(wm) : bflo(wm), b = (e & 1) ? bfhi(w0) : bflo(w0), c = (e & 1) ? bfhi(wp) : bflo(wp), u = (e & 1) ? bfhi(wu) : bflo(wu);
            const float pre = cb[c0 + e] + cw[c0 + e] * a + cw[DFF + c0 + e] * b + cw[2 * DFF + c0 + e] * c;
            r[e] = gelu_tanh(pre) * u;
        }
        v4u o; o.x = pk2(r[0], r[1]); o.y = pk2(r[2], r[3]); o.z = pk2(r[4], r[5]); o.w = pk2(r[6], r[7]);
        *(v4u*)(h + (size_t)m * DFF + c0) = o;
    }
}

__global__ void __launch_bounds__(512, 2) mk_fwd(MkArgs args) {
    extern __shared__ __attribute__((aligned(16))) unsigned char lds_raw[];
    LAS unsigned char* lds = (LAS unsigned char*)lds_raw;
    const int tid = threadIdx.x, lane = tid & 63, wave = __builtin_amdgcn_readfirstlane(tid >> 6);
    const int G = gridDim.x, bx = blockIdx.x;
    unsigned char* ws = args.ws;
    const float* const* in = args.in;
    volatile LAS unsigned* MISC = (volatile LAS unsigned*)(lds + LDSCTL_OFF);
    for (int u = tid; u < (LDS_BYTES - LDSCTL_OFF) / 4; u += 512) ((LAS unsigned*)(lds + LDSCTL_OFF))[u] = 0u;
    __syncthreads();
    XcdBarrier bar = xcd_barrier_post((unsigned*)(ws + WS_CTL) + CW_BAR, MISC + 8);

    bf16* XN = (bf16*)(ws + WS_XN); bf16* WIN = (bf16*)(ws + WS_WIN);
    {
        ProArgs pa; pa.xp = in[0]; pa.xs = in[1]; pa.g_premix = in[2]; pa.w_in = in[3]; pa.w_out = in[24]; pa.w_ffi = in[27]; pa.w_ffo = in[30]; pa.rg_a_w = in[6]; pa.rg_x_w = in[8];
        pa.hy_w1 = in[13]; pa.hy_b1 = in[14]; pa.hy_w2 = in[15]; pa.hy_b2 = in[16]; pa.hy_w3 = in[17]; pa.hy_b3 = in[18]; pa.hy_freq = in[20]; pa.ws = ws;
        p0_prologue<false>(pa, lds, bx * 8 + wave, G * 8, wave, lane);
    }
    xcd_barrier(bar);
    {
        pg8::StaticOrder S; S.init(NTOK, 2 * DRG, G, bx);
        pg8::gemm_phase<pg8::EpiBf16<0>, pg8::StaticOrder, true, true>(lds, dgemm(XN, WIN, NTOK, 2 * DRG, DM), S, depi((bf16*)(ws + WS_PRG), 2 * DRG));
    }
    {
        pg8::StaticOrder S; S.init(3 * DHY, NTOK, G, bx);
        pg8::gemm_phase<pg8::EpiBf16<0>, pg8::StaticOrder, true, true>(lds, dgemm(WIN + (size_t)2 * DRG * DM, XN, 3 * DHY, NTOK, DM), S, depi((bf16*)(ws + WS_PHY), NTOK));
    }
    xcd_barrier(bar);
    RgArgs ra; ra.prg = (const bf16*)(ws + WS_PRG); ra.conv_w = in[4]; ra.conv_b = in[5]; ra.rgw = (const bf16*)(ws + WS_RGW); ra.a_b = in[7]; ra.x_b = in[9]; ra.lam = in[10];
    ra.summ = (f32x2*)(ws + WS_SUMM); ra.rgy = (bf16*)(ws + WS_RGY);
    {
        HyArgs a; a.phy = (const bf16*)(ws + WS_PHY); a.conv_w = in[11]; a.conv_b = in[12]; a.w4 = in[19]; a.hy_bias = in[21]; a.h3 = (const float*)(ws + WS_H3); a.tw = (const f32x2*)(ws + WS_TW);
        a.zk = (f32x2*)(ws + WS_ZK); a.hyy = (bf16*)(ws + WS_HYY);
        for (int cp = bx; cp < DHY / 2; cp += G) hyena_unit(a, lds, cp, bx, tid);
    }
    for (int u = bx; u < RG_UNITS; u += G) rg_unit<1>(ra, lds, u, tid);
    xcd_barrier(bar);
    for (int u = bx; u < RG_UNITS; u += G) rg_unit<2>(ra, lds, u, tid);
    xcd_barrier(bar);
    for (int m = bx * 8 + wave; m < NTOK; m += G * 8) mixnorm_rg_row((const bf16*)(ws + WS_RGY), in[22], (bf16*)(ws + WS_MIX), m, lane);
    for (int t = bx; t < NTOK / 64; t += G) mixnorm_hy_tile((const bf16*)(ws + WS_HYY), in[23], (bf16*)(ws + WS_MIX), lds, t, tid);
    xcd_barrier(bar);
    {
        pg8::StaticOrder S; S.init(NTOK, DM, G, bx);
        pg8::gemm_phase<pg8::EpiBf16<0>, pg8::StaticOrder, true, true>(lds, dgemm((bf16*)(ws + WS_MIX), (bf16*)(ws + WS_WOUT), NTOK, DM, DM), S, depi((bf16*)(ws + WS_Y), DM));
    }
    xcd_barrier(bar);
    for (int m = bx * 8 + wave; m < NTOK; m += G * 8) rowpass1(xrow_ptr(in[0], in[1], m), (const bf16*)(ws + WS_Y) + (size_t)m * DM, in[25], in[26], args.out + (size_t)m * DM, XN + (size_t)m * DM, lane);
    xcd_barrier(bar);
    bf16* GU = (bf16*)(ws + WS_PHY);
    bf16* HS = (bf16*)(ws + WS_PHY + (size_t)344 * MiB);
#pragma unroll 1
    for (int s = 0; s < NSEQ; ++s) {
        {
            pg8::StaticOrder S; S.init(SEQL, 2 * DFF, G, bx);
            pg8::gemm_phase<pg8::EpiBf16<0>, pg8::StaticOrder, true, true>(lds, dgemm(XN + (size_t)s * SEQL * DM, (bf16*)(ws + WS_WFI), SEQL, 2 * DFF, DM), S, depi(GU, 2 * DFF));
        }
        xcd_barrier(bar);
        { int tq = tid; asm volatile("" : "+v"(tq)); gate_seq(GU, in[28], in[29], HS, bx * 512 + tq, G * 512); }
        xcd_barrier(bar);
        {
            pg8::StaticOrder S; S.init(SEQL, DM, G, bx);
            pg8::gemm_phase<pg8::EpiBf16<0>, pg8::StaticOrder, true, true>(lds, dgemm(HS, (bf16*)(ws + WS_WFO), SEQL, DM, DFF), S, depi((bf16*)(ws + WS_F) + (size_t)s * SEQL * DM, DM));
        }
        xcd_barrier(bar);
    }
    for (int m = bx * 8 + wave; m < NTOK; m += G * 8) rowpass2((const bf16*)(ws + WS_F) + (size_t)m * DM, in[31], args.out + (size_t)m * DM, lane);
}

extern "C" void kernel_launch(void* const* d_in, const int* in_sizes, int n_in, void* d_out, int out_size, void* d_ws, size_t ws_size, hipStream_t stream) {
    static int grid = 0;
    if (grid == 0) {
        grid = -1;
        if (n_in != 32 || out_size != NTOK * DM || ws_size < WS_END) { fprintf(stderr, "kernel_launch: unexpected sizes n_in %d out %d ws %zu (need %zu)\n", n_in, out_size, ws_size, (size_t)WS_END); return; }
        int dev = 0, cus = 0, per_cu = 0;
        if (hipGetDevice(&dev) != hipSuccess || hipDeviceGetAttribute(&cus, hipDeviceAttributeMultiprocessorCount, dev) != hipSuccess) return;
        if (hipFuncSetAttribute((const void*)mk_fwd, hipFuncAttributeMaxDynamicSharedMemorySize, LDS_BYTES) != hipSuccess) { fprintf(stderr, "kernel_launch: hipFuncSetAttribute failed\n"); return; }
        if (hipOccupancyMaxActiveBlocksPerMultiprocessor(&per_cu, (const void*)mk_fwd, 512, LDS_BYTES) != hipSuccess || per_cu < 1) { fprintf(stderr, "kernel_launch: occupancy query says %d blocks per CU\n", per_cu); (void)hipGetLastError(); return; }
        grid = cus;
    }
    if (grid < 0) return;
    if (hipMemsetAsync((char*)d_ws + WS_CTL, 0, CTL_ZERO_BYTES, stream) != hipSuccess) return;
    MkArgs a; memset(&a, 0, sizeof a);
    for (int i = 0; i < 32; ++i) a.in[i] = (const float*)d_in[i];
    a.out = (float*)d_out; a.ws = (unsigned char*)d_ws;
    hipLaunchKernelGGL(mk_fwd, dim3(grid), dim3(512), LDS_BYTES, stream, a);
}
```

```cpp
#include <cstring>
#include <hip/hip_runtime.h>
#include <cstdio>
#include <cstdint>
namespace pg8 {
#define PG8_LAS __attribute__((address_space(3)))
typedef unsigned short bf16_t;
typedef short bf16x8 __attribute__((ext_vector_type(8)));
typedef float f32x4 __attribute__((ext_vector_type(4)));
typedef unsigned u32x4 __attribute__((ext_vector_type(4)));
constexpr int BM = 256, BK = 64, HALF = 128, HTB = HALF * BK * 2  , STAGE_BYTES = 8 * HTB, NXCD = 8, WGM = 8;

__host__ __device__ __forceinline__ int lds_byte(int r, int c) { const int st = (r >> 4) * 2 + (c >> 5), rr = r & 15, cc = c & 31, ob = rr * 64 + cc * 2; return st * 1024 + (ob ^ (((ob >> 9) & 1) << 5)); }
__host__ __device__ __forceinline__ void stage_rc(int b, int& R, int& C) { const int st = b / 1024, sb = b % 1024, swz = sb ^ (((sb >> 9) & 1) << 5); R = (st >> 1) * 16 + swz / 64; C = (st & 1) * 32 + (swz % 64) / 2; }
__host__ __device__ __forceinline__ int perm32(int rho) { const int n = rho >> 4, i = rho & 15; return 8 * (i >> 2) + 4 * n + (i & 3); }

struct Unit { int pm, pn; };
struct Gemm { const bf16_t* A; const bf16_t* Bt; int M, N, K; };

struct StaticOrder {
    int nM, nN, nwg, G, c;
    __host__ __device__ void init(int M, int N, int G_, int c_) { nM = M / BM; nN = N / BM; nwg = nM * nN; G = G_; c = c_; }
    __host__ __device__ bool next(int i, Unit& u) const {
        const long L = (long)i * G + c; if (L >= nwg) return false;
        int wgid = (int)L; { const int q = nwg / NXCD, r = nwg % NXCD, xcd = wgid % NXCD, off = wgid / NXCD; wgid = (xcd < r ? xcd * (q + 1) : r * (q + 1) + (xcd - r) * q) + off; }
        const int nig = WGM * nN, gid = wgid / nig, fm = gid * WGM, gsz = (nM - fm) < WGM ? (nM - fm) : WGM;
        u.pm = fm + ((wgid % nig) % gsz); u.pn = (wgid % nig) / gsz; return true;
    }
    __device__ __forceinline__ void a_ready(const Unit&) const {}
    __device__ __forceinline__ void done(const Unit&) const {}
};

__device__ __forceinline__ unsigned cvt_pk_bf16(float lo, float hi) { unsigned r; asm volatile("v_cvt_pk_bf16_f32 %0, %1, %2" : "=v"(r) : "v"(lo), "v"(hi)); return r; }
typedef float f32x2 __attribute__((ext_vector_type(2)));
__device__ __forceinline__ f32x2 gelu_pk(f32x2 v) {
    const f32x2 av = __builtin_elementwise_abs(v), d = av * 0.2316418882f + 1.0f;
    f32x2 t; t.x = __builtin_amdgcn_rcpf(d.x); t.y = __builtin_amdgcn_rcpf(d.y);
    f32x2 q = t * 0.5307027145f + (-0.7265760135f); q = q * t + 0.7107068705f; q = q * t + (-0.142248368f); q = q * t + 0.127414796f; q = q * t;
    const f32x2 s = (v * v) * (-0.72134752044f);
    f32x2 e; e.x = __builtin_amdgcn_exp2f(s.x); e.y = __builtin_amdgcn_exp2f(s.y);
    const f32x2 m = v * (q * e), r = v - m;
    f32x2 o; o.x = v.x < 0.f ? m.x : r.x; o.y = v.y < 0.f ? m.y : r.y; return o;
}

template <int ACT  > struct EpiBf16 {
    static constexpr bool PERM = true, AFTER_DRAIN = false; static_assert(ACT == 0 || ACT == 1, "EpiBf16: ACT is 0 (none) or 1 (gelu_pk)");
    bf16_t* O; int ldc; const float* bias; int split_cols; size_t split_stride; float scale0;
    __device__ __forceinline__ void operator()(const f32x4 (&acc)[2][2][4][2], const Unit& u, int wr, int wc, int fr, int fq) const {
        const int row0 = u.pm * BM + wr * 64 + fr; int colt = u.pn * BM; bf16_t* base = O;
        float sc = 1.f; if (split_cols) { const int t = colt / split_cols; base += (size_t)t * split_stride; colt -= t * split_cols; if (t == 0) sc = scale0; }
        const int col0 = colt + wc * 32 + 8 * fq, bcol0 = u.pn * BM + wc * 32 + 8 * fq;
        f32x4 bv[2][2];
#pragma unroll
        for (int bj = 0; bj < 2; ++bj)
#pragma unroll
            for (int n = 0; n < 2; ++n) bv[bj][n] = bias ? *(const f32x4*)(bias + bcol0 + bj * HALF + 4 * n) : (f32x4){0.f, 0.f, 0.f, 0.f};
#pragma unroll
        for (int ai = 0; ai < 2; ++ai)
#pragma unroll
            for (int m = 0; m < 4; ++m) { bf16_t* rowp = base + (size_t)(row0 + ai * HALF + m * 16) * ldc + col0;
#pragma unroll
                for (int bj = 0; bj < 2; ++bj) { f32x4 v0 = acc[ai][bj][m][0] + bv[bj][0], v1 = acc[ai][bj][m][1] + bv[bj][1];
                    if (ACT == 1) { f32x2 a = gelu_pk((f32x2){v0[0], v0[1]}), b = gelu_pk((f32x2){v0[2], v0[3]}), c = gelu_pk((f32x2){v1[0], v1[1]}), d = gelu_pk((f32x2){v1[2], v1[3]});
                        v0 = (f32x4){a.x, a.y, b.x, b.y}; v1 = (f32x4){c.x, c.y, d.x, d.y}; }
                    v0 = v0 * sc; v1 = v1 * sc; u32x4 w; w.x = cvt_pk_bf16(v0[0], v0[1]); w.y = cvt_pk_bf16(v0[2], v0[3]); w.z = cvt_pk_bf16(v1[0], v1[1]); w.w = cvt_pk_bf16(v1[2], v1[3]);
                    *(u32x4*)(rowp + bj * HALF) = w; } }
    }
};
template <class Epi, class Sched, bool ALIGN_EPI = false, bool SP2 = false>
__device__ __forceinline__ void gemm_phase(PG8_LAS unsigned char* lds, const Gemm g, const Sched& S, const Epi& E) {
    int tid_ = threadIdx.x; asm volatile("" : "+v"(tid_));
    const int tid = tid_, wid = __builtin_amdgcn_readfirstlane(tid >> 6), lane = tid & 63, wr = wid >> 2, wc = wid & 3, fr = lane & 15, fq = lane >> 4;
    const int K = g.K, nt = K / BK;
    unsigned voffA[2], voffB[2];
#pragma unroll
    for (int i = 0; i < 2; ++i) { int R, C; stage_rc(tid * 16 + i * 8192, R, C); const int Rb = Epi::PERM ? ((R & ~31) + perm32(R & 31)) : R;
        voffA[i] = (unsigned)(R * K + C) * 2u; voffB[i] = (unsigned)(Rb * K + C) * 2u; }
    const size_t kstep = (size_t)(BK * 2);
    const size_t hstep = (size_t)HALF * K * 2;
    const size_t tstep = 2 * hstep;
    const unsigned ldsw = (unsigned)wid * 1024u;
    const int aoff = lds_byte(wr * 64 + fr, fq * 8), boff = lds_byte(wc * 32 + fr, fq * 8);
#define PG8_SA(b, h) (((b) * 2 + (h)) * HTB)
#define PG8_SB(b, h) ((4 + (b) * 2 + (h)) * HTB)
#define PG8_STAGE(bufoff, gbase, voff) do { _Pragma("unroll") for (int _i = 0; _i < 2; ++_i) \
        __builtin_amdgcn_global_load_lds((const unsigned*)((const char*)(gbase) + (voff)[_i]), (PG8_LAS unsigned*)(lds + (bufoff) + ldsw + _i * 8192), 16, 0, 0); } while (0)
#define PG8_LDA(dst, b, h) do { _Pragma("unroll") for (int m = 0; m < 4; ++m) _Pragma("unroll") for (int k = 0; k < 2; ++k) dst[m][k] = *(const PG8_LAS bf16x8*)(lds + PG8_SA(b, h) + aoff + m * 2048 + k * 1024); } while (0)
#define PG8_LDB(dst, b, h) do { _Pragma("unroll") for (int n = 0; n < 2; ++n) _Pragma("unroll") for (int k = 0; k < 2; ++k) dst[n][k] = *(const PG8_LAS bf16x8*)(lds + PG8_SB(b, h) + boff + n * 2048 + k * 1024); } while (0)
#define PG8_MMA(ai, bj, At, Bt) do { __builtin_amdgcn_s_setprio(1); _Pragma("unroll") for (int m = 0; m < 4; ++m) _Pragma("unroll") for (int n = 0; n < 2; ++n) _Pragma("unroll") for (int k = 0; k < 2; ++k) \
        acc[ai][bj][m][n] = __builtin_amdgcn_mfma_f32_16x16x32_bf16(Bt[n][k], At[m][k], acc[ai][bj][m][n], 0, 0, 0); __builtin_amdgcn_s_setprio(0); } while (0)
#define PG8_WAIT_V(n) asm volatile("s_waitcnt vmcnt(" #n ")" ::: "memory")
#define PG8_WAIT_L(n) asm volatile("s_waitcnt lgkmcnt(" #n ")" ::: "memory")
#define PG8_BAR __builtin_amdgcn_s_barrier()
#define PG8_SCHED __builtin_amdgcn_sched_barrier(0)
    Unit cur, nxt; int ui = 0;
    if (!S.next(0, cur)) return;
    f32x4 acc[2][2][4][2];
#pragma unroll
    for (int a = 0; a < 2; ++a)
#pragma unroll
        for (int b = 0; b < 2; ++b)
#pragma unroll
            for (int m = 0; m < 4; ++m)
#pragma unroll
                for (int n = 0; n < 2; ++n) acc[a][b][m][n] = (f32x4){0.f, 0.f, 0.f, 0.f};
    bf16x8 At[4][2], B0[2][2], B1[2][2];
    const char* cA = (const char*)g.A + (size_t)cur.pm * tstep; const char* cB = (const char*)g.Bt + (size_t)cur.pn * tstep;
    S.a_ready(cur);
    if constexpr (SP2) {
        PG8_STAGE(PG8_SB(0, 0), cB, voffB); PG8_STAGE(PG8_SB(0, 1), cB + hstep, voffB); PG8_STAGE(PG8_SA(0, 0), cA, voffA); PG8_STAGE(PG8_SA(0, 1), cA + hstep, voffA);
        if (wr == 1) PG8_BAR;
        PG8_WAIT_V(2); PG8_BAR;
        PG8_STAGE(PG8_SB(1, 0), cB + kstep, voffB); PG8_STAGE(PG8_SA(1, 0), cA + kstep, voffA); PG8_STAGE(PG8_SB(1, 1), cB + hstep + kstep, voffB);
        PG8_WAIT_V(6); PG8_BAR;
    } else {
        PG8_STAGE(PG8_SB(0, 0), cB, voffB); PG8_STAGE(PG8_SA(0, 0), cA, voffA); PG8_STAGE(PG8_SB(0, 1), cB + hstep, voffB); PG8_STAGE(PG8_SA(0, 1), cA + hstep, voffA);
        if (wr == 1) PG8_BAR;
        PG8_WAIT_V(4); PG8_BAR;
        PG8_STAGE(PG8_SB(1, 0), cB + kstep, voffB); PG8_STAGE(PG8_SA(1, 0), cA + kstep, voffA); PG8_STAGE(PG8_SB(1, 1), cB + hstep + kstep, voffB);
        PG8_WAIT_V(6); PG8_BAR;
    }
    for (;;) {
        const bool has_next = S.next(ui + 1, nxt);
        const char* nA = has_next ? (const char*)g.A + (size_t)nxt.pm * tstep : cA; const char* nB = has_next ? (const char*)g.Bt + (size_t)nxt.pn * tstep : cB;
        for (int t = 0; t < nt; t += 2) {
            const bool last = (t == nt - 2);
            const char* a1 = cA + (size_t)(t + 1) * kstep;
            const char* a2 = last ? nA : cA + (size_t)(t + 2) * kstep; const char* b2 = last ? nB : cB + (size_t)(t + 2) * kstep;
            const char* a3 = a2 + kstep; const char* b3 = b2 + kstep;
            if (last && has_next) S.a_ready(nxt);
            if constexpr (SP2) {
            PG8_LDB(B0, 0, 0); PG8_LDB(B1, 0, 1); PG8_SCHED; PG8_LDA(At, 0, 0); PG8_STAGE(PG8_SA(1, 1), a1 + hstep, voffA);
            PG8_WAIT_V(8); PG8_WAIT_L(0); PG8_BAR; PG8_MMA(0, 0, At, B0); PG8_MMA(0, 1, At, B1); PG8_BAR; PG8_SCHED;
            PG8_LDA(At, 0, 1); PG8_STAGE(PG8_SB(0, 0), b2, voffB); PG8_STAGE(PG8_SB(0, 1), b2 + hstep, voffB); PG8_STAGE(PG8_SA(0, 0), a2, voffA);
            PG8_WAIT_V(8); PG8_WAIT_L(0); PG8_BAR; PG8_MMA(1, 0, At, B0); PG8_MMA(1, 1, At, B1); PG8_BAR; PG8_SCHED;
            PG8_LDB(B0, 1, 0); PG8_LDB(B1, 1, 1); PG8_SCHED; PG8_LDA(At, 1, 0); PG8_STAGE(PG8_SA(0, 1), a2 + hstep, voffA);
            PG8_WAIT_V(8); PG8_WAIT_L(0); PG8_BAR; PG8_MMA(0, 0, At, B0); PG8_MMA(0, 1, At, B1); PG8_BAR; PG8_SCHED;
            PG8_LDA(At, 1, 1); PG8_STAGE(PG8_SB(1, 0), b3, voffB); PG8_STAGE(PG8_SB(1, 1), b3 + hstep, voffB); PG8_STAGE(PG8_SA(1, 0), a3, voffA);
            PG8_WAIT_V(8); PG8_WAIT_L(0); PG8_BAR; PG8_MMA(1, 0, At, B0); PG8_MMA(1, 1, At, B1); PG8_BAR; PG8_SCHED;
            } else {
            PG8_LDB(B0, 0, 0); PG8_SCHED; PG8_LDA(At, 0, 0); PG8_STAGE(PG8_SA(1, 1), a1 + hstep, voffA);
            PG8_WAIT_L(8); PG8_BAR; PG8_WAIT_L(0); PG8_MMA(0, 0, At, B0); PG8_BAR; PG8_SCHED;
            PG8_LDB(B1, 0, 1); PG8_STAGE(PG8_SB(0, 0), b2, voffB);
            PG8_BAR; PG8_WAIT_L(0); PG8_MMA(0, 1, At, B1); PG8_BAR;
            PG8_LDA(At, 0, 1); PG8_STAGE(PG8_SA(0, 0), a2, voffA);
            PG8_BAR; PG8_WAIT_L(0); PG8_MMA(1, 0, At, B0); PG8_BAR; PG8_SCHED;
            PG8_STAGE(PG8_SB(0, 1), b2 + hstep, voffB);
            PG8_WAIT_V(6); PG8_BAR; PG8_MMA(1, 1, At, B1); PG8_BAR;
            PG8_LDB(B0, 1, 0); PG8_SCHED; PG8_LDA(At, 1, 0); PG8_STAGE(PG8_SA(0, 1), a2 + hstep, voffA);
            PG8_WAIT_L(8); PG8_BAR; PG8_WAIT_L(0); PG8_MMA(0, 0, At, B0); PG8_BAR; PG8_SCHED;
            PG8_LDB(B1, 1, 1); PG8_STAGE(PG8_SB(1, 0), b3, voffB);
            PG8_BAR; PG8_WAIT_L(0); PG8_MMA(0, 1, At, B1); PG8_BAR;
            PG8_LDA(At, 1, 1); PG8_STAGE(PG8_SA(1, 0), a3, voffA);
            PG8_BAR; PG8_WAIT_L(0); PG8_MMA(1, 0, At, B0); PG8_BAR; PG8_SCHED;
            PG8_STAGE(PG8_SB(1, 1), b3 + hstep, voffB);
            PG8_WAIT_V(6); PG8_BAR; PG8_MMA(1, 1, At, B1); PG8_BAR;
            }
        }
        if constexpr (ALIGN_EPI) { if (wr == 0) PG8_BAR; }
        if constexpr (!Epi::AFTER_DRAIN) { E(acc, cur, wr, wc, fr, fq); S.done(cur); }
        if (!has_next) break;
#pragma unroll
        for (int a = 0; a < 2; ++a)
#pragma unroll
            for (int b = 0; b < 2; ++b)
#pragma unroll
                for (int m = 0; m < 4; ++m)
#pragma unroll
                    for (int n = 0; n < 2; ++n) acc[a][b][m][n] = (f32x4){0.f, 0.f, 0.f, 0.f};
        cur = nxt; cA = nA; cB = nB; ++ui;
        if constexpr (ALIGN_EPI) { if (wr == 1) PG8_BAR; }
    }
    PG8_WAIT_V(0);
    if constexpr (!ALIGN_EPI) { if (wr == 0) PG8_BAR; }
    PG8_BAR;
    if constexpr (Epi::AFTER_DRAIN) { E.fused(acc, cur, wr, wc, fr, fq, lds, wid, lane); S.done(cur); }
#undef PG8_SA
#undef PG8_SB
#undef PG8_STAGE
#undef PG8_LDA
#undef PG8_LDB
#undef PG8_MMA
#undef PG8_WAIT_V
#undef PG8_WAIT_L
#undef PG8_BAR
#undef PG8_SCHED
}
}
constexpr int SEQL = 8192, NSEQ = 3, NTOK = NSEQ * SEQL;
constexpr int DM = 4096, DRG = 2048, DHY = 2048, NIN = 10240, DFF = 11008;
constexpr int NHEAD = 16, HDIM = 128;
constexpr float EPSN = 1e-6f;
constexpr int FFT_N = 16384;

#define GAS __attribute__((address_space(1)))
#define LAS __attribute__((address_space(3)))
typedef unsigned short bf16;
typedef unsigned v4u __attribute__((ext_vector_type(4)));
typedef unsigned v2u __attribute__((ext_vector_type(2)));
typedef float f32x4 __attribute__((ext_vector_type(4)));
typedef float f32x2 __attribute__((ext_vector_type(2)));
typedef short bf16x8 __attribute__((ext_vector_type(8)));

__device__ __forceinline__ unsigned f2bf(float f) { unsigned u = __builtin_bit_cast(unsigned, f); return (u + 0x7fffu + ((u >> 16) & 1u)) >> 16; }
__device__ __forceinline__ unsigned pk2(float lo, float hi) { return f2bf(lo) | (f2bf(hi) << 16); }
__device__ __forceinline__ float bf2f(unsigned b) { return __builtin_bit_cast(float, b << 16); }
__device__ __forceinline__ float bflo(unsigned w) { return __builtin_bit_cast(float, w << 16); }
__device__ __forceinline__ float bfhi(unsigned w) { return __builtin_bit_cast(float, w & 0xffff0000u); }
__device__ __forceinline__ float wave_sum(float v) {
#pragma unroll
    for (int o = 1; o < 64; o <<= 1) v += __shfl_xor(v, o);
    return v;
}
__device__ __forceinline__ float frcp(float x) { return __builtin_amdgcn_rcpf(x); }
__device__ __forceinline__ float fexp(float x) { return __builtin_amdgcn_exp2f(x * 1.4426950408889634f); }
__device__ __forceinline__ float sigmoidf_(float x) { return frcp(1.0f + fexp(-x)); }
__device__ __forceinline__ float gelu_tanh(float x) { const float u = 1.5957691216057308f * (x + 0.044715f * x * x * x); return x * frcp(1.0f + fexp(-u)); }

constexpr size_t MiB = 1u << 20;
constexpr size_t WS_CTL = 0;
constexpr size_t WS_TW = 1 * MiB;
constexpr size_t WS_H3 = 2 * MiB;
constexpr size_t WS_RGW = 4 * MiB;
constexpr size_t WS_SUMM = 6 * MiB;
constexpr size_t WS_WIN = 16 * MiB;
constexpr size_t WS_WOUT = 96 * MiB;
constexpr size_t WS_WFI = 128 * MiB;
constexpr size_t WS_WFO = 300 * MiB;
constexpr size_t WS_XN = 386 * MiB;
constexpr size_t WS_PRG = 578 * MiB;
constexpr size_t WS_PHY = 770 * MiB;
constexpr size_t WS_HYY = 1058 * MiB;
constexpr size_t WS_RGY = 1154 * MiB;
constexpr size_t WS_ZK = 1250 * MiB;
constexpr size_t WS_END = 1314 * MiB;
constexpr size_t WS_MIX = WS_PHY;
constexpr size_t WS_Y = WS_PRG;
constexpr size_t WS_F = WS_PRG;
#define XB_TMO      128
#define XB_XCNT(j)  (256  + 64 * (j))
#define XB_XSUB(j)  (1280 + 64 * (j))
#define XB_XGEN(j)  (2304 + 64 * (j))
#define XB_TOP      3328
#define XB_TOPGEN   3392
#define XCD_BAR_WORDS 3456
#define XB_SPIN_CAP (1u << 18)

__device__ __forceinline__ unsigned xb_ld(unsigned* p)              { return __hip_atomic_load(p, __ATOMIC_RELAXED, __HIP_MEMORY_SCOPE_AGENT); }
__device__ __forceinline__ unsigned xb_add(unsigned* p, unsigned v) { return __hip_atomic_fetch_add(p, v, __ATOMIC_RELAXED, __HIP_MEMORY_SCOPE_AGENT); }
__device__ __forceinline__ unsigned xb_xcc_id() { return (unsigned)__builtin_amdgcn_s_getreg((3 << 11) | 20) & 0xFu; }
#define XB_SPIN(cond, bar) do { unsigned _sp = 0; while (cond) { __builtin_amdgcn_s_sleep(1); \
    if ((++_sp & 255u) == 0u) { if (xb_ld(&(bar)[XB_TMO])) break; if (_sp > XB_SPIN_CAP) { atomicAdd(&(bar)[XB_TMO], 1u); break; } } } } while (0)

struct XcdBarrier {
    unsigned* bar; unsigned x;
    volatile LAS unsigned* st;
};

__device__ __forceinline__ XcdBarrier xcd_barrier_post(unsigned* bar, volatile LAS unsigned* st) {
    XcdBarrier b; b.bar = bar; b.x = xb_xcc_id(); b.st = st;
    if (threadIdx.x == 0) (void)xb_add(&bar[XB_XCNT(b.x)], 1u);
    return b;
}
__device__ __forceinline__ void xcd_barrier_complete(unsigned* bar, unsigned x, unsigned& nloc, unsigned& nx) {
    const unsigned G = gridDim.x * gridDim.y * gridDim.z;
    unsigned sum, cnt, mine, sp = 0u;
    for (;;) {
        sum = 0u; cnt = 0u; mine = 0u;
#pragma unroll
        for (unsigned j = 0; j < 16; ++j) { const unsigned c = xb_ld(&bar[XB_XCNT(j)]); sum += c; cnt += (c > 0u) ? 1u : 0u; mine = (j == x) ? c : mine; }
        if (sum == G) break;
        __builtin_amdgcn_s_sleep(1);
        if ((++sp & 255u) == 0u) { if (xb_ld(&bar[XB_TMO])) break; if (sp > XB_SPIN_CAP) { atomicAdd(&bar[XB_TMO], 1u); break; } }
    }
    nloc = mine > 0u ? mine : 1u; nx = cnt > 0u ? cnt : 1u;
}

__device__ __forceinline__ void xcd_barrier(const XcdBarrier& b) {
    asm volatile("s_waitcnt vmcnt(0)" ::: "memory");
    __syncthreads();
    if (threadIdx.x == 0) {
        unsigned* bar = b.bar;
        __builtin_amdgcn_s_waitcnt(0);
        unsigned nloc = b.st[0], nx = b.st[1];
        if (nloc == 0u) { xcd_barrier_complete(bar, b.x, nloc, nx); b.st[0] = nloc; b.st[1] = nx; }
        const unsigned old = xb_add(&bar[XB_XSUB(b.x)], 1u);
        const unsigned gen = old / nloc;
        if (old + 1u == (gen + 1u) * nloc) {
            __builtin_amdgcn_fence(__ATOMIC_RELEASE, "agent");
            asm volatile("s_waitcnt vmcnt(0)" ::: "memory");
            const unsigned og = xb_add(&bar[XB_TOP], 1u);
            const unsigned tg = og / nx;
            if (og + 1u == (tg + 1u) * nx) xb_add(&bar[XB_TOPGEN], 1u);
            else XB_SPIN(xb_ld(&bar[XB_TOPGEN]) == tg, bar);
            __builtin_amdgcn_fence(__ATOMIC_ACQUIRE, "agent");
            xb_add(&bar[XB_XGEN(b.x)], 1u);
            asm volatile("s_waitcnt vmcnt(0)" ::: "memory");
        } else {
            XB_SPIN(xb_ld(&bar[XB_XGEN(b.x)]) == gen, bar);
            __builtin_amdgcn_fence(__ATOMIC_ACQUIRE, "agent");
            asm volatile("s_waitcnt vmcnt(0)" ::: "memory");
        }
    }
    __syncthreads();
}
__device__ __forceinline__ void p0_transpose_item(const float* W, int K, int N, bf16* WT, int k0, int n0, int drow0, LAS float* scr, int lane) {
#pragma unroll 8
    for (int i = 0; i < 32; ++i) { const int kk = 2 * i + (lane >> 5); scr[kk * 33 + (lane & 31)] = W[(size_t)(k0 + kk) * N + n0 + (lane & 31)]; }
    asm volatile("s_waitcnt lgkmcnt(0)" ::: "memory");
    const int c = lane & 7;
#pragma unroll
    for (int j = 0; j < 4; ++j) { const int n = (lane >> 3) + 8 * j; const LAS float* s = scr + (8 * c) * 33 + n;
        v4u o; o.x = pk2(s[0 * 33], s[1 * 33]); o.y = pk2(s[2 * 33], s[3 * 33]); o.z = pk2(s[4 * 33], s[5 * 33]); o.w = pk2(s[6 * 33], s[7 * 33]);
        *(v4u*)(WT + (size_t)(drow0 + n) * K + k0 + 8 * c) = o; }
    asm volatile("s_waitcnt lgkmcnt(0)" ::: "memory");
}
template <bool INTER> __device__ __forceinline__ int ffi_drow(int n) {
    if (!INTER) return n;
    const int up = n >= DFF ? 1 : 0, c = n - up * DFF; return (c >> 7) * 256 + up * 128 + (c & 127);
}
struct ProArgs {
    const float *xp, *xs, *g_premix;
    const float *w_in, *w_out, *w_ffi, *w_ffo;
    const float *rg_a_w, *rg_x_w;
    const float *hy_w1, *hy_b1, *hy_w2, *hy_b2, *hy_w3, *hy_b3, *hy_freq;
    unsigned char* ws;
};
__device__ __forceinline__ const float* xrow_ptr(const float* xp, const float* xs, int m) { return m < SEQL ? xp + (size_t)m * DM : xs + (size_t)(m - SEQL) * DM; }

template <bool INTER> __device__ __forceinline__ void p0_prologue(const ProArgs& a, LAS unsigned char* lds, int gw, int NGW, int wave, int lane) {
    bf16* WIN = (bf16*)(a.ws + WS_WIN); bf16* WOUT = (bf16*)(a.ws + WS_WOUT); bf16* WFI = (bf16*)(a.ws + WS_WFI); bf16* WFO = (bf16*)(a.ws + WS_WFO);
    LAS float* scr = (LAS float*)(lds + wave * 16384);
    constexpr int I_IN = (DM / 64) * (NIN / 32), I_OUT = (DM / 64) * (DM / 32), I_FI = (DM / 64) * (2 * DFF / 32), I_FO = (DFF / 64) * (DM / 32);
    constexpr int NITEMS = I_IN + I_OUT + I_FI + I_FO;
    for (int it = gw; it < NITEMS; it += NGW) {
        int r = it;
        if (r < I_IN) { const int nb = NIN / 32, kb = r / nb, n0 = (r % nb) * 32; p0_transpose_item(a.w_in, DM, NIN, WIN, kb * 64, n0, n0, scr, lane); continue; } r -= I_IN;
        if (r < I_OUT) { const int nb = DM / 32, kb = r / nb, n0 = (r % nb) * 32; p0_transpose_item(a.w_out, DM, DM, WOUT, kb * 64, n0, n0, scr, lane); continue; } r -= I_OUT;
        if (r < I_FI) { const int nb = 2 * DFF / 32, kb = r / nb, n0 = (r % nb) * 32; p0_transpose_item(a.w_ffi, DM, 2 * DFF, WFI, kb * 64, n0, ffi_drow<INTER>(n0), scr, lane); continue; } r -= I_FI;
        { const int nb = DM / 32, kb = r / nb, n0 = (r % nb) * 32; p0_transpose_item(a.w_ffo, DFF, DM, WFO, kb * 64, n0, n0, scr, lane); }
    }
    bf16* XN = (bf16*)(a.ws + WS_XN);
    for (int m = gw; m < NTOK; m += NGW) {
        const float* xr = xrow_ptr(a.xp, a.xs, m);
        f32x4 v[16]; float s = 0.f;
#pragma unroll
        for (int j = 0; j < 8; ++j) { const f32x4* p = (const f32x4*)(xr + (j * 64 + lane) * 8); v[2 * j] = p[0]; v[2 * j + 1] = p[1];
            s += (v[2 * j].x * v[2 * j].x + v[2 * j].y * v[2 * j].y) + (v[2 * j].z * v[2 * j].z + v[2 * j].w * v[2 * j].w);
            s += (v[2 * j + 1].x * v[2 * j + 1].x + v[2 * j + 1].y * v[2 * j + 1].y) + (v[2 * j + 1].z * v[2 * j + 1].z + v[2 * j + 1].w * v[2 * j + 1].w); }
        const float rs = 1.0f / sqrtf(wave_sum(s) * (1.0f / DM) + EPSN);
#pragma unroll
        for (int j = 0; j < 8; ++j) { const int c0 = (j * 64 + lane) * 8; const f32x4 g0 = *(const f32x4*)(a.g_premix + c0), g1 = *(const f32x4*)(a.g_premix + c0 + 4);
            const f32x4 a0 = v[2 * j] * rs * g0, a1 = v[2 * j + 1] * rs * g1;
            v4u o; o.x = pk2(a0.x, a0.y); o.y = pk2(a0.z, a0.w); o.z = pk2(a1.x, a1.y); o.w = pk2(a1.z, a1.w);
            *(v4u*)(XN + (size_t)m * DM + c0) = o; }
    }
    bf16* RGW = (bf16*)(a.ws + WS_RGW);
    for (int idx = gw * 64 + lane; idx < 2 * 2 * NHEAD * HDIM * HDIM; idx += NGW * 64) {
        const int i = idx & 127, j = (idx >> 7) & 127, h = (idx >> 14) & 15, gate = (idx >> 18) & 1, dir = idx >> 19;
        const float* W = gate ? a.rg_x_w : a.rg_a_w;
        RGW[idx] = (bf16)f2bf(W[(((size_t)dir * NHEAD + h) * HDIM + i) * HDIM + j]);
    }
    f32x2* TW = (f32x2*)(a.ws + WS_TW);
    for (int k = gw * 64 + lane; k < FFT_N; k += NGW * 64) { float sn, cs; sincospif((float)k * (1.0f / 8192.0f), &sn, &cs); TW[k] = (f32x2){cs, -sn}; }
    bf16* H3H = (bf16*)(a.ws + WS_H3); bf16* H3L = H3H + SEQL * 64;
    const float fr = a.hy_freq[lane], b1 = a.hy_b1[lane], b2 = a.hy_b2[lane], b3 = a.hy_b3[lane];
    for (int n = gw; n < SEQL; n += NGW) {
        float zv = 0.f;
        if (lane == 0) zv = (float)n * (1.0f / (float)(SEQL - 1));
        else if (lane < 33) { const int k = (lane - 1) & 15; const float band = 1e-4f + (float)k * ((15.0f - 1e-4f) / 15.0f);
            const float ang = (6.283185307179586f / (float)SEQL) * (float)n * band; zv = lane < 17 ? cosf(ang) : -sinf(ang); }
        float acc = b1;
        for (int e = 0; e < 33; ++e) acc += __shfl(zv, e) * a.hy_w1[e * 64 + lane];
        float h = sinf(fr * acc);
        acc = b2;
        for (int e = 0; e < 64; ++e) acc += __shfl(h, e) * a.hy_w2[e * 64 + lane];
        h = sinf(fr * acc);
        acc = b3;
        for (int e = 0; e < 64; ++e) acc += __shfl(h, e) * a.hy_w3[e * 64 + lane];
        h = sinf(fr * acc);
        { const unsigned hi = f2bf(h); H3H[n * 64 + lane] = (bf16)hi; H3L[n * 64 + lane] = (bf16)f2bf(h - bf2f(hi)); }
    }
}
constexpr int FFT_LDS_BYTES = (FFT_N + FFT_N / 32) * 8;
constexpr int HY_W4_OFF = FFT_LDS_BYTES;
constexpr int HY_PRM_OFF = FFT_LDS_BYTES + 1024;
constexpr int HY_LDS_BYTES = FFT_LDS_BYTES + 1024 + 256;
__device__ __forceinline__ int PH(int i) { return i + (i >> 5); }
__device__ __forceinline__ f32x2 cmul(f32x2 a, f32x2 b) { return (f32x2){a.x * b.x - a.y * b.y, a.x * b.y + a.y * b.x}; }
__device__ __forceinline__ constexpr int bitrev_c(int r, int bits) { int o = 0; for (int i = 0; i < bits; ++i) o |= ((r >> i) & 1) << (bits - 1 - i); return o; }

__device__ __forceinline__ f32x2 mul_w32(f32x2 d, int idx) {
    constexpr float C[16] = {1.0f, 0.98078528040323043f, 0.92387953251128674f, 0.83146961230254524f, 0.70710678118654752f, 0.55557023301960218f, 0.38268343236508977f, 0.19509032201612825f,
                             0.0f, -0.19509032201612825f, -0.38268343236508977f, -0.55557023301960218f, -0.70710678118654752f, -0.83146961230254524f, -0.92387953251128674f, -0.98078528040323043f};
    constexpr float S[16] = {0.0f, 0.19509032201612825f, 0.38268343236508977f, 0.55557023301960218f, 0.70710678118654752f, 0.83146961230254524f, 0.92387953251128674f, 0.98078528040323043f,
                             1.0f, 0.98078528040323043f, 0.92387953251128674f, 0.83146961230254524f, 0.70710678118654752f, 0.55557023301960218f, 0.38268343236508977f, 0.19509032201612825f};
    if (idx == 0) return d;
    if (idx == 8) return (f32x2){d.y, -d.x};
    const float c = C[idx], s = S[idx];
    return (f32x2){d.x * c + d.y * s, d.y * c - d.x * s};
}
template <int R> __device__ __forceinline__ void dft_inreg(f32x2 (&a)[R]) {
    constexpr int LOGR = (R == 32) ? 5 : 4;
#pragma unroll
    for (int t = 0; t < LOGR; ++t) {
        const int half = R >> (t + 1);
#pragma unroll
        for (int g = 0; g < R; g += 2 * half)
#pragma unroll
            for (int i = 0; i < half; ++i) {
                const f32x2 u = a[g + i], v = a[g + i + half];
                a[g + i] = u + v;
                a[g + i + half] = mul_w32(u - v, i * (16 / half));
            }
    }
}
template <int R, int S, bool TW> __device__ __forceinline__ void fft_pass(LAS f32x2* lds, const f32x2* tw, int tid) {
    constexpr int NB = FFT_N / R, PER = NB / 512, LOGR = (R == 32) ? 5 : 4;
    constexpr int RSTEP = NB + NB / 32;
    constexpr int WSTEP = (S == 1) ? 1 : (S + S / 32);
    f32x2 a[PER][R];
#pragma unroll
    for (int b = 0; b < PER; ++b) { const LAS f32x2* rp = lds + PH(tid + 512 * b);
#pragma unroll
        for (int k = 0; k < R; ++k) a[b][k] = rp[k * RSTEP]; }
    __syncthreads();
#pragma unroll
    for (int b = 0; b < PER; ++b) {
        const int beta = tid + 512 * b, q = beta & (S - 1), p = beta / S, base = q + R * S * p;
        dft_inreg<R>(a[b]);
        f32x2 w1 = (f32x2){1.f, 0.f}, wj = (f32x2){1.f, 0.f};
        if (TW) { w1 = tw[p * S]; wj = w1; }
        LAS f32x2* wp = lds + PH(base);
        wp[0] = a[b][0];
#pragma unroll
        for (int j = 1; j < R; ++j) {
            f32x2 v = a[b][bitrev_c(j, LOGR)];
            if (TW) { v = cmul(v, wj); wj = cmul(wj, w1); }
            wp[j * WSTEP] = v;
        }
    }
    __syncthreads();
}
__device__ __forceinline__ void fft16k(LAS f32x2* lds, const f32x2* tw, int tid) {
    asm volatile("" : "+v"(tid));
    fft_pass<32, 1, true>(lds, tw, tid);
    fft_pass<32, 32, true>(lds, tw, tid);
    fft_pass<16, 1024, false>(lds, tw, tid);
}
__device__ __forceinline__ void spec_pair(LAS f32x2* lds, const f32x2* ZK, int p) {
    const int f = p, f2 = (FFT_N - p) & (FFT_N - 1);
    const f32x2 A = ZK[f], A2 = ZK[f2], Z = lds[PH(f)], Z2 = lds[PH(f2)];
    const float kcx = 0.5f * (A.x + A2.x), kcy = 0.5f * (A.y - A2.y);
    const float dx = 0.5f * (A.x - A2.x), dy = 0.5f * (A.y + A2.y);
    const float k1x = dy, k1y = -dx;
    const float px = 0.5f * (kcx + k1x), py = 0.5f * (kcy + k1y), qx = 0.5f * (kcx - k1x), qy = 0.5f * (kcy - k1y);
    const float wx = Z.x * px - Z.y * py + (Z2.x * qx + Z2.y * qy);
    const float wy = Z.x * py + Z.y * px + (Z2.x * qy - Z2.y * qx);
    const float w2x = Z2.x * px + Z2.y * py + (Z.x * qx - Z.y * qy);
    const float w2y = Z2.y * px - Z2.x * py - (Z.x * qy + Z.y * qx);
    lds[PH(f)] = (f32x2){wx, -wy}; lds[PH(f2)] = (f32x2){w2x, -w2y};
}
__device__ __forceinline__ void spec_mul(LAS f32x2* lds, const f32x2* ZK, int tid) {
    asm volatile("" : "+v"(tid));
#pragma unroll 4
    for (int i = 0; i < 16; ++i) spec_pair(lds, ZK, tid + 512 * i);
    if (tid == 0) spec_pair(lds, ZK, 8192);
    __syncthreads();
}
struct HyArgs {
    const bf16* phy;
    const float *conv_w, *conv_b;
    const float* w4;
    const float* hy_bias;
    const bf16* h3h;
    const f32x2* tw;
    f32x2* zk;
    bf16* hyy;
};
__device__ __forceinline__ void load_conv3_16(const bf16* row, int t0, float w0, float w1, float w2, float bias, float (&out)[16]) {
    const v4u r0 = *(const v4u*)(row + t0), r1 = *(const v4u*)(row + t0 + 8);
    float u[18];
    u[0] = t0 > 0 ? bf2f(row[t0 - 1]) : 0.f;
    u[17] = (t0 + 16 < SEQL) ? bf2f(row[t0 + 16]) : 0.f;
    u[1] = bflo(r0.x); u[2] = bfhi(r0.x); u[3] = bflo(r0.y); u[4] = bfhi(r0.y); u[5] = bflo(r0.z); u[6] = bfhi(r0.z); u[7] = bflo(r0.w); u[8] = bfhi(r0.w);
    u[9] = bflo(r1.x); u[10] = bfhi(r1.x); u[11] = bflo(r1.y); u[12] = bfhi(r1.y); u[13] = bflo(r1.z); u[14] = bfhi(r1.z); u[15] = bflo(r1.w); u[16] = bfhi(r1.w);
#pragma unroll
    for (int e = 0; e < 16; ++e) out[e] = bias + w0 * u[e] + w1 * u[e + 1] + w2 * u[e + 2];
}
__device__ __forceinline__ void store16_bf16(bf16* dst, const float (&v)[16]) {
    v4u o0, o1; o0.x = pk2(v[0], v[1]); o0.y = pk2(v[2], v[3]); o0.z = pk2(v[4], v[5]); o0.w = pk2(v[6], v[7]);
    o1.x = pk2(v[8], v[9]); o1.y = pk2(v[10], v[11]); o1.z = pk2(v[12], v[13]); o1.w = pk2(v[14], v[15]);
    *(v4u*)dst = o0; *(v4u*)(dst + 8) = o1;
}
__device__ __forceinline__ void hyena_unit(const HyArgs& a, LAS unsigned char* ldsb_, int cp, int wgslot, int tid) {
    unsigned lzero; asm volatile("v_mov_b32 %0, 0" : "=v"(lzero));
    LAS unsigned char* ldsb = ldsb_ + lzero;
    LAS f32x2* lds = (LAS f32x2*)ldsb;
    const int c0 = 2 * cp, c1 = c0 + 1;
    f32x2* zk = a.zk + (size_t)wgslot * 2 * FFT_N;
    constexpr float MIN_DECAY = -3.0701134573253945f, MAX_DECAY = -15.350567286626973f;
    const float ad0 = fabsf(MIN_DECAY + (float)c0 * ((MAX_DECAY - MIN_DECAY) / (float)(DHY - 1)));
    const float ad1 = fabsf(MIN_DECAY + (float)c1 * ((MAX_DECAY - MIN_DECAY) / (float)(DHY - 1)));
    LAS float* prm = (LAS float*)(ldsb + HY_PRM_OFF);
    __syncthreads();
    if (tid < 24) { const int k = tid & 3, sc = tid >> 2, st = sc >> 1, chn = st * DHY + c0 + (sc & 1); prm[tid] = k < 3 ? a.conv_w[k * 6144 + chn] : a.conv_b[chn]; }
    if (tid >= 32 && tid < 36) { const int j = tid - 32; prm[tid] = a.hy_bias[(j >> 1) * DHY + c0 + (j & 1)]; }
#pragma unroll 1
    for (int o = 0; o < 2; ++o) {
        int tq = tid; asm volatile("" : "+v"(tq)); const int t0 = 16 * tq;
        __syncthreads();
        {
            const int lane = tq & 63, wv = tq >> 6, fr = lane & 15, fq = lane >> 4;
            const int colidx = o * 4096 + ((fr >> 1) & 1) * 2048 + c0 + (fr & 1);
            bf16x8 Bh[2], Bl[2];
#pragma unroll
            for (int kk = 0; kk < 2; ++kk)
#pragma unroll
                for (int i = 0; i < 8; ++i) { const float w = fr < 4 ? a.w4[(size_t)(32 * kk + 8 * fq + i) * 8192 + colidx] : 0.f; const unsigned hi = f2bf(w);
                    Bh[kk][i] = (short)hi; Bl[kk][i] = (short)f2bf(w - bf2f(hi)); }
            const float adl = (fr & 1) ? ad1 : ad0;
            LAS float* ldsf = (LAS float*)lds;
            if (tq == 0) lds[PH(SEQL)] = (f32x2){0.f, 0.f};
#pragma unroll 2
            for (int b = 0; b < 64; ++b) {
                const int row0 = (wv * 64 + b) * 16;
                const bf16* ap = a.h3h + (size_t)(row0 + fr) * 64 + 8 * fq;
                const bf16x8 ah0 = *(const bf16x8*)ap, ah1 = *(const bf16x8*)(ap + 32), al0 = *(const bf16x8*)(ap + SEQL * 64), al1 = *(const bf16x8*)(ap + SEQL * 64 + 32);
                f32x4 acc = (f32x4){0.f, 0.f, 0.f, 0.f};
                acc = __builtin_amdgcn_mfma_f32_16x16x32_bf16(al0, Bh[0], acc, 0, 0, 0); acc = __builtin_amdgcn_mfma_f32_16x16x32_bf16(al1, Bh[1], acc, 0, 0, 0);
                acc = __builtin_amdgcn_mfma_f32_16x16x32_bf16(ah0, Bl[0], acc, 0, 0, 0); acc = __builtin_amdgcn_mfma_f32_16x16x32_bf16(ah1, Bl[1], acc, 0, 0, 0);
                acc = __builtin_amdgcn_mfma_f32_16x16x32_bf16(ah0, Bh[0], acc, 0, 0, 0); acc = __builtin_amdgcn_mfma_f32_16x16x32_bf16(ah1, Bh[1], acc, 0, 0, 0);
                if (fr < 4) {
#pragma unroll
                    for (int e = 0; e < 4; ++e) {
                        const int n = row0 + 4 * fq + e;
                        const float val = acc[e] * fexp(-(float)n * (1.0f / (float)(SEQL - 1)) * adl);
                        if (fr < 2) ldsf[2 * PH(n) + (fr & 1)] = val;
                        else if (n >= 1) ldsf[2 * PH(FFT_N - n) + (fr & 1)] = val;
                    }
                }
            }
        }
        __syncthreads();
        fft16k(lds, a.tw, tid);
#pragma unroll 4
        for (int i = 0; i < 32; ++i) zk[(size_t)o * FFT_N + tq + 512 * i] = lds[PH(tq + 512 * i)];
    }
    const float inv_n = 1.0f / (float)FFT_N;
    asm volatile("s_waitcnt vmcnt(0)" ::: "memory");
    __syncthreads();
#pragma unroll 1
    for (int s = 0; s < NSEQ; ++s) {
        const size_t m0 = (size_t)s * SEQL;
        int tq = tid; asm volatile("" : "+v"(tq)); const int t0 = 16 * tq;
        {
            float v0[16], v1[16];
            load_conv3_16(a.phy + (size_t)(0 * DHY + c0) * NTOK + m0, t0, prm[0], prm[1], prm[2], prm[3], v0);
            load_conv3_16(a.phy + (size_t)(0 * DHY + c1) * NTOK + m0, t0, prm[4], prm[5], prm[6], prm[7], v1);
            __syncthreads();
#pragma unroll
            for (int e = 0; e < 16; ++e) { lds[PH(t0 + e)] = (f32x2){v0[e], v1[e]}; lds[PH(SEQL + t0 + e)] = (f32x2){0.f, 0.f}; }
        }
        __syncthreads();
        fft16k(lds, a.tw, tid);
        spec_mul(lds, zk, tid);
        fft16k(lds, a.tw, tid);
        float z0[16], z1[16];
        {
            float x0[16], x1[16];
            load_conv3_16(a.phy + (size_t)(0 * DHY + c0) * NTOK + m0, t0, prm[0], prm[1], prm[2], prm[3], x0);
            load_conv3_16(a.phy + (size_t)(0 * DHY + c1) * NTOK + m0, t0, prm[4], prm[5], prm[6], prm[7], x1);
#pragma unroll
            for (int e = 0; e < 16; ++e) { const f32x2 r = lds[PH(t0 + e)]; z0[e] = r.x * inv_n + prm[32] * x0[e]; z1[e] = -r.y * inv_n + prm[33] * x1[e]; }
            load_conv3_16(a.phy + (size_t)(1 * DHY + c0) * NTOK + m0, t0, prm[8], prm[9], prm[10], prm[11], x0);
            load_conv3_16(a.phy + (size_t)(1 * DHY + c1) * NTOK + m0, t0, prm[12], prm[13], prm[14], prm[15], x1);
#pragma unroll
            for (int e = 0; e < 16; ++e) { z0[e] *= x0[e]; z1[e] *= x1[e]; }
        }
#pragma unroll
        for (int e = 0; e < 16; ++e) { lds[PH(t0 + e)] = (f32x2){z0[e], z1[e]}; lds[PH(SEQL + t0 + e)] = (f32x2){0.f, 0.f}; }
        __syncthreads();
        fft16k(lds, a.tw, tid);
        spec_mul(lds, zk + FFT_N, tid);
        fft16k(lds, a.tw, tid);
        {
            float x0[16], x1[16];
            load_conv3_16(a.phy + (size_t)(2 * DHY + c0) * NTOK + m0, t0, prm[16], prm[17], prm[18], prm[19], x0);
            load_conv3_16(a.phy + (size_t)(2 * DHY + c1) * NTOK + m0, t0, prm[20], prm[21], prm[22], prm[23], x1);
#pragma unroll
            for (int e = 0; e < 16; ++e) { const f32x2 r = lds[PH(t0 + e)];
                x0[e] = x0[e] * (r.x * inv_n + prm[34] * z0[e]); x1[e] = x1[e] * (-r.y * inv_n + prm[35] * z1[e]); }
            store16_bf16(a.hyy + (size_t)c0 * NTOK + m0 + t0, x0);
            store16_bf16(a.hyy + (size_t)c1 * NTOK + m0 + t0, x1);
        }
    }
}
constexpr int RG_T = 128, RG_NT = SEQL / RG_T;
constexpr int RG_XC_STRIDE = 272;
constexpr int RG_HF_OFF = RG_T * RG_XC_STRIDE;
constexpr int RG_LDS_BYTES = RG_HF_OFF + (RG_T / 4) * 512 * 4;
constexpr int RG_UNITS = NSEQ * RG_NT * NHEAD;
struct RgArgs {
    const bf16* prg;
    const float *conv_w, *conv_b;
    const bf16* rgw;
    const float *a_b, *x_b;
    const float* lam;
    f32x2* summ;
    bf16* rgy;
};
template <int PASS> __device__ __forceinline__ void rg_unit(const RgArgs& a, LAS unsigned char* lds, int unit, int tid) {
    const int wave = tid >> 6, lane = tid & 63, fr = lane & 15, fq = lane >> 4;
    const int h = unit % NHEAD, tt = (unit / NHEAD) % RG_NT, s = unit / (NHEAD * RG_NT);
    const int tok0 = tt * RG_T;
    const size_t mrow0 = (size_t)s * SEQL;
    __syncthreads();
    {
        const int cg = h * HDIM + 2 * lane;
        float w0[4], w1[4];
#pragma unroll
        for (int k = 0; k < 4; ++k) { w0[k] = a.conv_w[k * DRG + cg]; w1[k] = a.conv_w[k * DRG + cg + 1]; }
        const float cb0 = a.conv_b[cg], cb1 = a.conv_b[cg + 1];
        float x0[4], x1[4];
        const int tb = tok0 + 16 * wave;
#pragma unroll
        for (int k = 0; k < 3; ++k) { const int t = tb - 2 + k; unsigned u = 0u; if (t >= 0 && t < SEQL) u = *(const unsigned*)(a.prg + (mrow0 + t) * DM + cg); x0[k] = bflo(u); x1[k] = bfhi(u); }
#pragma unroll
        for (int i = 0; i < 16; ++i) {
            const int t = tb + i + 1; unsigned u = 0u; if (t < SEQL) u = *(const unsigned*)(a.prg + (mrow0 + t) * DM + cg);
            x0[3] = bflo(u); x1[3] = bfhi(u);
            const float y0 = cb0 + w0[0] * x0[0] + w0[1] * x0[1] + w0[2] * x0[2] + w0[3] * x0[3];
            const float y1 = cb1 + w1[0] * x1[0] + w1[1] * x1[1] + w1[2] * x1[2] + w1[3] * x1[3];
            *(LAS unsigned*)(lds + (16 * wave + i) * RG_XC_STRIDE + lane * 4) = pk2(y0, y1);
            x0[0] = x0[1]; x0[1] = x0[2]; x0[2] = x0[3]; x1[0] = x1[1]; x1[1] = x1[2]; x1[2] = x1[3];
        }
    }
    __syncthreads();
    const int ch = h * HDIM + 16 * wave + fr;
    LAS float* hfl = (LAS float*)(lds + RG_HF_OFF) + tid;
#pragma unroll
    for (int dir = 0; dir < 2; ++dir) {
        bf16x8 Br[4], Bi[4];
#pragma unroll
        for (int kk = 0; kk < 4; ++kk) {
            Br[kk] = *(const bf16x8*)(a.rgw + ((((size_t)dir * 2 + 0) * NHEAD + h) * HDIM + 16 * wave + fr) * HDIM + 32 * kk + 8 * fq);
            Bi[kk] = *(const bf16x8*)(a.rgw + ((((size_t)dir * 2 + 1) * NHEAD + h) * HDIM + 16 * wave + fr) * HDIM + 32 * kk + 8 * fq);
        }
        const float ba = a.a_b[dir * DRG + ch], bx = a.x_b[dir * DRG + ch];
        const float sp = log1pf(expf(-a.lam[dir * DRG + ch]));
        float carry = 0.f, ptot = 1.f;
        if (PASS == 2) {
            const f32x2* sm = a.summ + ((size_t)dir * NSEQ + s) * RG_NT * DRG + ch;
            if (dir == 0) { for (int j = 0; j < tt; ++j) { const f32x2 pb = sm[(size_t)j * DRG]; carry = pb.x * carry + pb.y; } }
            else { for (int j = RG_NT - 1; j > tt; --j) { const f32x2 pb = sm[(size_t)j * DRG]; carry = pb.x * carry + pb.y; } }
        }
        for (int bi = 0; bi < RG_T / 16; ++bi) {
            const int blk = dir == 0 ? bi : (RG_T / 16 - 1 - bi);
            f32x4 accR = (f32x4){0.f, 0.f, 0.f, 0.f}, accI = (f32x4){0.f, 0.f, 0.f, 0.f};
#pragma unroll
            for (int kk = 0; kk < 4; ++kk) {
                const bf16x8 af = *(const LAS bf16x8*)(lds + (16 * blk + fr) * RG_XC_STRIDE + (32 * kk + 8 * fq) * 2);
                accR = __builtin_amdgcn_mfma_f32_16x16x32_bf16(af, Br[kk], accR, 0, 0, 0);
                accI = __builtin_amdgcn_mfma_f32_16x16x32_bf16(af, Bi[kk], accI, 0, 0, 0);
            }
            float av[4], bv[4];
#pragma unroll
            for (int e = 0; e < 4; ++e) {
                const float r = sigmoidf_(accR[e] + ba), ig = sigmoidf_(accI[e] + bx);
                const float log_a = -8.0f * r * sp;
                av[e] = fexp(log_a);
                const float x2 = 2.0f * log_a;
                const float em = -x2 * (1.0f + x2 * (0.5f + x2 * (0.16666667f + x2 * (0.041666668f + x2 * (0.0083333338f + x2 * (0.0013888889f + x2 * (0.0001984127f + x2 * 0.0000248016f)))))));
                const float em2 = x2 < -0.25f ? (1.0f - av[e] * av[e]) : em;
                const float mult = __builtin_amdgcn_sqrtf(fmaxf(em2, 0.f));
                const float xcv = bf2f(*(const LAS unsigned short*)(lds + (16 * blk + 4 * fq + e) * RG_XC_STRIDE + (16 * wave + fr) * 2));
                bv[e] = mult * ig * xcv;
            }
            float A = 1.f, B = 0.f;
            if (dir == 0) {
#pragma unroll
                for (int e = 0; e < 4; ++e) { B = av[e] * B + bv[e]; A *= av[e]; }
            } else {
#pragma unroll
                for (int e = 3; e >= 0; --e) { B = av[e] * B + bv[e]; A *= av[e]; }
            }
            float hin;
            if (dir == 0) {
                float Ap = __shfl_up(A, 16), Bp = __shfl_up(B, 16);
                if (fq >= 1) { B = A * Bp + B; A = Ap * A; }
                Ap = __shfl_up(A, 32); Bp = __shfl_up(B, 32);
                if (fq >= 2) { B = A * Bp + B; A = Ap * A; }
                const float hend = A * carry + B;
                const float hprev = __shfl_up(hend, 16);
                hin = fq == 0 ? carry : hprev;
                carry = __shfl(hend, 48 + fr);
                if (PASS == 1) ptot *= __shfl(A, 48 + fr);
            } else {
                float Ap = __shfl_down(A, 16), Bp = __shfl_down(B, 16);
                if (fq <= 2) { B = A * Bp + B; A = Ap * A; }
                Ap = __shfl_down(A, 32); Bp = __shfl_down(B, 32);
                if (fq <= 1) { B = A * Bp + B; A = Ap * A; }
                const float hend = A * carry + B;
                const float hprev = __shfl_down(hend, 16);
                hin = fq == 3 ? carry : hprev;
                carry = __shfl(hend, fr);
                if (PASS == 1) ptot *= __shfl(A, fr);
            }
            if (PASS == 2) {
                if (dir == 0) {
                    float hh = hin;
#pragma unroll
                    for (int e = 0; e < 4; ++e) { hh = av[e] * hh + bv[e]; hfl[(blk * 4 + e) * 512] = hh; }
                } else {
                    float hh = hin, hb[4];
#pragma unroll
                    for (int e = 3; e >= 0; --e) { hh = av[e] * hh + bv[e]; hb[e] = hh; }
#pragma unroll
                    for (int e = 0; e < 4; ++e) {
                        const size_t m = mrow0 + tok0 + 16 * blk + 4 * fq + e;
                        const float g = bf2f(a.prg[m * DM + DRG + ch]);
                        a.rgy[m * DRG + ch] = (bf16)f2bf((hfl[(blk * 4 + e) * 512] + hb[e]) * gelu_tanh(g));
                    }
                }
            }
        }
        if (PASS == 1 && fq == 0) a.summ[(((size_t)dir * NSEQ + s) * RG_NT + tt) * DRG + ch] = (f32x2){ptot, carry};
    }
}
__device__ __forceinline__ void mixnorm_rg_row(const bf16* rgy, const float* g_rg, bf16* mix, int m, int lane) {
    v4u r[4]; float s = 0.f;
#pragma unroll
    for (int j = 0; j < 4; ++j) { r[j] = *(const v4u*)(rgy + (size_t)m * DRG + (j * 64 + lane) * 8);
        const float a0 = bflo(r[j].x), a1 = bfhi(r[j].x), a2 = bflo(r[j].y), a3 = bfhi(r[j].y), a4 = bflo(r[j].z), a5 = bfhi(r[j].z), a6 = bflo(r[j].w), a7 = bfhi(r[j].w);
        s += (a0 * a0 + a1 * a1) + (a2 * a2 + a3 * a3) + (a4 * a4 + a5 * a5) + (a6 * a6 + a7 * a7); }
    const float rs = 1.0f / sqrtf(wave_sum(s) * (1.0f / DRG) + EPSN);
#pragma unroll
    for (int j = 0; j < 4; ++j) { const int c0 = (j * 64 + lane) * 8; const f32x4 g0 = *(const f32x4*)(g_rg + c0), g1 = *(const f32x4*)(g_rg + c0 + 4);
        v4u o; o.x = pk2(bflo(r[j].x) * rs * g0.x, bfhi(r[j].x) * rs * g0.y); o.y = pk2(bflo(r[j].y) * rs * g0.z, bfhi(r[j].y) * rs * g0.w);
        o.z = pk2(bflo(r[j].z) * rs * g1.x, bfhi(r[j].z) * rs * g1.y); o.w = pk2(bflo(r[j].w) * rs * g1.z, bfhi(r[j].w) * rs * g1.w);
        *(v4u*)(mix + (size_t)m * DM + c0) = o; }
}
constexpr int MN_TILE_STRIDE = 66;
constexpr int MN_LDS_BYTES = 8 * 64 * MN_TILE_STRIDE * 2 + 8 * 64 * 4 + 64 * 4;
__device__ __forceinline__ void mixnorm_hy_tile(const bf16* hyy, const float* g_hy, bf16* mix, LAS unsigned char* lds, int tile, int tid) {
    const int wave = tid >> 6, lane = tid & 63, m0 = tile * 64;
    LAS unsigned short* tl = (LAS unsigned short*)(lds + wave * 64 * MN_TILE_STRIDE * 2);
    LAS float* part = (LAS float*)(lds + 8 * 64 * MN_TILE_STRIDE * 2);
    LAS float* scl = part + 8 * 64;
    __syncthreads();
    float s = 0.f;
    for (int c = wave * 256; c < wave * 256 + 256; ++c) { const float v = bf2f(hyy[(size_t)c * NTOK + m0 + lane]); s += v * v; }
    part[wave * 64 + lane] = s;
    __syncthreads();
    if (tid < 64) { float t = 0.f;
#pragma unroll
        for (int w = 0; w < 8; ++w) t += part[w * 64 + tid];
        scl[tid] = 1.0f / sqrtf(t * (1.0f / DHY) + EPSN); }
    __syncthreads();
    for (int cb = wave; cb < DHY / 64; cb += 8) {
        for (int ci = 0; ci < 64; ++ci) tl[ci * MN_TILE_STRIDE + lane] = hyy[(size_t)(cb * 64 + ci) * NTOK + m0 + lane];
        asm volatile("s_waitcnt lgkmcnt(0)" ::: "memory");
        const float g = g_hy[cb * 64 + lane];
        for (int tk = 0; tk < 64; ++tk) mix[(size_t)(m0 + tk) * DM + DRG + cb * 64 + lane] = (bf16)f2bf(bf2f(tl[lane * MN_TILE_STRIDE + tk]) * scl[tk] * g);
        asm volatile("s_waitcnt lgkmcnt(0)" ::: "memory");
    }
}
__device__ __forceinline__ void rowpass1(const float* xr, const bf16* yr, const float* g_post, const float* g_pre, float* outr, bf16* xnr, int lane) {
    float v[64]; float s = 0.f;
#pragma unroll
    for (int j = 0; j < 8; ++j) { const v4u r = *(const v4u*)(yr + (j * 64 + lane) * 8);
        v[8 * j + 0] = bflo(r.x); v[8 * j + 1] = bfhi(r.x); v[8 * j + 2] = bflo(r.y); v[8 * j + 3] = bfhi(r.y); v[8 * j + 4] = bflo(r.z); v[8 * j + 5] = bfhi(r.z); v[8 * j + 6] = bflo(r.w); v[8 * j + 7] = bfhi(r.w);
#pragma unroll
        for (int e = 0; e < 8; ++e) s += v[8 * j + e] * v[8 * j + e]; }
    const float rs = 1.0f / sqrtf(wave_sum(s) * (1.0f / DM) + EPSN);
    float s2 = 0.f;
#pragma unroll
    for (int j = 0; j < 8; ++j) { const int c0 = (j * 64 + lane) * 8;
        const f32x4 x0 = *(const f32x4*)(xr + c0), x1 = *(const f32x4*)(xr + c0 + 4), g0 = *(const f32x4*)(g_post + c0), g1 = *(const f32x4*)(g_post + c0 + 4);
        f32x4 o0, o1;
        o0.x = x0.x + v[8 * j + 0] * rs * g0.x; o0.y = x0.y + v[8 * j + 1] * rs * g0.y; o0.z = x0.z + v[8 * j + 2] * rs * g0.z; o0.w = x0.w + v[8 * j + 3] * rs * g0.w;
        o1.x = x1.x + v[8 * j + 4] * rs * g1.x; o1.y = x1.y + v[8 * j + 5] * rs * g1.y; o1.z = x1.z + v[8 * j + 6] * rs * g1.z; o1.w = x1.w + v[8 * j + 7] * rs * g1.w;
        *(f32x4*)(outr + c0) = o0; *(f32x4*)(outr + c0 + 4) = o1;
        v[8 * j + 0] = o0.x; v[8 * j + 1] = o0.y; v[8 * j + 2] = o0.z; v[8 * j + 3] = o0.w; v[8 * j + 4] = o1.x; v[8 * j + 5] = o1.y; v[8 * j + 6] = o1.z; v[8 * j + 7] = o1.w;
        s2 += (o0.x * o0.x + o0.y * o0.y) + (o0.z * o0.z + o0.w * o0.w) + (o1.x * o1.x + o1.y * o1.y) + (o1.z * o1.z + o1.w * o1.w); }
    const float rs2 = 1.0f / sqrtf(wave_sum(s2) * (1.0f / DM) + EPSN);
#pragma unroll
    for (int j = 0; j < 8; ++j) { const int c0 = (j * 64 + lane) * 8; const f32x4 g0 = *(const f32x4*)(g_pre + c0), g1 = *(const f32x4*)(g_pre + c0 + 4);
        v4u o; o.x = pk2(v[8 * j + 0] * rs2 * g0.x, v[8 * j + 1] * rs2 * g0.y); o.y = pk2(v[8 * j + 2] * rs2 * g0.z, v[8 * j + 3] * rs2 * g0.w);
        o.z = pk2(v[8 * j + 4] * rs2 * g1.x, v[8 * j + 5] * rs2 * g1.y); o.w = pk2(v[8 * j + 6] * rs2 * g1.z, v[8 * j + 7] * rs2 * g1.w);
        *(v4u*)(xnr + c0) = o; }
}
__device__ __forceinline__ void rowpass2(const bf16* fr_, const float* g, float* outr, int lane) {
    float v[64]; float s = 0.f;
#pragma unroll
    for (int j = 0; j < 8; ++j) { const v4u r = *(const v4u*)(fr_ + (j * 64 + lane) * 8);
        v[8 * j + 0] = bflo(r.x); v[8 * j + 1] = bfhi(r.x); v[8 * j + 2] = bflo(r.y); v[8 * j + 3] = bfhi(r.y); v[8 * j + 4] = bflo(r.z); v[8 * j + 5] = bfhi(r.z); v[8 * j + 6] = bflo(r.w); v[8 * j + 7] = bfhi(r.w);
#pragma unroll
        for (int e = 0; e < 8; ++e) s += v[8 * j + e] * v[8 * j + e]; }
    const float rs = 1.0f / sqrtf(wave_sum(s) * (1.0f / DM) + EPSN);
#pragma unroll
    for (int j = 0; j < 8; ++j) { const int c0 = (j * 64 + lane) * 8;
        const f32x4 x0 = *(const f32x4*)(outr + c0), x1 = *(const f32x4*)(outr + c0 + 4), g0 = *(const f32x4*)(g + c0), g1 = *(const f32x4*)(g + c0 + 4);
        f32x4 o0, o1;
        o0.x = x0.x + v[8 * j + 0] * rs * g0.x; o0.y = x0.y + v[8 * j + 1] * rs * g0.y; o0.z = x0.z + v[8 * j + 2] * rs * g0.z; o0.w = x0.w + v[8 * j + 3] * rs * g0.w;
        o1.x = x1.x + v[8 * j + 4] * rs * g1.x; o1.y = x1.y + v[8 * j + 5] * rs * g1.y; o1.z = x1.z + v[8 * j + 6] * rs * g1.z; o1.w = x1.w + v[8 * j + 7] * rs * g1.w;
        *(f32x4*)(outr + c0) = o0; *(f32x4*)(outr + c0 + 4) = o1; }
}
constexpr int LDS_PHASE_BYTES = 143360;
constexpr int LDSCTL_OFF = LDS_PHASE_BYTES, LDS_BYTES = 147456;
constexpr int CW_BAR = 4096;
constexpr size_t CTL_ZERO_BYTES = 64 * 1024;
static_assert(HY_LDS_BYTES <= LDS_PHASE_BYTES && RG_LDS_BYTES <= LDS_PHASE_BYTES && MN_LDS_BYTES <= LDS_PHASE_BYTES && pg8::STAGE_BYTES <= LDS_PHASE_BYTES, "LDS map");
static_assert((CW_BAR + XCD_BAR_WORDS) * 4 <= (int)CTL_ZERO_BYTES, "control words inside the memset region");

struct MkArgs { const float* in[32]; float* out; unsigned char* ws; };
__device__ __forceinline__ pg8::Gemm dgemm(const bf16* A, const bf16* Bt, int M, int N, int K) { pg8::Gemm g; g.A = A; g.Bt = Bt; g.M = M; g.N = N; g.K = K; return g; }
__device__ __forceinline__ pg8::EpiBf16<0> depi(bf16* O, int ldc) { pg8::EpiBf16<0> e; e.O = O; e.ldc = ldc; e.bias = nullptr; e.split_cols = 0; e.split_stride = 0; e.scale0 = 1.f; return e; }

__device__ __forceinline__ void gate_seq(const bf16* gu, const float* cw, const float* cb, bf16* h, int gtid, int nthreads) {
    constexpr int CG = DFF / 8;
    for (int idx = gtid; idx < SEQL * CG; idx += nthreads) {
        const int m = idx / CG, c0 = (idx % CG) * 8;
        const v4u z = (v4u){0u, 0u, 0u, 0u};
        const v4u gm = m > 0 ? *(const v4u*)(gu + (size_t)(m - 1) * 2 * DFF + c0) : z;
        const v4u g0 = *(const v4u*)(gu + (size_t)m * 2 * DFF + c0);
        const v4u gp = m < SEQL - 1 ? *(const v4u*)(gu + (size_t)(m + 1) * 2 * DFF + c0) : z;
        const v4u uu = *(const v4u*)(gu + (size_t)m * 2 * DFF + DFF + c0);
        float r[8];
#pragma unroll
        for (int e = 0; e < 8; ++e) {
            const unsigned wm = e < 2 ? gm.x : e < 4 ? gm.y : e < 6 ? gm.z : gm.w, w0 = e < 2 ? g0.x : e < 4 ? g0.y : e < 6 ? g0.z : g0.w, wp = e < 2 ? gp.x : e < 4 ? gp.y : e < 6 ? gp.z : gp.w, wu = e < 2 ? uu.x : e < 4 ? uu.y : e < 6 ? uu.z : uu.w;
            const float a = (e & 1) ? bfhi(wm) : bflo(wm), b = (e & 1) ? bfhi(w0) : bflo(w0), c = (e & 1) ? bfhi(wp) : bflo(wp), u = (e & 1) ? bfhi(wu) : bflo(wu);
            const float pre = cb[c0 + e] + cw[c0 + e] * a + cw[DFF + c0 + e] * b + cw[2 * DFF + c0 + e] * c;
            r[e] = gelu_tanh(pre) * u;
        }
        v4u o; o.x = pk2(r[0], r[1]); o.y = pk2(r[2], r[3]); o.z = pk2(r[4], r[5]); o.w = pk2(r[6], r[7]);
        *(v4u*)(h + (size_t)m * DFF + c0) = o;
    }
}

__global__ void __launch_bounds__(512, 2) mk_fwd(MkArgs args) {
    extern __shared__ __attribute__((aligned(16))) unsigned char lds_raw[];
    LAS unsigned char* lds = (LAS unsigned char*)lds_raw;
    const int tid = threadIdx.x, lane = tid & 63, wave = __builtin_amdgcn_readfirstlane(tid >> 6);
    const int G = gridDim.x, bx = blockIdx.x;
    unsigned char* ws = args.ws;
    const float* const* in = args.in;
    volatile LAS unsigned* MISC = (volatile LAS unsigned*)(lds + LDSCTL_OFF);
    for (int u = tid; u < (LDS_BYTES - LDSCTL_OFF) / 4; u += 512) ((LAS unsigned*)(lds + LDSCTL_OFF))[u] = 0u;
    __syncthreads();
    XcdBarrier bar = xcd_barrier_post((unsigned*)(ws + WS_CTL) + CW_BAR, MISC + 8);

    bf16* XN = (bf16*)(ws + WS_XN); bf16* WIN = (bf16*)(ws + WS_WIN);
    {
        ProArgs pa; pa.xp = in[0]; pa.xs = in[1]; pa.g_premix = in[2]; pa.w_in = in[3]; pa.w_out = in[24]; pa.w_ffi = in[27]; pa.w_ffo = in[30]; pa.rg_a_w = in[6]; pa.rg_x_w = in[8];
        pa.hy_w1 = in[13]; pa.hy_b1 = in[14]; pa.hy_w2 = in[15]; pa.hy_b2 = in[16]; pa.hy_w3 = in[17]; pa.hy_b3 = in[18]; pa.hy_freq = in[20]; pa.ws = ws;
        p0_prologue<false>(pa, lds, bx * 8 + wave, G * 8, wave, lane);
    }
    xcd_barrier(bar);
    {
        pg8::StaticOrder S; S.init(NTOK, 2 * DRG, G, bx);
        pg8::gemm_phase<pg8::EpiBf16<0>, pg8::StaticOrder, true, true>(lds, dgemm(XN, WIN, NTOK, 2 * DRG, DM), S, depi((bf16*)(ws + WS_PRG), 2 * DRG));
    }
    {
        pg8::StaticOrder S; S.init(3 * DHY, NTOK, G, bx);
        pg8::gemm_phase<pg8::EpiBf16<0>, pg8::StaticOrder, true, true>(lds, dgemm(WIN + (size_t)2 * DRG * DM, XN, 3 * DHY, NTOK, DM), S, depi((bf16*)(ws + WS_PHY), NTOK));
    }
    xcd_barrier(bar);
    RgArgs ra; ra.prg = (const bf16*)(ws + WS_PRG); ra.conv_w = in[4]; ra.conv_b = in[5]; ra.rgw = (const bf16*)(ws + WS_RGW); ra.a_b = in[7]; ra.x_b = in[9]; ra.lam = in[10];
    ra.summ = (f32x2*)(ws + WS_SUMM); ra.rgy = (bf16*)(ws + WS_RGY);
    {
        HyArgs a; a.phy = (const bf16*)(ws + WS_PHY); a.conv_w = in[11]; a.conv_b = in[12]; a.w4 = in[19]; a.hy_bias = in[21]; a.h3h = (const bf16*)(ws + WS_H3); a.tw = (const f32x2*)(ws + WS_TW);
        a.zk = (f32x2*)(ws + WS_ZK); a.hyy = (bf16*)(ws + WS_HYY);
        for (int cp = bx; cp < DHY / 2; cp += G) hyena_unit(a, lds, cp, bx, tid);
    }
    for (int u = bx; u < RG_UNITS; u += G) rg_unit<1>(ra, lds, u, tid);
    xcd_barrier(bar);
    for (int u = bx; u < RG_UNITS; u += G) rg_unit<2>(ra, lds, u, tid);
    xcd_barrier(bar);
    for (int m = bx * 8 + wave; m < NTOK; m += G * 8) mixnorm_rg_row((const bf16*)(ws + WS_RGY), in[22], (bf16*)(ws + WS_MIX), m, lane);
    for (int t = bx; t < NTOK / 64; t += G) mixnorm_hy_tile((const bf16*)(ws + WS_HYY), in[23], (bf16*)(ws + WS_MIX), lds, t, tid);
    xcd_barrier(bar);
    {
        pg8::StaticOrder S; S.init(NTOK, DM, G, bx);
        pg8::gemm_phase<pg8::EpiBf16<0>, pg8::StaticOrder, true, true>(lds, dgemm((bf16*)(ws + WS_MIX), (bf16*)(ws + WS_WOUT), NTOK, DM, DM), S, depi((bf16*)(ws + WS_Y), DM));
    }
    xcd_barrier(bar);
    for (int m = bx * 8 + wave; m < NTOK; m += G * 8) rowpass1(xrow_ptr(in[0], in[1], m), (const bf16*)(ws + WS_Y) + (size_t)m * DM, in[25], in[26], args.out + (size_t)m * DM, XN + (size_t)m * DM, lane);
    xcd_barrier(bar);
    bf16* GU = (bf16*)(ws + WS_PHY);
    bf16* HS = (bf16*)(ws + WS_PHY + (size_t)344 * MiB);
#pragma unroll 1
    for (int s = 0; s < NSEQ; ++s) {
        {
            pg8::StaticOrder S; S.init(SEQL, 2 * DFF, G, bx);
            pg8::gemm_phase<pg8::EpiBf16<0>, pg8::StaticOrder, true, true>(lds, dgemm(XN + (size_t)s * SEQL * DM, (bf16*)(ws + WS_WFI), SEQL, 2 * DFF, DM), S, depi(GU, 2 * DFF));
        }
        xcd_barrier(bar);
        { int tq = tid; asm volatile("" : "+v"(tq)); gate_seq(GU, in[28], in[29], HS, bx * 512 + tq, G * 512); }
        xcd_barrier(bar);
        {
            pg8::StaticOrder S; S.init(SEQL, DM, G, bx);
            pg8::gemm_phase<pg8::EpiBf16<0>, pg8::StaticOrder, true, true>(lds, dgemm(HS, (bf16*)(ws + WS_WFO), SEQL, DM, DFF), S, depi((bf16*)(ws + WS_F) + (size_t)s * SEQL * DM, DM));
        }
        xcd_barrier(bar);
    }
    for (int m = bx * 8 + wave; m < NTOK; m += G * 8) rowpass2((const bf16*)(ws + WS_F) + (size_t)m * DM, in[31], args.out + (size_t)m * DM, lane);
}

extern "C" void kernel_launch(void* const* d_in, const int* in_sizes, int n_in, void* d_out, int out_size, void* d_ws, size_t ws_size, hipStream_t stream) {
    static int grid = 0;
    if (grid == 0) {
        grid = -1;
        if (n_in != 32 || out_size != NTOK * DM || ws_size < WS_END) { fprintf(stderr, "kernel_launch: unexpected sizes n_in %d out %d ws %zu (need %zu)\n", n_in, out_size, ws_size, (size_t)WS_END); return; }
        int dev = 0, cus = 0, per_cu = 0;
        if (hipGetDevice(&dev) != hipSuccess || hipDeviceGetAttribute(&cus, hipDeviceAttributeMultiprocessorCount, dev) != hipSuccess) return;
        if (hipFuncSetAttribute((const void*)mk_fwd, hipFuncAttributeMaxDynamicSharedMemorySize, LDS_BYTES) != hipSuccess) { fprintf(stderr, "kernel_launch: hipFuncSetAttribute failed\n"); return; }
        if (hipOccupancyMaxActiveBlocksPerMultiprocessor(&per_cu, (const void*)mk_fwd, 512, LDS_BYTES) != hipSuccess || per_cu < 1) { fprintf(stderr, "kernel_launch: occupancy query says %d blocks per CU\n", per_cu); (void)hipGetLastError(); return; }
        grid = cus;
    }
    if (grid < 0) return;
    if (hipMemsetAsync((char*)d_ws + WS_CTL, 0, CTL_ZERO_BYTES, stream) != hipSuccess) return;
    MkArgs a; memset(&a, 0, sizeof a);
    for (int i = 0; i < 32; ++i) a.in[i] = (const float*)d_in[i];
    a.out = (float*)d_out; a.ws = (unsigned char*)d_ws;
    hipLaunchKernelGGL(mk_fwd, dim3(grid), dim3(512), LDS_BYTES, stream, a);
}
```

```cpp
#include <cstring>
#include <hip/hip_runtime.h>
#include <cstdio>
#include <cstdint>
namespace pg8 {
#define PG8_LAS __attribute__((address_space(3)))
typedef unsigned short bf16_t;
typedef short bf16x8 __attribute__((ext_vector_type(8)));
typedef float f32x4 __attribute__((ext_vector_type(4)));
typedef unsigned u32x4 __attribute__((ext_vector_type(4)));
constexpr int BM = 256, BK = 64, HALF = 128, HTB = HALF * BK * 2  , STAGE_BYTES = 8 * HTB, NXCD = 8, WGM = 8;

__host__ __device__ __forceinline__ int lds_byte(int r, int c) { const int st = (r >> 4) * 2 + (c >> 5), rr = r & 15, cc = c & 31, ob = rr * 64 + cc * 2; return st * 1024 + (ob ^ (((ob >> 9) & 1) << 5)); }
__host__ __device__ __forceinline__ void stage_rc(int b, int& R, int& C) { const int st = b / 1024, sb = b % 1024, swz = sb ^ (((sb >> 9) & 1) << 5); R = (st >> 1) * 16 + swz / 64; C = (st & 1) * 32 + (swz % 64) / 2; }
__host__ __device__ __forceinline__ int perm32(int rho) { const int n = rho >> 4, i = rho & 15; return 8 * (i >> 2) + 4 * n + (i & 3); }

struct Unit { int pm, pn; };
struct Gemm { const bf16_t* A; const bf16_t* Bt; int M, N, K; };

struct StaticOrder {
    int nM, nN, nwg, G, c;
    __host__ __device__ void init(int M, int N, int G_, int c_) { nM = M / BM; nN = N / BM; nwg = nM * nN; G = G_; c = c_; }
    __host__ __device__ bool next(int i, Unit& u) const {
        const long L = (long)i * G + c; if (L >= nwg) return false;
        int wgid = (int)L; { const int q = nwg / NXCD, r = nwg % NXCD, xcd = wgid % NXCD, off = wgid / NXCD; wgid = (xcd < r ? xcd * (q + 1) : r * (q + 1) + (xcd - r) * q) + off; }
        const int nig = WGM * nN, gid = wgid / nig, fm = gid * WGM, gsz = (nM - fm) < WGM ? (nM - fm) : WGM;
        u.pm = fm + ((wgid % nig) % gsz); u.pn = (wgid % nig) / gsz; return true;
    }
    __device__ __forceinline__ void a_ready(const Unit&) const {}
    __device__ __forceinline__ void done(const Unit&) const {}
};

__device__ __forceinline__ unsigned cvt_pk_bf16(float lo, float hi) { unsigned r; asm volatile("v_cvt_pk_bf16_f32 %0, %1, %2" : "=v"(r) : "v"(lo), "v"(hi)); return r; }
typedef float f32x2 __attribute__((ext_vector_type(2)));
__device__ __forceinline__ f32x2 gelu_pk(f32x2 v) {
    const f32x2 av = __builtin_elementwise_abs(v), d = av * 0.2316418882f + 1.0f;
    f32x2 t; t.x = __builtin_amdgcn_rcpf(d.x); t.y = __builtin_amdgcn_rcpf(d.y);
    f32x2 q = t * 0.5307027145f + (-0.7265760135f); q = q * t + 0.7107068705f; q = q * t + (-0.142248368f); q = q * t + 0.127414796f; q = q * t;
    const f32x2 s = (v * v) * (-0.72134752044f);
    f32x2 e; e.x = __builtin_amdgcn_exp2f(s.x); e.y = __builtin_amdgcn_exp2f(s.y);
    const f32x2 m = v * (q * e), r = v - m;
    f32x2 o; o.x = v.x < 0.f ? m.x : r.x; o.y = v.y < 0.f ? m.y : r.y; return o;
}

template <int ACT  > struct EpiBf16 {
    static constexpr bool PERM = true, AFTER_DRAIN = false, AROWPERM = false; static_assert(ACT == 0 || ACT == 1, "EpiBf16: ACT is 0 (none) or 1 (gelu_pk)");
    bf16_t* O; int ldc; const float* bias; int split_cols; size_t split_stride; float scale0;
    __device__ __forceinline__ void operator()(const f32x4 (&acc)[2][2][4][2], const Unit& u, int wr, int wc, int fr, int fq) const {
        const int row0 = u.pm * BM + wr * 64 + fr; int colt = u.pn * BM; bf16_t* base = O;
        float sc = 1.f; if (split_cols) { const int t = colt / split_cols; base += (size_t)t * split_stride; colt -= t * split_cols; if (t == 0) sc = scale0; }
        const int col0 = colt + wc * 32 + 8 * fq, bcol0 = u.pn * BM + wc * 32 + 8 * fq;
        f32x4 bv[2][2];
#pragma unroll
        for (int bj = 0; bj < 2; ++bj)
#pragma unroll
            for (int n = 0; n < 2; ++n) bv[bj][n] = bias ? *(const f32x4*)(bias + bcol0 + bj * HALF + 4 * n) : (f32x4){0.f, 0.f, 0.f, 0.f};
#pragma unroll
        for (int ai = 0; ai < 2; ++ai)
#pragma unroll
            for (int m = 0; m < 4; ++m) { bf16_t* rowp = base + (size_t)(row0 + ai * HALF + m * 16) * ldc + col0;
#pragma unroll
                for (int bj = 0; bj < 2; ++bj) { f32x4 v0 = acc[ai][bj][m][0] + bv[bj][0], v1 = acc[ai][bj][m][1] + bv[bj][1];
                    if (ACT == 1) { f32x2 a = gelu_pk((f32x2){v0[0], v0[1]}), b = gelu_pk((f32x2){v0[2], v0[3]}), c = gelu_pk((f32x2){v1[0], v1[1]}), d = gelu_pk((f32x2){v1[2], v1[3]});
                        v0 = (f32x4){a.x, a.y, b.x, b.y}; v1 = (f32x4){c.x, c.y, d.x, d.y}; }
                    v0 = v0 * sc; v1 = v1 * sc; u32x4 w; w.x = cvt_pk_bf16(v0[0], v0[1]); w.y = cvt_pk_bf16(v0[2], v0[3]); w.z = cvt_pk_bf16(v1[0], v1[1]); w.w = cvt_pk_bf16(v1[2], v1[3]);
                    *(u32x4*)(rowp + bj * HALF) = w; } }
    }
};
template <class Epi, class Sched, bool ALIGN_EPI = false, bool SP2 = false>
__device__ __forceinline__ void gemm_phase(PG8_LAS unsigned char* lds, const Gemm g, const Sched& S, const Epi& E) {
    int tid_ = threadIdx.x; asm volatile("" : "+v"(tid_));
    const int tid = tid_, wid = __builtin_amdgcn_readfirstlane(tid >> 6), lane = tid & 63, wr = wid >> 2, wc = wid & 3, fr = lane & 15, fq = lane >> 4;
    const int K = g.K, nt = K / BK;
    unsigned voffA[2], voffB[2];
#pragma unroll
    for (int i = 0; i < 2; ++i) { int R, C; stage_rc(tid * 16 + i * 8192, R, C); const int Rb = Epi::PERM ? ((R & ~31) + perm32(R & 31)) : R; const int Ra = Epi::AROWPERM ? (128 * (R >> 6) + (R & 63)) : R;
        voffA[i] = (unsigned)(Ra * K + C) * 2u; voffB[i] = (unsigned)(Rb * K + C) * 2u; }
    const size_t kstep = (size_t)(BK * 2);
    const size_t hstep = (size_t)HALF * K * 2;
    const size_t hstepA = Epi::AROWPERM ? (size_t)64 * K * 2 : hstep;
    const size_t tstep = 2 * hstep;
    const unsigned ldsw = (unsigned)wid * 1024u;
    const int aoff = lds_byte(wr * 64 + fr, fq * 8), boff = lds_byte(wc * 32 + fr, fq * 8);
#define PG8_SA(b, h) (((b) * 2 + (h)) * HTB)
#define PG8_SB(b, h) ((4 + (b) * 2 + (h)) * HTB)
#define PG8_STAGE(bufoff, gbase, voff) do { _Pragma("unroll") for (int _i = 0; _i < 2; ++_i) \
        __builtin_amdgcn_global_load_lds((const unsigned*)((const char*)(gbase) + (voff)[_i]), (PG8_LAS unsigned*)(lds + (bufoff) + ldsw + _i * 8192), 16, 0, 0); } while (0)
#define PG8_LDA(dst, b, h) do { _Pragma("unroll") for (int m = 0; m < 4; ++m) _Pragma("unroll") for (int k = 0; k < 2; ++k) dst[m][k] = *(const PG8_LAS bf16x8*)(lds + PG8_SA(b, h) + aoff + m * 2048 + k * 1024); } while (0)
#define PG8_LDB(dst, b, h) do { _Pragma("unroll") for (int n = 0; n < 2; ++n) _Pragma("unroll") for (int k = 0; k < 2; ++k) dst[n][k] = *(const PG8_LAS bf16x8*)(lds + PG8_SB(b, h) + boff + n * 2048 + k * 1024); } while (0)
#define PG8_MMA(ai, bj, At, Bt) do { __builtin_amdgcn_s_setprio(1); _Pragma("unroll") for (int m = 0; m < 4; ++m) _Pragma("unroll") for (int n = 0; n < 2; ++n) _Pragma("unroll") for (int k = 0; k < 2; ++k) \
        acc[ai][bj][m][n] = __builtin_amdgcn_mfma_f32_16x16x32_bf16(Bt[n][k], At[m][k], acc[ai][bj][m][n], 0, 0, 0); __builtin_amdgcn_s_setprio(0); } while (0)
#define PG8_WAIT_V(n) asm volatile("s_waitcnt vmcnt(" #n ")" ::: "memory")
#define PG8_WAIT_L(n) asm volatile("s_waitcnt lgkmcnt(" #n ")" ::: "memory")
#define PG8_BAR __builtin_amdgcn_s_barrier()
#define PG8_SCHED __builtin_amdgcn_sched_barrier(0)
    Unit cur, nxt; int ui = 0;
    if (!S.next(0, cur)) return;
    f32x4 acc[2][2][4][2];
#pragma unroll
    for (int a = 0; a < 2; ++a)
#pragma unroll
        for (int b = 0; b < 2; ++b)
#pragma unroll
            for (int m = 0; m < 4; ++m)
#pragma unroll
                for (int n = 0; n < 2; ++n) acc[a][b][m][n] = (f32x4){0.f, 0.f, 0.f, 0.f};
    bf16x8 At[4][2], B0[2][2], B1[2][2];
    const char* cA = (const char*)g.A + (size_t)cur.pm * tstep; const char* cB = (const char*)g.Bt + (size_t)cur.pn * tstep;
    S.a_ready(cur);
    if constexpr (SP2) {
        PG8_STAGE(PG8_SB(0, 0), cB, voffB); PG8_STAGE(PG8_SB(0, 1), cB + hstep, voffB); PG8_STAGE(PG8_SA(0, 0), cA, voffA); PG8_STAGE(PG8_SA(0, 1), cA + hstepA, voffA);
        if (wr == 1) PG8_BAR;
        PG8_WAIT_V(2); PG8_BAR;
        PG8_STAGE(PG8_SB(1, 0), cB + kstep, voffB); PG8_STAGE(PG8_SA(1, 0), cA + kstep, voffA); PG8_STAGE(PG8_SB(1, 1), cB + hstep + kstep, voffB);
        PG8_WAIT_V(6); PG8_BAR;
    } else {
        PG8_STAGE(PG8_SB(0, 0), cB, voffB); PG8_STAGE(PG8_SA(0, 0), cA, voffA); PG8_STAGE(PG8_SB(0, 1), cB + hstep, voffB); PG8_STAGE(PG8_SA(0, 1), cA + hstepA, voffA);
        if (wr == 1) PG8_BAR;
        PG8_WAIT_V(4); PG8_BAR;
        PG8_STAGE(PG8_SB(1, 0), cB + kstep, voffB); PG8_STAGE(PG8_SA(1, 0), cA + kstep, voffA); PG8_STAGE(PG8_SB(1, 1), cB + hstep + kstep, voffB);
        PG8_WAIT_V(6); PG8_BAR;
    }
    for (;;) {
        const bool has_next = S.next(ui + 1, nxt);
        const char* nA = has_next ? (const char*)g.A + (size_t)nxt.pm * tstep : cA; const char* nB = has_next ? (const char*)g.Bt + (size_t)nxt.pn * tstep : cB;
        for (int t = 0; t < nt; t += 2) {
            const bool last = (t == nt - 2);
            const char* a1 = cA + (size_t)(t + 1) * kstep;
            const char* a2 = last ? nA : cA + (size_t)(t + 2) * kstep; const char* b2 = last ? nB : cB + (size_t)(t + 2) * kstep;
            const char* a3 = a2 + kstep; const char* b3 = b2 + kstep;
            if (last && has_next) S.a_ready(nxt);
            if constexpr (SP2) {
            PG8_LDB(B0, 0, 0); PG8_LDB(B1, 0, 1); PG8_SCHED; PG8_LDA(At, 0, 0); PG8_STAGE(PG8_SA(1, 1), a1 + hstepA, voffA);
            PG8_WAIT_V(8); PG8_WAIT_L(0); PG8_BAR; PG8_MMA(0, 0, At, B0); PG8_MMA(0, 1, At, B1); PG8_BAR; PG8_SCHED;
            PG8_LDA(At, 0, 1); PG8_STAGE(PG8_SB(0, 0), b2, voffB); PG8_STAGE(PG8_SB(0, 1), b2 + hstep, voffB); PG8_STAGE(PG8_SA(0, 0), a2, voffA);
            PG8_WAIT_V(8); PG8_WAIT_L(0); PG8_BAR; PG8_MMA(1, 0, At, B0); PG8_MMA(1, 1, At, B1); PG8_BAR; PG8_SCHED;
            PG8_LDB(B0, 1, 0); PG8_LDB(B1, 1, 1); PG8_SCHED; PG8_LDA(At, 1, 0); PG8_STAGE(PG8_SA(0, 1), a2 + hstepA, voffA);
            PG8_WAIT_V(8); PG8_WAIT_L(0); PG8_BAR; PG8_MMA(0, 0, At, B0); PG8_MMA(0, 1, At, B1); PG8_BAR; PG8_SCHED;
            PG8_LDA(At, 1, 1); PG8_STAGE(PG8_SB(1, 0), b3, voffB); PG8_STAGE(PG8_SB(1, 1), b3 + hstep, voffB); PG8_STAGE(PG8_SA(1, 0), a3, voffA);
            PG8_WAIT_V(8); PG8_WAIT_L(0); PG8_BAR; PG8_MMA(1, 0, At, B0); PG8_MMA(1, 1, At, B1); PG8_BAR; PG8_SCHED;
            } else {
            PG8_LDB(B0, 0, 0); PG8_SCHED; PG8_LDA(At, 0, 0); PG8_STAGE(PG8_SA(1, 1), a1 + hstepA, voffA);
            PG8_WAIT_L(8); PG8_BAR; PG8_WAIT_L(0); PG8_MMA(0, 0, At, B0); PG8_BAR; PG8_SCHED;
            PG8_LDB(B1, 0, 1); PG8_STAGE(PG8_SB(0, 0), b2, voffB);
            PG8_BAR; PG8_WAIT_L(0); PG8_MMA(0, 1, At, B1); PG8_BAR;
            PG8_LDA(At, 0, 1); PG8_STAGE(PG8_SA(0, 0), a2, voffA);
            PG8_BAR; PG8_WAIT_L(0); PG8_MMA(1, 0, At, B0); PG8_BAR; PG8_SCHED;
            PG8_STAGE(PG8_SB(0, 1), b2 + hstep, voffB);
            PG8_WAIT_V(6); PG8_BAR; PG8_MMA(1, 1, At, B1); PG8_BAR;
            PG8_LDB(B0, 1, 0); PG8_SCHED; PG8_LDA(At, 1, 0); PG8_STAGE(PG8_SA(0, 1), a2 + hstepA, voffA);
            PG8_WAIT_L(8); PG8_BAR; PG8_WAIT_L(0); PG8_MMA(0, 0, At, B0); PG8_BAR; PG8_SCHED;
            PG8_LDB(B1, 1, 1); PG8_STAGE(PG8_SB(1, 0), b3, voffB);
            PG8_BAR; PG8_WAIT_L(0); PG8_MMA(0, 1, At, B1); PG8_BAR;
            PG8_LDA(At, 1, 1); PG8_STAGE(PG8_SA(1, 0), a3, voffA);
            PG8_BAR; PG8_WAIT_L(0); PG8_MMA(1, 0, At, B0); PG8_BAR; PG8_SCHED;
            PG8_STAGE(PG8_SB(1, 1), b3 + hstep, voffB);
            PG8_WAIT_V(6); PG8_BAR; PG8_MMA(1, 1, At, B1); PG8_BAR;
            }
        }
        if constexpr (ALIGN_EPI) { if (wr == 0) PG8_BAR; }
        if constexpr (!Epi::AFTER_DRAIN) { E(acc, cur, wr, wc, fr, fq); S.done(cur); }
        if (!has_next) break;
#pragma unroll
        for (int a = 0; a < 2; ++a)
#pragma unroll
            for (int b = 0; b < 2; ++b)
#pragma unroll
                for (int m = 0; m < 4; ++m)
#pragma unroll
                    for (int n = 0; n < 2; ++n) acc[a][b][m][n] = (f32x4){0.f, 0.f, 0.f, 0.f};
        cur = nxt; cA = nA; cB = nB; ++ui;
        if constexpr (ALIGN_EPI) { if (wr == 1) PG8_BAR; }
    }
    PG8_WAIT_V(0);
    if constexpr (!ALIGN_EPI) { if (wr == 0) PG8_BAR; }
    PG8_BAR;
    if constexpr (Epi::AFTER_DRAIN) { E.fused(acc, cur, wr, wc, fr, fq, lds, wid, lane); S.done(cur); }
#undef PG8_SA
#undef PG8_SB
#undef PG8_STAGE
#undef PG8_LDA
#undef PG8_LDB
#undef PG8_MMA
#undef PG8_WAIT_V
#undef PG8_WAIT_L
#undef PG8_BAR
#undef PG8_SCHED
}
}
constexpr int SEQL = 8192, NSEQ = 3, NTOK = NSEQ * SEQL;
constexpr int DM = 4096, DRG = 2048, DHY = 2048, NIN = 10240, DFF = 11008;
constexpr int NHEAD = 16, HDIM = 128;
constexpr float EPSN = 1e-6f;
constexpr int FFT_N = 16384;

#define GAS __attribute__((address_space(1)))
#define LAS __attribute__((address_space(3)))
typedef unsigned short bf16;
typedef unsigned v4u __attribute__((ext_vector_type(4)));
typedef unsigned v2u __attribute__((ext_vector_type(2)));
typedef float f32x4 __attribute__((ext_vector_type(4)));
typedef float f32x2 __attribute__((ext_vector_type(2)));
typedef short bf16x8 __attribute__((ext_vector_type(8)));

__device__ __forceinline__ unsigned f2bf(float f) { unsigned u = __builtin_bit_cast(unsigned, f); return (u + 0x7fffu + ((u >> 16) & 1u)) >> 16; }
__device__ __forceinline__ unsigned pk2(float lo, float hi) { return f2bf(lo) | (f2bf(hi) << 16); }
__device__ __forceinline__ float bf2f(unsigned b) { return __builtin_bit_cast(float, b << 16); }
__device__ __forceinline__ float bflo(unsigned w) { return __builtin_bit_cast(float, w << 16); }
__device__ __forceinline__ float bfhi(unsigned w) { return __builtin_bit_cast(float, w & 0xffff0000u); }
__device__ __forceinline__ float wave_sum(float v) {
#pragma unroll
    for (int o = 1; o < 64; o <<= 1) v += __shfl_xor(v, o);
    return v;
}
__device__ __forceinline__ float frcp(float x) { return __builtin_amdgcn_rcpf(x); }
__device__ __forceinline__ float fexp(float x) { return __builtin_amdgcn_exp2f(x * 1.4426950408889634f); }
__device__ __forceinline__ float sigmoidf_(float x) { return frcp(1.0f + fexp(-x)); }
__device__ __forceinline__ float gelu_tanh(float x) { const float u = 1.5957691216057308f * (x + 0.044715f * x * x * x); return x * frcp(1.0f + fexp(-u)); }

constexpr size_t MiB = 1u << 20;
constexpr size_t WS_CTL = 0;
constexpr size_t WS_TW = 1 * MiB;
constexpr size_t WS_H3 = 2 * MiB;
constexpr size_t WS_RGW = 4 * MiB;
constexpr size_t WS_SUMM = 6 * MiB;
constexpr size_t WS_WIN = 16 * MiB;
constexpr size_t WS_WOUT = 96 * MiB;
constexpr size_t WS_WFI = 128 * MiB;
constexpr size_t WS_WFO = 300 * MiB;
constexpr size_t WS_XN = 386 * MiB;
constexpr size_t WS_PRG = 578 * MiB;
constexpr size_t WS_PHY = 770 * MiB;
constexpr size_t WS_HYY = 1058 * MiB;
constexpr size_t WS_RGY = 1154 * MiB;
constexpr size_t WS_ZK = 1250 * MiB;
constexpr size_t WS_H = WS_PHY;
constexpr size_t WS_SIDEG = 1286 * MiB;
constexpr size_t WS_SIDEU = 1320 * MiB;
constexpr size_t WS_END = 1338 * MiB;
constexpr size_t WS_MIX = WS_PHY;
constexpr size_t WS_Y = WS_PRG;
constexpr size_t WS_F = WS_PRG;
#define XB_TMO      128
#define XB_XCNT(j)  (256  + 64 * (j))
#define XB_XSUB(j)  (1280 + 64 * (j))
#define XB_XGEN(j)  (2304 + 64 * (j))
#define XB_TOP      3328
#define XB_TOPGEN   3392
#define XCD_BAR_WORDS 3456
#define XB_SPIN_CAP (1u << 18)

__device__ __forceinline__ unsigned xb_ld(unsigned* p)              { return __hip_atomic_load(p, __ATOMIC_RELAXED, __HIP_MEMORY_SCOPE_AGENT); }
__device__ __forceinline__ unsigned xb_add(unsigned* p, unsigned v) { return __hip_atomic_fetch_add(p, v, __ATOMIC_RELAXED, __HIP_MEMORY_SCOPE_AGENT); }
__device__ __forceinline__ unsigned xb_xcc_id() { return (unsigned)__builtin_amdgcn_s_getreg((3 << 11) | 20) & 0xFu; }
#define XB_SPIN(cond, bar) do { unsigned _sp = 0; while (cond) { __builtin_amdgcn_s_sleep(1); \
    if ((++_sp & 255u) == 0u) { if (xb_ld(&(bar)[XB_TMO])) break; if (_sp > XB_SPIN_CAP) { atomicAdd(&(bar)[XB_TMO], 1u); break; } } } } while (0)

struct XcdBarrier {
    unsigned* bar; unsigned x;
    volatile LAS unsigned* st;
};

__device__ __forceinline__ XcdBarrier xcd_barrier_post(unsigned* bar, volatile LAS unsigned* st) {
    XcdBarrier b; b.bar = bar; b.x = xb_xcc_id(); b.st = st;
    if (threadIdx.x == 0) (void)xb_add(&bar[XB_XCNT(b.x)], 1u);
    return b;
}
__device__ __forceinline__ void xcd_barrier_complete(unsigned* bar, unsigned x, unsigned& nloc, unsigned& nx) {
    const unsigned G = gridDim.x * gridDim.y * gridDim.z;
    unsigned sum, cnt, mine, sp = 0u;
    for (;;) {
        sum = 0u; cnt = 0u; mine = 0u;
#pragma unroll
        for (unsigned j = 0; j < 16; ++j) { const unsigned c = xb_ld(&bar[XB_XCNT(j)]); sum += c; cnt += (c > 0u) ? 1u : 0u; mine = (j == x) ? c : mine; }
        if (sum == G) break;
        __builtin_amdgcn_s_sleep(1);
        if ((++sp & 255u) == 0u) { if (xb_ld(&bar[XB_TMO])) break; if (sp > XB_SPIN_CAP) { atomicAdd(&bar[XB_TMO], 1u); break; } }
    }
    nloc = mine > 0u ? mine : 1u; nx = cnt > 0u ? cnt : 1u;
}

__device__ __forceinline__ void xcd_barrier(const XcdBarrier& b) {
    asm volatile("s_waitcnt vmcnt(0)" ::: "memory");
    __syncthreads();
    if (threadIdx.x == 0) {
        unsigned* bar = b.bar;
        __builtin_amdgcn_s_waitcnt(0);
        unsigned nloc = b.st[0], nx = b.st[1];
        if (nloc == 0u) { xcd_barrier_complete(bar, b.x, nloc, nx); b.st[0] = nloc; b.st[1] = nx; }
        const unsigned old = xb_add(&bar[XB_XSUB(b.x)], 1u);
        const unsigned gen = old / nloc;
        if (old + 1u == (gen + 1u) * nloc) {
            __builtin_amdgcn_fence(__ATOMIC_RELEASE, "agent");
            asm volatile("s_waitcnt vmcnt(0)" ::: "memory");
            const unsigned og = xb_add(&bar[XB_TOP], 1u);
            const unsigned tg = og / nx;
            if (og + 1u == (tg + 1u) * nx) xb_add(&bar[XB_TOPGEN], 1u);
            else XB_SPIN(xb_ld(&bar[XB_TOPGEN]) == tg, bar);
            __builtin_amdgcn_fence(__ATOMIC_ACQUIRE, "agent");
            xb_add(&bar[XB_XGEN(b.x)], 1u);
            asm volatile("s_waitcnt vmcnt(0)" ::: "memory");
        } else {
            XB_SPIN(xb_ld(&bar[XB_XGEN(b.x)]) == gen, bar);
            __builtin_amdgcn_fence(__ATOMIC_ACQUIRE, "agent");
            asm volatile("s_waitcnt vmcnt(0)" ::: "memory");
        }
    }
    __syncthreads();
}
__device__ __forceinline__ void p0_transpose_item(const float* W, int K, int N, bf16* WT, int k0, int n0, int drow0, LAS float* scr, int lane) {
#pragma unroll 8
    for (int i = 0; i < 32; ++i) { const int kk = 2 * i + (lane >> 5); scr[kk * 33 + (lane & 31)] = W[(size_t)(k0 + kk) * N + n0 + (lane & 31)]; }
    asm volatile("s_waitcnt lgkmcnt(0)" ::: "memory");
    const int c = lane & 7;
#pragma unroll
    for (int j = 0; j < 4; ++j) { const int n = (lane >> 3) + 8 * j; const LAS float* s = scr + (8 * c) * 33 + n;
        v4u o; o.x = pk2(s[0 * 33], s[1 * 33]); o.y = pk2(s[2 * 33], s[3 * 33]); o.z = pk2(s[4 * 33], s[5 * 33]); o.w = pk2(s[6 * 33], s[7 * 33]);
        *(v4u*)(WT + (size_t)(drow0 + n) * K + k0 + 8 * c) = o; }
    asm volatile("s_waitcnt lgkmcnt(0)" ::: "memory");
}
template <bool INTER> __device__ __forceinline__ int ffi_drow(int n) {
    if (!INTER) return n;
    const int up = n >= DFF ? 1 : 0, c = n - up * DFF; return (c >> 7) * 256 + up * 128 + (c & 127);
}
struct ProArgs {
    const float *xp, *xs, *g_premix;
    const float *w_in, *w_out, *w_ffi, *w_ffo;
    const float *rg_a_w, *rg_x_w;
    const float *hy_w1, *hy_b1, *hy_w2, *hy_b2, *hy_w3, *hy_b3, *hy_freq;
    unsigned char* ws;
};
__device__ __forceinline__ const float* xrow_ptr(const float* xp, const float* xs, int m) { return m < SEQL ? xp + (size_t)m * DM : xs + (size_t)(m - SEQL) * DM; }

template <bool INTER> __device__ __forceinline__ void p0_prologue(const ProArgs& a, LAS unsigned char* lds, int gw, int NGW, int wave, int lane) {
    bf16* WIN = (bf16*)(a.ws + WS_WIN); bf16* WOUT = (bf16*)(a.ws + WS_WOUT); bf16* WFI = (bf16*)(a.ws + WS_WFI); bf16* WFO = (bf16*)(a.ws + WS_WFO);
    LAS float* scr = (LAS float*)(lds + wave * 16384);
    constexpr int I_IN = (DM / 64) * (NIN / 32), I_OUT = (DM / 64) * (DM / 32), I_FI = (DM / 64) * (2 * DFF / 32), I_FO = (DFF / 64) * (DM / 32);
    constexpr int NITEMS = I_IN + I_OUT + I_FI + I_FO;
    for (int it = gw; it < NITEMS; it += NGW) {
        int r = it;
        if (r < I_IN) { const int nb = NIN / 32, kb = r / nb, n0 = (r % nb) * 32; p0_transpose_item(a.w_in, DM, NIN, WIN, kb * 64, n0, n0, scr, lane); continue; } r -= I_IN;
        if (r < I_OUT) { const int nb = DM / 32, kb = r / nb, n0 = (r % nb) * 32; p0_transpose_item(a.w_out, DM, DM, WOUT, kb * 64, n0, n0, scr, lane); continue; } r -= I_OUT;
        if (r < I_FI) { const int nb = 2 * DFF / 32, kb = r / nb, n0 = (r % nb) * 32; p0_transpose_item(a.w_ffi, DM, 2 * DFF, WFI, kb * 64, n0, ffi_drow<INTER>(n0), scr, lane); continue; } r -= I_FI;
        { const int nb = DM / 32, kb = r / nb, n0 = (r % nb) * 32; p0_transpose_item(a.w_ffo, DFF, DM, WFO, kb * 64, n0, n0, scr, lane); }
    }
    bf16* XN = (bf16*)(a.ws + WS_XN);
    for (int m = gw; m < NTOK; m += NGW) {
        const float* xr = xrow_ptr(a.xp, a.xs, m);
        f32x4 v[16]; float s = 0.f;
#pragma unroll
        for (int j = 0; j < 8; ++j) { const f32x4* p = (const f32x4*)(xr + (j * 64 + lane) * 8); v[2 * j] = p[0]; v[2 * j + 1] = p[1];
            s += (v[2 * j].x * v[2 * j].x + v[2 * j].y * v[2 * j].y) + (v[2 * j].z * v[2 * j].z + v[2 * j].w * v[2 * j].w);
            s += (v[2 * j + 1].x * v[2 * j + 1].x + v[2 * j + 1].y * v[2 * j + 1].y) + (v[2 * j + 1].z * v[2 * j + 1].z + v[2 * j + 1].w * v[2 * j + 1].w); }
        const float rs = 1.0f / sqrtf(wave_sum(s) * (1.0f / DM) + EPSN);
#pragma unroll
        for (int j = 0; j < 8; ++j) { const int c0 = (j * 64 + lane) * 8; const f32x4 g0 = *(const f32x4*)(a.g_premix + c0), g1 = *(const f32x4*)(a.g_premix + c0 + 4);
            const f32x4 a0 = v[2 * j] * rs * g0, a1 = v[2 * j + 1] * rs * g1;
            v4u o; o.x = pk2(a0.x, a0.y); o.y = pk2(a0.z, a0.w); o.z = pk2(a1.x, a1.y); o.w = pk2(a1.z, a1.w);
            *(v4u*)(XN + (size_t)m * DM + c0) = o; }
    }
    bf16* RGW = (bf16*)(a.ws + WS_RGW);
    for (int idx = gw * 64 + lane; idx < 2 * 2 * NHEAD * HDIM * HDIM; idx += NGW * 64) {
        const int i = idx & 127, j = (idx >> 7) & 127, h = (idx >> 14) & 15, gate = (idx >> 18) & 1, dir = idx >> 19;
        const float* W = gate ? a.rg_x_w : a.rg_a_w;
        RGW[idx] = (bf16)f2bf(W[(((size_t)dir * NHEAD + h) * HDIM + i) * HDIM + j]);
    }
    f32x2* TW = (f32x2*)(a.ws + WS_TW);
    for (int k = gw * 64 + lane; k < FFT_N; k += NGW * 64) { float sn, cs; sincospif((float)k * (1.0f / 8192.0f), &sn, &cs); TW[k] = (f32x2){cs, -sn}; }
    bf16* H3H = (bf16*)(a.ws + WS_H3); bf16* H3L = H3H + SEQL * 64;
    const float fr = a.hy_freq[lane], b1 = a.hy_b1[lane], b2 = a.hy_b2[lane], b3 = a.hy_b3[lane];
    for (int n = gw; n < SEQL; n += NGW) {
        float zv = 0.f;
        if (lane == 0) zv = (float)n * (1.0f / (float)(SEQL - 1));
        else if (lane < 33) { const int k = (lane - 1) & 15; const float band = 1e-4f + (float)k * ((15.0f - 1e-4f) / 15.0f);
            const float ang = (6.283185307179586f / (float)SEQL) * (float)n * band; zv = lane < 17 ? cosf(ang) : -sinf(ang); }
        float acc = b1;
        for (int e = 0; e < 33; ++e) acc += __shfl(zv, e) * a.hy_w1[e * 64 + lane];
        float h = sinf(fr * acc);
        acc = b2;
        for (int e = 0; e < 64; ++e) acc += __shfl(h, e) * a.hy_w2[e * 64 + lane];
        h = sinf(fr * acc);
        acc = b3;
        for (int e = 0; e < 64; ++e) acc += __shfl(h, e) * a.hy_w3[e * 64 + lane];
        h = sinf(fr * acc);
        { const unsigned hi = f2bf(h); H3H[n * 64 + lane] = (bf16)hi; H3L[n * 64 + lane] = (bf16)f2bf(h - bf2f(hi)); }
    }
}
constexpr int FFT_LDS_BYTES = (FFT_N + FFT_N / 32) * 8;
constexpr int HY_W4_OFF = FFT_LDS_BYTES;
constexpr int HY_PRM_OFF = FFT_LDS_BYTES + 1024;
constexpr int HY_LDS_BYTES = FFT_LDS_BYTES + 1024 + 256;
__device__ __forceinline__ int PH(int i) { return i + (i >> 5); }
__device__ __forceinline__ f32x2 cmul(f32x2 a, f32x2 b) { return (f32x2){a.x * b.x - a.y * b.y, a.x * b.y + a.y * b.x}; }
__device__ __forceinline__ constexpr int bitrev_c(int r, int bits) { int o = 0; for (int i = 0; i < bits; ++i) o |= ((r >> i) & 1) << (bits - 1 - i); return o; }

__device__ __forceinline__ f32x2 mul_w32(f32x2 d, int idx) {
    constexpr float C[16] = {1.0f, 0.98078528040323043f, 0.92387953251128674f, 0.83146961230254524f, 0.70710678118654752f, 0.55557023301960218f, 0.38268343236508977f, 0.19509032201612825f,
                             0.0f, -0.19509032201612825f, -0.38268343236508977f, -0.55557023301960218f, -0.70710678118654752f, -0.83146961230254524f, -0.92387953251128674f, -0.98078528040323043f};
    constexpr float S[16] = {0.0f, 0.19509032201612825f, 0.38268343236508977f, 0.55557023301960218f, 0.70710678118654752f, 0.83146961230254524f, 0.92387953251128674f, 0.98078528040323043f,
                             1.0f, 0.98078528040323043f, 0.92387953251128674f, 0.83146961230254524f, 0.70710678118654752f, 0.55557023301960218f, 0.38268343236508977f, 0.19509032201612825f};
    if (idx == 0) return d;
    if (idx == 8) return (f32x2){d.y, -d.x};
    const float c = C[idx], s = S[idx];
    return (f32x2){d.x * c + d.y * s, d.y * c - d.x * s};
}
template <int R> __device__ __forceinline__ void dft_inreg(f32x2 (&a)[R]) {
    constexpr int LOGR = (R == 32) ? 5 : 4;
#pragma unroll
    for (int t = 0; t < LOGR; ++t) {
        const int half = R >> (t + 1);
#pragma unroll
        for (int g = 0; g < R; g += 2 * half)
#pragma unroll
            for (int i = 0; i < half; ++i) {
                const f32x2 u = a[g + i], v = a[g + i + half];
                a[g + i] = u + v;
                a[g + i + half] = mul_w32(u - v, i * (16 / half));
            }
    }
}
template <int R, int S, bool TW> __device__ __forceinline__ void fft_pass(LAS f32x2* lds, const f32x2* tw, int tid) {
    constexpr int NB = FFT_N / R, PER = NB / 512, LOGR = (R == 32) ? 5 : 4;
    constexpr int RSTEP = NB + NB / 32;
    constexpr int WSTEP = (S == 1) ? 1 : (S + S / 32);
    f32x2 a[PER][R];
#pragma unroll
    for (int b = 0; b < PER; ++b) { const LAS f32x2* rp = lds + PH(tid + 512 * b);
#pragma unroll
        for (int k = 0; k < R; ++k) a[b][k] = rp[k * RSTEP]; }
    __syncthreads();
#pragma unroll
    for (int b = 0; b < PER; ++b) {
        const int beta = tid + 512 * b, q = beta & (S - 1), p = beta / S, base = q + R * S * p;
        dft_inreg<R>(a[b]);
        f32x2 w1 = (f32x2){1.f, 0.f}, wj = (f32x2){1.f, 0.f};
        if (TW) { w1 = tw[p * S]; wj = w1; }
        LAS f32x2* wp = lds + PH(base);
        wp[0] = a[b][0];
#pragma unroll
        for (int j = 1; j < R; ++j) {
            f32x2 v = a[b][bitrev_c(j, LOGR)];
            if (TW) { v = cmul(v, wj); wj = cmul(wj, w1); }
            wp[j * WSTEP] = v;
        }
    }
    __syncthreads();
}
__device__ __forceinline__ void fft16k(LAS f32x2* lds, const f32x2* tw, int tid) {
    asm volatile("" : "+v"(tid));
    fft_pass<32, 1, true>(lds, tw, tid);
    fft_pass<32, 32, true>(lds, tw, tid);
    fft_pass<16, 1024, false>(lds, tw, tid);
}
__device__ __forceinline__ void spec_pair(LAS f32x2* lds, const f32x2* ZK, int p) {
    const int f = p, f2 = (FFT_N - p) & (FFT_N - 1);
    const f32x2 A = ZK[f], A2 = ZK[f2], Z = lds[PH(f)], Z2 = lds[PH(f2)];
    const float kcx = 0.5f * (A.x + A2.x), kcy = 0.5f * (A.y - A2.y);
    const float dx = 0.5f * (A.x - A2.x), dy = 0.5f * (A.y + A2.y);
    const float k1x = dy, k1y = -dx;
    const float px = 0.5f * (kcx + k1x), py = 0.5f * (kcy + k1y), qx = 0.5f * (kcx - k1x), qy = 0.5f * (kcy - k1y);
    const float wx = Z.x * px - Z.y * py + (Z2.x * qx + Z2.y * qy);
    const float wy = Z.x * py + Z.y * px + (Z2.x * qy - Z2.y * qx);
    const float w2x = Z2.x * px + Z2.y * py + (Z.x * qx - Z.y * qy);
    const float w2y = Z2.y * px - Z2.x * py - (Z.x * qy + Z.y * qx);
    lds[PH(f)] = (f32x2){wx, -wy}; lds[PH(f2)] = (f32x2){w2x, -w2y};
}
__device__ __forceinline__ void spec_mul(LAS f32x2* lds, const f32x2* ZK, int tid) {
    asm volatile("" : "+v"(tid));
#pragma unroll 4
    for (int i = 0; i < 16; ++i) spec_pair(lds, ZK, tid + 512 * i);
    if (tid == 0) spec_pair(lds, ZK, 8192);
    __syncthreads();
}
struct HyArgs {
    const bf16* phy;
    const float *conv_w, *conv_b;
    const float* w4;
    const float* hy_bias;
    const bf16* h3h;
    const f32x2* tw;
    f32x2* zk;
    bf16* hyy;
};
__device__ __forceinline__ void load_conv3_16(const bf16* row, int t0, float w0, float w1, float w2, float bias, float (&out)[16]) {
    const v4u r0 = *(const v4u*)(row + t0), r1 = *(const v4u*)(row + t0 + 8);
    float u[18];
    u[0] = t0 > 0 ? bf2f(row[t0 - 1]) : 0.f;
    u[17] = (t0 + 16 < SEQL) ? bf2f(row[t0 + 16]) : 0.f;
    u[1] = bflo(r0.x); u[2] = bfhi(r0.x); u[3] = bflo(r0.y); u[4] = bfhi(r0.y); u[5] = bflo(r0.z); u[6] = bfhi(r0.z); u[7] = bflo(r0.w); u[8] = bfhi(r0.w);
    u[9] = bflo(r1.x); u[10] = bfhi(r1.x); u[11] = bflo(r1.y); u[12] = bfhi(r1.y); u[13] = bflo(r1.z); u[14] = bfhi(r1.z); u[15] = bflo(r1.w); u[16] = bfhi(r1.w);
#pragma unroll
    for (int e = 0; e < 16; ++e) out[e] = bias + w0 * u[e] + w1 * u[e + 1] + w2 * u[e + 2];
}
__device__ __forceinline__ void store16_bf16(bf16* dst, const float (&v)[16]) {
    v4u o0, o1; o0.x = pk2(v[0], v[1]); o0.y = pk2(v[2], v[3]); o0.z = pk2(v[4], v[5]); o0.w = pk2(v[6], v[7]);
    o1.x = pk2(v[8], v[9]); o1.y = pk2(v[10], v[11]); o1.z = pk2(v[12], v[13]); o1.w = pk2(v[14], v[15]);
    *(v4u*)dst = o0; *(v4u*)(dst + 8) = o1;
}
__device__ __forceinline__ void hyena_unit(const HyArgs& a, LAS unsigned char* ldsb_, int cp, int wgslot, int tid) {
    unsigned lzero; asm volatile("v_mov_b32 %0, 0" : "=v"(lzero));
    LAS unsigned char* ldsb = ldsb_ + lzero;
    LAS f32x2* lds = (LAS f32x2*)ldsb;
    const int c0 = 2 * cp, c1 = c0 + 1;
    f32x2* zk = a.zk + (size_t)wgslot * 2 * FFT_N;
    constexpr float MIN_DECAY = -3.0701134573253945f, MAX_DECAY = -15.350567286626973f;
    const float ad0 = fabsf(MIN_DECAY + (float)c0 * ((MAX_DECAY - MIN_DECAY) / (float)(DHY - 1)));
    const float ad1 = fabsf(MIN_DECAY + (float)c1 * ((MAX_DECAY - MIN_DECAY) / (float)(DHY - 1)));
    LAS float* prm = (LAS float*)(ldsb + HY_PRM_OFF);
    __syncthreads();
    if (tid < 24) { const int k = tid & 3, sc = tid >> 2, st = sc >> 1, chn = st * DHY + c0 + (sc & 1); prm[tid] = k < 3 ? a.conv_w[k * 6144 + chn] : a.conv_b[chn]; }
    if (tid >= 32 && tid < 36) { const int j = tid - 32; prm[tid] = a.hy_bias[(j >> 1) * DHY + c0 + (j & 1)]; }
#pragma unroll 1
    for (int o = 0; o < 2; ++o) {
        int tq = tid; asm volatile("" : "+v"(tq)); const int t0 = 16 * tq;
        __syncthreads();
        {
            const int lane = tq & 63, wv = tq >> 6, fr = lane & 15, fq = lane >> 4;
            const int colidx = o * 4096 + ((fr >> 1) & 1) * 2048 + c0 + (fr & 1);
            bf16x8 Bh[2], Bl[2];
#pragma unroll
            for (int kk = 0; kk < 2; ++kk)
#pragma unroll
                for (int i = 0; i < 8; ++i) { const float w = fr < 4 ? a.w4[(size_t)(32 * kk + 8 * fq + i) * 8192 + colidx] : 0.f; const unsigned hi = f2bf(w);
                    Bh[kk][i] = (short)hi; Bl[kk][i] = (short)f2bf(w - bf2f(hi)); }
            const float adl = (fr & 1) ? ad1 : ad0;
            LAS float* ldsf = (LAS float*)lds;
            if (tq == 0) lds[PH(SEQL)] = (f32x2){0.f, 0.f};
#pragma unroll 2
            for (int b = 0; b < 64; ++b) {
                const int row0 = (wv * 64 + b) * 16;
                const bf16* ap = a.h3h + (size_t)(row0 + fr) * 64 + 8 * fq;
                const bf16x8 ah0 = *(const bf16x8*)ap, ah1 = *(const bf16x8*)(ap + 32), al0 = *(const bf16x8*)(ap + SEQL * 64), al1 = *(const bf16x8*)(ap + SEQL * 64 + 32);
                f32x4 acc = (f32x4){0.f, 0.f, 0.f, 0.f};
                acc = __builtin_amdgcn_mfma_f32_16x16x32_bf16(al0, Bh[0], acc, 0, 0, 0); acc = __builtin_amdgcn_mfma_f32_16x16x32_bf16(al1, Bh[1], acc, 0, 0, 0);
                acc = __builtin_amdgcn_mfma_f32_16x16x32_bf16(ah0, Bl[0], acc, 0, 0, 0); acc = __builtin_amdgcn_mfma_f32_16x16x32_bf16(ah1, Bl[1], acc, 0, 0, 0);
                acc = __builtin_amdgcn_mfma_f32_16x16x32_bf16(ah0, Bh[0], acc, 0, 0, 0); acc = __builtin_amdgcn_mfma_f32_16x16x32_bf16(ah1, Bh[1], acc, 0, 0, 0);
                if (fr < 4) {
#pragma unroll
                    for (int e = 0; e < 4; ++e) {
                        const int n = row0 + 4 * fq + e;
                        const float val = acc[e] * fexp(-(float)n * (1.0f / (float)(SEQL - 1)) * adl);
                        if (fr < 2) ldsf[2 * PH(n) + (fr & 1)] = val;
                        else if (n >= 1) ldsf[2 * PH(FFT_N - n) + (fr & 1)] = val;
                    }
                }
            }
        }
        __syncthreads();
        fft16k(lds, a.tw, tid);
#pragma unroll 4
        for (int i = 0; i < 32; ++i) zk[(size_t)o * FFT_N + tq + 512 * i] = lds[PH(tq + 512 * i)];
    }
    const float inv_n = 1.0f / (float)FFT_N;
    asm volatile("s_waitcnt vmcnt(0)" ::: "memory");
    __syncthreads();
#pragma unroll 1
    for (int s = 0; s < NSEQ; ++s) {
        const size_t m0 = (size_t)s * SEQL;
        int tq = tid; asm volatile("" : "+v"(tq)); const int t0 = 16 * tq;
        {
            float v0[16], v1[16];
            load_conv3_16(a.phy + (size_t)(0 * DHY + c0) * NTOK + m0, t0, prm[0], prm[1], prm[2], prm[3], v0);
            load_conv3_16(a.phy + (size_t)(0 * DHY + c1) * NTOK + m0, t0, prm[4], prm[5], prm[6], prm[7], v1);
            __syncthreads();
#pragma unroll
            for (int e = 0; e < 16; ++e) { lds[PH(t0 + e)] = (f32x2){v0[e], v1[e]}; lds[PH(SEQL + t0 + e)] = (f32x2){0.f, 0.f}; }
        }
        __syncthreads();
        fft16k(lds, a.tw, tid);
        spec_mul(lds, zk, tid);
        fft16k(lds, a.tw, tid);
        float z0[16], z1[16];
        {
            float x0[16], x1[16];
            load_conv3_16(a.phy + (size_t)(0 * DHY + c0) * NTOK + m0, t0, prm[0], prm[1], prm[2], prm[3], x0);
            load_conv3_16(a.phy + (size_t)(0 * DHY + c1) * NTOK + m0, t0, prm[4], prm[5], prm[6], prm[7], x1);
#pragma unroll
            for (int e = 0; e < 16; ++e) { const f32x2 r = lds[PH(t0 + e)]; z0[e] = r.x * inv_n + prm[32] * x0[e]; z1[e] = -r.y * inv_n + prm[33] * x1[e]; }
            load_conv3_16(a.phy + (size_t)(1 * DHY + c0) * NTOK + m0, t0, prm[8], prm[9], prm[10], prm[11], x0);
            load_conv3_16(a.phy + (size_t)(1 * DHY + c1) * NTOK + m0, t0, prm[12], prm[13], prm[14], prm[15], x1);
#pragma unroll
            for (int e = 0; e < 16; ++e) { z0[e] *= x0[e]; z1[e] *= x1[e]; }
        }
#pragma unroll
        for (int e = 0; e < 16; ++e) { lds[PH(t0 + e)] = (f32x2){z0[e], z1[e]}; lds[PH(SEQL + t0 + e)] = (f32x2){0.f, 0.f}; }
        __syncthreads();
        fft16k(lds, a.tw, tid);
        spec_mul(lds, zk + FFT_N, tid);
        fft16k(lds, a.tw, tid);
        {
            float x0[16], x1[16];
            load_conv3_16(a.phy + (size_t)(2 * DHY + c0) * NTOK + m0, t0, prm[16], prm[17], prm[18], prm[19], x0);
            load_conv3_16(a.phy + (size_t)(2 * DHY + c1) * NTOK + m0, t0, prm[20], prm[21], prm[22], prm[23], x1);
#pragma unroll
            for (int e = 0; e < 16; ++e) { const f32x2 r = lds[PH(t0 + e)];
                x0[e] = x0[e] * (r.x * inv_n + prm[34] * z0[e]); x1[e] = x1[e] * (-r.y * inv_n + prm[35] * z1[e]); }
            store16_bf16(a.hyy + (size_t)c0 * NTOK + m0 + t0, x0);
            store16_bf16(a.hyy + (size_t)c1 * NTOK + m0 + t0, x1);
        }
    }
}
constexpr int RG_T = 128, RG_NT = SEQL / RG_T;
constexpr int RG_XC_STRIDE = 272;
constexpr int RG_HF_OFF = RG_T * RG_XC_STRIDE;
constexpr int RG_LDS_BYTES = RG_HF_OFF + (RG_T / 4) * 512 * 4;
constexpr int RG_UNITS = NSEQ * RG_NT * NHEAD;
struct RgArgs {
    const bf16* prg;
    const float *conv_w, *conv_b;
    const bf16* rgw;
    const float *a_b, *x_b;
    const float* lam;
    f32x2* summ;
    bf16* rgy;
};
template <int PASS> __device__ __forceinline__ void rg_unit(const RgArgs& a, LAS unsigned char* lds, int unit, int tid) {
    const int wave = tid >> 6, lane = tid & 63, fr = lane & 15, fq = lane >> 4;
    const int h = unit % NHEAD, tt = (unit / NHEAD) % RG_NT, s = unit / (NHEAD * RG_NT);
    const int tok0 = tt * RG_T;
    const size_t mrow0 = (size_t)s * SEQL;
    __syncthreads();
    {
        const int cg = h * HDIM + 2 * lane;
        float w0[4], w1[4];
#pragma unroll
        for (int k = 0; k < 4; ++k) { w0[k] = a.conv_w[k * DRG + cg]; w1[k] = a.conv_w[k * DRG + cg + 1]; }
        const float cb0 = a.conv_b[cg], cb1 = a.conv_b[cg + 1];
        float x0[4], x1[4];
        const int tb = tok0 + 16 * wave;
#pragma unroll
        for (int k = 0; k < 3; ++k) { const int t = tb - 2 + k; unsigned u = 0u; if (t >= 0 && t < SEQL) u = *(const unsigned*)(a.prg + (mrow0 + t) * DM + cg); x0[k] = bflo(u); x1[k] = bfhi(u); }
#pragma unroll
        for (int i = 0; i < 16; ++i) {
            const int t = tb + i + 1; unsigned u = 0u; if (t < SEQL) u = *(const unsigned*)(a.prg + (mrow0 + t) * DM + cg);
            x0[3] = bflo(u); x1[3] = bfhi(u);
            const float y0 = cb0 + w0[0] * x0[0] + w0[1] * x0[1] + w0[2] * x0[2] + w0[3] * x0[3];
            const float y1 = cb1 + w1[0] * x1[0] + w1[1] * x1[1] + w1[2] * x1[2] + w1[3] * x1[3];
            *(LAS unsigned*)(lds + (16 * wave + i) * RG_XC_STRIDE + lane * 4) = pk2(y0, y1);
            x0[0] = x0[1]; x0[1] = x0[2]; x0[2] = x0[3]; x1[0] = x1[1]; x1[1] = x1[2]; x1[2] = x1[3];
        }
    }
    __syncthreads();
    const int ch = h * HDIM + 16 * wave + fr;
    LAS float* hfl = (LAS float*)(lds + RG_HF_OFF) + tid;
#pragma unroll
    for (int dir = 0; dir < 2; ++dir) {
        bf16x8 Br[4], Bi[4];
#pragma unroll
        for (int kk = 0; kk < 4; ++kk) {
            Br[kk] = *(const bf16x8*)(a.rgw + ((((size_t)dir * 2 + 0) * NHEAD + h) * HDIM + 16 * wave + fr) * HDIM + 32 * kk + 8 * fq);
            Bi[kk] = *(const bf16x8*)(a.rgw + ((((size_t)dir * 2 + 1) * NHEAD + h) * HDIM + 16 * wave + fr) * HDIM + 32 * kk + 8 * fq);
        }
        const float ba = a.a_b[dir * DRG + ch], bx = a.x_b[dir * DRG + ch];
        const float sp = log1pf(expf(-a.lam[dir * DRG + ch]));
        float carry = 0.f, ptot = 1.f;
        if (PASS == 2) {
            const f32x2* sm = a.summ + ((size_t)dir * NSEQ + s) * RG_NT * DRG + ch;
            if (dir == 0) { for (int j = 0; j < tt; ++j) { const f32x2 pb = sm[(size_t)j * DRG]; carry = pb.x * carry + pb.y; } }
            else { for (int j = RG_NT - 1; j > tt; --j) { const f32x2 pb = sm[(size_t)j * DRG]; carry = pb.x * carry + pb.y; } }
        }
        for (int bi = 0; bi < RG_T / 16; ++bi) {
            const int blk = dir == 0 ? bi : (RG_T / 16 - 1 - bi);
            f32x4 accR = (f32x4){0.f, 0.f, 0.f, 0.f}, accI = (f32x4){0.f, 0.f, 0.f, 0.f};
#pragma unroll
            for (int kk = 0; kk < 4; ++kk) {
                const bf16x8 af = *(const LAS bf16x8*)(lds + (16 * blk + fr) * RG_XC_STRIDE + (32 * kk + 8 * fq) * 2);
                accR = __builtin_amdgcn_mfma_f32_16x16x32_bf16(af, Br[kk], accR, 0, 0, 0);
                accI = __builtin_amdgcn_mfma_f32_16x16x32_bf16(af, Bi[kk], accI, 0, 0, 0);
            }
            float av[4], bv[4];
#pragma unroll
            for (int e = 0; e < 4; ++e) {
                const float r = sigmoidf_(accR[e] + ba), ig = sigmoidf_(accI[e] + bx);
                const float log_a = -8.0f * r * sp;
                av[e] = fexp(log_a);
                const float x2 = 2.0f * log_a;
                const float em = -x2 * (1.0f + x2 * (0.5f + x2 * (0.16666667f + x2 * (0.041666668f + x2 * (0.0083333338f + x2 * (0.0013888889f + x2 * (0.0001984127f + x2 * 0.0000248016f)))))));
                const float em2 = x2 < -0.25f ? (1.0f - av[e] * av[e]) : em;
                const float mult = __builtin_amdgcn_sqrtf(fmaxf(em2, 0.f));
                const float xcv = bf2f(*(const LAS unsigned short*)(lds + (16 * blk + 4 * fq + e) * RG_XC_STRIDE + (16 * wave + fr) * 2));
                bv[e] = mult * ig * xcv;
            }
            float A = 1.f, B = 0.f;
            if (dir == 0) {
#pragma unroll
                for (int e = 0; e < 4; ++e) { B = av[e] * B + bv[e]; A *= av[e]; }
            } else {
#pragma unroll
                for (int e = 3; e >= 0; --e) { B = av[e] * B + bv[e]; A *= av[e]; }
            }
            float hin;
            if (dir == 0) {
                float Ap = __shfl_up(A, 16), Bp = __shfl_up(B, 16);
                if (fq >= 1) { B = A * Bp + B; A = Ap * A; }
                Ap = __shfl_up(A, 32); Bp = __shfl_up(B, 32);
                if (fq >= 2) { B = A * Bp + B; A = Ap * A; }
                const float hend = A * carry + B;
                const float hprev = __shfl_up(hend, 16);
                hin = fq == 0 ? carry : hprev;
                carry = __shfl(hend, 48 + fr);
                if (PASS == 1) ptot *= __shfl(A, 48 + fr);
            } else {
                float Ap = __shfl_down(A, 16), Bp = __shfl_down(B, 16);
                if (fq <= 2) { B = A * Bp + B; A = Ap * A; }
                Ap = __shfl_down(A, 32); Bp = __shfl_down(B, 32);
                if (fq <= 1) { B = A * Bp + B; A = Ap * A; }
                const float hend = A * carry + B;
                const float hprev = __shfl_down(hend, 16);
                hin = fq == 3 ? carry : hprev;
                carry = __shfl(hend, fr);
                if (PASS == 1) ptot *= __shfl(A, fr);
            }
            if (PASS == 2) {
                if (dir == 0) {
                    float hh = hin;
#pragma unroll
                    for (int e = 0; e < 4; ++e) { hh = av[e] * hh + bv[e]; hfl[(blk * 4 + e) * 512] = hh; }
                } else {
                    float hh = hin, hb[4];
#pragma unroll
                    for (int e = 3; e >= 0; --e) { hh = av[e] * hh + bv[e]; hb[e] = hh; }
#pragma unroll
                    for (int e = 0; e < 4; ++e) {
                        const size_t m = mrow0 + tok0 + 16 * blk + 4 * fq + e;
                        const float g = bf2f(a.prg[m * DM + DRG + ch]);
                        a.rgy[m * DRG + ch] = (bf16)f2bf((hfl[(blk * 4 + e) * 512] + hb[e]) * gelu_tanh(g));
                    }
                }
            }
        }
        if (PASS == 1 && fq == 0) a.summ[(((size_t)dir * NSEQ + s) * RG_NT + tt) * DRG + ch] = (f32x2){ptot, carry};
    }
}
__device__ __forceinline__ void mixnorm_rg_row(const bf16* rgy, const float* g_rg, bf16* mix, int m, int lane) {
    v4u r[4]; float s = 0.f;
#pragma unroll
    for (int j = 0; j < 4; ++j) { r[j] = *(const v4u*)(rgy + (size_t)m * DRG + (j * 64 + lane) * 8);
        const float a0 = bflo(r[j].x), a1 = bfhi(r[j].x), a2 = bflo(r[j].y), a3 = bfhi(r[j].y), a4 = bflo(r[j].z), a5 = bfhi(r[j].z), a6 = bflo(r[j].w), a7 = bfhi(r[j].w);
        s += (a0 * a0 + a1 * a1) + (a2 * a2 + a3 * a3) + (a4 * a4 + a5 * a5) + (a6 * a6 + a7 * a7); }
    const float rs = 1.0f / sqrtf(wave_sum(s) * (1.0f / DRG) + EPSN);
#pragma unroll
    for (int j = 0; j < 4; ++j) { const int c0 = (j * 64 + lane) * 8; const f32x4 g0 = *(const f32x4*)(g_rg + c0), g1 = *(const f32x4*)(g_rg + c0 + 4);
        v4u o; o.x = pk2(bflo(r[j].x) * rs * g0.x, bfhi(r[j].x) * rs * g0.y); o.y = pk2(bflo(r[j].y) * rs * g0.z, bfhi(r[j].y) * rs * g0.w);
        o.z = pk2(bflo(r[j].z) * rs * g1.x, bfhi(r[j].z) * rs * g1.y); o.w = pk2(bflo(r[j].w) * rs * g1.z, bfhi(r[j].w) * rs * g1.w);
        *(v4u*)(mix + (size_t)m * DM + c0) = o; }
}
constexpr int MN_TILE_STRIDE = 66;
constexpr int MN_LDS_BYTES = 8 * 64 * MN_TILE_STRIDE * 2 + 8 * 64 * 4 + 64 * 4;
__device__ __forceinline__ void mixnorm_hy_tile(const bf16* hyy, const float* g_hy, bf16* mix, LAS unsigned char* lds, int tile, int tid) {
    const int wave = tid >> 6, lane = tid & 63, m0 = tile * 64;
    LAS unsigned short* tl = (LAS unsigned short*)(lds + wave * 64 * MN_TILE_STRIDE * 2);
    LAS float* part = (LAS float*)(lds + 8 * 64 * MN_TILE_STRIDE * 2);
    LAS float* scl = part + 8 * 64;
    __syncthreads();
    float s = 0.f;
    for (int c = wave * 256; c < wave * 256 + 256; ++c) { const float v = bf2f(hyy[(size_t)c * NTOK + m0 + lane]); s += v * v; }
    part[wave * 64 + lane] = s;
    __syncthreads();
    if (tid < 64) { float t = 0.f;
#pragma unroll
        for (int w = 0; w < 8; ++w) t += part[w * 64 + tid];
        scl[tid] = 1.0f / sqrtf(t * (1.0f / DHY) + EPSN); }
    __syncthreads();
    for (int cb = wave; cb < DHY / 64; cb += 8) {
        for (int ci = 0; ci < 64; ++ci) tl[ci * MN_TILE_STRIDE + lane] = hyy[(size_t)(cb * 64 + ci) * NTOK + m0 + lane];
        asm volatile("s_waitcnt lgkmcnt(0)" ::: "memory");
        const float g = g_hy[cb * 64 + lane];
        for (int tk = 0; tk < 64; ++tk) mix[(size_t)(m0 + tk) * DM + DRG + cb * 64 + lane] = (bf16)f2bf(bf2f(tl[lane * MN_TILE_STRIDE + tk]) * scl[tk] * g);
        asm volatile("s_waitcnt lgkmcnt(0)" ::: "memory");
    }
}
__device__ __forceinline__ void rowpass1(const float* xr, const bf16* yr, const float* g_post, const float* g_pre, float* outr, bf16* xnr, int lane) {
    float v[64]; float s = 0.f;
#pragma unroll
    for (int j = 0; j < 8; ++j) { const v4u r = *(const v4u*)(yr + (j * 64 + lane) * 8);
        v[8 * j + 0] = bflo(r.x); v[8 * j + 1] = bfhi(r.x); v[8 * j + 2] = bflo(r.y); v[8 * j + 3] = bfhi(r.y); v[8 * j + 4] = bflo(r.z); v[8 * j + 5] = bfhi(r.z); v[8 * j + 6] = bflo(r.w); v[8 * j + 7] = bfhi(r.w);
#pragma unroll
        for (int e = 0; e < 8; ++e) s += v[8 * j + e] * v[8 * j + e]; }
    const float rs = 1.0f / sqrtf(wave_sum(s) * (1.0f / DM) + EPSN);
    float s2 = 0.f;
#pragma unroll
    for (int j = 0; j < 8; ++j) { const int c0 = (j * 64 + lane) * 8;
        const f32x4 x0 = *(const f32x4*)(xr + c0), x1 = *(const f32x4*)(xr + c0 + 4), g0 = *(const f32x4*)(g_post + c0), g1 = *(const f32x4*)(g_post + c0 + 4);
        f32x4 o0, o1;
        o0.x = x0.x + v[8 * j + 0] * rs * g0.x; o0.y = x0.y + v[8 * j + 1] * rs * g0.y; o0.z = x0.z + v[8 * j + 2] * rs * g0.z; o0.w = x0.w + v[8 * j + 3] * rs * g0.w;
        o1.x = x1.x + v[8 * j + 4] * rs * g1.x; o1.y = x1.y + v[8 * j + 5] * rs * g1.y; o1.z = x1.z + v[8 * j + 6] * rs * g1.z; o1.w = x1.w + v[8 * j + 7] * rs * g1.w;
        *(f32x4*)(outr + c0) = o0; *(f32x4*)(outr + c0 + 4) = o1;
        v[8 * j + 0] = o0.x; v[8 * j + 1] = o0.y; v[8 * j + 2] = o0.z; v[8 * j + 3] = o0.w; v[8 * j + 4] = o1.x; v[8 * j + 5] = o1.y; v[8 * j + 6] = o1.z; v[8 * j + 7] = o1.w;
        s2 += (o0.x * o0.x + o0.y * o0.y) + (o0.z * o0.z + o0.w * o0.w) + (o1.x * o1.x + o1.y * o1.y) + (o1.z * o1.z + o1.w * o1.w); }
    const float rs2 = 1.0f / sqrtf(wave_sum(s2) * (1.0f / DM) + EPSN);
#pragma unroll
    for (int j = 0; j < 8; ++j) { const int c0 = (j * 64 + lane) * 8; const f32x4 g0 = *(const f32x4*)(g_pre + c0), g1 = *(const f32x4*)(g_pre + c0 + 4);
        v4u o; o.x = pk2(v[8 * j + 0] * rs2 * g0.x, v[8 * j + 1] * rs2 * g0.y); o.y = pk2(v[8 * j + 2] * rs2 * g0.z, v[8 * j + 3] * rs2 * g0.w);
        o.z = pk2(v[8 * j + 4] * rs2 * g1.x, v[8 * j + 5] * rs2 * g1.y); o.w = pk2(v[8 * j + 6] * rs2 * g1.z, v[8 * j + 7] * rs2 * g1.w);
        *(v4u*)(xnr + c0) = o; }
}
__device__ __forceinline__ void rowpass2(const bf16* fr_, const float* g, float* outr, int lane) {
    float v[64]; float s = 0.f;
#pragma unroll
    for (int j = 0; j < 8; ++j) { const v4u r = *(const v4u*)(fr_ + (j * 64 + lane) * 8);
        v[8 * j + 0] = bflo(r.x); v[8 * j + 1] = bfhi(r.x); v[8 * j + 2] = bflo(r.y); v[8 * j + 3] = bfhi(r.y); v[8 * j + 4] = bflo(r.z); v[8 * j + 5] = bfhi(r.z); v[8 * j + 6] = bflo(r.w); v[8 * j + 7] = bfhi(r.w);
#pragma unroll
        for (int e = 0; e < 8; ++e) s += v[8 * j + e] * v[8 * j + e]; }
    const float rs = 1.0f / sqrtf(wave_sum(s) * (1.0f / DM) + EPSN);
#pragma unroll
    for (int j = 0; j < 8; ++j) { const int c0 = (j * 64 + lane) * 8;
        const f32x4 x0 = *(const f32x4*)(outr + c0), x1 = *(const f32x4*)(outr + c0 + 4), g0 = *(const f32x4*)(g + c0), g1 = *(const f32x4*)(g + c0 + 4);
        f32x4 o0, o1;
        o0.x = x0.x + v[8 * j + 0] * rs * g0.x; o0.y = x0.y + v[8 * j + 1] * rs * g0.y; o0.z = x0.z + v[8 * j + 2] * rs * g0.z; o0.w = x0.w + v[8 * j + 3] * rs * g0.w;
        o1.x = x1.x + v[8 * j + 4] * rs * g1.x; o1.y = x1.y + v[8 * j + 5] * rs * g1.y; o1.z = x1.z + v[8 * j + 6] * rs * g1.z; o1.w = x1.w + v[8 * j + 7] * rs * g1.w;
        *(f32x4*)(outr + c0) = o0; *(f32x4*)(outr + c0 + 4) = o1; }
}
constexpr int SIDE_G_ROWS = 8, SIDE_U_ROWS = 4;
__device__ __forceinline__ float dpp_prev(float x, float xprevblk) {
    const int old = __builtin_amdgcn_update_dpp(0, __builtin_bit_cast(int, xprevblk), 0x121  , 0xf, 0xf, false);
    return __builtin_bit_cast(float, __builtin_amdgcn_update_dpp(old, __builtin_bit_cast(int, x), 0x111  , 0xf, 0xf, false));
}
__device__ __forceinline__ float dpp_next(float x, float xnextblk) {
    const int old = __builtin_amdgcn_update_dpp(0, __builtin_bit_cast(int, xnextblk), 0x12F  , 0xf, 0xf, false);
    return __builtin_bit_cast(float, __builtin_amdgcn_update_dpp(old, __builtin_bit_cast(int, x), 0x101  , 0xf, 0xf, false));
}
struct EpiGate {
    static constexpr bool PERM = true, AFTER_DRAIN = false, AROWPERM = true;
    bf16* H; const float* cw; const float* cb; float* sideG; float* sideU;
    __device__ __forceinline__ void operator()(const pg8::f32x4 (&acc)[2][2][4][2], const pg8::Unit& u, int wr, int wc, int fr, int fq) const {
        const int hc0 = u.pn * 128 + wc * 32 + 8 * fq;
        f32x4 w0[2], w1[2], w2[2], bb[2];
#pragma unroll
        for (int n = 0; n < 2; ++n) { w0[n] = *(const f32x4*)(cw + hc0 + 4 * n); w1[n] = *(const f32x4*)(cw + DFF + hc0 + 4 * n); w2[n] = *(const f32x4*)(cw + 2 * DFF + hc0 + 4 * n); bb[n] = *(const f32x4*)(cb + hc0 + 4 * n); }
        const size_t row0 = (size_t)u.pm * 256 + wr * 128 + fr;
        const f32x4 zero4 = (f32x4){0.f, 0.f, 0.f, 0.f};
#pragma unroll
        for (int blk = 0; blk < 8; ++blk) {
            const int ai = blk >> 2, m = blk & 3;
            float r[8];
#pragma unroll
            for (int n = 0; n < 2; ++n) {
                const f32x4 x = acc[ai][0][m][n];
                const f32x4 xp = blk > 0 ? acc[(blk - 1) >> 2][0][(blk - 1) & 3][n] : zero4;
                const f32x4 xn = blk < 7 ? acc[(blk + 1) >> 2][0][(blk + 1) & 3][n] : zero4;
                const f32x4 uu = acc[ai][1][m][n];
#pragma unroll
                for (int j = 0; j < 4; ++j) {
                    const float pre = bb[n][j] + w0[n][j] * dpp_prev(x[j], xp[j]) + w1[n][j] * x[j] + w2[n][j] * dpp_next(x[j], xn[j]);
                    r[4 * n + j] = gelu_tanh(pre) * uu[j];
                }
            }
            v4u o; o.x = pk2(r[0], r[1]); o.y = pk2(r[2], r[3]); o.z = pk2(r[4], r[5]); o.w = pk2(r[6], r[7]);
            *(v4u*)(H + (row0 + 16 * blk) * DFF + hc0) = o;
        }
        float* sg = sideG + ((size_t)u.pm * SIDE_G_ROWS + 4 * wr) * DFF + hc0;
        float* su = sideU + ((size_t)u.pm * SIDE_U_ROWS + 2 * wr) * DFF + hc0;
        if (fr < 2) { *(f32x4*)(sg + (size_t)fr * DFF) = acc[0][0][0][0]; *(f32x4*)(sg + (size_t)fr * DFF + 4) = acc[0][0][0][1]; }
        if (fr >= 14) { *(f32x4*)(sg + (size_t)(fr - 12) * DFF) = acc[1][0][3][0]; *(f32x4*)(sg + (size_t)(fr - 12) * DFF + 4) = acc[1][0][3][1]; }
        if (fr == 0) { *(f32x4*)su = acc[0][1][0][0]; *(f32x4*)(su + 4) = acc[0][1][0][1]; }
        if (fr == 15) { *(f32x4*)(su + DFF) = acc[1][1][3][0]; *(f32x4*)(su + DFF + 4) = acc[1][1][3][1]; }
    }
};
__device__ __forceinline__ void gate_fixup(const float* sideG, const float* sideU, const float* cw, const float* cb, bf16* H, int gtid, int nthreads) {
    constexpr int C4 = DFF / 4, NT = NTOK / 256;
    for (int idx = gtid; idx < NT * 4 * C4; idx += nthreads) {
        const int c = (idx % C4) * 4, k = (idx / C4) & 3, pm = idx / (4 * C4);
        const float* g = sideG + (size_t)pm * SIDE_G_ROWS * DFF + c;
        f32x4 prev, cur, next; int row;
        const f32x4 z = (f32x4){0.f, 0.f, 0.f, 0.f};
        if (k == 0) { row = 0; prev = (pm % 32 == 0) ? z : *(const f32x4*)(g - (size_t)SIDE_G_ROWS * DFF + 7 * (size_t)DFF); cur = *(const f32x4*)g; next = *(const f32x4*)(g + DFF); }
        else if (k == 1) { row = 127; prev = *(const f32x4*)(g + 2 * (size_t)DFF); cur = *(const f32x4*)(g + 3 * (size_t)DFF); next = *(const f32x4*)(g + 4 * (size_t)DFF); }
        else if (k == 2) { row = 128; prev = *(const f32x4*)(g + 3 * (size_t)DFF); cur = *(const f32x4*)(g + 4 * (size_t)DFF); next = *(const f32x4*)(g + 5 * (size_t)DFF); }
        else { row = 255; prev = *(const f32x4*)(g + 6 * (size_t)DFF); cur = *(const f32x4*)(g + 7 * (size_t)DFF); next = (pm % 32 == 31) ? z : *(const f32x4*)(g + (size_t)SIDE_G_ROWS * DFF); }
        const f32x4 uu = *(const f32x4*)(sideU + ((size_t)pm * SIDE_U_ROWS + k) * DFF + c);
        const f32x4 w0 = *(const f32x4*)(cw + c), w1 = *(const f32x4*)(cw + DFF + c), w2 = *(const f32x4*)(cw + 2 * DFF + c), b = *(const f32x4*)(cb + c);
        float r[4];
#pragma unroll
        for (int j = 0; j < 4; ++j) r[j] = gelu_tanh(b[j] + w0[j] * prev[j] + w1[j] * cur[j] + w2[j] * next[j]) * uu[j];
        v2u o; o.x = pk2(r[0], r[1]); o.y = pk2(r[2], r[3]);
        *(v2u*)(H + ((size_t)pm * 256 + row) * DFF + c) = o;
    }
}
constexpr int LDS_PHASE_BYTES = 143360;
constexpr int LDSCTL_OFF = LDS_PHASE_BYTES, LDS_BYTES = 147456;
constexpr int CW_BAR = 4096;
constexpr size_t CTL_ZERO_BYTES = 64 * 1024;
static_assert(HY_LDS_BYTES <= LDS_PHASE_BYTES && RG_LDS_BYTES <= LDS_PHASE_BYTES && MN_LDS_BYTES <= LDS_PHASE_BYTES && pg8::STAGE_BYTES <= LDS_PHASE_BYTES, "LDS map");
static_assert((CW_BAR + XCD_BAR_WORDS) * 4 <= (int)CTL_ZERO_BYTES, "control words inside the memset region");

struct MkArgs { const float* in[32]; float* out; unsigned char* ws; };
__device__ __forceinline__ pg8::Gemm dgemm(const bf16* A, const bf16* Bt, int M, int N, int K) { pg8::Gemm g; g.A = A; g.Bt = Bt; g.M = M; g.N = N; g.K = K; return g; }
__device__ __forceinline__ pg8::EpiBf16<0> depi(bf16* O, int ldc) { pg8::EpiBf16<0> e; e.O = O; e.ldc = ldc; e.bias = nullptr; e.split_cols = 0; e.split_stride = 0; e.scale0 = 1.f; return e; }

__device__ __forceinline__ void gate_seq(const bf16* gu, const float* cw, const float* cb, bf16* h, int gtid, int nthreads) {
    constexpr int CG = DFF / 8;
    for (int idx = gtid; idx < SEQL * CG; idx += nthreads) {
        const int m = idx / CG, c0 = (idx % CG) * 8;
        const v4u z = (v4u){0u, 0u, 0u, 0u};
        const v4u gm = m > 0 ? *(const v4u*)(gu + (size_t)(m - 1) * 2 * DFF + c0) : z;
        const v4u g0 = *(const v4u*)(gu + (size_t)m * 2 * DFF + c0);
        const v4u gp = m < SEQL - 1 ? *(const v4u*)(gu + (size_t)(m + 1) * 2 * DFF + c0) : z;
        const v4u uu = *(const v4u*)(gu + (size_t)m * 2 * DFF + DFF + c0);
        float r[8];
#pragma unroll
        for (int e = 0; e < 8; ++e) {
            const unsigned wm = e < 2 ? gm.x : e < 4 ? gm.y : e < 6 ? gm.z : gm.w, w0 = e < 2 ? g0.x : e < 4 ? g0.y : e < 6 ? g0.z : g0.w, wp = e < 2 ? gp.x : e < 4 ? gp.y : e < 6 ? gp.z : gp.w, wu = e < 2 ? uu.x : e < 4 ? uu.y : e < 6 ? uu.z : uu.w;
            const float a = (e & 1) ? bfhi(wm) : bflo(wm), b = (e & 1) ? bfhi(w0) : bflo(w0), c = (e & 1) ? bfhi(wp) : bflo(wp), u = (e & 1) ? bfhi(wu) : bflo(wu);
            const float pre = cb[c0 + e] + cw[c0 + e] * a + cw[DFF + c0 + e] * b + cw[2 * DFF + c0 + e] * c;
            r[e] = gelu_tanh(pre) * u;
        }
        v4u o; o.x = pk2(r[0], r[1]); o.y = pk2(r[2], r[3]); o.z = pk2(r[4], r[5]); o.w = pk2(r[6], r[7]);
        *(v4u*)(h + (size_t)m * DFF + c0) = o;
    }
}

__global__ void __launch_bounds__(512, 2) mk_fwd(MkArgs args) {
    extern __shared__ __attribute__((aligned(16))) unsigned char lds_raw[];
    LAS unsigned char* lds = (LAS unsigned char*)lds_raw;
    const int tid = threadIdx.x, lane = tid & 63, wave = __builtin_amdgcn_readfirstlane(tid >> 6);
    const int G = gridDim.x, bx = blockIdx.x;
    unsigned char* ws = args.ws;
    const float* const* in = args.in;
    volatile LAS unsigned* MISC = (volatile LAS unsigned*)(lds + LDSCTL_OFF);
    for (int u = tid; u < (LDS_BYTES - LDSCTL_OFF) / 4; u += 512) ((LAS unsigned*)(lds + LDSCTL_OFF))[u] = 0u;
    __syncthreads();
    XcdBarrier bar = xcd_barrier_post((unsigned*)(ws + WS_CTL) + CW_BAR, MISC + 8);

    bf16* XN = (bf16*)(ws + WS_XN); bf16* WIN = (bf16*)(ws + WS_WIN);
    {
        ProArgs pa; pa.xp = in[0]; pa.xs = in[1]; pa.g_premix = in[2]; pa.w_in = in[3]; pa.w_out = in[24]; pa.w_ffi = in[27]; pa.w_ffo = in[30]; pa.rg_a_w = in[6]; pa.rg_x_w = in[8];
        pa.hy_w1 = in[13]; pa.hy_b1 = in[14]; pa.hy_w2 = in[15]; pa.hy_b2 = in[16]; pa.hy_w3 = in[17]; pa.hy_b3 = in[18]; pa.hy_freq = in[20]; pa.ws = ws;
        p0_prologue<true>(pa, lds, bx * 8 + wave, G * 8, wave, lane);
    }
    xcd_barrier(bar);
    {
        pg8::StaticOrder S; S.init(NTOK, 2 * DRG, G, bx);
        pg8::gemm_phase<pg8::EpiBf16<0>, pg8::StaticOrder, true, true>(lds, dgemm(XN, WIN, NTOK, 2 * DRG, DM), S, depi((bf16*)(ws + WS_PRG), 2 * DRG));
    }
    {
        pg8::StaticOrder S; S.init(3 * DHY, NTOK, G, bx);
        pg8::gemm_phase<pg8::EpiBf16<0>, pg8::StaticOrder, true, true>(lds, dgemm(WIN + (size_t)2 * DRG * DM, XN, 3 * DHY, NTOK, DM), S, depi((bf16*)(ws + WS_PHY), NTOK));
    }
    xcd_barrier(bar);
    RgArgs ra; ra.prg = (const bf16*)(ws + WS_PRG); ra.conv_w = in[4]; ra.conv_b = in[5]; ra.rgw = (const bf16*)(ws + WS_RGW); ra.a_b = in[7]; ra.x_b = in[9]; ra.lam = in[10];
    ra.summ = (f32x2*)(ws + WS_SUMM); ra.rgy = (bf16*)(ws + WS_RGY);
    {
        HyArgs a; a.phy = (const bf16*)(ws + WS_PHY); a.conv_w = in[11]; a.conv_b = in[12]; a.w4 = in[19]; a.hy_bias = in[21]; a.h3h = (const bf16*)(ws + WS_H3); a.tw = (const f32x2*)(ws + WS_TW);
        a.zk = (f32x2*)(ws + WS_ZK); a.hyy = (bf16*)(ws + WS_HYY);
        for (int cp = bx; cp < DHY / 2; cp += G) hyena_unit(a, lds, cp, bx, tid);
    }
    for (int u = bx; u < RG_UNITS; u += G) rg_unit<1>(ra, lds, u, tid);
    xcd_barrier(bar);
    for (int u = bx; u < RG_UNITS; u += G) rg_unit<2>(ra, lds, u, tid);
    xcd_barrier(bar);
    for (int m = bx * 8 + wave; m < NTOK; m += G * 8) mixnorm_rg_row((const bf16*)(ws + WS_RGY), in[22], (bf16*)(ws + WS_MIX), m, lane);
    for (int t = bx; t < NTOK / 64; t += G) mixnorm_hy_tile((const bf16*)(ws + WS_HYY), in[23], (bf16*)(ws + WS_MIX), lds, t, tid);
    xcd_barrier(bar);
    {
        pg8::StaticOrder S; S.init(NTOK, DM, G, bx);
        pg8::gemm_phase<pg8::EpiBf16<0>, pg8::StaticOrder, true, true>(lds, dgemm((bf16*)(ws + WS_MIX), (bf16*)(ws + WS_WOUT), NTOK, DM, DM), S, depi((bf16*)(ws + WS_Y), DM));
    }
    xcd_barrier(bar);
    for (int m = bx * 8 + wave; m < NTOK; m += G * 8) rowpass1(xrow_ptr(in[0], in[1], m), (const bf16*)(ws + WS_Y) + (size_t)m * DM, in[25], in[26], args.out + (size_t)m * DM, XN + (size_t)m * DM, lane);
    xcd_barrier(bar);
    bf16* HB = (bf16*)(ws + WS_H);
    {
        pg8::StaticOrder S; S.init(NTOK, 2 * DFF, G, bx);
        EpiGate E; E.H = HB; E.cw = in[28]; E.cb = in[29]; E.sideG = (float*)(ws + WS_SIDEG); E.sideU = (float*)(ws + WS_SIDEU);
        pg8::gemm_phase<EpiGate, pg8::StaticOrder, true, true>(lds, dgemm(XN, (bf16*)(ws + WS_WFI), NTOK, 2 * DFF, DM), S, E);
    }
    xcd_barrier(bar);
    { int tq = tid; asm volatile("" : "+v"(tq)); gate_fixup((const float*)(ws + WS_SIDEG), (const float*)(ws + WS_SIDEU), in[28], in[29], HB, bx * 512 + tq, G * 512); }
    xcd_barrier(bar);
    {
        pg8::StaticOrder S; S.init(NTOK, DM, G, bx);
        pg8::gemm_phase<pg8::EpiBf16<0>, pg8::StaticOrder, true, true>(lds, dgemm(HB, (bf16*)(ws + WS_WFO), NTOK, DM, DFF), S, depi((bf16*)(ws + WS_F), DM));
    }
    xcd_barrier(bar);
    for (int m = bx * 8 + wave; m < NTOK; m += G * 8) rowpass2((const bf16*)(ws + WS_F) + (size_t)m * DM, in[31], args.out + (size_t)m * DM, lane);
}

extern "C" void kernel_launch(void* const* d_in, const int* in_sizes, int n_in, void* d_out, int out_size, void* d_ws, size_t ws_size, hipStream_t stream) {
    static int grid = 0;
    if (grid == 0) {
        grid = -1;
        if (n_in != 32 || out_size != NTOK * DM || ws_size < WS_END) { fprintf(stderr, "kernel_launch: unexpected sizes n_in %d out %d ws %zu (need %zu)\n", n_in, out_size, ws_size, (size_t)WS_END); return; }
        int dev = 0, cus = 0, per_cu = 0;
        if (hipGetDevice(&dev) != hipSuccess || hipDeviceGetAttribute(&cus, hipDeviceAttributeMultiprocessorCount, dev) != hipSuccess) return;
        if (hipFuncSetAttribute((const void*)mk_fwd, hipFuncAttributeMaxDynamicSharedMemorySize, LDS_BYTES) != hipSuccess) { fprintf(stderr, "kernel_launch: hipFuncSetAttribute failed\n"); return; }
        if (hipOccupancyMaxActiveBlocksPerMultiprocessor(&per_cu, (const void*)mk_fwd, 512, LDS_BYTES) != hipSuccess || per_cu < 1) { fprintf(stderr, "kernel_launch: occupancy query says %d blocks per CU\n", per_cu); (void)hipGetLastError(); return; }
        grid = cus;
    }
    if (grid < 0) return;
    if (hipMemsetAsync((char*)d_ws + WS_CTL, 0, CTL_ZERO_BYTES, stream) != hipSuccess) return;
    MkArgs a; memset(&a, 0, sizeof a);
    for (int i = 0; i < 32; ++i) a.in[i] = (const float*)d_in[i];
    a.out = (float*)d_out; a.ws = (unsigned char*)d_ws;
    hipLaunchKernelGGL(mk_fwd, dim3(grid), dim3(512), LDS_BYTES, stream, a);
}
```

```cpp
#include <cstring>
#include <hip/hip_runtime.h>
#include <cstdio>
#include <cstdint>
namespace pg8 {
#define PG8_LAS __attribute__((address_space(3)))
typedef unsigned short bf16_t;
typedef short bf16x8 __attribute__((ext_vector_type(8)));
typedef float f32x4 __attribute__((ext_vector_type(4)));
typedef unsigned u32x4 __attribute__((ext_vector_type(4)));
constexpr int BM = 256, BK = 64, HALF = 128, HTB = HALF * BK * 2  , STAGE_BYTES = 8 * HTB, NXCD = 8, WGM = 8;

__host__ __device__ __forceinline__ int lds_byte(int r, int c) { const int st = (r >> 4) * 2 + (c >> 5), rr = r & 15, cc = c & 31, ob = rr * 64 + cc * 2; return st * 1024 + (ob ^ (((ob >> 9) & 1) << 5)); }
__host__ __device__ __forceinline__ void stage_rc(int b, int& R, int& C) { const int st = b / 1024, sb = b % 1024, swz = sb ^ (((sb >> 9) & 1) << 5); R = (st >> 1) * 16 + swz / 64; C = (st & 1) * 32 + (swz % 64) / 2; }
__host__ __device__ __forceinline__ int perm32(int rho) { const int n = rho >> 4, i = rho & 15; return 8 * (i >> 2) + 4 * n + (i & 3); }

struct Unit { int pm, pn; };
struct Gemm { const bf16_t* A; const bf16_t* Bt; int M, N, K, lda, ldb; };

struct StaticOrder {
    int nM, nN, nwg, G, c;
    __host__ __device__ void init(int M, int N, int G_, int c_) { nM = M / BM; nN = N / BM; nwg = nM * nN; G = G_; c = c_; }
    __host__ __device__ bool next(int i, Unit& u) const {
        const long L = (long)i * G + c; if (L >= nwg) return false;
        int wgid = (int)L; { const int q = nwg / NXCD, r = nwg % NXCD, xcd = wgid % NXCD, off = wgid / NXCD; wgid = (xcd < r ? xcd * (q + 1) : r * (q + 1) + (xcd - r) * q) + off; }
        const int nig = WGM * nN, gid = wgid / nig, fm = gid * WGM, gsz = (nM - fm) < WGM ? (nM - fm) : WGM;
        u.pm = fm + ((wgid % nig) % gsz); u.pn = (wgid % nig) / gsz; return true;
    }
    __device__ __forceinline__ void a_ready(const Unit&, int) const {}
    __device__ __forceinline__ void done(const Unit&) const {}
};

__device__ __forceinline__ unsigned cvt_pk_bf16(float lo, float hi) { unsigned r; asm volatile("v_cvt_pk_bf16_f32 %0, %1, %2" : "=v"(r) : "v"(lo), "v"(hi)); return r; }
typedef float f32x2 __attribute__((ext_vector_type(2)));
__device__ __forceinline__ f32x2 gelu_pk(f32x2 v) {
    const f32x2 av = __builtin_elementwise_abs(v), d = av * 0.2316418882f + 1.0f;
    f32x2 t; t.x = __builtin_amdgcn_rcpf(d.x); t.y = __builtin_amdgcn_rcpf(d.y);
    f32x2 q = t * 0.5307027145f + (-0.7265760135f); q = q * t + 0.7107068705f; q = q * t + (-0.142248368f); q = q * t + 0.127414796f; q = q * t;
    const f32x2 s = (v * v) * (-0.72134752044f);
    f32x2 e; e.x = __builtin_amdgcn_exp2f(s.x); e.y = __builtin_amdgcn_exp2f(s.y);
    const f32x2 m = v * (q * e), r = v - m;
    f32x2 o; o.x = v.x < 0.f ? m.x : r.x; o.y = v.y < 0.f ? m.y : r.y; return o;
}

template <int ACT  > struct EpiBf16 {
    static constexpr bool PERM = true, AFTER_DRAIN = false, AROWPERM = false; static_assert(ACT == 0 || ACT == 1, "EpiBf16: ACT is 0 (none) or 1 (gelu_pk)");
    bf16_t* O; int ldc; const float* bias; int split_cols; size_t split_stride; float scale0;
    __device__ __forceinline__ void operator()(const f32x4 (&acc)[2][2][4][2], const Unit& u, int wr, int wc, int fr, int fq) const {
        const int row0 = u.pm * BM + wr * 64 + fr; int colt = u.pn * BM; bf16_t* base = O;
        float sc = 1.f; if (split_cols) { const int t = colt / split_cols; base += (size_t)t * split_stride; colt -= t * split_cols; if (t == 0) sc = scale0; }
        const int col0 = colt + wc * 32 + 8 * fq, bcol0 = u.pn * BM + wc * 32 + 8 * fq;
        f32x4 bv[2][2];
#pragma unroll
        for (int bj = 0; bj < 2; ++bj)
#pragma unroll
            for (int n = 0; n < 2; ++n) bv[bj][n] = bias ? *(const f32x4*)(bias + bcol0 + bj * HALF + 4 * n) : (f32x4){0.f, 0.f, 0.f, 0.f};
#pragma unroll
        for (int ai = 0; ai < 2; ++ai)
#pragma unroll
            for (int m = 0; m < 4; ++m) { bf16_t* rowp = base + (size_t)(row0 + ai * HALF + m * 16) * ldc + col0;
#pragma unroll
                for (int bj = 0; bj < 2; ++bj) { f32x4 v0 = acc[ai][bj][m][0] + bv[bj][0], v1 = acc[ai][bj][m][1] + bv[bj][1];
                    if (ACT == 1) { f32x2 a = gelu_pk((f32x2){v0[0], v0[1]}), b = gelu_pk((f32x2){v0[2], v0[3]}), c = gelu_pk((f32x2){v1[0], v1[1]}), d = gelu_pk((f32x2){v1[2], v1[3]});
                        v0 = (f32x4){a.x, a.y, b.x, b.y}; v1 = (f32x4){c.x, c.y, d.x, d.y}; }
                    v0 = v0 * sc; v1 = v1 * sc; u32x4 w; w.x = cvt_pk_bf16(v0[0], v0[1]); w.y = cvt_pk_bf16(v0[2], v0[3]); w.z = cvt_pk_bf16(v1[0], v1[1]); w.w = cvt_pk_bf16(v1[2], v1[3]);
                    *(u32x4*)(rowp + bj * HALF) = w; } }
    }
};
template <class Epi, class Sched, bool ALIGN_EPI = false, bool SP2 = false>
__device__ __forceinline__ void gemm_phase(PG8_LAS unsigned char* lds, const Gemm g, const Sched& S, const Epi& E) {
    int tid_ = threadIdx.x; asm volatile("" : "+v"(tid_));
    const int tid = tid_, wid = __builtin_amdgcn_readfirstlane(tid >> 6), lane = tid & 63, wr = wid >> 2, wc = wid & 3, fr = lane & 15, fq = lane >> 4;
    const int K = g.K, nt = K / BK;
    unsigned voffA[2], voffB[2];
#pragma unroll
    for (int i = 0; i < 2; ++i) { int R, C; stage_rc(tid * 16 + i * 8192, R, C); const int Rb = Epi::PERM ? ((R & ~31) + perm32(R & 31)) : R; const int Ra = Epi::AROWPERM ? (128 * (R >> 6) + (R & 63)) : R;
        voffA[i] = (unsigned)(Ra * g.lda + C) * 2u; voffB[i] = (unsigned)(Rb * g.ldb + C) * 2u; }
    const size_t kstep = (size_t)(BK * 2);
    const size_t hstep = (size_t)HALF * g.ldb * 2;
    const size_t hstepA = (size_t)(Epi::AROWPERM ? 64 : HALF) * g.lda * 2;
    const size_t tstep = 2 * hstep, tstepA = (size_t)BM * g.lda * 2;
    const unsigned ldsw = (unsigned)wid * 1024u;
    const int aoff = lds_byte(wr * 64 + fr, fq * 8), boff = lds_byte(wc * 32 + fr, fq * 8);
#define PG8_SA(b, h) (((b) * 2 + (h)) * HTB)
#define PG8_SB(b, h) ((4 + (b) * 2 + (h)) * HTB)
#define PG8_STAGE(bufoff, gbase, voff) do { _Pragma("unroll") for (int _i = 0; _i < 2; ++_i) \
        __builtin_amdgcn_global_load_lds((const unsigned*)((const char*)(gbase) + (voff)[_i]), (PG8_LAS unsigned*)(lds + (bufoff) + ldsw + _i * 8192), 16, 0, 0); } while (0)
#define PG8_LDA(dst, b, h) do { _Pragma("unroll") for (int m = 0; m < 4; ++m) _Pragma("unroll") for (int k = 0; k < 2; ++k) dst[m][k] = *(const PG8_LAS bf16x8*)(lds + PG8_SA(b, h) + aoff + m * 2048 + k * 1024); } while (0)
#define PG8_LDB(dst, b, h) do { _Pragma("unroll") for (int n = 0; n < 2; ++n) _Pragma("unroll") for (int k = 0; k < 2; ++k) dst[n][k] = *(const PG8_LAS bf16x8*)(lds + PG8_SB(b, h) + boff + n * 2048 + k * 1024); } while (0)
#define PG8_MMA(ai, bj, At, Bt) do { __builtin_amdgcn_s_setprio(1); _Pragma("unroll") for (int m = 0; m < 4; ++m) _Pragma("unroll") for (int n = 0; n < 2; ++n) _Pragma("unroll") for (int k = 0; k < 2; ++k) \
        acc[ai][bj][m][n] = __builtin_amdgcn_mfma_f32_16x16x32_bf16(Bt[n][k], At[m][k], acc[ai][bj][m][n], 0, 0, 0); __builtin_amdgcn_s_setprio(0); } while (0)
#define PG8_WAIT_V(n) asm volatile("s_waitcnt vmcnt(" #n ")" ::: "memory")
#define PG8_WAIT_L(n) asm volatile("s_waitcnt lgkmcnt(" #n ")" ::: "memory")
#define PG8_BAR __builtin_amdgcn_s_barrier()
#define PG8_SCHED __builtin_amdgcn_sched_barrier(0)
    Unit cur, nxt; int ui = 0;
    if (!S.next(0, cur)) return;
    f32x4 acc[2][2][4][2];
#pragma unroll
    for (int a = 0; a < 2; ++a)
#pragma unroll
        for (int b = 0; b < 2; ++b)
#pragma unroll
            for (int m = 0; m < 4; ++m)
#pragma unroll
                for (int n = 0; n < 2; ++n) acc[a][b][m][n] = (f32x4){0.f, 0.f, 0.f, 0.f};
    bf16x8 At[4][2], B0[2][2], B1[2][2];
    const char* cA = (const char*)g.A + (size_t)cur.pm * tstepA; const char* cB = (const char*)g.Bt + (size_t)cur.pn * tstep;
    S.a_ready(cur, 0);
    if constexpr (SP2) {
        PG8_STAGE(PG8_SB(0, 0), cB, voffB); PG8_STAGE(PG8_SB(0, 1), cB + hstep, voffB); PG8_STAGE(PG8_SA(0, 0), cA, voffA); PG8_STAGE(PG8_SA(0, 1), cA + hstepA, voffA);
        if (wr == 1) PG8_BAR;
        PG8_WAIT_V(2); PG8_BAR;
        PG8_STAGE(PG8_SB(1, 0), cB + kstep, voffB); PG8_STAGE(PG8_SA(1, 0), cA + kstep, voffA); PG8_STAGE(PG8_SB(1, 1), cB + hstep + kstep, voffB);
        PG8_WAIT_V(6); PG8_BAR;
    } else {
        PG8_STAGE(PG8_SB(0, 0), cB, voffB); PG8_STAGE(PG8_SA(0, 0), cA, voffA); PG8_STAGE(PG8_SB(0, 1), cB + hstep, voffB); PG8_STAGE(PG8_SA(0, 1), cA + hstepA, voffA);
        if (wr == 1) PG8_BAR;
        PG8_WAIT_V(4); PG8_BAR;
        PG8_STAGE(PG8_SB(1, 0), cB + kstep, voffB); PG8_STAGE(PG8_SA(1, 0), cA + kstep, voffA); PG8_STAGE(PG8_SB(1, 1), cB + hstep + kstep, voffB);
        PG8_WAIT_V(6); PG8_BAR;
    }
    for (;;) {
        const bool has_next = S.next(ui + 1, nxt);
        const char* nA = has_next ? (const char*)g.A + (size_t)nxt.pm * tstepA : cA; const char* nB = has_next ? (const char*)g.Bt + (size_t)nxt.pn * tstep : cB;
        for (int t = 0; t < nt; t += 2) {
            const bool last = (t == nt - 2);
            const char* a1 = cA + (size_t)(t + 1) * kstep;
            const char* a2 = last ? nA : cA + (size_t)(t + 2) * kstep; const char* b2 = last ? nB : cB + (size_t)(t + 2) * kstep;
            const char* a3 = a2 + kstep; const char* b3 = b2 + kstep;
            if (last && has_next) S.a_ready(nxt, ui + 1);
            if constexpr (SP2) {
            PG8_LDB(B0, 0, 0); PG8_LDB(B1, 0, 1); PG8_SCHED; PG8_LDA(At, 0, 0); PG8_STAGE(PG8_SA(1, 1), a1 + hstepA, voffA);
            PG8_WAIT_V(8); PG8_WAIT_L(0); PG8_BAR; PG8_MMA(0, 0, At, B0); PG8_MMA(0, 1, At, B1); PG8_BAR; PG8_SCHED;
            PG8_LDA(At, 0, 1); PG8_STAGE(PG8_SB(0, 0), b2, voffB); PG8_STAGE(PG8_SB(0, 1), b2 + hstep, voffB); PG8_STAGE(PG8_SA(0, 0), a2, voffA);
            PG8_WAIT_V(8); PG8_WAIT_L(0); PG8_BAR; PG8_MMA(1, 0, At, B0); PG8_MMA(1, 1, At, B1); PG8_BAR; PG8_SCHED;
            PG8_LDB(B0, 1, 0); PG8_LDB(B1, 1, 1); PG8_SCHED; PG8_LDA(At, 1, 0); PG8_STAGE(PG8_SA(0, 1), a2 + hstepA, voffA);
            PG8_WAIT_V(8); PG8_WAIT_L(0); PG8_BAR; PG8_MMA(0, 0, At, B0); PG8_MMA(0, 1, At, B1); PG8_BAR; PG8_SCHED;
            PG8_LDA(At, 1, 1); PG8_STAGE(PG8_SB(1, 0), b3, voffB); PG8_STAGE(PG8_SB(1, 1), b3 + hstep, voffB); PG8_STAGE(PG8_SA(1, 0), a3, voffA);
            PG8_WAIT_V(8); PG8_WAIT_L(0); PG8_BAR; PG8_MMA(1, 0, At, B0); PG8_MMA(1, 1, At, B1); PG8_BAR; PG8_SCHED;
            } else {
            PG8_LDB(B0, 0, 0); PG8_SCHED; PG8_LDA(At, 0, 0); PG8_STAGE(PG8_SA(1, 1), a1 + hstepA, voffA);
            PG8_WAIT_L(8); PG8_BAR; PG8_WAIT_L(0); PG8_MMA(0, 0, At, B0); PG8_BAR; PG8_SCHED;
            PG8_LDB(B1, 0, 1); PG8_STAGE(PG8_SB(0, 0), b2, voffB);
            PG8_BAR; PG8_WAIT_L(0); PG8_MMA(0, 1, At, B1); PG8_BAR;
            PG8_LDA(At, 0, 1); PG8_STAGE(PG8_SA(0, 0), a2, voffA);
            PG8_BAR; PG8_WAIT_L(0); PG8_MMA(1, 0, At, B0); PG8_BAR; PG8_SCHED;
            PG8_STAGE(PG8_SB(0, 1), b2 + hstep, voffB);
            PG8_WAIT_V(6); PG8_BAR; PG8_MMA(1, 1, At, B1); PG8_BAR;
            PG8_LDB(B0, 1, 0); PG8_SCHED; PG8_LDA(At, 1, 0); PG8_STAGE(PG8_SA(0, 1), a2 + hstepA, voffA);
            PG8_WAIT_L(8); PG8_BAR; PG8_WAIT_L(0); PG8_MMA(0, 0, At, B0); PG8_BAR; PG8_SCHED;
            PG8_LDB(B1, 1, 1); PG8_STAGE(PG8_SB(1, 0), b3, voffB);
            PG8_BAR; PG8_WAIT_L(0); PG8_MMA(0, 1, At, B1); PG8_BAR;
            PG8_LDA(At, 1, 1); PG8_STAGE(PG8_SA(1, 0), a3, voffA);
            PG8_BAR; PG8_WAIT_L(0); PG8_MMA(1, 0, At, B0); PG8_BAR; PG8_SCHED;
            PG8_STAGE(PG8_SB(1, 1), b3 + hstep, voffB);
            PG8_WAIT_V(6); PG8_BAR; PG8_MMA(1, 1, At, B1); PG8_BAR;
            }
        }
        if constexpr (ALIGN_EPI) { if (wr == 0) PG8_BAR; }
        if constexpr (!Epi::AFTER_DRAIN) { E(acc, cur, wr, wc, fr, fq); S.done(cur); }
        if (!has_next) break;
#pragma unroll
        for (int a = 0; a < 2; ++a)
#pragma unroll
            for (int b = 0; b < 2; ++b)
#pragma unroll
                for (int m = 0; m < 4; ++m)
#pragma unroll
                    for (int n = 0; n < 2; ++n) acc[a][b][m][n] = (f32x4){0.f, 0.f, 0.f, 0.f};
        cur = nxt; cA = nA; cB = nB; ++ui;
        if constexpr (ALIGN_EPI) { if (wr == 1) PG8_BAR; }
    }
    PG8_WAIT_V(0);
    if constexpr (!ALIGN_EPI) { if (wr == 0) PG8_BAR; }
    PG8_BAR;
    if constexpr (Epi::AFTER_DRAIN) { E.fused(acc, cur, wr, wc, fr, fq, lds, wid, lane); S.done(cur); }
#undef PG8_SA
#undef PG8_SB
#undef PG8_STAGE
#undef PG8_LDA
#undef PG8_LDB
#undef PG8_MMA
#undef PG8_WAIT_V
#undef PG8_WAIT_L
#undef PG8_BAR
#undef PG8_SCHED
}
}
constexpr int SEQL = 8192, NSEQ = 3, NTOK = NSEQ * SEQL;
constexpr int DM = 4096, DRG = 2048, DHY = 2048, NIN = 10240, DFF = 11008;
constexpr int NHEAD = 16, HDIM = 128;
constexpr float EPSN = 1e-6f;
constexpr int FFT_N = 16384;
constexpr int LDK = DM;

#define GAS __attribute__((address_space(1)))
#define LAS __attribute__((address_space(3)))
typedef unsigned short bf16;
typedef unsigned v4u __attribute__((ext_vector_type(4)));
typedef unsigned v2u __attribute__((ext_vector_type(2)));
typedef float f32x4 __attribute__((ext_vector_type(4)));
typedef float f32x2 __attribute__((ext_vector_type(2)));
typedef short bf16x8 __attribute__((ext_vector_type(8)));

__device__ __forceinline__ unsigned f2bf(float f) { unsigned u = __builtin_bit_cast(unsigned, f); return (u + 0x7fffu + ((u >> 16) & 1u)) >> 16; }
__device__ __forceinline__ unsigned pk2(float lo, float hi) { return f2bf(lo) | (f2bf(hi) << 16); }
__device__ __forceinline__ float bf2f(unsigned b) { return __builtin_bit_cast(float, b << 16); }
__device__ __forceinline__ float bflo(unsigned w) { return __builtin_bit_cast(float, w << 16); }
__device__ __forceinline__ float bfhi(unsigned w) { return __builtin_bit_cast(float, w & 0xffff0000u); }
__device__ __forceinline__ float wave_sum(float v) {
#pragma unroll
    for (int o = 1; o < 64; o <<= 1) v += __shfl_xor(v, o);
    return v;
}
__device__ __forceinline__ float frcp(float x) { return __builtin_amdgcn_rcpf(x); }
__device__ __forceinline__ float fexp(float x) { return __builtin_amdgcn_exp2f(x * 1.4426950408889634f); }
__device__ __forceinline__ float sigmoidf_(float x) { return frcp(1.0f + fexp(-x)); }
__device__ __forceinline__ float gelu_tanh(float x) { const float u = 1.5957691216057308f * (x + 0.044715f * x * x * x); return x * frcp(1.0f + fexp(-u)); }

constexpr size_t MiB = 1u << 20;
constexpr size_t WS_CTL = 0;
constexpr size_t WS_TW = 1 * MiB;
constexpr size_t WS_H3 = 2 * MiB;
constexpr size_t WS_RGW = 4 * MiB;
constexpr size_t WS_SUMM = 6 * MiB;
constexpr size_t WS_WIN = 16 * MiB;
constexpr size_t WS_WOUT = 98 * MiB;
constexpr size_t WS_WFI = 131 * MiB;
constexpr size_t WS_WFO = 306 * MiB;
constexpr size_t WS_XN = 392 * MiB;
constexpr size_t WS_PRG = 588 * MiB;
constexpr size_t WS_PHY = 780 * MiB;
constexpr size_t WS_HYY = 1068 * MiB;
constexpr size_t WS_RGY = 1164 * MiB;
constexpr size_t WS_ZK = 1260 * MiB;
constexpr size_t WS_H = WS_PHY;
constexpr size_t WS_SIDEG = 1296 * MiB;
constexpr size_t WS_SIDEU = 1329 * MiB;
constexpr size_t WS_END = 1346 * MiB;
static_assert(WS_WIN + (size_t)NIN * LDK * 2 <= WS_WOUT && WS_WOUT + (size_t)DM * LDK * 2 <= WS_WFI && WS_WFI + (size_t)2 * DFF * LDK * 2 <= WS_WFO && WS_WFO + (size_t)DM * DFF * 2 <= WS_XN &&
              WS_XN + (size_t)NTOK * LDK * 2 <= WS_PRG && WS_PRG + (size_t)NTOK * DM * 2 <= WS_PHY && WS_PHY + (size_t)3 * DHY * NTOK * 2 <= WS_HYY && WS_PHY + (size_t)NTOK * LDK * 2 <= WS_HYY &&
              WS_HYY + (size_t)DHY * NTOK * 2 <= WS_RGY && WS_RGY + (size_t)NTOK * DRG * 2 <= WS_ZK && WS_ZK + (size_t)256 * 2 * FFT_N * 8 <= WS_END && WS_H + (size_t)NTOK * DFF * 2 <= WS_SIDEG &&
              WS_SIDEG + (size_t)96 * 8 * DFF * 4 <= WS_SIDEU && WS_SIDEU + (size_t)96 * 4 * DFF * 4 <= WS_END, "d_ws map");
constexpr size_t WS_MIX = WS_PHY;
constexpr size_t WS_Y = WS_PRG;
constexpr size_t WS_F = WS_PRG;
#define XB_TMO      128
#define XB_XCNT(j)  (256  + 64 * (j))
#define XB_XSUB(j)  (1280 + 64 * (j))
#define XB_XGEN(j)  (2304 + 64 * (j))
#define XB_TOP      3328
#define XB_TOPGEN   3392
#define XCD_BAR_WORDS 3456
#define XB_SPIN_CAP (1u << 18)

__device__ __forceinline__ unsigned xb_ld(unsigned* p)              { return __hip_atomic_load(p, __ATOMIC_RELAXED, __HIP_MEMORY_SCOPE_AGENT); }
__device__ __forceinline__ unsigned xb_add(unsigned* p, unsigned v) { return __hip_atomic_fetch_add(p, v, __ATOMIC_RELAXED, __HIP_MEMORY_SCOPE_AGENT); }
__device__ __forceinline__ unsigned xb_xcc_id() { return (unsigned)__builtin_amdgcn_s_getreg((3 << 11) | 20) & 0xFu; }
#define XB_SPIN(cond, bar) do { unsigned _sp = 0; while (cond) { __builtin_amdgcn_s_sleep(1); \
    if ((++_sp & 255u) == 0u) { if (xb_ld(&(bar)[XB_TMO])) break; if (_sp > XB_SPIN_CAP) { atomicAdd(&(bar)[XB_TMO], 1u); break; } } } } while (0)

struct XcdBarrier {
    unsigned* bar; unsigned x;
    volatile LAS unsigned* st;
};

__device__ __forceinline__ XcdBarrier xcd_barrier_post(unsigned* bar, volatile LAS unsigned* st) {
    XcdBarrier b; b.bar = bar; b.x = xb_xcc_id(); b.st = st;
    if (threadIdx.x == 0) (void)xb_add(&bar[XB_XCNT(b.x)], 1u);
    return b;
}
__device__ __forceinline__ void xcd_barrier_complete(unsigned* bar, unsigned x, unsigned& nloc, unsigned& nx) {
    const unsigned G = gridDim.x * gridDim.y * gridDim.z;
    unsigned sum, cnt, mine, sp = 0u;
    for (;;) {
        sum = 0u; cnt = 0u; mine = 0u;
#pragma unroll
        for (unsigned j = 0; j < 16; ++j) { const unsigned c = xb_ld(&bar[XB_XCNT(j)]); sum += c; cnt += (c > 0u) ? 1u : 0u; mine = (j == x) ? c : mine; }
        if (sum == G) break;
        __builtin_amdgcn_s_sleep(1);
        if ((++sp & 255u) == 0u) { if (xb_ld(&bar[XB_TMO])) break; if (sp > XB_SPIN_CAP) { atomicAdd(&bar[XB_TMO], 1u); break; } }
    }
    nloc = mine > 0u ? mine : 1u; nx = cnt > 0u ? cnt : 1u;
}

__device__ __forceinline__ void xcd_barrier(const XcdBarrier& b) {
    asm volatile("s_waitcnt vmcnt(0)" ::: "memory");
    __syncthreads();
    if (threadIdx.x == 0) {
        unsigned* bar = b.bar;
        __builtin_amdgcn_s_waitcnt(0);
        unsigned nloc = b.st[0], nx = b.st[1];
        if (nloc == 0u) { xcd_barrier_complete(bar, b.x, nloc, nx); b.st[0] = nloc; b.st[1] = nx; }
        const unsigned old = xb_add(&bar[XB_XSUB(b.x)], 1u);
        const unsigned gen = old / nloc;
        if (old + 1u == (gen + 1u) * nloc) {
            __builtin_amdgcn_fence(__ATOMIC_RELEASE, "agent");
            asm volatile("s_waitcnt vmcnt(0)" ::: "memory");
            const unsigned og = xb_add(&bar[XB_TOP], 1u);
            const unsigned tg = og / nx;
            if (og + 1u == (tg + 1u) * nx) xb_add(&bar[XB_TOPGEN], 1u);
            else XB_SPIN(xb_ld(&bar[XB_TOPGEN]) == tg, bar);
            __builtin_amdgcn_fence(__ATOMIC_ACQUIRE, "agent");
            xb_add(&bar[XB_XGEN(b.x)], 1u);
            asm volatile("s_waitcnt vmcnt(0)" ::: "memory");
        } else {
            XB_SPIN(xb_ld(&bar[XB_XGEN(b.x)]) == gen, bar);
            __builtin_amdgcn_fence(__ATOMIC_ACQUIRE, "agent");
            asm volatile("s_waitcnt vmcnt(0)" ::: "memory");
        }
    }
    __syncthreads();
}
struct TrItem { const float* W; bf16* WT; int K, N, k0, n0, drow0, ldt; };
__device__ __forceinline__ void tr_load(const TrItem& t, int lane, f32x4 (&v)[8]) {
    const float* p = t.W + (size_t)(t.k0 + (lane >> 3)) * t.N + t.n0 + (lane & 7) * 4;
#pragma unroll
    for (int ii = 0; ii < 8; ++ii) v[ii] = __builtin_nontemporal_load((const f32x4*)(p + (size_t)8 * ii * t.N));
}
__device__ __forceinline__ void tr_store(const TrItem& t, int lane, const f32x4 (&v)[8], LAS float* scr) {
    LAS float* w = scr + (lane >> 3) * 33 + (lane & 7) * 4;
#pragma unroll
    for (int ii = 0; ii < 8; ++ii) { w[ii * 8 * 33 + 0] = v[ii].x; w[ii * 8 * 33 + 1] = v[ii].y; w[ii * 8 * 33 + 2] = v[ii].z; w[ii * 8 * 33 + 3] = v[ii].w; }
    asm volatile("s_waitcnt lgkmcnt(0)" ::: "memory");
    const int c = lane & 7;
#pragma unroll
    for (int j = 0; j < 4; ++j) { const int n = (lane >> 3) + 8 * j; const LAS float* s = scr + (8 * c) * 33 + n;
        v4u o; o.x = pk2(s[0 * 33], s[1 * 33]); o.y = pk2(s[2 * 33], s[3 * 33]); o.z = pk2(s[4 * 33], s[5 * 33]); o.w = pk2(s[6 * 33], s[7 * 33]);
        *(v4u*)(t.WT + (size_t)(t.drow0 + n) * t.ldt + t.k0 + 8 * c) = o; }
    asm volatile("s_waitcnt lgkmcnt(0)" ::: "memory");
}
template <bool INTER> __device__ __forceinline__ int ffi_drow(int n) {
    if (!INTER) return n;
    const int up = n >= DFF ? 1 : 0, c = n - up * DFF; return (c >> 7) * 256 + up * 128 + (c & 127);
}
struct ProArgs {
    const float *xp, *xs, *g_premix;
    const float *w_in, *w_out, *w_ffi, *w_ffo;
    const float *rg_a_w, *rg_x_w;
    const float *hy_w1, *hy_b1, *hy_w2, *hy_b2, *hy_w3, *hy_b3, *hy_freq;
    unsigned char* ws;
};
__device__ __forceinline__ const float* xrow_ptr(const float* xp, const float* xs, int m) { return m < SEQL ? xp + (size_t)m * DM : xs + (size_t)(m - SEQL) * DM; }

template <bool INTER> __device__ __forceinline__ void p0_prologue(const ProArgs& a, LAS unsigned char* lds, int gw, int NGW, int wave, int lane) {
    bf16* WIN = (bf16*)(a.ws + WS_WIN); bf16* WOUT = (bf16*)(a.ws + WS_WOUT); bf16* WFI = (bf16*)(a.ws + WS_WFI); bf16* WFO = (bf16*)(a.ws + WS_WFO);
    LAS float* scr = (LAS float*)(lds + wave * 16384);
    constexpr int I_IN = (DM / 64) * (NIN / 32), I_OUT = (DM / 64) * (DM / 32), I_FI = (DM / 64) * (2 * DFF / 32), I_FO = (DFF / 64) * (DM / 32);
    constexpr int NITEMS = I_IN + I_OUT + I_FI + I_FO;
    auto decode = [&](int it) -> TrItem {
        TrItem t; int r = it;
        if (r < I_IN) { const int nb = NIN / 32, kb = r / nb, n0 = (r % nb) * 32; t.W = a.w_in; t.WT = WIN; t.K = DM; t.N = NIN; t.k0 = kb * 64; t.n0 = n0; t.drow0 = n0; t.ldt = LDK; return t; } r -= I_IN;
        if (r < I_OUT) { const int nb = DM / 32, kb = r / nb, n0 = (r % nb) * 32; t.W = a.w_out; t.WT = WOUT; t.K = DM; t.N = DM; t.k0 = kb * 64; t.n0 = n0; t.drow0 = n0; t.ldt = LDK; return t; } r -= I_OUT;
        if (r < I_FI) { const int nb = 2 * DFF / 32, kb = r / nb, n0 = (r % nb) * 32; t.W = a.w_ffi; t.WT = WFI; t.K = DM; t.N = 2 * DFF; t.k0 = kb * 64; t.n0 = n0; t.drow0 = ffi_drow<INTER>(n0); t.ldt = LDK; return t; } r -= I_FI;
        { const int nb = DM / 32, kb = r / nb, n0 = (r % nb) * 32; t.W = a.w_ffo; t.WT = WFO; t.K = DFF; t.N = DM; t.k0 = kb * 64; t.n0 = n0; t.drow0 = n0; t.ldt = DFF; return t; }
    };
    {
        int it = gw; TrItem cur; f32x4 vc[8], vn[8];
        if (it < NITEMS) { cur = decode(it); tr_load(cur, lane, vc); }
        while (it < NITEMS) {
            const int nx = it + NGW; TrItem nxt = cur;
            if (nx < NITEMS) { nxt = decode(nx); tr_load(nxt, lane, vn); }
            tr_store(cur, lane, vc, scr);
            cur = nxt; it = nx;
#pragma unroll
            for (int ii = 0; ii < 8; ++ii) vc[ii] = vn[ii];
        }
    }
    bf16* XN = (bf16*)(a.ws + WS_XN);
    for (int m = gw; m < NTOK; m += NGW) {
        const float* xr = xrow_ptr(a.xp, a.xs, m);
        f32x4 v[16]; float s = 0.f;
#pragma unroll
        for (int j = 0; j < 8; ++j) { const f32x4* p = (const f32x4*)(xr + (j * 64 + lane) * 8); v[2 * j] = p[0]; v[2 * j + 1] = p[1];
            s += (v[2 * j].x * v[2 * j].x + v[2 * j].y * v[2 * j].y) + (v[2 * j].z * v[2 * j].z + v[2 * j].w * v[2 * j].w);
            s += (v[2 * j + 1].x * v[2 * j + 1].x + v[2 * j + 1].y * v[2 * j + 1].y) + (v[2 * j + 1].z * v[2 * j + 1].z + v[2 * j + 1].w * v[2 * j + 1].w); }
        const float rs = 1.0f / sqrtf(wave_sum(s) * (1.0f / DM) + EPSN);
#pragma unroll
        for (int j = 0; j < 8; ++j) { const int c0 = (j * 64 + lane) * 8; const f32x4 g0 = *(const f32x4*)(a.g_premix + c0), g1 = *(const f32x4*)(a.g_premix + c0 + 4);
            const f32x4 a0 = v[2 * j] * rs * g0, a1 = v[2 * j + 1] * rs * g1;
            v4u o; o.x = pk2(a0.x, a0.y); o.y = pk2(a0.z, a0.w); o.z = pk2(a1.x, a1.y); o.w = pk2(a1.z, a1.w);
            *(v4u*)(XN + (size_t)m * LDK + c0) = o; }
    }
    bf16* RGW = (bf16*)(a.ws + WS_RGW);
    for (int idx = gw * 64 + lane; idx < 2 * 2 * NHEAD * HDIM * HDIM; idx += NGW * 64) {
        const int i = idx & 127, j = (idx >> 7) & 127, h = (idx >> 14) & 15, gate = (idx >> 18) & 1, dir = idx >> 19;
        const float* W = gate ? a.rg_x_w : a.rg_a_w;
        RGW[idx] = (bf16)f2bf(W[(((size_t)dir * NHEAD + h) * HDIM + i) * HDIM + j]);
    }
    f32x2* TW = (f32x2*)(a.ws + WS_TW);
    for (int k = gw * 64 + lane; k < FFT_N; k += NGW * 64) { float sn, cs; sincospif((float)k * (1.0f / 8192.0f), &sn, &cs); TW[k] = (f32x2){cs, -sn}; }
    bf16* H3H = (bf16*)(a.ws + WS_H3); bf16* H3L = H3H + SEQL * 64;
    const float fr = a.hy_freq[lane], b1 = a.hy_b1[lane], b2 = a.hy_b2[lane], b3 = a.hy_b3[lane];
    for (int n = gw; n < SEQL; n += NGW) {
        float zv = 0.f;
        if (lane == 0) zv = (float)n * (1.0f / (float)(SEQL - 1));
        else if (lane < 33) { const int k = (lane - 1) & 15; const float band = 1e-4f + (float)k * ((15.0f - 1e-4f) / 15.0f);
            const float ang = (6.283185307179586f / (float)SEQL) * (float)n * band; zv = lane < 17 ? cosf(ang) : -sinf(ang); }
        float acc = b1;
        for (int e = 0; e < 33; ++e) acc += __shfl(zv, e) * a.hy_w1[e * 64 + lane];
        float h = sinf(fr * acc);
        acc = b2;
        for (int e = 0; e < 64; ++e) acc += __shfl(h, e) * a.hy_w2[e * 64 + lane];
        h = sinf(fr * acc);
        acc = b3;
        for (int e = 0; e < 64; ++e) acc += __shfl(h, e) * a.hy_w3[e * 64 + lane];
        h = sinf(fr * acc);
        { const unsigned hi = f2bf(h); H3H[n * 64 + lane] = (bf16)hi; H3L[n * 64 + lane] = (bf16)f2bf(h - bf2f(hi)); }
    }
}
constexpr int FFT_LDS_BYTES = (FFT_N + FFT_N / 32) * 8;
constexpr int HY_W4_OFF = FFT_LDS_BYTES;
constexpr int HY_PRM_OFF = FFT_LDS_BYTES + 1024;
constexpr int HY_LDS_BYTES = FFT_LDS_BYTES + 1024 + 256;
__device__ __forceinline__ int PH(int i) { return i + (i >> 5); }
__device__ __forceinline__ f32x2 cmul(f32x2 a, f32x2 b) { return (f32x2){a.x * b.x - a.y * b.y, a.x * b.y + a.y * b.x}; }
__device__ __forceinline__ constexpr int bitrev_c(int r, int bits) { int o = 0; for (int i = 0; i < bits; ++i) o |= ((r >> i) & 1) << (bits - 1 - i); return o; }

__device__ __forceinline__ f32x2 mul_w32(f32x2 d, int idx) {
    constexpr float C[16] = {1.0f, 0.98078528040323043f, 0.92387953251128674f, 0.83146961230254524f, 0.70710678118654752f, 0.55557023301960218f, 0.38268343236508977f, 0.19509032201612825f,
                             0.0f, -0.19509032201612825f, -0.38268343236508977f, -0.55557023301960218f, -0.70710678118654752f, -0.83146961230254524f, -0.92387953251128674f, -0.98078528040323043f};
    constexpr float S[16] = {0.0f, 0.19509032201612825f, 0.38268343236508977f, 0.55557023301960218f, 0.70710678118654752f, 0.83146961230254524f, 0.92387953251128674f, 0.98078528040323043f,
                             1.0f, 0.98078528040323043f, 0.92387953251128674f, 0.83146961230254524f, 0.70710678118654752f, 0.55557023301960218f, 0.38268343236508977f, 0.19509032201612825f};
    if (idx == 0) return d;
    if (idx == 8) return (f32x2){d.y, -d.x};
    const float c = C[idx], s = S[idx];
    return (f32x2){d.x * c + d.y * s, d.y * c - d.x * s};
}
template <int R> __device__ __forceinline__ void dft_inreg(f32x2 (&a)[R]) {
    constexpr int LOGR = (R == 32) ? 5 : 4;
#pragma unroll
    for (int t = 0; t < LOGR; ++t) {
        const int half = R >> (t + 1);
#pragma unroll
        for (int g = 0; g < R; g += 2 * half)
#pragma unroll
            for (int i = 0; i < half; ++i) {
                const f32x2 u = a[g + i], v = a[g + i + half];
                a[g + i] = u + v;
                a[g + i + half] = mul_w32(u - v, i * (16 / half));
            }
    }
}
template <int R, int S, bool TW, bool ZPAD = false, bool HALFOUT = false> __device__ __forceinline__ void fft_pass(LAS f32x2* lds, const f32x2* tw, int tid) {
    constexpr int NB = FFT_N / R, PER = NB / 512, LOGR = (R == 32) ? 5 : 4;
    constexpr int RSTEP = NB + NB / 32;
    constexpr int WSTEP = (S == 1) ? 1 : (S + S / 32);
    f32x2 a[PER][R];
#pragma unroll
    for (int b = 0; b < PER; ++b) { const LAS f32x2* rp = lds + PH(tid + 512 * b);
#pragma unroll
        for (int k = 0; k < R; ++k) a[b][k] = (ZPAD && k >= R / 2) ? (f32x2){0.f, 0.f} : rp[k * RSTEP]; }
    __syncthreads();
#pragma unroll
    for (int b = 0; b < PER; ++b) {
        const int beta = tid + 512 * b, q = beta & (S - 1), p = beta / S, base = q + R * S * p;
        dft_inreg<R>(a[b]);
        f32x2 w1 = (f32x2){1.f, 0.f}, wj = (f32x2){1.f, 0.f};
        if (TW) { w1 = tw[p * S]; wj = w1; }
        LAS f32x2* wp = lds + PH(base);
        wp[0] = a[b][0];
#pragma unroll
        for (int j = 1; j < (HALFOUT ? R / 2 : R); ++j) {
            f32x2 v = a[b][bitrev_c(j, LOGR)];
            if (TW) { v = cmul(v, wj); wj = cmul(wj, w1); }
            wp[j * WSTEP] = v;
        }
    }
    __syncthreads();
}
template <bool ZPAD = false, bool HALFOUT = false> __device__ __forceinline__ void fft16k(LAS f32x2* lds, const f32x2* tw, int tid) {
    asm volatile("" : "+v"(tid));
    fft_pass<32, 1, true, ZPAD, false>(lds, tw, tid);
    fft_pass<32, 32, true>(lds, tw, tid);
    fft_pass<16, 1024, false, false, HALFOUT>(lds, tw, tid);
}
__device__ __forceinline__ void spec_pair(LAS f32x2* lds, const f32x2* ZK, int p) {
    const int f = p, f2 = (FFT_N - p) & (FFT_N - 1);
    const f32x2 A = ZK[f], A2 = ZK[f2], Z = lds[PH(f)], Z2 = lds[PH(f2)];
    const float kcx = 0.5f * (A.x + A2.x), kcy = 0.5f * (A.y - A2.y);
    const float dx = 0.5f * (A.x - A2.x), dy = 0.5f * (A.y + A2.y);
    const float k1x = dy, k1y = -dx;
    const float px = 0.5f * (kcx + k1x), py = 0.5f * (kcy + k1y), qx = 0.5f * (kcx - k1x), qy = 0.5f * (kcy - k1y);
    const float wx = Z.x * px - Z.y * py + (Z2.x * qx + Z2.y * qy);
    const float wy = Z.x * py + Z.y * px + (Z2.x * qy - Z2.y * qx);
    const float w2x = Z2.x * px + Z2.y * py + (Z.x * qx - Z.y * qy);
    const float w2y = Z2.y * px - Z2.x * py - (Z.x * qy + Z.y * qx);
    lds[PH(f)] = (f32x2){wx, -wy}; lds[PH(f2)] = (f32x2){w2x, -w2y};
}
__device__ __forceinline__ void spec_mul(LAS f32x2* lds, const f32x2* ZK, int tid) {
    asm volatile("" : "+v"(tid));
#pragma unroll 8
    for (int i = 0; i < 16; ++i) spec_pair(lds, ZK, tid + 512 * i);
    if (tid == 0) spec_pair(lds, ZK, 8192);
    __syncthreads();
}
struct HyArgs {
    const bf16* phy;
    const float *conv_w, *conv_b;
    const float* w4;
    const float* hy_bias;
    const bf16* h3h;
    const f32x2* tw;
    f32x2* zk;
    bf16* hyy;
};
__device__ __forceinline__ void load_conv3_16(const bf16* row, int t0, float w0, float w1, float w2, float bias, float (&out)[16]) {
    const v4u r0 = *(const v4u*)(row + t0), r1 = *(const v4u*)(row + t0 + 8);
    float u[18];
    u[0] = t0 > 0 ? bf2f(row[t0 - 1]) : 0.f;
    u[17] = (t0 + 16 < SEQL) ? bf2f(row[t0 + 16]) : 0.f;
    u[1] = bflo(r0.x); u[2] = bfhi(r0.x); u[3] = bflo(r0.y); u[4] = bfhi(r0.y); u[5] = bflo(r0.z); u[6] = bfhi(r0.z); u[7] = bflo(r0.w); u[8] = bfhi(r0.w);
    u[9] = bflo(r1.x); u[10] = bfhi(r1.x); u[11] = bflo(r1.y); u[12] = bfhi(r1.y); u[13] = bflo(r1.z); u[14] = bfhi(r1.z); u[15] = bflo(r1.w); u[16] = bfhi(r1.w);
#pragma unroll
    for (int e = 0; e < 16; ++e) out[e] = bias + w0 * u[e] + w1 * u[e + 1] + w2 * u[e + 2];
}
__device__ __forceinline__ void store16_bf16(bf16* dst, const float (&v)[16]) {
    v4u o0, o1; o0.x = pk2(v[0], v[1]); o0.y = pk2(v[2], v[3]); o0.z = pk2(v[4], v[5]); o0.w = pk2(v[6], v[7]);
    o1.x = pk2(v[8], v[9]); o1.y = pk2(v[10], v[11]); o1.z = pk2(v[12], v[13]); o1.w = pk2(v[14], v[15]);
    *(v4u*)dst = o0; *(v4u*)(dst + 8) = o1;
}
__device__ __forceinline__ void hyena_unit(const HyArgs& a, LAS unsigned char* ldsb_, int cp, int wgslot, int tid) {
    unsigned lzero; asm volatile("v_mov_b32 %0, 0" : "=v"(lzero));
    LAS unsigned char* ldsb = ldsb_ + lzero;
    LAS f32x2* lds = (LAS f32x2*)ldsb;
    const int c0 = 2 * cp, c1 = c0 + 1;
    f32x2* zk = a.zk + (size_t)wgslot * 2 * FFT_N;
    constexpr float MIN_DECAY = -3.0701134573253945f, MAX_DECAY = -15.350567286626973f;
    const float ad0 = fabsf(MIN_DECAY + (float)c0 * ((MAX_DECAY - MIN_DECAY) / (float)(DHY - 1)));
    const float ad1 = fabsf(MIN_DECAY + (float)c1 * ((MAX_DECAY - MIN_DECAY) / (float)(DHY - 1)));
    LAS float* prm = (LAS float*)(ldsb + HY_PRM_OFF);
    __syncthreads();
    if (tid < 24) { const int k = tid & 3, sc = tid >> 2, st = sc >> 1, chn = st * DHY + c0 + (sc & 1); prm[tid] = k < 3 ? a.conv_w[k * 6144 + chn] : a.conv_b[chn]; }
    if (tid >= 32 && tid < 36) { const int j = tid - 32; prm[tid] = a.hy_bias[(j >> 1) * DHY + c0 + (j & 1)]; }
#pragma unroll 1
    for (int o = 0; o < 2; ++o) {
        int tq = tid; asm volatile("" : "+v"(tq)); const int t0 = 16 * tq;
        __syncthreads();
        {
            const int lane = tq & 63, wv = tq >> 6, fr = lane & 15, fq = lane >> 4;
            const int colidx = o * 4096 + ((fr >> 1) & 1) * 2048 + c0 + (fr & 1);
            bf16x8 Bh[2], Bl[2];
#pragma unroll
            for (int kk = 0; kk < 2; ++kk)
#pragma unroll
                for (int i = 0; i < 8; ++i) { const float w = fr < 4 ? a.w4[(size_t)(32 * kk + 8 * fq + i) * 8192 + colidx] : 0.f; const unsigned hi = f2bf(w);
                    Bh[kk][i] = (short)hi; Bl[kk][i] = (short)f2bf(w - bf2f(hi)); }
            const float adl = (fr & 1) ? ad1 : ad0;
            LAS float* ldsf = (LAS float*)lds;
            if (tq == 0) lds[PH(SEQL)] = (f32x2){0.f, 0.f};
            const bf16* apw = a.h3h + (size_t)(wv * 1024 + fr) * 64 + 8 * fq;
            bf16x8 fc[4][4], fn[4][4];
#pragma unroll
            for (int q = 0; q < 4; ++q) { const bf16* ap = apw + (size_t)q * 16 * 64;
                fc[q][0] = *(const bf16x8*)ap; fc[q][1] = *(const bf16x8*)(ap + 32); fc[q][2] = *(const bf16x8*)(ap + SEQL * 64); fc[q][3] = *(const bf16x8*)(ap + SEQL * 64 + 32); }
#pragma unroll 1
            for (int gq = 0; gq < 16; ++gq) {
                const int gnx = gq < 15 ? gq + 1 : gq;
#pragma unroll
                for (int q = 0; q < 4; ++q) { const bf16* ap = apw + (size_t)(gnx * 4 + q) * 16 * 64;
                    fn[q][0] = *(const bf16x8*)ap; fn[q][1] = *(const bf16x8*)(ap + 32); fn[q][2] = *(const bf16x8*)(ap + SEQL * 64); fn[q][3] = *(const bf16x8*)(ap + SEQL * 64 + 32); }
#pragma unroll
                for (int q = 0; q < 4; ++q) {
                    const int row0 = wv * 1024 + (gq * 4 + q) * 16;
                    f32x4 acc = (f32x4){0.f, 0.f, 0.f, 0.f};
                    acc = __builtin_amdgcn_mfma_f32_16x16x32_bf16(fc[q][2], Bh[0], acc, 0, 0, 0); acc = __builtin_amdgcn_mfma_f32_16x16x32_bf16(fc[q][3], Bh[1], acc, 0, 0, 0);
                    acc = __builtin_amdgcn_mfma_f32_16x16x32_bf16(fc[q][0], Bl[0], acc, 0, 0, 0); acc = __builtin_amdgcn_mfma_f32_16x16x32_bf16(fc[q][1], Bl[1], acc, 0, 0, 0);
                    acc = __builtin_amdgcn_mfma_f32_16x16x32_bf16(fc[q][0], Bh[0], acc, 0, 0, 0); acc = __builtin_amdgcn_mfma_f32_16x16x32_bf16(fc[q][1], Bh[1], acc, 0, 0, 0);
                    if (fr < 4) {
#pragma unroll
                        for (int e = 0; e < 4; ++e) {
                            const int n = row0 + 4 * fq + e;
                            const float val = acc[e] * fexp(-(float)n * (1.0f / (float)(SEQL - 1)) * adl);
                            if (fr < 2) ldsf[2 * PH(n) + (fr & 1)] = val;
                            else if (n >= 1) ldsf[2 * PH(FFT_N - n) + (fr & 1)] = val;
                        }
                    }
                }
#pragma unroll
                for (int q = 0; q < 4; ++q)
#pragma unroll
                    for (int z = 0; z < 4; ++z) fc[q][z] = fn[q][z];
            }
        }
        __syncthreads();
        fft16k(lds, a.tw, tid);
#pragma unroll 4
        for (int i = 0; i < 32; ++i) zk[(size_t)o * FFT_N + tq + 512 * i] = lds[PH(tq + 512 * i)];
    }
    const float inv_n = 1.0f / (float)FFT_N;
    asm volatile("s_waitcnt vmcnt(0)" ::: "memory");
    __syncthreads();
#pragma unroll 1
    for (int s = 0; s < NSEQ; ++s) {
        const size_t m0 = (size_t)s * SEQL;
        int tq = tid; asm volatile("" : "+v"(tq)); const int t0 = 16 * tq;
        {
            float v0[16], v1[16];
            load_conv3_16(a.phy + (size_t)(0 * DHY + c0) * NTOK + m0, t0, prm[0], prm[1], prm[2], prm[3], v0);
            load_conv3_16(a.phy + (size_t)(0 * DHY + c1) * NTOK + m0, t0, prm[4], prm[5], prm[6], prm[7], v1);
            __syncthreads();
#pragma unroll
            for (int e = 0; e < 16; ++e) { lds[PH(t0 + e)] = (f32x2){v0[e], v1[e]}; }
        }
        __syncthreads();
        fft16k<true, false>(lds, a.tw, tid);
        spec_mul(lds, zk, tid);
        fft16k<false, true>(lds, a.tw, tid);
        float z0[16], z1[16];
        {
            float x0[16], x1[16];
            load_conv3_16(a.phy + (size_t)(0 * DHY + c0) * NTOK + m0, t0, prm[0], prm[1], prm[2], prm[3], x0);
            load_conv3_16(a.phy + (size_t)(0 * DHY + c1) * NTOK + m0, t0, prm[4], prm[5], prm[6], prm[7], x1);
#pragma unroll
            for (int e = 0; e < 16; ++e) { const f32x2 r = lds[PH(t0 + e)]; z0[e] = r.x * inv_n + prm[32] * x0[e]; z1[e] = -r.y * inv_n + prm[33] * x1[e]; }
            load_conv3_16(a.phy + (size_t)(1 * DHY + c0) * NTOK + m0, t0, prm[8], prm[9], prm[10], prm[11], x0);
            load_conv3_16(a.phy + (size_t)(1 * DHY + c1) * NTOK + m0, t0, prm[12], prm[13], prm[14], prm[15], x1);
#pragma unroll
            for (int e = 0; e < 16; ++e) { z0[e] *= x0[e]; z1[e] *= x1[e]; }
        }
#pragma unroll
        for (int e = 0; e < 16; ++e) { lds[PH(t0 + e)] = (f32x2){z0[e], z1[e]}; }
        __syncthreads();
        fft16k<true, false>(lds, a.tw, tid);
        spec_mul(lds, zk + FFT_N, tid);
        fft16k<false, true>(lds, a.tw, tid);
        {
            float x0[16], x1[16];
            load_conv3_16(a.phy + (size_t)(2 * DHY + c0) * NTOK + m0, t0, prm[16], prm[17], prm[18], prm[19], x0);
            load_conv3_16(a.phy + (size_t)(2 * DHY + c1) * NTOK + m0, t0, prm[20], prm[21], prm[22], prm[23], x1);
#pragma unroll
            for (int e = 0; e < 16; ++e) { const f32x2 r = lds[PH(t0 + e)];
                x0[e] = x0[e] * (r.x * inv_n + prm[34] * z0[e]); x1[e] = x1[e] * (-r.y * inv_n + prm[35] * z1[e]); }
            store16_bf16(a.hyy + (size_t)c0 * NTOK + m0 + t0, x0);
            store16_bf16(a.hyy + (size_t)c1 * NTOK + m0 + t0, x1);
        }
    }
}
constexpr int RG_T = 128, RG_NT = SEQL / RG_T;
constexpr int RG_XC_STRIDE = 272;
constexpr int RG_G_OFF = RG_T * RG_XC_STRIDE;
constexpr int RG_HF_OFF = 2 * RG_T * RG_XC_STRIDE;
constexpr int RG_LDS_BYTES = RG_HF_OFF + (RG_T / 4) * 512 * 4;
constexpr int RG_UNITS = NSEQ * RG_NT * NHEAD;
struct RgArgs {
    const bf16* prg;
    const float *conv_w, *conv_b;
    const bf16* rgw;
    const float *a_b, *x_b;
    const float* lam;
    f32x2* summ;
    bf16* rgy;
};
template <int PASS> __device__ __forceinline__ void rg_unit(const RgArgs& a, LAS unsigned char* lds, int unit, int tid) {
    const int wave = tid >> 6, lane = tid & 63, fr = lane & 15, fq = lane >> 4;
    const int h = unit % NHEAD, tt = (unit / NHEAD) % RG_NT, s = unit / (NHEAD * RG_NT);
    const int tok0 = tt * RG_T;
    const size_t mrow0 = (size_t)s * SEQL;
    __syncthreads();
    {
        const int cg = h * HDIM + 2 * lane;
        float w0[4], w1[4];
#pragma unroll
        for (int k = 0; k < 4; ++k) { w0[k] = a.conv_w[k * DRG + cg]; w1[k] = a.conv_w[k * DRG + cg + 1]; }
        const float cb0 = a.conv_b[cg], cb1 = a.conv_b[cg + 1];
        const int tb = tok0 + 16 * wave;
        unsigned raw[19], graw[16];
#pragma unroll
        for (int q = 0; q < 19; ++q) { const int t = tb - 2 + q, tc = t < 0 ? 0 : (t > SEQL - 1 ? SEQL - 1 : t); raw[q] = *(const unsigned*)(a.prg + (mrow0 + tc) * DM + cg); }
        if (PASS == 2) {
#pragma unroll
            for (int i = 0; i < 16; ++i) graw[i] = *(const unsigned*)(a.prg + (mrow0 + tb + i) * DM + DRG + cg);
        }
#pragma unroll
        for (int q = 0; q < 19; ++q) { const int t = tb - 2 + q; if (t < 0 || t > SEQL - 1) raw[q] = 0u; }
#pragma unroll
        for (int i = 0; i < 16; ++i) {
            const float y0 = cb0 + w0[0] * bflo(raw[i]) + w0[1] * bflo(raw[i + 1]) + w0[2] * bflo(raw[i + 2]) + w0[3] * bflo(raw[i + 3]);
            const float y1 = cb1 + w1[0] * bfhi(raw[i]) + w1[1] * bfhi(raw[i + 1]) + w1[2] * bfhi(raw[i + 2]) + w1[3] * bfhi(raw[i + 3]);
            *(LAS unsigned*)(lds + (16 * wave + i) * RG_XC_STRIDE + lane * 4) = pk2(y0, y1);
            if (PASS == 2) *(LAS unsigned*)(lds + RG_G_OFF + (16 * wave + i) * RG_XC_STRIDE + lane * 4) = graw[i];
        }
    }
    __syncthreads();
    const int ch = h * HDIM + 16 * wave + fr;
    LAS float* hfl = (LAS float*)(lds + RG_HF_OFF) + tid;
#pragma unroll
    for (int dir = 0; dir < 2; ++dir) {
        bf16x8 Br[4], Bi[4];
#pragma unroll
        for (int kk = 0; kk < 4; ++kk) {
            Br[kk] = *(const bf16x8*)(a.rgw + ((((size_t)dir * 2 + 0) * NHEAD + h) * HDIM + 16 * wave + fr) * HDIM + 32 * kk + 8 * fq);
            Bi[kk] = *(const bf16x8*)(a.rgw + ((((size_t)dir * 2 + 1) * NHEAD + h) * HDIM + 16 * wave + fr) * HDIM + 32 * kk + 8 * fq);
        }
        const float ba = a.a_b[dir * DRG + ch], bx = a.x_b[dir * DRG + ch];
        const float sp = log1pf(expf(-a.lam[dir * DRG + ch]));
        float carry = 0.f, ptot = 1.f;
        if (PASS == 2) {
            const f32x2* sm = a.summ + ((size_t)dir * NSEQ + s) * RG_NT * DRG + ch;
            const int cnt = dir == 0 ? tt : RG_NT - 1 - tt;
            for (int j0 = 0; j0 < cnt; j0 += 16) {
                f32x2 pb[16];
#pragma unroll
                for (int q = 0; q < 16; ++q) { const int jj = j0 + q, j = dir == 0 ? jj : RG_NT - 1 - jj, jc = jj < cnt ? j : tt; pb[q] = sm[(size_t)jc * DRG]; if (jj >= cnt) pb[q] = (f32x2){1.f, 0.f}; }
#pragma unroll
                for (int q = 0; q < 16; ++q) carry = pb[q].x * carry + pb[q].y;
            }
        }
        for (int bi = 0; bi < RG_T / 16; ++bi) {
            const int blk = dir == 0 ? bi : (RG_T / 16 - 1 - bi);
            f32x4 accR = (f32x4){0.f, 0.f, 0.f, 0.f}, accI = (f32x4){0.f, 0.f, 0.f, 0.f};
#pragma unroll
            for (int kk = 0; kk < 4; ++kk) {
                const bf16x8 af = *(const LAS bf16x8*)(lds + (16 * blk + fr) * RG_XC_STRIDE + (32 * kk + 8 * fq) * 2);
                accR = __builtin_amdgcn_mfma_f32_16x16x32_bf16(af, Br[kk], accR, 0, 0, 0);
                accI = __builtin_amdgcn_mfma_f32_16x16x32_bf16(af, Bi[kk], accI, 0, 0, 0);
            }
            float av[4], bv[4];
#pragma unroll
            for (int e = 0; e < 4; ++e) {
                const float r = sigmoidf_(accR[e] + ba), ig = sigmoidf_(accI[e] + bx);
                const float log_a = -8.0f * r * sp;
                av[e] = fexp(log_a);
                const float x2 = 2.0f * log_a;
                const float em = -x2 * (1.0f + x2 * (0.5f + x2 * (0.16666667f + x2 * (0.041666668f + x2 * (0.0083333338f + x2 * (0.0013888889f + x2 * (0.0001984127f + x2 * 0.0000248016f)))))));
                const float em2 = x2 < -0.25f ? (1.0f - av[e] * av[e]) : em;
                const float mult = __builtin_amdgcn_sqrtf(fmaxf(em2, 0.f));
                const float xcv = bf2f(*(const LAS unsigned short*)(lds + (16 * blk + 4 * fq + e) * RG_XC_STRIDE + (16 * wave + fr) * 2));
                bv[e] = mult * ig * xcv;
            }
            float A = 1.f, B = 0.f;
            if (dir == 0) {
#pragma unroll
                for (int e = 0; e < 4; ++e) { B = av[e] * B + bv[e]; A *= av[e]; }
            } else {
#pragma unroll
                for (int e = 3; e >= 0; --e) { B = av[e] * B + bv[e]; A *= av[e]; }
            }
            float hin;
            if (dir == 0) {
                float Ap = __shfl_up(A, 16), Bp = __shfl_up(B, 16);
                if (fq >= 1) { B = A * Bp + B; A = Ap * A; }
                Ap = __shfl_up(A, 32); Bp = __shfl_up(B, 32);
                if (fq >= 2) { B = A * Bp + B; A = Ap * A; }
                const float hend = A * carry + B;
                const float hprev = __shfl_up(hend, 16);
                hin = fq == 0 ? carry : hprev;
                carry = __shfl(hend, 48 + fr);
                if (PASS == 1) ptot *= __shfl(A, 48 + fr);
            } else {
                float Ap = __shfl_down(A, 16), Bp = __shfl_down(B, 16);
                if (fq <= 2) { B = A * Bp + B; A = Ap * A; }
                Ap = __shfl_down(A, 32); Bp = __shfl_down(B, 32);
                if (fq <= 1) { B = A * Bp + B; A = Ap * A; }
                const float hend = A * carry + B;
                const float hprev = __shfl_down(hend, 16);
                hin = fq == 3 ? carry : hprev;
                carry = __shfl(hend, fr);
                if (PASS == 1) ptot *= __shfl(A, fr);
            }
            if (PASS == 2) {
                if (dir == 0) {
                    float hh = hin;
#pragma unroll
                    for (int e = 0; e < 4; ++e) { hh = av[e] * hh + bv[e]; hfl[(blk * 4 + e) * 512] = hh; }
                } else {
                    float hh = hin, hb[4];
#pragma unroll
                    for (int e = 3; e >= 0; --e) { hh = av[e] * hh + bv[e]; hb[e] = hh; }
#pragma unroll
                    for (int e = 0; e < 4; ++e) {
                        const size_t m = mrow0 + tok0 + 16 * blk + 4 * fq + e;
                        const float g = bf2f(*(const LAS unsigned short*)(lds + RG_G_OFF + (16 * blk + 4 * fq + e) * RG_XC_STRIDE + (16 * wave + fr) * 2));
                        a.rgy[m * DRG + ch] = (bf16)f2bf((hfl[(blk * 4 + e) * 512] + hb[e]) * gelu_tanh(g));
                    }
                }
            }
        }
        if (PASS == 1 && fq == 0) a.summ[(((size_t)dir * NSEQ + s) * RG_NT + tt) * DRG + ch] = (f32x2){ptot, carry};
    }
}
__device__ __forceinline__ void mixnorm_rg_row(const bf16* rgy, const float* g_rg, bf16* mix, int m, int lane) {
    v4u r[4]; float s = 0.f;
#pragma unroll
    for (int j = 0; j < 4; ++j) { r[j] = *(const v4u*)(rgy + (size_t)m * DRG + (j * 64 + lane) * 8);
        const float a0 = bflo(r[j].x), a1 = bfhi(r[j].x), a2 = bflo(r[j].y), a3 = bfhi(r[j].y), a4 = bflo(r[j].z), a5 = bfhi(r[j].z), a6 = bflo(r[j].w), a7 = bfhi(r[j].w);
        s += (a0 * a0 + a1 * a1) + (a2 * a2 + a3 * a3) + (a4 * a4 + a5 * a5) + (a6 * a6 + a7 * a7); }
    const float rs = 1.0f / sqrtf(wave_sum(s) * (1.0f / DRG) + EPSN);
#pragma unroll
    for (int j = 0; j < 4; ++j) { const int c0 = (j * 64 + lane) * 8; const f32x4 g0 = *(const f32x4*)(g_rg + c0), g1 = *(const f32x4*)(g_rg + c0 + 4);
        v4u o; o.x = pk2(bflo(r[j].x) * rs * g0.x, bfhi(r[j].x) * rs * g0.y); o.y = pk2(bflo(r[j].y) * rs * g0.z, bfhi(r[j].y) * rs * g0.w);
        o.z = pk2(bflo(r[j].z) * rs * g1.x, bfhi(r[j].z) * rs * g1.y); o.w = pk2(bflo(r[j].w) * rs * g1.z, bfhi(r[j].w) * rs * g1.w);
        *(v4u*)(mix + (size_t)m * LDK + c0) = o; }
}
constexpr int MN_TILE_STRIDE = 66;
constexpr int MN_LDS_BYTES = 8 * 64 * MN_TILE_STRIDE * 2 + 8 * 64 * 4 + 64 * 4;
__device__ __forceinline__ void mixnorm_hy_tile(const bf16* hyy, const float* g_hy, bf16* mix, LAS unsigned char* lds, int tile, int tid) {
    const int wave = tid >> 6, lane = tid & 63, m0 = tile * 64;
    LAS unsigned short* tl = (LAS unsigned short*)(lds + wave * 64 * MN_TILE_STRIDE * 2);
    LAS float* part = (LAS float*)(lds + 8 * 64 * MN_TILE_STRIDE * 2);
    LAS float* scl = part + 8 * 64;
    __syncthreads();
    float s = 0.f;
    for (int c = wave * 256; c < wave * 256 + 256; ++c) { const float v = bf2f(hyy[(size_t)c * NTOK + m0 + lane]); s += v * v; }
    part[wave * 64 + lane] = s;
    __syncthreads();
    if (tid < 64) { float t = 0.f;
#pragma unroll
        for (int w = 0; w < 8; ++w) t += part[w * 64 + tid];
        scl[tid] = 1.0f / sqrtf(t * (1.0f / DHY) + EPSN); }
    __syncthreads();
    for (int cb = wave; cb < DHY / 64; cb += 8) {
        for (int ci = 0; ci < 64; ++ci) tl[ci * MN_TILE_STRIDE + lane] = hyy[(size_t)(cb * 64 + ci) * NTOK + m0 + lane];
        asm volatile("s_waitcnt lgkmcnt(0)" ::: "memory");
        const float g = g_hy[cb * 64 + lane];
        for (int tk = 0; tk < 64; ++tk) mix[(size_t)(m0 + tk) * LDK + DRG + cb * 64 + lane] = (bf16)f2bf(bf2f(tl[lane * MN_TILE_STRIDE + tk]) * scl[tk] * g);
        asm volatile("s_waitcnt lgkmcnt(0)" ::: "memory");
    }
}
__device__ __forceinline__ void rowpass1(const float* xr, const bf16* yr, const float* g_post, const float* g_pre, float* outr, bf16* xnr, int lane) {
    float v[64]; float s = 0.f;
#pragma unroll
    for (int j = 0; j < 8; ++j) { const v4u r = *(const v4u*)(yr + (j * 64 + lane) * 8);
        v[8 * j + 0] = bflo(r.x); v[8 * j + 1] = bfhi(r.x); v[8 * j + 2] = bflo(r.y); v[8 * j + 3] = bfhi(r.y); v[8 * j + 4] = bflo(r.z); v[8 * j + 5] = bfhi(r.z); v[8 * j + 6] = bflo(r.w); v[8 * j + 7] = bfhi(r.w);
#pragma unroll
        for (int e = 0; e < 8; ++e) s += v[8 * j + e] * v[8 * j + e]; }
    const float rs = 1.0f / sqrtf(wave_sum(s) * (1.0f / DM) + EPSN);
    float s2 = 0.f;
#pragma unroll
    for (int j = 0; j < 8; ++j) { const int c0 = (j * 64 + lane) * 8;
        const f32x4 x0 = *(const f32x4*)(xr + c0), x1 = *(const f32x4*)(xr + c0 + 4), g0 = *(const f32x4*)(g_post + c0), g1 = *(const f32x4*)(g_post + c0 + 4);
        f32x4 o0, o1;
        o0.x = x0.x + v[8 * j + 0] * rs * g0.x; o0.y = x0.y + v[8 * j + 1] * rs * g0.y; o0.z = x0.z + v[8 * j + 2] * rs * g0.z; o0.w = x0.w + v[8 * j + 3] * rs * g0.w;
        o1.x = x1.x + v[8 * j + 4] * rs * g1.x; o1.y = x1.y + v[8 * j + 5] * rs * g1.y; o1.z = x1.z + v[8 * j + 6] * rs * g1.z; o1.w = x1.w + v[8 * j + 7] * rs * g1.w;
        *(f32x4*)(outr + c0) = o0; *(f32x4*)(outr + c0 + 4) = o1;
        v[8 * j + 0] = o0.x; v[8 * j + 1] = o0.y; v[8 * j + 2] = o0.z; v[8 * j + 3] = o0.w; v[8 * j + 4] = o1.x; v[8 * j + 5] = o1.y; v[8 * j + 6] = o1.z; v[8 * j + 7] = o1.w;
        s2 += (o0.x * o0.x + o0.y * o0.y) + (o0.z * o0.z + o0.w * o0.w) + (o1.x * o1.x + o1.y * o1.y) + (o1.z * o1.z + o1.w * o1.w); }
    const float rs2 = 1.0f / sqrtf(wave_sum(s2) * (1.0f / DM) + EPSN);
#pragma unroll
    for (int j = 0; j < 8; ++j) { const int c0 = (j * 64 + lane) * 8; const f32x4 g0 = *(const f32x4*)(g_pre + c0), g1 = *(const f32x4*)(g_pre + c0 + 4);
        v4u o; o.x = pk2(v[8 * j + 0] * rs2 * g0.x, v[8 * j + 1] * rs2 * g0.y); o.y = pk2(v[8 * j + 2] * rs2 * g0.z, v[8 * j + 3] * rs2 * g0.w);
        o.z = pk2(v[8 * j + 4] * rs2 * g1.x, v[8 * j + 5] * rs2 * g1.y); o.w = pk2(v[8 * j + 6] * rs2 * g1.z, v[8 * j + 7] * rs2 * g1.w);
        *(v4u*)(xnr + c0) = o; }
}
__device__ __forceinline__ void rowpass2(const bf16* fr_, const float* g, float* outr, int lane) {
    float v[64]; float s = 0.f;
#pragma unroll
    for (int j = 0; j < 8; ++j) { const v4u r = *(const v4u*)(fr_ + (j * 64 + lane) * 8);
        v[8 * j + 0] = bflo(r.x); v[8 * j + 1] = bfhi(r.x); v[8 * j + 2] = bflo(r.y); v[8 * j + 3] = bfhi(r.y); v[8 * j + 4] = bflo(r.z); v[8 * j + 5] = bfhi(r.z); v[8 * j + 6] = bflo(r.w); v[8 * j + 7] = bfhi(r.w);
#pragma unroll
        for (int e = 0; e < 8; ++e) s += v[8 * j + e] * v[8 * j + e]; }
    const float rs = 1.0f / sqrtf(wave_sum(s) * (1.0f / DM) + EPSN);
#pragma unroll
    for (int j = 0; j < 8; ++j) { const int c0 = (j * 64 + lane) * 8;
        const f32x4 x0 = *(const f32x4*)(outr + c0), x1 = *(const f32x4*)(outr + c0 + 4), g0 = *(const f32x4*)(g + c0), g1 = *(const f32x4*)(g + c0 + 4);
        f32x4 o0, o1;
        o0.x = x0.x + v[8 * j + 0] * rs * g0.x; o0.y = x0.y + v[8 * j + 1] * rs * g0.y; o0.z = x0.z + v[8 * j + 2] * rs * g0.z; o0.w = x0.w + v[8 * j + 3] * rs * g0.w;
        o1.x = x1.x + v[8 * j + 4] * rs * g1.x; o1.y = x1.y + v[8 * j + 5] * rs * g1.y; o1.z = x1.z + v[8 * j + 6] * rs * g1.z; o1.w = x1.w + v[8 * j + 7] * rs * g1.w;
        *(f32x4*)(outr + c0) = o0; *(f32x4*)(outr + c0 + 4) = o1; }
}
constexpr int SIDE_G_ROWS = 8, SIDE_U_ROWS = 4;
__device__ __forceinline__ float dpp_prev(float x, float xprevblk) {
    const int old = __builtin_amdgcn_update_dpp(0, __builtin_bit_cast(int, xprevblk), 0x121  , 0xf, 0xf, false);
    return __builtin_bit_cast(float, __builtin_amdgcn_update_dpp(old, __builtin_bit_cast(int, x), 0x111  , 0xf, 0xf, false));
}
__device__ __forceinline__ float dpp_next(float x, float xnextblk) {
    const int old = __builtin_amdgcn_update_dpp(0, __builtin_bit_cast(int, xnextblk), 0x12F  , 0xf, 0xf, false);
    return __builtin_bit_cast(float, __builtin_amdgcn_update_dpp(old, __builtin_bit_cast(int, x), 0x101  , 0xf, 0xf, false));
}
struct EpiGate {
    static constexpr bool PERM = true, AFTER_DRAIN = false, AROWPERM = true;
    bf16* H; const float* cw; const float* cb; float* sideG; float* sideU;
    __device__ __forceinline__ void operator()(const pg8::f32x4 (&acc)[2][2][4][2], const pg8::Unit& u, int wr, int wc, int fr, int fq) const {
        const int hc0 = u.pn * 128 + wc * 32 + 8 * fq;
        f32x4 w0[2], w1[2], w2[2], bb[2];
#pragma unroll
        for (int n = 0; n < 2; ++n) { w0[n] = *(const f32x4*)(cw + hc0 + 4 * n); w1[n] = *(const f32x4*)(cw + DFF + hc0 + 4 * n); w2[n] = *(const f32x4*)(cw + 2 * DFF + hc0 + 4 * n); bb[n] = *(const f32x4*)(cb + hc0 + 4 * n); }
        const size_t row0 = (size_t)u.pm * 256 + wr * 128 + fr;
        const f32x4 zero4 = (f32x4){0.f, 0.f, 0.f, 0.f};
#pragma unroll
        for (int blk = 0; blk < 8; ++blk) {
            const int ai = blk >> 2, m = blk & 3;
            float r[8];
#pragma unroll
            for (int n = 0; n < 2; ++n) {
                const f32x4 x = acc[ai][0][m][n];
                const f32x4 xp = blk > 0 ? acc[(blk - 1) >> 2][0][(blk - 1) & 3][n] : zero4;
                const f32x4 xn = blk < 7 ? acc[(blk + 1) >> 2][0][(blk + 1) & 3][n] : zero4;
                const f32x4 uu = acc[ai][1][m][n];
#pragma unroll
                for (int j = 0; j < 4; ++j) {
                    const float pre = bb[n][j] + w0[n][j] * dpp_prev(x[j], xp[j]) + w1[n][j] * x[j] + w2[n][j] * dpp_next(x[j], xn[j]);
                    r[4 * n + j] = gelu_tanh(pre) * uu[j];
                }
            }
            v4u o; o.x = pk2(r[0], r[1]); o.y = pk2(r[2], r[3]); o.z = pk2(r[4], r[5]); o.w = pk2(r[6], r[7]);
            *(v4u*)(H + (row0 + 16 * blk) * DFF + hc0) = o;
        }
        float* sg = sideG + ((size_t)u.pm * SIDE_G_ROWS + 4 * wr) * DFF + hc0;
        float* su = sideU + ((size_t)u.pm * SIDE_U_ROWS + 2 * wr) * DFF + hc0;
        if (fr < 2) { *(f32x4*)(sg + (size_t)fr * DFF) = acc[0][0][0][0]; *(f32x4*)(sg + (size_t)fr * DFF + 4) = acc[0][0][0][1]; }
        if (fr >= 14) { *(f32x4*)(sg + (size_t)(fr - 12) * DFF) = acc[1][0][3][0]; *(f32x4*)(sg + (size_t)(fr - 12) * DFF + 4) = acc[1][0][3][1]; }
        if (fr == 0) { *(f32x4*)su = acc[0][1][0][0]; *(f32x4*)(su + 4) = acc[0][1][0][1]; }
        if (fr == 15) { *(f32x4*)(su + DFF) = acc[1][1][3][0]; *(f32x4*)(su + DFF + 4) = acc[1][1][3][1]; }
    }
};
__device__ __forceinline__ void gate_fixup(const float* sideG, const float* sideU, const float* cw, const float* cb, bf16* H, int gtid, int nthreads) {
    constexpr int C4 = DFF / 4, NT = NTOK / 256;
    for (int idx = gtid; idx < NT * 4 * C4; idx += nthreads) {
        const int c = (idx % C4) * 4, k = (idx / C4) & 3, pm = idx / (4 * C4);
        const float* g = sideG + (size_t)pm * SIDE_G_ROWS * DFF + c;
        f32x4 prev, cur, next; int row;
        const f32x4 z = (f32x4){0.f, 0.f, 0.f, 0.f};
        if (k == 0) { row = 0; prev = (pm % 32 == 0) ? z : *(const f32x4*)(g - (size_t)SIDE_G_ROWS * DFF + 7 * (size_t)DFF); cur = *(const f32x4*)g; next = *(const f32x4*)(g + DFF); }
        else if (k == 1) { row = 127; prev = *(const f32x4*)(g + 2 * (size_t)DFF); cur = *(const f32x4*)(g + 3 * (size_t)DFF); next = *(const f32x4*)(g + 4 * (size_t)DFF); }
        else if (k == 2) { row = 128; prev = *(const f32x4*)(g + 3 * (size_t)DFF); cur = *(const f32x4*)(g + 4 * (size_t)DFF); next = *(const f32x4*)(g + 5 * (size_t)DFF); }
        else { row = 255; prev = *(const f32x4*)(g + 6 * (size_t)DFF); cur = *(const f32x4*)(g + 7 * (size_t)DFF); next = (pm % 32 == 31) ? z : *(const f32x4*)(g + (size_t)SIDE_G_ROWS * DFF); }
        const f32x4 uu = *(const f32x4*)(sideU + ((size_t)pm * SIDE_U_ROWS + k) * DFF + c);
        const f32x4 w0 = *(const f32x4*)(cw + c), w1 = *(const f32x4*)(cw + DFF + c), w2 = *(const f32x4*)(cw + 2 * DFF + c), b = *(const f32x4*)(cb + c);
        float r[4];
#pragma unroll
        for (int j = 0; j < 4; ++j) r[j] = gelu_tanh(b[j] + w0[j] * prev[j] + w1[j] * cur[j] + w2[j] * next[j]) * uu[j];
        v2u o; o.x = pk2(r[0], r[1]); o.y = pk2(r[2], r[3]);
        *(v2u*)(H + ((size_t)pm * 256 + row) * DFF + c) = o;
    }
}
constexpr int LDS_PHASE_BYTES = 143360;
constexpr int LDSCTL_OFF = LDS_PHASE_BYTES, LDS_BYTES = 147456;
constexpr int CW_BAR = 4096;
constexpr size_t CTL_ZERO_BYTES = 64 * 1024;
static_assert(HY_LDS_BYTES <= LDS_PHASE_BYTES && RG_LDS_BYTES <= LDS_PHASE_BYTES && MN_LDS_BYTES <= LDS_PHASE_BYTES && pg8::STAGE_BYTES <= LDS_PHASE_BYTES, "LDS map");
static_assert((CW_BAR + XCD_BAR_WORDS) * 4 <= (int)CTL_ZERO_BYTES, "control words inside the memset region");

struct MkArgs { const float* in[32]; float* out; unsigned char* ws; };
__device__ __forceinline__ pg8::Gemm dgemm(const bf16* A, const bf16* Bt, int M, int N, int K, int lda, int ldb) { pg8::Gemm g; g.A = A; g.Bt = Bt; g.M = M; g.N = N; g.K = K; g.lda = lda; g.ldb = ldb; return g; }
__device__ __forceinline__ pg8::EpiBf16<0> depi(bf16* O, int ldc) { pg8::EpiBf16<0> e; e.O = O; e.ldc = ldc; e.bias = nullptr; e.split_cols = 0; e.split_stride = 0; e.scale0 = 1.f; return e; }

__device__ __forceinline__ void gate_seq(const bf16* gu, const float* cw, const float* cb, bf16* h, int gtid, int nthreads) {
    constexpr int CG = DFF / 8;
    for (int idx = gtid; idx < SEQL * CG; idx += nthreads) {
        const int m = idx / CG, c0 = (idx % CG) * 8;
        const v4u z = (v4u){0u, 0u, 0u, 0u};
        const v4u gm = m > 0 ? *(const v4u*)(gu + (size_t)(m - 1) * 2 * DFF + c0) : z;
        const v4u g0 = *(const v4u*)(gu + (size_t)m * 2 * DFF + c0);
        const v4u gp = m < SEQL - 1 ? *(const v4u*)(gu + (size_t)(m + 1) * 2 * DFF + c0) : z;
        const v4u uu = *(const v4u*)(gu + (size_t)m * 2 * DFF + DFF + c0);
        float r[8];
#pragma unroll
        for (int e = 0; e < 8; ++e) {
            const unsigned wm = e < 2 ? gm.x : e < 4 ? gm.y : e < 6 ? gm.z : gm.w, w0 = e < 2 ? g0.x : e < 4 ? g0.y : e < 6 ? g0.z : g0.w, wp = e < 2 ? gp.x : e < 4 ? gp.y : e < 6 ? gp.z : gp.w, wu = e < 2 ? uu.x : e < 4 ? uu.y : e < 6 ? uu.z : uu.w;
            const float a = (e & 1) ? bfhi(wm) : bflo(wm), b = (e & 1) ? bfhi(w0) : bflo(w0), c = (e & 1) ? bfhi(wp) : bflo(wp), u = (e & 1) ? bfhi(wu) : bflo(wu);
            const float pre = cb[c0 + e] + cw[c0 + e] * a + cw[DFF + c0 + e] * b + cw[2 * DFF + c0 + e] * c;
            r[e] = gelu_tanh(pre) * u;
        }
        v4u o; o.x = pk2(r[0], r[1]); o.y = pk2(r[2], r[3]); o.z = pk2(r[4], r[5]); o.w = pk2(r[6], r[7]);
        *(v4u*)(h + (size_t)m * DFF + c0) = o;
    }
}

__global__ void __launch_bounds__(512, 2) mk_fwd(MkArgs args) {
    extern __shared__ __attribute__((aligned(16))) unsigned char lds_raw[];
    LAS unsigned char* lds = (LAS unsigned char*)lds_raw;
    const int tid = threadIdx.x, lane = tid & 63, wave = __builtin_amdgcn_readfirstlane(tid >> 6);
    const int G = gridDim.x, bx = blockIdx.x;
    unsigned char* ws = args.ws;
    const float* const* in = args.in;
    volatile LAS unsigned* MISC = (volatile LAS unsigned*)(lds + LDSCTL_OFF);
    for (int u = tid; u < (LDS_BYTES - LDSCTL_OFF) / 4; u += 512) ((LAS unsigned*)(lds + LDSCTL_OFF))[u] = 0u;
    __syncthreads();
    XcdBarrier bar = xcd_barrier_post((unsigned*)(ws + WS_CTL) + CW_BAR, MISC + 8);

    bf16* XN = (bf16*)(ws + WS_XN); bf16* WIN = (bf16*)(ws + WS_WIN);
    {
        ProArgs pa; pa.xp = in[0]; pa.xs = in[1]; pa.g_premix = in[2]; pa.w_in = in[3]; pa.w_out = in[24]; pa.w_ffi = in[27]; pa.w_ffo = in[30]; pa.rg_a_w = in[6]; pa.rg_x_w = in[8];
        pa.hy_w1 = in[13]; pa.hy_b1 = in[14]; pa.hy_w2 = in[15]; pa.hy_b2 = in[16]; pa.hy_w3 = in[17]; pa.hy_b3 = in[18]; pa.hy_freq = in[20]; pa.ws = ws;
        p0_prologue<true>(pa, lds, bx * 8 + wave, G * 8, wave, lane);
    }
    xcd_barrier(bar);
    {
        pg8::StaticOrder S; S.init(NTOK, 2 * DRG, G, bx);
        pg8::gemm_phase<pg8::EpiBf16<0>, pg8::StaticOrder, true, true>(lds, dgemm(XN, WIN, NTOK, 2 * DRG, DM, LDK, LDK), S, depi((bf16*)(ws + WS_PRG), 2 * DRG));
    }
    {
        pg8::StaticOrder S; S.init(3 * DHY, NTOK, G, bx);
        pg8::gemm_phase<pg8::EpiBf16<0>, pg8::StaticOrder, true, true>(lds, dgemm(WIN + (size_t)2 * DRG * LDK, XN, 3 * DHY, NTOK, DM, LDK, LDK), S, depi((bf16*)(ws + WS_PHY), NTOK));
    }
    xcd_barrier(bar);
    RgArgs ra; ra.prg = (const bf16*)(ws + WS_PRG); ra.conv_w = in[4]; ra.conv_b = in[5]; ra.rgw = (const bf16*)(ws + WS_RGW); ra.a_b = in[7]; ra.x_b = in[9]; ra.lam = in[10];
    ra.summ = (f32x2*)(ws + WS_SUMM); ra.rgy = (bf16*)(ws + WS_RGY);
    {
        HyArgs a; a.phy = (const bf16*)(ws + WS_PHY); a.conv_w = in[11]; a.conv_b = in[12]; a.w4 = in[19]; a.hy_bias = in[21]; a.h3h = (const bf16*)(ws + WS_H3); a.tw = (const f32x2*)(ws + WS_TW);
        a.zk = (f32x2*)(ws + WS_ZK); a.hyy = (bf16*)(ws + WS_HYY);
        for (int cp = bx; cp < DHY / 2; cp += G) hyena_unit(a, lds, cp, bx, tid);
    }
    for (int u = bx; u < RG_UNITS; u += G) rg_unit<1>(ra, lds, u, tid);
    xcd_barrier(bar);
    for (int u = bx; u < RG_UNITS; u += G) rg_unit<2>(ra, lds, u, tid);
    xcd_barrier(bar);
    for (int m = bx * 8 + wave; m < NTOK; m += G * 8) mixnorm_rg_row((const bf16*)(ws + WS_RGY), in[22], (bf16*)(ws + WS_MIX), m, lane);
    for (int t = bx; t < NTOK / 64; t += G) mixnorm_hy_tile((const bf16*)(ws + WS_HYY), in[23], (bf16*)(ws + WS_MIX), lds, t, tid);
    xcd_barrier(bar);
    {
        pg8::StaticOrder S; S.init(NTOK, DM, G, bx);
        pg8::gemm_phase<pg8::EpiBf16<0>, pg8::StaticOrder, true, true>(lds, dgemm((bf16*)(ws + WS_MIX), (bf16*)(ws + WS_WOUT), NTOK, DM, DM, LDK, LDK), S, depi((bf16*)(ws + WS_Y), DM));
    }
    xcd_barrier(bar);
    for (int m = bx * 8 + wave; m < NTOK; m += G * 8) rowpass1(xrow_ptr(in[0], in[1], m), (const bf16*)(ws + WS_Y) + (size_t)m * DM, in[25], in[26], args.out + (size_t)m * DM, XN + (size_t)m * LDK, lane);
    xcd_barrier(bar);
    bf16* HB = (bf16*)(ws + WS_H);
    {
        pg8::StaticOrder S; S.init(NTOK, 2 * DFF, G, bx);
        EpiGate E; E.H = HB; E.cw = in[28]; E.cb = in[29]; E.sideG = (float*)(ws + WS_SIDEG); E.sideU = (float*)(ws + WS_SIDEU);
        pg8::gemm_phase<EpiGate, pg8::StaticOrder, true, true>(lds, dgemm(XN, (bf16*)(ws + WS_WFI), NTOK, 2 * DFF, DM, LDK, LDK), S, E);
    }
    xcd_barrier(bar);
    { int tq = tid; asm volatile("" : "+v"(tq)); gate_fixup((const float*)(ws + WS_SIDEG), (const float*)(ws + WS_SIDEU), in[28], in[29], HB, bx * 512 + tq, G * 512); }
    xcd_barrier(bar);
    {
        pg8::StaticOrder S; S.init(NTOK, DM, G, bx);
        pg8::gemm_phase<pg8::EpiBf16<0>, pg8::StaticOrder, true, true>(lds, dgemm(HB, (bf16*)(ws + WS_WFO), NTOK, DM, DFF, DFF, DFF), S, depi((bf16*)(ws + WS_F), DM));
    }
    xcd_barrier(bar);
    for (int m = bx * 8 + wave; m < NTOK; m += G * 8) rowpass2((const bf16*)(ws + WS_F) + (size_t)m * DM, in[31], args.out + (size_t)m * DM, lane);
}

extern "C" void kernel_launch(void* const* d_in, const int* in_sizes, int n_in, void* d_out, int out_size, void* d_ws, size_t ws_size, hipStream_t stream) {
    static int grid = 0;
    if (grid == 0) {
        grid = -1;
        if (n_in != 32 || out_size != NTOK * DM || ws_size < WS_END) { fprintf(stderr, "kernel_launch: unexpected sizes n_in %d out %d ws %zu (need %zu)\n", n_in, out_size, ws_size, (size_t)WS_END); return; }
        int dev = 0, cus = 0, per_cu = 0;
        if (hipGetDevice(&dev) != hipSuccess || hipDeviceGetAttribute(&cus, hipDeviceAttributeMultiprocessorCount, dev) != hipSuccess) return;
        if (hipFuncSetAttribute((const void*)mk_fwd, hipFuncAttributeMaxDynamicSharedMemorySize, LDS_BYTES) != hipSuccess) { fprintf(stderr, "kernel_launch: hipFuncSetAttribute failed\n"); return; }
        if (hipOccupancyMaxActiveBlocksPerMultiprocessor(&per_cu, (const void*)mk_fwd, 512, LDS_BYTES) != hipSuccess || per_cu < 1) { fprintf(stderr, "kernel_launch: occupancy query says %d blocks per CU\n", per_cu); (void)hipGetLastError(); return; }
        grid = cus;
    }
    if (grid < 0) return;
    if (hipMemsetAsync((char*)d_ws + WS_CTL, 0, CTL_ZERO_BYTES, stream) != hipSuccess) return;
    MkArgs a; memset(&a, 0, sizeof a);
    for (int i = 0; i < 32; ++i) a.in[i] = (const float*)d_in[i];
    a.out = (float*)d_out; a.ws = (unsigned char*)d_ws;
    hipLaunchKernelGGL(mk_fwd, dim3(grid), dim3(512), LDS_BYTES, stream, a);
}
```

```cpp
#include <cstring>
#include <hip/hip_runtime.h>
#include <cstdio>
#include <cstdint>
namespace pg8 {
#define PG8_LAS __attribute__((address_space(3)))
typedef unsigned short bf16_t;
typedef short bf16x8 __attribute__((ext_vector_type(8)));
typedef float f32x4 __attribute__((ext_vector_type(4)));
typedef unsigned u32x4 __attribute__((ext_vector_type(4)));
constexpr int BM = 256, BK = 64, HALF = 128, HTB = HALF * BK * 2  , STAGE_BYTES = 8 * HTB, NXCD = 8, WGM = 8;

__host__ __device__ __forceinline__ int lds_byte(int r, int c) { const int st = (r >> 4) * 2 + (c >> 5), rr = r & 15, cc = c & 31, ob = rr * 64 + cc * 2; return st * 1024 + (ob ^ (((ob >> 9) & 1) << 5)); }
__host__ __device__ __forceinline__ void stage_rc(int b, int& R, int& C) { const int st = b / 1024, sb = b % 1024, swz = sb ^ (((sb >> 9) & 1) << 5); R = (st >> 1) * 16 + swz / 64; C = (st & 1) * 32 + (swz % 64) / 2; }
__host__ __device__ __forceinline__ int perm32(int rho) { const int n = rho >> 4, i = rho & 15; return 8 * (i >> 2) + 4 * n + (i & 3); }

struct Unit { int pm, pn; };
struct Gemm { const bf16_t* A; const bf16_t* Bt; int M, N, K, lda, ldb; };

struct StaticOrder {
    int nM, nN, nwg, G, c;
    __host__ __device__ __forceinline__ void init(int M, int N, int G_, int c_) { nM = M / BM; nN = N / BM; nwg = nM * nN; G = G_; c = c_; }
    __host__ __device__ __forceinline__ bool next(int i, Unit& u) const {
        const long L = (long)i * G + c; if (L >= nwg) return false;
        int wgid = (int)L; { const int q = nwg / NXCD, r = nwg % NXCD, xcd = wgid % NXCD, off = wgid / NXCD; wgid = (xcd < r ? xcd * (q + 1) : r * (q + 1) + (xcd - r) * q) + off; }
        const int nig = WGM * nN, gid = wgid / nig, fm = gid * WGM, gsz = (nM - fm) < WGM ? (nM - fm) : WGM;
        u.pm = fm + ((wgid % nig) % gsz); u.pn = (wgid % nig) / gsz; return true;
    }
    __device__ __forceinline__ void a_ready(const Unit&, int) const {}
    __device__ __forceinline__ void done(const Unit&) const {}
};

__device__ __forceinline__ unsigned cvt_pk_bf16(float lo, float hi) { unsigned r; asm volatile("v_cvt_pk_bf16_f32 %0, %1, %2" : "=v"(r) : "v"(lo), "v"(hi)); return r; }
typedef float f32x2 __attribute__((ext_vector_type(2)));
__device__ __forceinline__ f32x2 gelu_pk(f32x2 v) {
    const f32x2 av = __builtin_elementwise_abs(v), d = av * 0.2316418882f + 1.0f;
    f32x2 t; t.x = __builtin_amdgcn_rcpf(d.x); t.y = __builtin_amdgcn_rcpf(d.y);
    f32x2 q = t * 0.5307027145f + (-0.7265760135f); q = q * t + 0.7107068705f; q = q * t + (-0.142248368f); q = q * t + 0.127414796f; q = q * t;
    const f32x2 s = (v * v) * (-0.72134752044f);
    f32x2 e; e.x = __builtin_amdgcn_exp2f(s.x); e.y = __builtin_amdgcn_exp2f(s.y);
    const f32x2 m = v * (q * e), r = v - m;
    f32x2 o; o.x = v.x < 0.f ? m.x : r.x; o.y = v.y < 0.f ? m.y : r.y; return o;
}

template <int ACT  > struct EpiBf16 {
    static constexpr bool PERM = true, AFTER_DRAIN = false, AROWPERM = false; static_assert(ACT == 0 || ACT == 1, "EpiBf16: ACT is 0 (none) or 1 (gelu_pk)");
    bf16_t* O; int ldc; const float* bias; int split_cols; size_t split_stride; float scale0;
    __device__ __forceinline__ void operator()(const f32x4 (&acc)[2][2][4][2], const Unit& u, int wr, int wc, int fr, int fq) const {
        const int row0 = u.pm * BM + wr * 64 + fr; int colt = u.pn * BM; bf16_t* base = O;
        float sc = 1.f; if (split_cols) { const int t = colt / split_cols; base += (size_t)t * split_stride; colt -= t * split_cols; if (t == 0) sc = scale0; }
        const int col0 = colt + wc * 32 + 8 * fq, bcol0 = u.pn * BM + wc * 32 + 8 * fq;
        f32x4 bv[2][2];
#pragma unroll
        for (int bj = 0; bj < 2; ++bj)
#pragma unroll
            for (int n = 0; n < 2; ++n) bv[bj][n] = bias ? *(const f32x4*)(bias + bcol0 + bj * HALF + 4 * n) : (f32x4){0.f, 0.f, 0.f, 0.f};
#pragma unroll
        for (int ai = 0; ai < 2; ++ai)
#pragma unroll
            for (int m = 0; m < 4; ++m) { bf16_t* rowp = base + (size_t)(row0 + ai * HALF + m * 16) * ldc + col0;
#pragma unroll
                for (int bj = 0; bj < 2; ++bj) { f32x4 v0 = acc[ai][bj][m][0] + bv[bj][0], v1 = acc[ai][bj][m][1] + bv[bj][1];
                    if (ACT == 1) { f32x2 a = gelu_pk((f32x2){v0[0], v0[1]}), b = gelu_pk((f32x2){v0[2], v0[3]}), c = gelu_pk((f32x2){v1[0], v1[1]}), d = gelu_pk((f32x2){v1[2], v1[3]});
                        v0 = (f32x4){a.x, a.y, b.x, b.y}; v1 = (f32x4){c.x, c.y, d.x, d.y}; }
                    v0 = v0 * sc; v1 = v1 * sc; u32x4 w; w.x = cvt_pk_bf16(v0[0], v0[1]); w.y = cvt_pk_bf16(v0[2], v0[3]); w.z = cvt_pk_bf16(v1[0], v1[1]); w.w = cvt_pk_bf16(v1[2], v1[3]);
                    *(u32x4*)(rowp + bj * HALF) = w; } }
    }
};
template <class Epi, class Sched, bool ALIGN_EPI = false, bool SP2 = false>
__device__ __forceinline__ void gemm_phase(PG8_LAS unsigned char* lds, const Gemm g, const Sched& S, const Epi& E) {
    int tid_ = threadIdx.x; asm volatile("" : "+v"(tid_));
    const int tid = tid_, wid = __builtin_amdgcn_readfirstlane(tid >> 6), lane = tid & 63, wr = wid >> 2, wc = wid & 3, fr = lane & 15, fq = lane >> 4;
    const int K = g.K, nt = K / BK;
    unsigned voffA[2], voffB[2];
#pragma unroll
    for (int i = 0; i < 2; ++i) { int R, C; stage_rc(tid * 16 + i * 8192, R, C); const int Rb = Epi::PERM ? ((R & ~31) + perm32(R & 31)) : R; const int Ra = Epi::AROWPERM ? (128 * (R >> 6) + (R & 63)) : R;
        voffA[i] = (unsigned)(Ra * g.lda + C) * 2u; voffB[i] = (unsigned)(Rb * g.ldb + C) * 2u; }
    const size_t kstep = (size_t)(BK * 2);
    const size_t hstep = (size_t)HALF * g.ldb * 2;
    const size_t hstepA = (size_t)(Epi::AROWPERM ? 64 : HALF) * g.lda * 2;
    const size_t tstep = 2 * hstep, tstepA = (size_t)BM * g.lda * 2;
    const unsigned ldsw = (unsigned)wid * 1024u;
    const int aoff = lds_byte(wr * 64 + fr, fq * 8), boff = lds_byte(wc * 32 + fr, fq * 8);
#define PG8_SA(b, h) (((b) * 2 + (h)) * HTB)
#define PG8_SB(b, h) ((4 + (b) * 2 + (h)) * HTB)
#define PG8_STAGE(bufoff, gbase, voff) do { _Pragma("unroll") for (int _i = 0; _i < 2; ++_i) \
        __builtin_amdgcn_global_load_lds((const unsigned*)((const char*)(gbase) + (voff)[_i]), (PG8_LAS unsigned*)(lds + (bufoff) + ldsw + _i * 8192), 16, 0, 0); } while (0)
#define PG8_LDA(dst, b, h) do { _Pragma("unroll") for (int m = 0; m < 4; ++m) _Pragma("unroll") for (int k = 0; k < 2; ++k) dst[m][k] = *(const PG8_LAS bf16x8*)(lds + PG8_SA(b, h) + aoff + m * 2048 + k * 1024); } while (0)
#define PG8_LDB(dst, b, h) do { _Pragma("unroll") for (int n = 0; n < 2; ++n) _Pragma("unroll") for (int k = 0; k < 2; ++k) dst[n][k] = *(const PG8_LAS bf16x8*)(lds + PG8_SB(b, h) + boff + n * 2048 + k * 1024); } while (0)
#define PG8_MMA(ai, bj, At, Bt) do { __builtin_amdgcn_s_setprio(1); _Pragma("unroll") for (int m = 0; m < 4; ++m) _Pragma("unroll") for (int n = 0; n < 2; ++n) _Pragma("unroll") for (int k = 0; k < 2; ++k) \
        acc[ai][bj][m][n] = __builtin_amdgcn_mfma_f32_16x16x32_bf16(Bt[n][k], At[m][k], acc[ai][bj][m][n], 0, 0, 0); __builtin_amdgcn_s_setprio(0); } while (0)
#define PG8_WAIT_V(n) asm volatile("s_waitcnt vmcnt(" #n ")" ::: "memory")
#define PG8_WAIT_L(n) asm volatile("s_waitcnt lgkmcnt(" #n ")" ::: "memory")
#define PG8_BAR __builtin_amdgcn_s_barrier()
#define PG8_SCHED __builtin_amdgcn_sched_barrier(0)
    Unit cur, nxt; int ui = 0;
    if (!S.next(0, cur)) return;
    f32x4 acc[2][2][4][2];
#pragma unroll
    for (int a = 0; a < 2; ++a)
#pragma unroll
        for (int b = 0; b < 2; ++b)
#pragma unroll
            for (int m = 0; m < 4; ++m)
#pragma unroll
                for (int n = 0; n < 2; ++n) acc[a][b][m][n] = (f32x4){0.f, 0.f, 0.f, 0.f};
    bf16x8 At[4][2], B0[2][2], B1[2][2];
    const char* cA = (const char*)g.A + (size_t)cur.pm * tstepA; const char* cB = (const char*)g.Bt + (size_t)cur.pn * tstep;
    S.a_ready(cur, 0);
    if constexpr (SP2) {
        PG8_STAGE(PG8_SB(0, 0), cB, voffB); PG8_STAGE(PG8_SB(0, 1), cB + hstep, voffB); PG8_STAGE(PG8_SA(0, 0), cA, voffA); PG8_STAGE(PG8_SA(0, 1), cA + hstepA, voffA);
        if (wr == 1) PG8_BAR;
        PG8_WAIT_V(2); PG8_BAR;
        PG8_STAGE(PG8_SB(1, 0), cB + kstep, voffB); PG8_STAGE(PG8_SA(1, 0), cA + kstep, voffA); PG8_STAGE(PG8_SB(1, 1), cB + hstep + kstep, voffB);
        PG8_WAIT_V(6); PG8_BAR;
    } else {
        PG8_STAGE(PG8_SB(0, 0), cB, voffB); PG8_STAGE(PG8_SA(0, 0), cA, voffA); PG8_STAGE(PG8_SB(0, 1), cB + hstep, voffB); PG8_STAGE(PG8_SA(0, 1), cA + hstepA, voffA);
        if (wr == 1) PG8_BAR;
        PG8_WAIT_V(4); PG8_BAR;
        PG8_STAGE(PG8_SB(1, 0), cB + kstep, voffB); PG8_STAGE(PG8_SA(1, 0), cA + kstep, voffA); PG8_STAGE(PG8_SB(1, 1), cB + hstep + kstep, voffB);
        PG8_WAIT_V(6); PG8_BAR;
    }
    for (;;) {
        const bool has_next = S.next(ui + 1, nxt);
        const char* nA = has_next ? (const char*)g.A + (size_t)nxt.pm * tstepA : cA; const char* nB = has_next ? (const char*)g.Bt + (size_t)nxt.pn * tstep : cB;
        for (int t = 0; t < nt; t += 2) {
            const bool last = (t == nt - 2);
            const char* a1 = cA + (size_t)(t + 1) * kstep;
            const char* a2 = last ? nA : cA + (size_t)(t + 2) * kstep; const char* b2 = last ? nB : cB + (size_t)(t + 2) * kstep;
            const char* a3 = a2 + kstep; const char* b3 = b2 + kstep;
            if (last && has_next) S.a_ready(nxt, ui + 1);
            if constexpr (SP2) {
            PG8_LDB(B0, 0, 0); PG8_LDB(B1, 0, 1); PG8_SCHED; PG8_LDA(At, 0, 0); PG8_STAGE(PG8_SA(1, 1), a1 + hstepA, voffA);
            PG8_WAIT_V(8); PG8_WAIT_L(0); PG8_BAR; PG8_MMA(0, 0, At, B0); PG8_MMA(0, 1, At, B1); PG8_BAR; PG8_SCHED;
            PG8_LDA(At, 0, 1); PG8_STAGE(PG8_SB(0, 0), b2, voffB); PG8_STAGE(PG8_SB(0, 1), b2 + hstep, voffB); PG8_STAGE(PG8_SA(0, 0), a2, voffA);
            PG8_WAIT_V(8); PG8_WAIT_L(0); PG8_BAR; PG8_MMA(1, 0, At, B0); PG8_MMA(1, 1, At, B1); PG8_BAR; PG8_SCHED;
            PG8_LDB(B0, 1, 0); PG8_LDB(B1, 1, 1); PG8_SCHED; PG8_LDA(At, 1, 0); PG8_STAGE(PG8_SA(0, 1), a2 + hstepA, voffA);
            PG8_WAIT_V(8); PG8_WAIT_L(0); PG8_BAR; PG8_MMA(0, 0, At, B0); PG8_MMA(0, 1, At, B1); PG8_BAR; PG8_SCHED;
            PG8_LDA(At, 1, 1); PG8_STAGE(PG8_SB(1, 0), b3, voffB); PG8_STAGE(PG8_SB(1, 1), b3 + hstep, voffB); PG8_STAGE(PG8_SA(1, 0), a3, voffA);
            PG8_WAIT_V(8); PG8_WAIT_L(0); PG8_BAR; PG8_MMA(1, 0, At, B0); PG8_MMA(1, 1, At, B1); PG8_BAR; PG8_SCHED;
            } else {
            PG8_LDB(B0, 0, 0); PG8_SCHED; PG8_LDA(At, 0, 0); PG8_STAGE(PG8_SA(1, 1), a1 + hstepA, voffA);
            PG8_WAIT_L(8); PG8_BAR; PG8_WAIT_L(0); PG8_MMA(0, 0, At, B0); PG8_BAR; PG8_SCHED;
            PG8_LDB(B1, 0, 1); PG8_STAGE(PG8_SB(0, 0), b2, voffB);
            PG8_BAR; PG8_WAIT_L(0); PG8_MMA(0, 1, At, B1); PG8_BAR;
            PG8_LDA(At, 0, 1); PG8_STAGE(PG8_SA(0, 0), a2, voffA);
            PG8_BAR; PG8_WAIT_L(0); PG8_MMA(1, 0, At, B0); PG8_BAR; PG8_SCHED;
            PG8_STAGE(PG8_SB(0, 1), b2 + hstep, voffB);
            PG8_WAIT_V(6); PG8_BAR; PG8_MMA(1, 1, At, B1); PG8_BAR;
            PG8_LDB(B0, 1, 0); PG8_SCHED; PG8_LDA(At, 1, 0); PG8_STAGE(PG8_SA(0, 1), a2 + hstepA, voffA);
            PG8_WAIT_L(8); PG8_BAR; PG8_WAIT_L(0); PG8_MMA(0, 0, At, B0); PG8_BAR; PG8_SCHED;
            PG8_LDB(B1, 1, 1); PG8_STAGE(PG8_SB(1, 0), b3, voffB);
            PG8_BAR; PG8_WAIT_L(0); PG8_MMA(0, 1, At, B1); PG8_BAR;
            PG8_LDA(At, 1, 1); PG8_STAGE(PG8_SA(1, 0), a3, voffA);
            PG8_BAR; PG8_WAIT_L(0); PG8_MMA(1, 0, At, B0); PG8_BAR; PG8_SCHED;
            PG8_STAGE(PG8_SB(1, 1), b3 + hstep, voffB);
            PG8_WAIT_V(6); PG8_BAR; PG8_MMA(1, 1, At, B1); PG8_BAR;
            }
        }
        if constexpr (ALIGN_EPI) { if (wr == 0) PG8_BAR; }
        if constexpr (!Epi::AFTER_DRAIN) { E(acc, cur, wr, wc, fr, fq); S.done(cur); }
        if (!has_next) break;
#pragma unroll
        for (int a = 0; a < 2; ++a)
#pragma unroll
            for (int b = 0; b < 2; ++b)
#pragma unroll
                for (int m = 0; m < 4; ++m)
#pragma unroll
                    for (int n = 0; n < 2; ++n) acc[a][b][m][n] = (f32x4){0.f, 0.f, 0.f, 0.f};
        cur = nxt; cA = nA; cB = nB; ++ui;
        if constexpr (ALIGN_EPI) { if (wr == 1) PG8_BAR; }
    }
    PG8_WAIT_V(0);
    if constexpr (!ALIGN_EPI) { if (wr == 0) PG8_BAR; }
    PG8_BAR;
    if constexpr (Epi::AFTER_DRAIN) { E.fused(acc, cur, wr, wc, fr, fq, lds, wid, lane); S.done(cur); }
#undef PG8_SA
#undef PG8_SB
#undef PG8_STAGE
#undef PG8_LDA
#undef PG8_LDB
#undef PG8_MMA
#undef PG8_WAIT_V
#undef PG8_WAIT_L
#undef PG8_BAR
#undef PG8_SCHED
}
}
constexpr int SEQL = 8192, NSEQ = 3, NTOK = NSEQ * SEQL;
constexpr int DM = 4096, DRG = 2048, DHY = 2048, NIN = 10240, DFF = 11008;
constexpr int NHEAD = 16, HDIM = 128;
constexpr float EPSN = 1e-6f;
constexpr int FFT_N = 16384;
constexpr int LDK = DM;

#define GAS __attribute__((address_space(1)))
#define LAS __attribute__((address_space(3)))
typedef unsigned short bf16;
typedef unsigned v4u __attribute__((ext_vector_type(4)));
typedef unsigned v2u __attribute__((ext_vector_type(2)));
typedef float f32x4 __attribute__((ext_vector_type(4)));
typedef float f32x2 __attribute__((ext_vector_type(2)));
typedef short bf16x8 __attribute__((ext_vector_type(8)));

__device__ __forceinline__ void wg_sync() { __builtin_amdgcn_fence(__ATOMIC_RELEASE, "workgroup"); __builtin_amdgcn_s_barrier(); __builtin_amdgcn_fence(__ATOMIC_ACQUIRE, "workgroup"); }
__device__ __forceinline__ unsigned f2bf(float f) { unsigned u = __builtin_bit_cast(unsigned, f); return (u + 0x7fffu + ((u >> 16) & 1u)) >> 16; }
__device__ __forceinline__ unsigned pk2(float lo, float hi) { return f2bf(lo) | (f2bf(hi) << 16); }
__device__ __forceinline__ float bf2f(unsigned b) { return __builtin_bit_cast(float, b << 16); }
__device__ __forceinline__ float bflo(unsigned w) { return __builtin_bit_cast(float, w << 16); }
__device__ __forceinline__ float bfhi(unsigned w) { return __builtin_bit_cast(float, w & 0xffff0000u); }
__device__ __forceinline__ float wave_sum(float v) {
#pragma unroll
    for (int o = 1; o < 64; o <<= 1) v += __shfl_xor(v, o);
    return v;
}
__device__ __forceinline__ float frcp(float x) { return __builtin_amdgcn_rcpf(x); }
__device__ __forceinline__ float fexp(float x) { return __builtin_amdgcn_exp2f(x * 1.4426950408889634f); }
__device__ __forceinline__ float sigmoidf_(float x) { return frcp(1.0f + fexp(-x)); }
__device__ __forceinline__ float gelu_tanh(float x) { const float u = 1.5957691216057308f * (x + 0.044715f * x * x * x); return x * frcp(1.0f + fexp(-u)); }

constexpr size_t MiB = 1u << 20;
constexpr size_t WS_CTL = 0;
constexpr size_t WS_TW = 1 * MiB;
constexpr size_t WS_H3 = 2 * MiB;
constexpr size_t WS_RGW = 4 * MiB;
constexpr size_t WS_SUMM = 6 * MiB;
constexpr size_t WS_WIN = 16 * MiB;
constexpr size_t WS_WOUT = 98 * MiB;
constexpr size_t WS_WFI = 131 * MiB;
constexpr size_t WS_WFO = 306 * MiB;
constexpr size_t WS_XN = 392 * MiB;
constexpr size_t WS_PRG = 588 * MiB;
constexpr size_t WS_PHY = 780 * MiB;
constexpr size_t WS_HYY = 1068 * MiB;
constexpr size_t WS_RGY = 1164 * MiB;
constexpr size_t WS_ZK = 1260 * MiB;
constexpr size_t WS_H = WS_PHY;
constexpr size_t WS_SIDEG = 1296 * MiB;
constexpr size_t WS_SIDEU = 1329 * MiB;
constexpr size_t WS_END = 1346 * MiB;
static_assert(WS_WIN + (size_t)NIN * LDK * 2 <= WS_WOUT && WS_WOUT + (size_t)DM * LDK * 2 <= WS_WFI && WS_WFI + (size_t)2 * DFF * LDK * 2 <= WS_WFO && WS_WFO + (size_t)DM * DFF * 2 <= WS_XN &&
              WS_XN + (size_t)NTOK * LDK * 2 <= WS_PRG && WS_PRG + (size_t)NTOK * DM * 2 <= WS_PHY && WS_PHY + (size_t)3 * DHY * NTOK * 2 <= WS_HYY && WS_PHY + (size_t)NTOK * LDK * 2 <= WS_HYY &&
              WS_HYY + (size_t)DHY * NTOK * 2 <= WS_RGY && WS_RGY + (size_t)NTOK * DRG * 2 <= WS_ZK && WS_ZK + (size_t)256 * 2 * FFT_N * 8 <= WS_END && WS_H + (size_t)NTOK * DFF * 2 <= WS_SIDEG &&
              WS_SIDEG + (size_t)96 * 8 * DFF * 4 <= WS_SIDEU && WS_SIDEU + (size_t)96 * 4 * DFF * 4 <= WS_END, "d_ws map");
constexpr size_t WS_MIX = WS_PHY;
constexpr size_t WS_Y = WS_PRG;
constexpr size_t WS_F = WS_PRG;
#define XB_TMO      128
#define XB_XCNT(j)  (256  + 64 * (j))
#define XB_XSUB(j)  (1280 + 64 * (j))
#define XB_XGEN(j)  (2304 + 64 * (j))
#define XB_TOP      3328
#define XB_TOPGEN   3392
#define XCD_BAR_WORDS 3456
#define XB_SPIN_CAP (1u << 18)

__device__ __forceinline__ unsigned xb_ld(unsigned* p)              { return __hip_atomic_load(p, __ATOMIC_RELAXED, __HIP_MEMORY_SCOPE_AGENT); }
__device__ __forceinline__ unsigned xb_add(unsigned* p, unsigned v) { return __hip_atomic_fetch_add(p, v, __ATOMIC_RELAXED, __HIP_MEMORY_SCOPE_AGENT); }
__device__ __forceinline__ unsigned xb_xcc_id() { return (unsigned)__builtin_amdgcn_s_getreg((3 << 11) | 20) & 0xFu; }
#define XB_SPIN(cond, bar) do { unsigned _sp = 0; while (cond) { __builtin_amdgcn_s_sleep(1); \
    if ((++_sp & 255u) == 0u) { if (xb_ld(&(bar)[XB_TMO])) break; if (_sp > XB_SPIN_CAP) { atomicAdd(&(bar)[XB_TMO], 1u); break; } } } } while (0)

struct XcdBarrier {
    unsigned* bar; unsigned x;
    volatile LAS unsigned* st;
};

__device__ __forceinline__ XcdBarrier xcd_barrier_post(unsigned* bar, volatile LAS unsigned* st) {
    XcdBarrier b; b.bar = bar; b.x = xb_xcc_id(); b.st = st;
    if (threadIdx.x == 0) (void)xb_add(&bar[XB_XCNT(b.x)], 1u);
    return b;
}
__device__ __forceinline__ void xcd_barrier_complete(unsigned* bar, unsigned x, unsigned& nloc, unsigned& nx) {
    const unsigned G = gridDim.x * gridDim.y * gridDim.z;
    unsigned sum, cnt, mine, sp = 0u;
    for (;;) {
        sum = 0u; cnt = 0u; mine = 0u;
#pragma unroll
        for (unsigned j = 0; j < 16; ++j) { const unsigned c = xb_ld(&bar[XB_XCNT(j)]); sum += c; cnt += (c > 0u) ? 1u : 0u; mine = (j == x) ? c : mine; }
        if (sum == G) break;
        __builtin_amdgcn_s_sleep(1);
        if ((++sp & 255u) == 0u) { if (xb_ld(&bar[XB_TMO])) break; if (sp > XB_SPIN_CAP) { atomicAdd(&bar[XB_TMO], 1u); break; } }
    }
    nloc = mine > 0u ? mine : 1u; nx = cnt > 0u ? cnt : 1u;
}

__device__ __forceinline__ void xcd_barrier(const XcdBarrier& b) {
    asm volatile("s_waitcnt vmcnt(0)" ::: "memory");
    wg_sync();
    if (threadIdx.x == 0) {
        unsigned* bar = b.bar;
        __builtin_amdgcn_s_waitcnt(0);
        unsigned nloc = b.st[0], nx = b.st[1];
        if (nloc == 0u) { xcd_barrier_complete(bar, b.x, nloc, nx); b.st[0] = nloc; b.st[1] = nx; }
        const unsigned old = xb_add(&bar[XB_XSUB(b.x)], 1u);
        const unsigned gen = old / nloc;
        if (old + 1u == (gen + 1u) * nloc) {
            __builtin_amdgcn_fence(__ATOMIC_RELEASE, "agent");
            asm volatile("s_waitcnt vmcnt(0)" ::: "memory");
            const unsigned og = xb_add(&bar[XB_TOP], 1u);
            const unsigned tg = og / nx;
            if (og + 1u == (tg + 1u) * nx) xb_add(&bar[XB_TOPGEN], 1u);
            else XB_SPIN(xb_ld(&bar[XB_TOPGEN]) == tg, bar);
            __builtin_amdgcn_fence(__ATOMIC_ACQUIRE, "agent");
            xb_add(&bar[XB_XGEN(b.x)], 1u);
            asm volatile("s_waitcnt vmcnt(0)" ::: "memory");
        } else {
            XB_SPIN(xb_ld(&bar[XB_XGEN(b.x)]) == gen, bar);
            __builtin_amdgcn_fence(__ATOMIC_ACQUIRE, "agent");
            asm volatile("s_waitcnt vmcnt(0)" ::: "memory");
        }
    }
    wg_sync();
}
struct TrItem { const float* W; bf16* WT; int K, N, k0, n0, drow0, ldt; };
__device__ __forceinline__ void tr_load(const TrItem& t, int lane, f32x4 (&v)[8]) {
    const float* p = t.W + (size_t)(t.k0 + (lane >> 3)) * t.N + t.n0 + (lane & 7) * 4;
#pragma unroll
    for (int ii = 0; ii < 8; ++ii) v[ii] = __builtin_nontemporal_load((const f32x4*)(p + (size_t)8 * ii * t.N));
}
__device__ __forceinline__ void tr_store(const TrItem& t, int lane, const f32x4 (&v)[8], LAS float* scr) {
    LAS float* w = scr + (lane >> 3) * 33 + (lane & 7) * 4;
#pragma unroll
    for (int ii = 0; ii < 8; ++ii) { w[ii * 8 * 33 + 0] = v[ii].x; w[ii * 8 * 33 + 1] = v[ii].y; w[ii * 8 * 33 + 2] = v[ii].z; w[ii * 8 * 33 + 3] = v[ii].w; }
    asm volatile("s_waitcnt lgkmcnt(0)" ::: "memory");
    const int c = lane & 7;
#pragma unroll
    for (int j = 0; j < 4; ++j) { const int n = (lane >> 3) + 8 * j; const LAS float* s = scr + (8 * c) * 33 + n;
        v4u o; o.x = pk2(s[0 * 33], s[1 * 33]); o.y = pk2(s[2 * 33], s[3 * 33]); o.z = pk2(s[4 * 33], s[5 * 33]); o.w = pk2(s[6 * 33], s[7 * 33]);
        *(v4u*)(t.WT + (size_t)(t.drow0 + n) * t.ldt + t.k0 + 8 * c) = o; }
    asm volatile("s_waitcnt lgkmcnt(0)" ::: "memory");
}
template <bool INTER> __device__ __forceinline__ int ffi_drow(int n) {
    if (!INTER) return n;
    const int up = n >= DFF ? 1 : 0, c = n - up * DFF; return (c >> 7) * 256 + up * 128 + (c & 127);
}
struct ProArgs {
    const float *xp, *xs, *g_premix;
    const float *w_in, *w_out, *w_ffi, *w_ffo;
    const float *rg_a_w, *rg_x_w;
    const float *hy_w1, *hy_b1, *hy_w2, *hy_b2, *hy_w3, *hy_b3, *hy_freq;
    unsigned char* ws;
};
__device__ __forceinline__ const float* xrow_ptr(const float* xp, const float* xs, int m) { return m < SEQL ? xp + (size_t)m * DM : xs + (size_t)(m - SEQL) * DM; }

template <bool INTER> __device__ __forceinline__ void p0_prologue(const ProArgs& a, LAS unsigned char* lds, int gw, int NGW, int wave, int lane) {
    bf16* WIN = (bf16*)(a.ws + WS_WIN); bf16* WOUT = (bf16*)(a.ws + WS_WOUT); bf16* WFI = (bf16*)(a.ws + WS_WFI); bf16* WFO = (bf16*)(a.ws + WS_WFO);
    LAS float* scr = (LAS float*)(lds + wave * 16384);
    constexpr int I_IN = (DM / 64) * (NIN / 32), I_OUT = (DM / 64) * (DM / 32), I_FI = (DM / 64) * (2 * DFF / 32), I_FO = (DFF / 64) * (DM / 32);
    constexpr int NITEMS = I_IN + I_OUT + I_FI + I_FO;
    auto decode = [&](int it) -> TrItem {
        TrItem t; int r = it;
        if (r < I_IN) { const int nb = NIN / 32, kb = r / nb, n0 = (r % nb) * 32; t.W = a.w_in; t.WT = WIN; t.K = DM; t.N = NIN; t.k0 = kb * 64; t.n0 = n0; t.drow0 = n0; t.ldt = LDK; return t; } r -= I_IN;
        if (r < I_OUT) { const int nb = DM / 32, kb = r / nb, n0 = (r % nb) * 32; t.W = a.w_out; t.WT = WOUT; t.K = DM; t.N = DM; t.k0 = kb * 64; t.n0 = n0; t.drow0 = n0; t.ldt = LDK; return t; } r -= I_OUT;
        if (r < I_FI) { const int nb = 2 * DFF / 32, kb = r / nb, n0 = (r % nb) * 32; t.W = a.w_ffi; t.WT = WFI; t.K = DM; t.N = 2 * DFF; t.k0 = kb * 64; t.n0 = n0; t.drow0 = ffi_drow<INTER>(n0); t.ldt = LDK; return t; } r -= I_FI;
        { const int nb = DM / 32, kb = r / nb, n0 = (r % nb) * 32; t.W = a.w_ffo; t.WT = WFO; t.K = DFF; t.N = DM; t.k0 = kb * 64; t.n0 = n0; t.drow0 = n0; t.ldt = DFF; return t; }
    };
    {
        int it = gw; TrItem cur; f32x4 vc[8], vn[8];
        if (it < NITEMS) { cur = decode(it); tr_load(cur, lane, vc); }
        while (it < NITEMS) {
            const int nx = it + NGW; TrItem nxt = cur;
            if (nx < NITEMS) { nxt = decode(nx); tr_load(nxt, lane, vn); }
            tr_store(cur, lane, vc, scr);
            cur = nxt; it = nx;
#pragma unroll
            for (int ii = 0; ii < 8; ++ii) vc[ii] = vn[ii];
        }
    }
    bf16* XN = (bf16*)(a.ws + WS_XN);
    for (int m = gw; m < NTOK; m += NGW) {
        const float* xr = xrow_ptr(a.xp, a.xs, m);
        f32x4 v[16]; float s = 0.f;
#pragma unroll
        for (int j = 0; j < 8; ++j) { const f32x4* p = (const f32x4*)(xr + (j * 64 + lane) * 8); v[2 * j] = p[0]; v[2 * j + 1] = p[1];
            s += (v[2 * j].x * v[2 * j].x + v[2 * j].y * v[2 * j].y) + (v[2 * j].z * v[2 * j].z + v[2 * j].w * v[2 * j].w);
            s += (v[2 * j + 1].x * v[2 * j + 1].x + v[2 * j + 1].y * v[2 * j + 1].y) + (v[2 * j + 1].z * v[2 * j + 1].z + v[2 * j + 1].w * v[2 * j + 1].w); }
        const float rs = 1.0f / sqrtf(wave_sum(s) * (1.0f / DM) + EPSN);
#pragma unroll
        for (int j = 0; j < 8; ++j) { const int c0 = (j * 64 + lane) * 8; const f32x4 g0 = *(const f32x4*)(a.g_premix + c0), g1 = *(const f32x4*)(a.g_premix + c0 + 4);
            const f32x4 a0 = v[2 * j] * rs * g0, a1 = v[2 * j + 1] * rs * g1;
            v4u o; o.x = pk2(a0.x, a0.y); o.y = pk2(a0.z, a0.w); o.z = pk2(a1.x, a1.y); o.w = pk2(a1.z, a1.w);
            *(v4u*)(XN + (size_t)m * LDK + c0) = o; }
    }
    bf16* RGW = (bf16*)(a.ws + WS_RGW);
    for (int idx = gw * 64 + lane; idx < 2 * 2 * NHEAD * HDIM * HDIM; idx += NGW * 64) {
        const int i = idx & 127, j = (idx >> 7) & 127, h = (idx >> 14) & 15, gate = (idx >> 18) & 1, dir = idx >> 19;
        const float* W = gate ? a.rg_x_w : a.rg_a_w;
        RGW[idx] = (bf16)f2bf(W[(((size_t)dir * NHEAD + h) * HDIM + i) * HDIM + j]);
    }
    f32x2* TW = (f32x2*)(a.ws + WS_TW);
    for (int k = gw * 64 + lane; k < FFT_N; k += NGW * 64) { float sn, cs; sincospif((float)k * (1.0f / 8192.0f), &sn, &cs); TW[k] = (f32x2){cs, -sn}; }
    bf16* H3H = (bf16*)(a.ws + WS_H3); bf16* H3L = H3H + SEQL * 64;
    const float fr = a.hy_freq[lane], b1 = a.hy_b1[lane], b2 = a.hy_b2[lane], b3 = a.hy_b3[lane];
    for (int n = gw; n < SEQL; n += NGW) {
        float zv = 0.f;
        if (lane == 0) zv = (float)n * (1.0f / (float)(SEQL - 1));
        else if (lane < 33) { const int k = (lane - 1) & 15; const float band = 1e-4f + (float)k * ((15.0f - 1e-4f) / 15.0f);
            const float ang = (6.283185307179586f / (float)SEQL) * (float)n * band; zv = lane < 17 ? cosf(ang) : -sinf(ang); }
        float acc = b1;
        for (int e = 0; e < 33; ++e) acc += __shfl(zv, e) * a.hy_w1[e * 64 + lane];
        float h = sinf(fr * acc);
        acc = b2;
        for (int e = 0; e < 64; ++e) acc += __shfl(h, e) * a.hy_w2[e * 64 + lane];
        h = sinf(fr * acc);
        acc = b3;
        for (int e = 0; e < 64; ++e) acc += __shfl(h, e) * a.hy_w3[e * 64 + lane];
        h = sinf(fr * acc);
        { const unsigned hi = f2bf(h); H3H[n * 64 + lane] = (bf16)hi; H3L[n * 64 + lane] = (bf16)f2bf(h - bf2f(hi)); }
    }
}
constexpr int FFT_LDS_BYTES = (FFT_N + FFT_N / 32) * 8;
constexpr int HY_W4_OFF = FFT_LDS_BYTES;
constexpr int HY_PRM_OFF = FFT_LDS_BYTES + 1024;
constexpr int HY_LDS_BYTES = FFT_LDS_BYTES + 1024 + 256;
__device__ __forceinline__ int PH(int i) { return i + (i >> 5); }
__device__ __forceinline__ f32x2 cmul(f32x2 a, f32x2 b) { return (f32x2){a.x * b.x - a.y * b.y, a.x * b.y + a.y * b.x}; }
__device__ __forceinline__ constexpr int bitrev_c(int r, int bits) { int o = 0; for (int i = 0; i < bits; ++i) o |= ((r >> i) & 1) << (bits - 1 - i); return o; }

__device__ __forceinline__ f32x2 mul_w32(f32x2 d, int idx) {
    constexpr float C[16] = {1.0f, 0.98078528040323043f, 0.92387953251128674f, 0.83146961230254524f, 0.70710678118654752f, 0.55557023301960218f, 0.38268343236508977f, 0.19509032201612825f,
                             0.0f, -0.19509032201612825f, -0.38268343236508977f, -0.55557023301960218f, -0.70710678118654752f, -0.83146961230254524f, -0.92387953251128674f, -0.98078528040323043f};
    constexpr float S[16] = {0.0f, 0.19509032201612825f, 0.38268343236508977f, 0.55557023301960218f, 0.70710678118654752f, 0.83146961230254524f, 0.92387953251128674f, 0.98078528040323043f,
                             1.0f, 0.98078528040323043f, 0.92387953251128674f, 0.83146961230254524f, 0.70710678118654752f, 0.55557023301960218f, 0.38268343236508977f, 0.19509032201612825f};
    if (idx == 0) return d;
    if (idx == 8) return (f32x2){d.y, -d.x};
    const float c = C[idx], s = S[idx];
    return (f32x2){d.x * c + d.y * s, d.y * c - d.x * s};
}
template <int R> __device__ __forceinline__ void dft_inreg(f32x2 (&a)[R]) {
    constexpr int LOGR = (R == 32) ? 5 : 4;
#pragma unroll
    for (int t = 0; t < LOGR; ++t) {
        const int half = R >> (t + 1);
#pragma unroll
        for (int g = 0; g < R; g += 2 * half)
#pragma unroll
            for (int i = 0; i < half; ++i) {
                const f32x2 u = a[g + i], v = a[g + i + half];
                a[g + i] = u + v;
                a[g + i + half] = mul_w32(u - v, i * (16 / half));
            }
    }
}
template <int R, int S, bool TW, bool ZPAD = false, bool HALFOUT = false> __device__ __forceinline__ void fft_pass(LAS f32x2* lds, const f32x2* tw, int tid) {
    constexpr int NB = FFT_N / R, PER = NB / 512, LOGR = (R == 32) ? 5 : 4;
    constexpr int RSTEP = NB + NB / 32;
    constexpr int WSTEP = (S == 1) ? 1 : (S + S / 32);
    f32x2 a[PER][R];
#pragma unroll
    for (int b = 0; b < PER; ++b) { const LAS f32x2* rp = lds + PH(tid + 512 * b);
#pragma unroll
        for (int k = 0; k < R; ++k) a[b][k] = (ZPAD && k >= R / 2) ? (f32x2){0.f, 0.f} : rp[k * RSTEP]; }
    wg_sync();
#pragma unroll
    for (int b = 0; b < PER; ++b) {
        const int beta = tid + 512 * b, q = beta & (S - 1), p = beta / S, base = q + R * S * p;
        dft_inreg<R>(a[b]);
        f32x2 w1 = (f32x2){1.f, 0.f}, wj = (f32x2){1.f, 0.f};
        if (TW) { w1 = tw[p * S]; wj = w1; }
        LAS f32x2* wp = lds + PH(base);
        wp[0] = a[b][0];
#pragma unroll
        for (int j = 1; j < (HALFOUT ? R / 2 : R); ++j) {
            f32x2 v = a[b][bitrev_c(j, LOGR)];
            if (TW) { v = cmul(v, wj); wj = cmul(wj, w1); }
            wp[j * WSTEP] = v;
        }
    }
    wg_sync();
}
template <bool ZPAD = false, bool HALFOUT = false> __device__ __forceinline__ void fft16k(LAS f32x2* lds, const f32x2* tw, int tid) {
    asm volatile("" : "+v"(tid));
    fft_pass<32, 1, true, ZPAD, false>(lds, tw, tid);
    fft_pass<32, 32, true>(lds, tw, tid);
    fft_pass<16, 1024, false, false, HALFOUT>(lds, tw, tid);
}
__device__ __forceinline__ void spec_pair(LAS f32x2* lds, const f32x2* ZK, int p) {
    const int f = p, f2 = (FFT_N - p) & (FFT_N - 1);
    const f32x2 A = ZK[f], A2 = ZK[f2], Z = lds[PH(f)], Z2 = lds[PH(f2)];
    const float kcx = 0.5f * (A.x + A2.x), kcy = 0.5f * (A.y - A2.y);
    const float dx = 0.5f * (A.x - A2.x), dy = 0.5f * (A.y + A2.y);
    const float k1x = dy, k1y = -dx;
    const float px = 0.5f * (kcx + k1x), py = 0.5f * (kcy + k1y), qx = 0.5f * (kcx - k1x), qy = 0.5f * (kcy - k1y);
    const float wx = Z.x * px - Z.y * py + (Z2.x * qx + Z2.y * qy);
    const float wy = Z.x * py + Z.y * px + (Z2.x * qy - Z2.y * qx);
    const float w2x = Z2.x * px + Z2.y * py + (Z.x * qx - Z.y * qy);
    const float w2y = Z2.y * px - Z2.x * py - (Z.x * qy + Z.y * qx);
    lds[PH(f)] = (f32x2){wx, -wy}; lds[PH(f2)] = (f32x2){w2x, -w2y};
}
__device__ __forceinline__ void spec_mul(LAS f32x2* lds, const f32x2* ZK, int tid) {
    asm volatile("" : "+v"(tid));
#pragma unroll 8
    for (int i = 0; i < 16; ++i) spec_pair(lds, ZK, tid + 512 * i);
    if (tid == 0) spec_pair(lds, ZK, 8192);
    wg_sync();
}
struct HyArgs {
    const bf16* phy;
    const float *conv_w, *conv_b;
    const float* w4;
    const float* hy_bias;
    const bf16* h3h;
    const f32x2* tw;
    f32x2* zk;
    bf16* hyy;
};
__device__ __forceinline__ void load_conv3_16(const bf16* row, int t0, float w0, float w1, float w2, float bias, float (&out)[16]) {
    const v4u r0 = *(const v4u*)(row + t0), r1 = *(const v4u*)(row + t0 + 8);
    float u[18];
    u[0] = t0 > 0 ? bf2f(row[t0 - 1]) : 0.f;
    u[17] = (t0 + 16 < SEQL) ? bf2f(row[t0 + 16]) : 0.f;
    u[1] = bflo(r0.x); u[2] = bfhi(r0.x); u[3] = bflo(r0.y); u[4] = bfhi(r0.y); u[5] = bflo(r0.z); u[6] = bfhi(r0.z); u[7] = bflo(r0.w); u[8] = bfhi(r0.w);
    u[9] = bflo(r1.x); u[10] = bfhi(r1.x); u[11] = bflo(r1.y); u[12] = bfhi(r1.y); u[13] = bflo(r1.z); u[14] = bfhi(r1.z); u[15] = bflo(r1.w); u[16] = bfhi(r1.w);
#pragma unroll
    for (int e = 0; e < 16; ++e) out[e] = bias + w0 * u[e] + w1 * u[e + 1] + w2 * u[e + 2];
}
__device__ __forceinline__ void store16_bf16(bf16* dst, const float (&v)[16]) {
    v4u o0, o1; o0.x = pk2(v[0], v[1]); o0.y = pk2(v[2], v[3]); o0.z = pk2(v[4], v[5]); o0.w = pk2(v[6], v[7]);
    o1.x = pk2(v[8], v[9]); o1.y = pk2(v[10], v[11]); o1.z = pk2(v[12], v[13]); o1.w = pk2(v[14], v[15]);
    *(v4u*)dst = o0; *(v4u*)(dst + 8) = o1;
}
__device__ __forceinline__ void hyena_unit(const HyArgs& a, LAS unsigned char* ldsb_, int cp, int wgslot, int tid) {
    unsigned lzero; asm volatile("v_mov_b32 %0, 0" : "=v"(lzero));
    LAS unsigned char* ldsb = ldsb_ + lzero;
    LAS f32x2* lds = (LAS f32x2*)ldsb;
    const int c0 = 2 * cp, c1 = c0 + 1;
    f32x2* zk = a.zk + (size_t)wgslot * 2 * FFT_N;
    constexpr float MIN_DECAY = -3.0701134573253945f, MAX_DECAY = -15.350567286626973f;
    const float ad0 = fabsf(MIN_DECAY + (float)c0 * ((MAX_DECAY - MIN_DECAY) / (float)(DHY - 1)));
    const float ad1 = fabsf(MIN_DECAY + (float)c1 * ((MAX_DECAY - MIN_DECAY) / (float)(DHY - 1)));
    LAS float* prm = (LAS float*)(ldsb + HY_PRM_OFF);
    wg_sync();
    if (tid < 24) { const int k = tid & 3, sc = tid >> 2, st = sc >> 1, chn = st * DHY + c0 + (sc & 1); prm[tid] = k < 3 ? a.conv_w[k * 6144 + chn] : a.conv_b[chn]; }
    if (tid >= 32 && tid < 36) { const int j = tid - 32; prm[tid] = a.hy_bias[(j >> 1) * DHY + c0 + (j & 1)]; }
#pragma unroll 1
    for (int o = 0; o < 2; ++o) {
        int tq = tid; asm volatile("" : "+v"(tq)); const int t0 = 16 * tq;
        wg_sync();
        {
            const int lane = tq & 63, wv = tq >> 6, fr = lane & 15, fq = lane >> 4;
            const int colidx = o * 4096 + ((fr >> 1) & 1) * 2048 + c0 + (fr & 1);
            bf16x8 Bh[2], Bl[2];
#pragma unroll
            for (int kk = 0; kk < 2; ++kk)
#pragma unroll
                for (int i = 0; i < 8; ++i) { const float w = fr < 4 ? a.w4[(size_t)(32 * kk + 8 * fq + i) * 8192 + colidx] : 0.f; const unsigned hi = f2bf(w);
                    Bh[kk][i] = (short)hi; Bl[kk][i] = (short)f2bf(w - bf2f(hi)); }
            const float adl = (fr & 1) ? ad1 : ad0;
            LAS float* ldsf = (LAS float*)lds;
            if (tq == 0) lds[PH(SEQL)] = (f32x2){0.f, 0.f};
            const bf16* apw = a.h3h + (size_t)(wv * 1024 + fr) * 64 + 8 * fq;
            bf16x8 fc[4][4], fn[4][4];
#pragma unroll
            for (int q = 0; q < 4; ++q) { const bf16* ap = apw + (size_t)q * 16 * 64;
                fc[q][0] = *(const bf16x8*)ap; fc[q][1] = *(const bf16x8*)(ap + 32); fc[q][2] = *(const bf16x8*)(ap + SEQL * 64); fc[q][3] = *(const bf16x8*)(ap + SEQL * 64 + 32); }
#pragma unroll 1
            for (int gq = 0; gq < 16; ++gq) {
                const int gnx = gq < 15 ? gq + 1 : gq;
#pragma unroll
                for (int q = 0; q < 4; ++q) { const bf16* ap = apw + (size_t)(gnx * 4 + q) * 16 * 64;
                    fn[q][0] = *(const bf16x8*)ap; fn[q][1] = *(const bf16x8*)(ap + 32); fn[q][2] = *(const bf16x8*)(ap + SEQL * 64); fn[q][3] = *(const bf16x8*)(ap + SEQL * 64 + 32); }
#pragma unroll
                for (int q = 0; q < 4; ++q) {
                    const int row0 = wv * 1024 + (gq * 4 + q) * 16;
                    f32x4 acc = (f32x4){0.f, 0.f, 0.f, 0.f};
                    acc = __builtin_amdgcn_mfma_f32_16x16x32_bf16(fc[q][2], Bh[0], acc, 0, 0, 0); acc = __builtin_amdgcn_mfma_f32_16x16x32_bf16(fc[q][3], Bh[1], acc, 0, 0, 0);
                    acc = __builtin_amdgcn_mfma_f32_16x16x32_bf16(fc[q][0], Bl[0], acc, 0, 0, 0); acc = __builtin_amdgcn_mfma_f32_16x16x32_bf16(fc[q][1], Bl[1], acc, 0, 0, 0);
                    acc = __builtin_amdgcn_mfma_f32_16x16x32_bf16(fc[q][0], Bh[0], acc, 0, 0, 0); acc = __builtin_amdgcn_mfma_f32_16x16x32_bf16(fc[q][1], Bh[1], acc, 0, 0, 0);
                    if (fr < 4) {
#pragma unroll
                        for (int e = 0; e < 4; ++e) {
                            const int n = row0 + 4 * fq + e;
                            const float val = acc[e] * fexp(-(float)n * (1.0f / (float)(SEQL - 1)) * adl);
                            if (fr < 2) ldsf[2 * PH(n) + (fr & 1)] = val;
                            else if (n >= 1) ldsf[2 * PH(FFT_N - n) + (fr & 1)] = val;
                        }
                    }
                }
#pragma unroll
                for (int q = 0; q < 4; ++q)
#pragma unroll
                    for (int z = 0; z < 4; ++z) fc[q][z] = fn[q][z];
            }
        }
        wg_sync();
        fft16k(lds, a.tw, tid);
#pragma unroll 4
        for (int i = 0; i < 32; ++i) zk[(size_t)o * FFT_N + tq + 512 * i] = lds[PH(tq + 512 * i)];
    }
    const float inv_n = 1.0f / (float)FFT_N;
    asm volatile("s_waitcnt vmcnt(0)" ::: "memory");
    wg_sync();
#pragma unroll 1
    for (int s = 0; s < NSEQ; ++s) {
        const size_t m0 = (size_t)s * SEQL;
        int tq = tid; asm volatile("" : "+v"(tq)); const int t0 = 16 * tq;
        {
            float v0[16], v1[16];
            load_conv3_16(a.phy + (size_t)(0 * DHY + c0) * NTOK + m0, t0, prm[0], prm[1], prm[2], prm[3], v0);
            load_conv3_16(a.phy + (size_t)(0 * DHY + c1) * NTOK + m0, t0, prm[4], prm[5], prm[6], prm[7], v1);
            wg_sync();
#pragma unroll
            for (int e = 0; e < 16; ++e) { lds[PH(t0 + e)] = (f32x2){v0[e], v1[e]}; }
        }
        wg_sync();
        fft16k<true, false>(lds, a.tw, tid);
        spec_mul(lds, zk, tid);
        fft16k<false, true>(lds, a.tw, tid);
        float z0[16], z1[16];
        {
            float x0[16], x1[16];
            load_conv3_16(a.phy + (size_t)(0 * DHY + c0) * NTOK + m0, t0, prm[0], prm[1], prm[2], prm[3], x0);
            load_conv3_16(a.phy + (size_t)(0 * DHY + c1) * NTOK + m0, t0, prm[4], prm[5], prm[6], prm[7], x1);
#pragma unroll
            for (int e = 0; e < 16; ++e) { const f32x2 r = lds[PH(t0 + e)]; z0[e] = r.x * inv_n + prm[32] * x0[e]; z1[e] = -r.y * inv_n + prm[33] * x1[e]; }
            load_conv3_16(a.phy + (size_t)(1 * DHY + c0) * NTOK + m0, t0, prm[8], prm[9], prm[10], prm[11], x0);
            load_conv3_16(a.phy + (size_t)(1 * DHY + c1) * NTOK + m0, t0, prm[12], prm[13], prm[14], prm[15], x1);
#pragma unroll
            for (int e = 0; e < 16; ++e) { z0[e] *= x0[e]; z1[e] *= x1[e]; }
        }
#pragma unroll
        for (int e = 0; e < 16; ++e) { lds[PH(t0 + e)] = (f32x2){z0[e], z1[e]}; }
        wg_sync();
        fft16k<true, false>(lds, a.tw, tid);
        spec_mul(lds, zk + FFT_N, tid);
        fft16k<false, true>(lds, a.tw, tid);
        {
            float x0[16], x1[16];
            load_conv3_16(a.phy + (size_t)(2 * DHY + c0) * NTOK + m0, t0, prm[16], prm[17], prm[18], prm[19], x0);
            load_conv3_16(a.phy + (size_t)(2 * DHY + c1) * NTOK + m0, t0, prm[20], prm[21], prm[22], prm[23], x1);
#pragma unroll
            for (int e = 0; e < 16; ++e) { const f32x2 r = lds[PH(t0 + e)];
                x0[e] = x0[e] * (r.x * inv_n + prm[34] * z0[e]); x1[e] = x1[e] * (-r.y * inv_n + prm[35] * z1[e]); }
            store16_bf16(a.hyy + (size_t)c0 * NTOK + m0 + t0, x0);
            store16_bf16(a.hyy + (size_t)c1 * NTOK + m0 + t0, x1);
        }
    }
}
constexpr int RG_T = 128, RG_NT = SEQL / RG_T;
constexpr int RG_XC_STRIDE = 272;
constexpr int RG_G_OFF = RG_T * RG_XC_STRIDE;
constexpr int RG_HF_OFF = 2 * RG_T * RG_XC_STRIDE;
constexpr int RG_LDS_BYTES = RG_HF_OFF + (RG_T / 4) * 512 * 4;
constexpr int RG_UNITS = NSEQ * RG_NT * NHEAD;
struct RgArgs {
    const bf16* prg;
    const float *conv_w, *conv_b;
    const bf16* rgw;
    const float *a_b, *x_b;
    const float* lam;
    f32x2* summ;
    bf16* rgy;
};
template <int PASS> __device__ __forceinline__ void rg_unit(const RgArgs& a, LAS unsigned char* lds, int unit, int tid) {
    const int wave = tid >> 6, lane = tid & 63, fr = lane & 15, fq = lane >> 4;
    const int h = unit % NHEAD, tt = (unit / NHEAD) % RG_NT, s = unit / (NHEAD * RG_NT);
    const int tok0 = tt * RG_T;
    const size_t mrow0 = (size_t)s * SEQL;
    wg_sync();
    {
        const int cg = h * HDIM + 2 * lane;
        float w0[4], w1[4];
#pragma unroll
        for (int k = 0; k < 4; ++k) { w0[k] = a.conv_w[k * DRG + cg]; w1[k] = a.conv_w[k * DRG + cg + 1]; }
        const float cb0 = a.conv_b[cg], cb1 = a.conv_b[cg + 1];
        const int tb = tok0 + 16 * wave;
        unsigned raw[19], graw[16];
#pragma unroll
        for (int q = 0; q < 19; ++q) { const int t = tb - 2 + q, tc = t < 0 ? 0 : (t > SEQL - 1 ? SEQL - 1 : t); raw[q] = *(const unsigned*)(a.prg + (mrow0 + tc) * DM + cg); }
        if (PASS == 2) {
#pragma unroll
            for (int i = 0; i < 16; ++i) graw[i] = *(const unsigned*)(a.prg + (mrow0 + tb + i) * DM + DRG + cg);
        }
#pragma unroll
        for (int q = 0; q < 19; ++q) { const int t = tb - 2 + q; if (t < 0 || t > SEQL - 1) raw[q] = 0u; }
#pragma unroll
        for (int i = 0; i < 16; ++i) {
            const float y0 = cb0 + w0[0] * bflo(raw[i]) + w0[1] * bflo(raw[i + 1]) + w0[2] * bflo(raw[i + 2]) + w0[3] * bflo(raw[i + 3]);
            const float y1 = cb1 + w1[0] * bfhi(raw[i]) + w1[1] * bfhi(raw[i + 1]) + w1[2] * bfhi(raw[i + 2]) + w1[3] * bfhi(raw[i + 3]);
            *(LAS unsigned*)(lds + (16 * wave + i) * RG_XC_STRIDE + lane * 4) = pk2(y0, y1);
            if (PASS == 2) *(LAS unsigned*)(lds + RG_G_OFF + (16 * wave + i) * RG_XC_STRIDE + lane * 4) = graw[i];
        }
    }
    wg_sync();
    const int ch = h * HDIM + 16 * wave + fr;
    LAS float* hfl = (LAS float*)(lds + RG_HF_OFF) + tid;
#pragma unroll
    for (int dir = 0; dir < 2; ++dir) {
        bf16x8 Br[4], Bi[4];
#pragma unroll
        for (int kk = 0; kk < 4; ++kk) {
            Br[kk] = *(const bf16x8*)(a.rgw + ((((size_t)dir * 2 + 0) * NHEAD + h) * HDIM + 16 * wave + fr) * HDIM + 32 * kk + 8 * fq);
            Bi[kk] = *(const bf16x8*)(a.rgw + ((((size_t)dir * 2 + 1) * NHEAD + h) * HDIM + 16 * wave + fr) * HDIM + 32 * kk + 8 * fq);
        }
        const float ba = a.a_b[dir * DRG + ch], bx = a.x_b[dir * DRG + ch];
        const float sp = log1pf(expf(-a.lam[dir * DRG + ch]));
        float carry = 0.f, ptot = 1.f;
        if (PASS == 2) {
            const f32x2* sm = a.summ + ((size_t)dir * NSEQ + s) * RG_NT * DRG + ch;
            const int cnt = dir == 0 ? tt : RG_NT - 1 - tt;
            for (int j0 = 0; j0 < cnt; j0 += 16) {
                f32x2 pb[16];
#pragma unroll
                for (int q = 0; q < 16; ++q) { const int jj = j0 + q, j = dir == 0 ? jj : RG_NT - 1 - jj, jc = jj < cnt ? j : tt; pb[q] = sm[(size_t)jc * DRG]; if (jj >= cnt) pb[q] = (f32x2){1.f, 0.f}; }
#pragma unroll
                for (int q = 0; q < 16; ++q) carry = pb[q].x * carry + pb[q].y;
            }
        }
        for (int bi = 0; bi < RG_T / 16; ++bi) {
            const int blk = dir == 0 ? bi : (RG_T / 16 - 1 - bi);
            f32x4 accR = (f32x4){0.f, 0.f, 0.f, 0.f}, accI = (f32x4){0.f, 0.f, 0.f, 0.f};
#pragma unroll
            for (int kk = 0; kk < 4; ++kk) {
                const bf16x8 af = *(const LAS bf16x8*)(lds + (16 * blk + fr) * RG_XC_STRIDE + (32 * kk + 8 * fq) * 2);
                accR = __builtin_amdgcn_mfma_f32_16x16x32_bf16(af, Br[kk], accR, 0, 0, 0);
                accI = __builtin_amdgcn_mfma_f32_16x16x32_bf16(af, Bi[kk], accI, 0, 0, 0);
            }
            float av[4], bv[4];
#pragma unroll
            for (int e = 0; e < 4; ++e) {
                const float r = sigmoidf_(accR[e] + ba), ig = sigmoidf_(accI[e] + bx);
                const float log_a = -8.0f * r * sp;
                av[e] = fexp(log_a);
                const float x2 = 2.0f * log_a;
                const float em = -x2 * (1.0f + x2 * (0.5f + x2 * (0.16666667f + x2 * (0.041666668f + x2 * (0.0083333338f + x2 * (0.0013888889f + x2 * (0.0001984127f + x2 * 0.0000248016f)))))));
                const float em2 = x2 < -0.25f ? (1.0f - av[e] * av[e]) : em;
                const float mult = __builtin_amdgcn_sqrtf(fmaxf(em2, 0.f));
                const float xcv = bf2f(*(const LAS unsigned short*)(lds + (16 * blk + 4 * fq + e) * RG_XC_STRIDE + (16 * wave + fr) * 2));
                bv[e] = mult * ig * xcv;
            }
            float A = 1.f, B = 0.f;
            if (dir == 0) {
#pragma unroll
                for (int e = 0; e < 4; ++e) { B = av[e] * B + bv[e]; A *= av[e]; }
            } else {
#pragma unroll
                for (int e = 3; e >= 0; --e) { B = av[e] * B + bv[e]; A *= av[e]; }
            }
            float hin;
            if (dir == 0) {
                float Ap = __shfl_up(A, 16), Bp = __shfl_up(B, 16);
                if (fq >= 1) { B = A * Bp + B; A = Ap * A; }
                Ap = __shfl_up(A, 32); Bp = __shfl_up(B, 32);
                if (fq >= 2) { B = A * Bp + B; A = Ap * A; }
                const float hend = A * carry + B;
                const float hprev = __shfl_up(hend, 16);
                hin = fq == 0 ? carry : hprev;
                carry = __shfl(hend, 48 + fr);
                if (PASS == 1) ptot *= __shfl(A, 48 + fr);
            } else {
                float Ap = __shfl_down(A, 16), Bp = __shfl_down(B, 16);
                if (fq <= 2) { B = A * Bp + B; A = Ap * A; }
                Ap = __shfl_down(A, 32); Bp = __shfl_down(B, 32);
                if (fq <= 1) { B = A * Bp + B; A = Ap * A; }
                const float hend = A * carry + B;
                const float hprev = __shfl_down(hend, 16);
                hin = fq == 3 ? carry : hprev;
                carry = __shfl(hend, fr);
                if (PASS == 1) ptot *= __shfl(A, fr);
            }
            if (PASS == 2) {
                if (dir == 0) {
                    float hh = hin;
#pragma unroll
                    for (int e = 0; e < 4; ++e) { hh = av[e] * hh + bv[e]; hfl[(blk * 4 + e) * 512] = hh; }
                } else {
                    float hh = hin, hb[4];
#pragma unroll
                    for (int e = 3; e >= 0; --e) { hh = av[e] * hh + bv[e]; hb[e] = hh; }
#pragma unroll
                    for (int e = 0; e < 4; ++e) {
                        const size_t m = mrow0 + tok0 + 16 * blk + 4 * fq + e;
                        const float g = bf2f(*(const LAS unsigned short*)(lds + RG_G_OFF + (16 * blk + 4 * fq + e) * RG_XC_STRIDE + (16 * wave + fr) * 2));
                        a.rgy[m * DRG + ch] = (bf16)f2bf((hfl[(blk * 4 + e) * 512] + hb[e]) * gelu_tanh(g));
                    }
                }
            }
        }
        if (PASS == 1 && fq == 0) a.summ[(((size_t)dir * NSEQ + s) * RG_NT + tt) * DRG + ch] = (f32x2){ptot, carry};
    }
}
__device__ __forceinline__ void mixnorm_rg_row(const bf16* rgy, const float* g_rg, bf16* mix, int m, int lane) {
    v4u r[4]; float s = 0.f;
#pragma unroll
    for (int j = 0; j < 4; ++j) { r[j] = *(const v4u*)(rgy + (size_t)m * DRG + (j * 64 + lane) * 8);
        const float a0 = bflo(r[j].x), a1 = bfhi(r[j].x), a2 = bflo(r[j].y), a3 = bfhi(r[j].y), a4 = bflo(r[j].z), a5 = bfhi(r[j].z), a6 = bflo(r[j].w), a7 = bfhi(r[j].w);
        s += (a0 * a0 + a1 * a1) + (a2 * a2 + a3 * a3) + (a4 * a4 + a5 * a5) + (a6 * a6 + a7 * a7); }
    const float rs = 1.0f / sqrtf(wave_sum(s) * (1.0f / DRG) + EPSN);
#pragma unroll
    for (int j = 0; j < 4; ++j) { const int c0 = (j * 64 + lane) * 8; const f32x4 g0 = *(const f32x4*)(g_rg + c0), g1 = *(const f32x4*)(g_rg + c0 + 4);
        v4u o; o.x = pk2(bflo(r[j].x) * rs * g0.x, bfhi(r[j].x) * rs * g0.y); o.y = pk2(bflo(r[j].y) * rs * g0.z, bfhi(r[j].y) * rs * g0.w);
        o.z = pk2(bflo(r[j].z) * rs * g1.x, bfhi(r[j].z) * rs * g1.y); o.w = pk2(bflo(r[j].w) * rs * g1.z, bfhi(r[j].w) * rs * g1.w);
        *(v4u*)(mix + (size_t)m * LDK + c0) = o; }
}
constexpr int MN_TILE_STRIDE = 66;
constexpr int MN_LDS_BYTES = 8 * 64 * MN_TILE_STRIDE * 2 + 8 * 64 * 4 + 64 * 4;
__device__ __forceinline__ void mixnorm_hy_tile(const bf16* hyy, const float* g_hy, bf16* mix, LAS unsigned char* lds, int tile, int tid) {
    const int wave = tid >> 6, lane = tid & 63, m0 = tile * 64;
    LAS unsigned short* tl = (LAS unsigned short*)(lds + wave * 64 * MN_TILE_STRIDE * 2);
    LAS float* part = (LAS float*)(lds + 8 * 64 * MN_TILE_STRIDE * 2);
    LAS float* scl = part + 8 * 64;
    wg_sync();
    float s = 0.f;
    for (int c = wave * 256; c < wave * 256 + 256; ++c) { const float v = bf2f(hyy[(size_t)c * NTOK + m0 + lane]); s += v * v; }
    part[wave * 64 + lane] = s;
    wg_sync();
    if (tid < 64) { float t = 0.f;
#pragma unroll
        for (int w = 0; w < 8; ++w) t += part[w * 64 + tid];
        scl[tid] = 1.0f / sqrtf(t * (1.0f / DHY) + EPSN); }
    wg_sync();
    for (int cb = wave; cb < DHY / 64; cb += 8) {
        for (int ci = 0; ci < 64; ++ci) tl[ci * MN_TILE_STRIDE + lane] = hyy[(size_t)(cb * 64 + ci) * NTOK + m0 + lane];
        asm volatile("s_waitcnt lgkmcnt(0)" ::: "memory");
        const float g = g_hy[cb * 64 + lane];
        for (int tk = 0; tk < 64; ++tk) mix[(size_t)(m0 + tk) * LDK + DRG + cb * 64 + lane] = (bf16)f2bf(bf2f(tl[lane * MN_TILE_STRIDE + tk]) * scl[tk] * g);
        asm volatile("s_waitcnt lgkmcnt(0)" ::: "memory");
    }
}
__device__ __forceinline__ void rowpass1(const float* xr, const bf16* yr, const float* g_post, const float* g_pre, float* outr, bf16* xnr, int lane) {
    float v[64]; float s = 0.f;
#pragma unroll
    for (int j = 0; j < 8; ++j) { const v4u r = *(const v4u*)(yr + (j * 64 + lane) * 8);
        v[8 * j + 0] = bflo(r.x); v[8 * j + 1] = bfhi(r.x); v[8 * j + 2] = bflo(r.y); v[8 * j + 3] = bfhi(r.y); v[8 * j + 4] = bflo(r.z); v[8 * j + 5] = bfhi(r.z); v[8 * j + 6] = bflo(r.w); v[8 * j + 7] = bfhi(r.w);
#pragma unroll
        for (int e = 0; e < 8; ++e) s += v[8 * j + e] * v[8 * j + e]; }
    const float rs = 1.0f / sqrtf(wave_sum(s) * (1.0f / DM) + EPSN);
    float s2 = 0.f;
#pragma unroll
    for (int j = 0; j < 8; ++j) { const int c0 = (j * 64 + lane) * 8;
        const f32x4 x0 = *(const f32x4*)(xr + c0), x1 = *(const f32x4*)(xr + c0 + 4), g0 = *(const f32x4*)(g_post + c0), g1 = *(const f32x4*)(g_post + c0 + 4);
        f32x4 o0, o1;
        o0.x = x0.x + v[8 * j + 0] * rs * g0.x; o0.y = x0.y + v[8 * j + 1] * rs * g0.y; o0.z = x0.z + v[8 * j + 2] * rs * g0.z; o0.w = x0.w + v[8 * j + 3] * rs * g0.w;
        o1.x = x1.x + v[8 * j + 4] * rs * g1.x; o1.y = x1.y + v[8 * j + 5] * rs * g1.y; o1.z = x1.z + v[8 * j + 6] * rs * g1.z; o1.w = x1.w + v[8 * j + 7] * rs * g1.w;
        *(f32x4*)(outr + c0) = o0; *(f32x4*)(outr + c0 + 4) = o1;
        v[8 * j + 0] = o0.x; v[8 * j + 1] = o0.y; v[8 * j + 2] = o0.z; v[8 * j + 3] = o0.w; v[8 * j + 4] = o1.x; v[8 * j + 5] = o1.y; v[8 * j + 6] = o1.z; v[8 * j + 7] = o1.w;
        s2 += (o0.x * o0.x + o0.y * o0.y) + (o0.z * o0.z + o0.w * o0.w) + (o1.x * o1.x + o1.y * o1.y) + (o1.z * o1.z + o1.w * o1.w); }
    const float rs2 = 1.0f / sqrtf(wave_sum(s2) * (1.0f / DM) + EPSN);
#pragma unroll
    for (int j = 0; j < 8; ++j) { const int c0 = (j * 64 + lane) * 8; const f32x4 g0 = *(const f32x4*)(g_pre + c0), g1 = *(const f32x4*)(g_pre + c0 + 4);
        v4u o; o.x = pk2(v[8 * j + 0] * rs2 * g0.x, v[8 * j + 1] * rs2 * g0.y); o.y = pk2(v[8 * j + 2] * rs2 * g0.z, v[8 * j + 3] * rs2 * g0.w);
        o.z = pk2(v[8 * j + 4] * rs2 * g1.x, v[8 * j + 5] * rs2 * g1.y); o.w = pk2(v[8 * j + 6] * rs2 * g1.z, v[8 * j + 7] * rs2 * g1.w);
        *(v4u*)(xnr + c0) = o; }
}
__device__ __forceinline__ void rowpass2(const bf16* fr_, const float* g, float* outr, int lane) {
    float v[64]; float s = 0.f;
#pragma unroll
    for (int j = 0; j < 8; ++j) { const v4u r = *(const v4u*)(fr_ + (j * 64 + lane) * 8);
        v[8 * j + 0] = bflo(r.x); v[8 * j + 1] = bfhi(r.x); v[8 * j + 2] = bflo(r.y); v[8 * j + 3] = bfhi(r.y); v[8 * j + 4] = bflo(r.z); v[8 * j + 5] = bfhi(r.z); v[8 * j + 6] = bflo(r.w); v[8 * j + 7] = bfhi(r.w);
#pragma unroll
        for (int e = 0; e < 8; ++e) s += v[8 * j + e] * v[8 * j + e]; }
    const float rs = 1.0f / sqrtf(wave_sum(s) * (1.0f / DM) + EPSN);
#pragma unroll
    for (int j = 0; j < 8; ++j) { const int c0 = (j * 64 + lane) * 8;
        const f32x4 x0 = *(const f32x4*)(outr + c0), x1 = *(const f32x4*)(outr + c0 + 4), g0 = *(const f32x4*)(g + c0), g1 = *(const f32x4*)(g + c0 + 4);
        f32x4 o0, o1;
        o0.x = x0.x + v[8 * j + 0] * rs * g0.x; o0.y = x0.y + v[8 * j + 1] * rs * g0.y; o0.z = x0.z + v[8 * j + 2] * rs * g0.z; o0.w = x0.w + v[8 * j + 3] * rs * g0.w;
        o1.x = x1.x + v[8 * j + 4] * rs * g1.x; o1.y = x1.y + v[8 * j + 5] * rs * g1.y; o1.z = x1.z + v[8 * j + 6] * rs * g1.z; o1.w = x1.w + v[8 * j + 7] * rs * g1.w;
        *(f32x4*)(outr + c0) = o0; *(f32x4*)(outr + c0 + 4) = o1; }
}
constexpr int SIDE_G_ROWS = 8, SIDE_U_ROWS = 4;
__device__ __forceinline__ float dpp_prev(float x, float xprevblk) {
    const int old = __builtin_amdgcn_update_dpp(0, __builtin_bit_cast(int, xprevblk), 0x121  , 0xf, 0xf, false);
    return __builtin_bit_cast(float, __builtin_amdgcn_update_dpp(old, __builtin_bit_cast(int, x), 0x111  , 0xf, 0xf, false));
}
__device__ __forceinline__ float dpp_next(float x, float xnextblk) {
    const int old = __builtin_amdgcn_update_dpp(0, __builtin_bit_cast(int, xnextblk), 0x12F  , 0xf, 0xf, false);
    return __builtin_bit_cast(float, __builtin_amdgcn_update_dpp(old, __builtin_bit_cast(int, x), 0x101  , 0xf, 0xf, false));
}
struct EpiGate {
    static constexpr bool PERM = true, AFTER_DRAIN = false, AROWPERM = true;
    bf16* H; const float* cw; const float* cb; float* sideG; float* sideU;
    __device__ __forceinline__ void operator()(const pg8::f32x4 (&acc)[2][2][4][2], const pg8::Unit& u, int wr, int wc, int fr, int fq) const {
        const int hc0 = u.pn * 128 + wc * 32 + 8 * fq;
        f32x4 w0[2], w1[2], w2[2], bb[2];
#pragma unroll
        for (int n = 0; n < 2; ++n) { w0[n] = *(const f32x4*)(cw + hc0 + 4 * n); w1[n] = *(const f32x4*)(cw + DFF + hc0 + 4 * n); w2[n] = *(const f32x4*)(cw + 2 * DFF + hc0 + 4 * n); bb[n] = *(const f32x4*)(cb + hc0 + 4 * n); }
        const size_t row0 = (size_t)u.pm * 256 + wr * 128 + fr;
        const f32x4 zero4 = (f32x4){0.f, 0.f, 0.f, 0.f};
#pragma unroll
        for (int blk = 0; blk < 8; ++blk) {
            const int ai = blk >> 2, m = blk & 3;
            float r[8];
#pragma unroll
            for (int n = 0; n < 2; ++n) {
                const f32x4 x = acc[ai][0][m][n];
                const f32x4 xp = blk > 0 ? acc[(blk - 1) >> 2][0][(blk - 1) & 3][n] : zero4;
                const f32x4 xn = blk < 7 ? acc[(blk + 1) >> 2][0][(blk + 1) & 3][n] : zero4;
                const f32x4 uu = acc[ai][1][m][n];
#pragma unroll
                for (int j = 0; j < 4; ++j) {
                    const float pre = bb[n][j] + w0[n][j] * dpp_prev(x[j], xp[j]) + w1[n][j] * x[j] + w2[n][j] * dpp_next(x[j], xn[j]);
                    r[4 * n + j] = gelu_tanh(pre) * uu[j];
                }
            }
            v4u o; o.x = pk2(r[0], r[1]); o.y = pk2(r[2], r[3]); o.z = pk2(r[4], r[5]); o.w = pk2(r[6], r[7]);
            *(v4u*)(H + (row0 + 16 * blk) * DFF + hc0) = o;
        }
        float* sg = sideG + ((size_t)u.pm * SIDE_G_ROWS + 4 * wr) * DFF + hc0;
        float* su = sideU + ((size_t)u.pm * SIDE_U_ROWS + 2 * wr) * DFF + hc0;
        if (fr < 2) { *(f32x4*)(sg + (size_t)fr * DFF) = acc[0][0][0][0]; *(f32x4*)(sg + (size_t)fr * DFF + 4) = acc[0][0][0][1]; }
        if (fr >= 14) { *(f32x4*)(sg + (size_t)(fr - 12) * DFF) = acc[1][0][3][0]; *(f32x4*)(sg + (size_t)(fr - 12) * DFF + 4) = acc[1][0][3][1]; }
        if (fr == 0) { *(f32x4*)su = acc[0][1][0][0]; *(f32x4*)(su + 4) = acc[0][1][0][1]; }
        if (fr == 15) { *(f32x4*)(su + DFF) = acc[1][1][3][0]; *(f32x4*)(su + DFF + 4) = acc[1][1][3][1]; }
    }
};
__device__ __forceinline__ void gate_fixup(const float* sideG, const float* sideU, const float* cw, const float* cb, bf16* H, int gtid, int nthreads) {
    constexpr int C4 = DFF / 4, NT = NTOK / 256;
    for (int idx = gtid; idx < NT * 4 * C4; idx += nthreads) {
        const int c = (idx % C4) * 4, k = (idx / C4) & 3, pm = idx / (4 * C4);
        const float* g = sideG + (size_t)pm * SIDE_G_ROWS * DFF + c;
        f32x4 prev, cur, next; int row;
        const f32x4 z = (f32x4){0.f, 0.f, 0.f, 0.f};
        if (k == 0) { row = 0; prev = (pm % 32 == 0) ? z : *(const f32x4*)(g - (size_t)SIDE_G_ROWS * DFF + 7 * (size_t)DFF); cur = *(const f32x4*)g; next = *(const f32x4*)(g + DFF); }
        else if (k == 1) { row = 127; prev = *(const f32x4*)(g + 2 * (size_t)DFF); cur = *(const f32x4*)(g + 3 * (size_t)DFF); next = *(const f32x4*)(g + 4 * (size_t)DFF); }
        else if (k == 2) { row = 128; prev = *(const f32x4*)(g + 3 * (size_t)DFF); cur = *(const f32x4*)(g + 4 * (size_t)DFF); next = *(const f32x4*)(g + 5 * (size_t)DFF); }
        else { row = 255; prev = *(const f32x4*)(g + 6 * (size_t)DFF); cur = *(const f32x4*)(g + 7 * (size_t)DFF); next = (pm % 32 == 31) ? z : *(const f32x4*)(g + (size_t)SIDE_G_ROWS * DFF); }
        const f32x4 uu = *(const f32x4*)(sideU + ((size_t)pm * SIDE_U_ROWS + k) * DFF + c);
        const f32x4 w0 = *(const f32x4*)(cw + c), w1 = *(const f32x4*)(cw + DFF + c), w2 = *(const f32x4*)(cw + 2 * DFF + c), b = *(const f32x4*)(cb + c);
        float r[4];
#pragma unroll
        for (int j = 0; j < 4; ++j) r[j] = gelu_tanh(b[j] + w0[j] * prev[j] + w1[j] * cur[j] + w2[j] * next[j]) * uu[j];
        v2u o; o.x = pk2(r[0], r[1]); o.y = pk2(r[2], r[3]);
        *(v2u*)(H + ((size_t)pm * 256 + row) * DFF + c) = o;
    }
}
constexpr int LDS_PHASE_BYTES = 143360;
constexpr int LDSCTL_OFF = LDS_PHASE_BYTES, LDS_BYTES = 147456;
constexpr int CW_BAR = 4096;
constexpr size_t CTL_ZERO_BYTES = 64 * 1024;
static_assert(HY_LDS_BYTES <= LDS_PHASE_BYTES && RG_LDS_BYTES <= LDS_PHASE_BYTES && MN_LDS_BYTES <= LDS_PHASE_BYTES && pg8::STAGE_BYTES <= LDS_PHASE_BYTES, "LDS map");
static_assert((CW_BAR + XCD_BAR_WORDS) * 4 <= (int)CTL_ZERO_BYTES, "control words inside the memset region");

struct MkArgs { const float* in[32]; float* out; unsigned char* ws; };
__device__ __forceinline__ pg8::Gemm dgemm(const bf16* A, const bf16* Bt, int M, int N, int K, int lda, int ldb) { pg8::Gemm g; g.A = A; g.Bt = Bt; g.M = M; g.N = N; g.K = K; g.lda = lda; g.ldb = ldb; return g; }
__device__ __forceinline__ pg8::EpiBf16<0> depi(bf16* O, int ldc) { pg8::EpiBf16<0> e; e.O = O; e.ldc = ldc; e.bias = nullptr; e.split_cols = 0; e.split_stride = 0; e.scale0 = 1.f; return e; }

__device__ __forceinline__ void gate_seq(const bf16* gu, const float* cw, const float* cb, bf16* h, int gtid, int nthreads) {
    constexpr int CG = DFF / 8;
    for (int idx = gtid; idx < SEQL * CG; idx += nthreads) {
        const int m = idx / CG, c0 = (idx % CG) * 8;
        const v4u z = (v4u){0u, 0u, 0u, 0u};
        const v4u gm = m > 0 ? *(const v4u*)(gu + (size_t)(m - 1) * 2 * DFF + c0) : z;
        const v4u g0 = *(const v4u*)(gu + (size_t)m * 2 * DFF + c0);
        const v4u gp = m < SEQL - 1 ? *(const v4u*)(gu + (size_t)(m + 1) * 2 * DFF + c0) : z;
        const v4u uu = *(const v4u*)(gu + (size_t)m * 2 * DFF + DFF + c0);
        float r[8];
#pragma unroll
        for (int e = 0; e < 8; ++e) {
            const unsigned wm = e < 2 ? gm.x : e < 4 ? gm.y : e < 6 ? gm.z : gm.w, w0 = e < 2 ? g0.x : e < 4 ? g0.y : e < 6 ? g0.z : g0.w, wp = e < 2 ? gp.x : e < 4 ? gp.y : e < 6 ? gp.z : gp.w, wu = e < 2 ? uu.x : e < 4 ? uu.y : e < 6 ? uu.z : uu.w;
            const float a = (e & 1) ? bfhi(wm) : bflo(wm), b = (e & 1) ? bfhi(w0) : bflo(w0), c = (e & 1) ? bfhi(wp) : bflo(wp), u = (e & 1) ? bfhi(wu) : bflo(wu);
            const float pre = cb[c0 + e] + cw[c0 + e] * a + cw[DFF + c0 + e] * b + cw[2 * DFF + c0 + e] * c;
            r[e] = gelu_tanh(pre) * u;
        }
        v4u o; o.x = pk2(r[0], r[1]); o.y = pk2(r[2], r[3]); o.z = pk2(r[4], r[5]); o.w = pk2(r[6], r[7]);
        *(v4u*)(h + (size_t)m * DFF + c0) = o;
    }
}

#if defined(__HIP_DEVICE_COMPILE__)
#define MK_NOPK __attribute__((target("no-packed-fp32-ops")))
#else
#define MK_NOPK
#endif
__global__ void __launch_bounds__(512, 2) MK_NOPK mk_fwd(MkArgs args) {
    extern __shared__ __attribute__((aligned(16))) unsigned char lds_raw[];
    LAS unsigned char* lds = (LAS unsigned char*)lds_raw;
    const int tid = threadIdx.x, lane = tid & 63, wave = __builtin_amdgcn_readfirstlane(tid >> 6);
    const int G = gridDim.x, bx = blockIdx.x;
    unsigned char* ws = args.ws;
    const float* const* in = args.in;
    volatile LAS unsigned* MISC = (volatile LAS unsigned*)(lds + LDSCTL_OFF);
    for (int u = tid; u < (LDS_BYTES - LDSCTL_OFF) / 4; u += 512) ((LAS unsigned*)(lds + LDSCTL_OFF))[u] = 0u;
    wg_sync();
    XcdBarrier bar = xcd_barrier_post((unsigned*)(ws + WS_CTL) + CW_BAR, MISC + 8);

    bf16* XN = (bf16*)(ws + WS_XN); bf16* WIN = (bf16*)(ws + WS_WIN);
    {
        ProArgs pa; pa.xp = in[0]; pa.xs = in[1]; pa.g_premix = in[2]; pa.w_in = in[3]; pa.w_out = in[24]; pa.w_ffi = in[27]; pa.w_ffo = in[30]; pa.rg_a_w = in[6]; pa.rg_x_w = in[8];
        pa.hy_w1 = in[13]; pa.hy_b1 = in[14]; pa.hy_w2 = in[15]; pa.hy_b2 = in[16]; pa.hy_w3 = in[17]; pa.hy_b3 = in[18]; pa.hy_freq = in[20]; pa.ws = ws;
        p0_prologue<true>(pa, lds, bx * 8 + wave, G * 8, wave, lane);
    }
    xcd_barrier(bar);
    {
        pg8::StaticOrder S; S.init(NTOK, 2 * DRG, G, bx);
        pg8::gemm_phase<pg8::EpiBf16<0>, pg8::StaticOrder, true, true>(lds, dgemm(XN, WIN, NTOK, 2 * DRG, DM, LDK, LDK), S, depi((bf16*)(ws + WS_PRG), 2 * DRG));
    }
    {
        pg8::StaticOrder S; S.init(3 * DHY, NTOK, G, bx);
        pg8::gemm_phase<pg8::EpiBf16<0>, pg8::StaticOrder, true, true>(lds, dgemm(WIN + (size_t)2 * DRG * LDK, XN, 3 * DHY, NTOK, DM, LDK, LDK), S, depi((bf16*)(ws + WS_PHY), NTOK));
    }
    xcd_barrier(bar);
    RgArgs ra; ra.prg = (const bf16*)(ws + WS_PRG); ra.conv_w = in[4]; ra.conv_b = in[5]; ra.rgw = (const bf16*)(ws + WS_RGW); ra.a_b = in[7]; ra.x_b = in[9]; ra.lam = in[10];
    ra.summ = (f32x2*)(ws + WS_SUMM); ra.rgy = (bf16*)(ws + WS_RGY);
    {
        HyArgs a; a.phy = (const bf16*)(ws + WS_PHY); a.conv_w = in[11]; a.conv_b = in[12]; a.w4 = in[19]; a.hy_bias = in[21]; a.h3h = (const bf16*)(ws + WS_H3); a.tw = (const f32x2*)(ws + WS_TW);
        a.zk = (f32x2*)(ws + WS_ZK); a.hyy = (bf16*)(ws + WS_HYY);
        for (int cp = bx; cp < DHY / 2; cp += G) hyena_unit(a, lds, cp, bx, tid);
    }
    for (int u = bx; u < RG_UNITS; u += G) rg_unit<1>(ra, lds, u, tid);
    xcd_barrier(bar);
    for (int u = bx; u < RG_UNITS; u += G) rg_unit<2>(ra, lds, u, tid);
    xcd_barrier(bar);
    for (int m = bx * 8 + wave; m < NTOK; m += G * 8) mixnorm_rg_row((const bf16*)(ws + WS_RGY), in[22], (bf16*)(ws + WS_MIX), m, lane);
    for (int t = bx; t < NTOK / 64; t += G) mixnorm_hy_tile((const bf16*)(ws + WS_HYY), in[23], (bf16*)(ws + WS_MIX), lds, t, tid);
    xcd_barrier(bar);
    {
        pg8::StaticOrder S; S.init(NTOK, DM, G, bx);
        pg8::gemm_phase<pg8::EpiBf16<0>, pg8::StaticOrder, true, true>(lds, dgemm((bf16*)(ws + WS_MIX), (bf16*)(ws + WS_WOUT), NTOK, DM, DM, LDK, LDK), S, depi((bf16*)(ws + WS_Y), DM));
    }
    xcd_barrier(bar);
    for (int m = bx * 8 + wave; m < NTOK; m += G * 8) rowpass1(xrow_ptr(in[0], in[1], m), (const bf16*)(ws + WS_Y) + (size_t)m * DM, in[25], in[26], args.out + (size_t)m * DM, XN + (size_t)m * LDK, lane);
    xcd_barrier(bar);
    bf16* HB = (bf16*)(ws + WS_H);
    {
        pg8::StaticOrder S; S.init(NTOK, 2 * DFF, G, bx);
        EpiGate E; E.H = HB; E.cw = in[28]; E.cb = in[29]; E.sideG = (float*)(ws + WS_SIDEG); E.sideU = (float*)(ws + WS_SIDEU);
        pg8::gemm_phase<EpiGate, pg8::StaticOrder, true, true>(lds, dgemm(XN, (bf16*)(ws + WS_WFI), NTOK, 2 * DFF, DM, LDK, LDK), S, E);
    }
    xcd_barrier(bar);
    { int tq = tid; asm volatile("" : "+v"(tq)); gate_fixup((const float*)(ws + WS_SIDEG), (const float*)(ws + WS_SIDEU), in[28], in[29], HB, bx * 512 + tq, G * 512); }
    xcd_barrier(bar);
    {
        pg8::StaticOrder S; S.init(NTOK, DM, G, bx);
        pg8::gemm_phase<pg8::EpiBf16<0>, pg8::StaticOrder, true, true>(lds, dgemm(HB, (bf16*)(ws + WS_WFO), NTOK, DM, DFF, DFF, DFF), S, depi((bf16*)(ws + WS_F), DM));
    }
    xcd_barrier(bar);
    for (int m = bx * 8 + wave; m < NTOK; m += G * 8) rowpass2((const bf16*)(ws + WS_F) + (size_t)m * DM, in[31], args.out + (size_t)m * DM, lane);
}

extern "C" void kernel_launch(void* const* d_in, const int* in_sizes, int n_in, void* d_out, int out_size, void* d_ws, size_t ws_size, hipStream_t stream) {
    static int grid = 0;
    if (grid == 0) {
        grid = -1;
        if (n_in != 32 || out_size != NTOK * DM || ws_size < WS_END) { fprintf(stderr, "kernel_launch: unexpected sizes n_in %d out %d ws %zu (need %zu)\n", n_in, out_size, ws_size, (size_t)WS_END); return; }
        int dev = 0, cus = 0, per_cu = 0;
        if (hipGetDevice(&dev) != hipSuccess || hipDeviceGetAttribute(&cus, hipDeviceAttributeMultiprocessorCount, dev) != hipSuccess) return;
        if (hipFuncSetAttribute((const void*)mk_fwd, hipFuncAttributeMaxDynamicSharedMemorySize, LDS_BYTES) != hipSuccess) { fprintf(stderr, "kernel_launch: hipFuncSetAttribute failed\n"); return; }
        if (hipOccupancyMaxActiveBlocksPerMultiprocessor(&per_cu, (const void*)mk_fwd, 512, LDS_BYTES) != hipSuccess || per_cu < 1) { fprintf(stderr, "kernel_launch: occupancy query says %d blocks per CU\n", per_cu); (void)hipGetLastError(); return; }
        grid = cus;
    }
    if (grid < 0) return;
    if (hipMemsetAsync((char*)d_ws + WS_CTL, 0, CTL_ZERO_BYTES, stream) != hipSuccess) return;
    MkArgs a; memset(&a, 0, sizeof a);
    for (int i = 0; i < 32; ++i) a.in[i] = (const float*)d_in[i];
    a.out = (float*)d_out; a.ws = (unsigned char*)d_ws;
    hipLaunchKernelGGL(mk_fwd, dim3(grid), dim3(512), LDS_BYTES, stream, a);
}
```

```cpp
#include <cstring>
#include <hip/hip_runtime.h>
#include <cstdio>
#include <cstdint>
namespace pg8 {
#define PG8_LAS __attribute__((address_space(3)))
typedef unsigned short bf16_t;
typedef short bf16x8 __attribute__((ext_vector_type(8)));
typedef float f32x4 __attribute__((ext_vector_type(4)));
typedef unsigned u32x4 __attribute__((ext_vector_type(4)));
constexpr int BM = 256, BK = 64, HALF = 128, HTB = HALF * BK * 2  , STAGE_BYTES = 8 * HTB, NXCD = 8, WGM = 8;

__host__ __device__ __forceinline__ int lds_byte(int r, int c) { const int st = (r >> 4) * 2 + (c >> 5), rr = r & 15, cc = c & 31, ob = rr * 64 + cc * 2; return st * 1024 + (ob ^ (((ob >> 9) & 1) << 5)); }
__host__ __device__ __forceinline__ void stage_rc(int b, int& R, int& C) { const int st = b / 1024, sb = b % 1024, swz = sb ^ (((sb >> 9) & 1) << 5); R = (st >> 1) * 16 + swz / 64; C = (st & 1) * 32 + (swz % 64) / 2; }
__host__ __device__ __forceinline__ int perm32(int rho) { const int n = rho >> 4, i = rho & 15; return 8 * (i >> 2) + 4 * n + (i & 3); }

struct Unit { int pm, pn; };
struct Gemm { const bf16_t* A; const bf16_t* Bt; int M, N, K, lda, ldb; };

struct StaticOrder {
    int nM, nN, nwg, G, c;
    __host__ __device__ __forceinline__ void init(int M, int N, int G_, int c_) { nM = M / BM; nN = N / BM; nwg = nM * nN; G = G_; c = c_; }
    __host__ __device__ __forceinline__ bool next(int i, Unit& u) const {
        const long L = (long)i * G + c; if (L >= nwg) return false;
        int wgid = (int)L; { const int q = nwg / NXCD, r = nwg % NXCD, xcd = wgid % NXCD, off = wgid / NXCD; wgid = (xcd < r ? xcd * (q + 1) : r * (q + 1) + (xcd - r) * q) + off; }
        const int nig = WGM * nN, gid = wgid / nig, fm = gid * WGM, gsz = (nM - fm) < WGM ? (nM - fm) : WGM;
        u.pm = fm + ((wgid % nig) % gsz); u.pn = (wgid % nig) / gsz; return true;
    }
    __device__ __forceinline__ void a_ready(const Unit&, int) const {}
    __device__ __forceinline__ void done(const Unit&) const {}
};

__device__ __forceinline__ unsigned cvt_pk_bf16(float lo, float hi) { unsigned r; asm volatile("v_cvt_pk_bf16_f32 %0, %1, %2" : "=v"(r) : "v"(lo), "v"(hi)); return r; }
typedef float f32x2 __attribute__((ext_vector_type(2)));
__device__ __forceinline__ f32x2 gelu_pk(f32x2 v) {
    const f32x2 av = __builtin_elementwise_abs(v), d = av * 0.2316418882f + 1.0f;
    f32x2 t; t.x = __builtin_amdgcn_rcpf(d.x); t.y = __builtin_amdgcn_rcpf(d.y);
    f32x2 q = t * 0.5307027145f + (-0.7265760135f); q = q * t + 0.7107068705f; q = q * t + (-0.142248368f); q = q * t + 0.127414796f; q = q * t;
    const f32x2 s = (v * v) * (-0.72134752044f);
    f32x2 e; e.x = __builtin_amdgcn_exp2f(s.x); e.y = __builtin_amdgcn_exp2f(s.y);
    const f32x2 m = v * (q * e), r = v - m;
    f32x2 o; o.x = v.x < 0.f ? m.x : r.x; o.y = v.y < 0.f ? m.y : r.y; return o;
}

template <int ACT  > struct EpiBf16 {
    static constexpr bool PERM = true, AFTER_DRAIN = false, AROWPERM = false; static_assert(ACT == 0 || ACT == 1, "EpiBf16: ACT is 0 (none) or 1 (gelu_pk)");
    bf16_t* O; int ldc; const float* bias; int split_cols; size_t split_stride; float scale0;
    __device__ __forceinline__ void operator()(const f32x4 (&acc)[2][2][4][2], const Unit& u, int wr, int wc, int fr, int fq) const {
        const int row0 = u.pm * BM + wr * 64 + fr; int colt = u.pn * BM; bf16_t* base = O;
        float sc = 1.f; if (split_cols) { const int t = colt / split_cols; base += (size_t)t * split_stride; colt -= t * split_cols; if (t == 0) sc = scale0; }
        const int col0 = colt + wc * 32 + 8 * fq, bcol0 = u.pn * BM + wc * 32 + 8 * fq;
        f32x4 bv[2][2];
#pragma unroll
        for (int bj = 0; bj < 2; ++bj)
#pragma unroll
            for (int n = 0; n < 2; ++n) bv[bj][n] = bias ? *(const f32x4*)(bias + bcol0 + bj * HALF + 4 * n) : (f32x4){0.f, 0.f, 0.f, 0.f};
#pragma unroll
        for (int ai = 0; ai < 2; ++ai)
#pragma unroll
            for (int m = 0; m < 4; ++m) { bf16_t* rowp = base + (size_t)(row0 + ai * HALF + m * 16) * ldc + col0;
#pragma unroll
                for (int bj = 0; bj < 2; ++bj) { f32x4 v0 = acc[ai][bj][m][0] + bv[bj][0], v1 = acc[ai][bj][m][1] + bv[bj][1];
                    if (ACT == 1) { f32x2 a = gelu_pk((f32x2){v0[0], v0[1]}), b = gelu_pk((f32x2){v0[2], v0[3]}), c = gelu_pk((f32x2){v1[0], v1[1]}), d = gelu_pk((f32x2){v1[2], v1[3]});
                        v0 = (f32x4){a.x, a.y, b.x, b.y}; v1 = (f32x4){c.x, c.y, d.x, d.y}; }
                    v0 = v0 * sc; v1 = v1 * sc; u32x4 w; w.x = cvt_pk_bf16(v0[0], v0[1]); w.y = cvt_pk_bf16(v0[2], v0[3]); w.z = cvt_pk_bf16(v1[0], v1[1]); w.w = cvt_pk_bf16(v1[2], v1[3]);
                    *(u32x4*)(rowp + bj * HALF) = w; } }
    }
};
template <class Epi, class Sched, bool ALIGN_EPI = false, bool SP2 = false>
__device__ __forceinline__ void gemm_phase(PG8_LAS unsigned char* lds, const Gemm g, const Sched& S, const Epi& E) {
    int tid_ = threadIdx.x; asm volatile("" : "+v"(tid_));
    const int tid = tid_, wid = __builtin_amdgcn_readfirstlane(tid >> 6), lane = tid & 63, wr = wid >> 2, wc = wid & 3, fr = lane & 15, fq = lane >> 4;
    const int K = g.K, nt = K / BK;
    unsigned voffA[2], voffB[2];
#pragma unroll
    for (int i = 0; i < 2; ++i) { int R, C; stage_rc(tid * 16 + i * 8192, R, C); const int Rb = Epi::PERM ? ((R & ~31) + perm32(R & 31)) : R; const int Ra = Epi::AROWPERM ? (128 * (R >> 6) + (R & 63)) : R;
        voffA[i] = (unsigned)(Ra * g.lda + C) * 2u; voffB[i] = (unsigned)(Rb * g.ldb + C) * 2u; }
    const size_t kstep = (size_t)(BK * 2);
    const size_t hstep = (size_t)HALF * g.ldb * 2;
    const size_t hstepA = (size_t)(Epi::AROWPERM ? 64 : HALF) * g.lda * 2;
    const size_t tstep = 2 * hstep, tstepA = (size_t)BM * g.lda * 2;
    const unsigned ldsw = (unsigned)wid * 1024u;
    const int aoff = lds_byte(wr * 64 + fr, fq * 8), boff = lds_byte(wc * 32 + fr, fq * 8);
#define PG8_SA(b, h) (((b) * 2 + (h)) * HTB)
#define PG8_SB(b, h) ((4 + (b) * 2 + (h)) * HTB)
#define PG8_STAGE(bufoff, gbase, voff) do { _Pragma("unroll") for (int _i = 0; _i < 2; ++_i) \
        __builtin_amdgcn_global_load_lds((const unsigned*)((const char*)(gbase) + (voff)[_i]), (PG8_LAS unsigned*)(lds + (bufoff) + ldsw + _i * 8192), 16, 0, 0); } while (0)
#define PG8_LDA(dst, b, h) do { _Pragma("unroll") for (int m = 0; m < 4; ++m) _Pragma("unroll") for (int k = 0; k < 2; ++k) dst[m][k] = *(const PG8_LAS bf16x8*)(lds + PG8_SA(b, h) + aoff + m * 2048 + k * 1024); } while (0)
#define PG8_LDB(dst, b, h) do { _Pragma("unroll") for (int n = 0; n < 2; ++n) _Pragma("unroll") for (int k = 0; k < 2; ++k) dst[n][k] = *(const PG8_LAS bf16x8*)(lds + PG8_SB(b, h) + boff + n * 2048 + k * 1024); } while (0)
#define PG8_MMA(ai, bj, At, Bt) do { __builtin_amdgcn_s_setprio(1); _Pragma("unroll") for (int m = 0; m < 4; ++m) _Pragma("unroll") for (int n = 0; n < 2; ++n) _Pragma("unroll") for (int k = 0; k < 2; ++k) \
        acc[ai][bj][m][n] = __builtin_amdgcn_mfma_f32_16x16x32_bf16(Bt[n][k], At[m][k], acc[ai][bj][m][n], 0, 0, 0); __builtin_amdgcn_s_setprio(0); } while (0)
#define PG8_WAIT_V(n) asm volatile("s_waitcnt vmcnt(" #n ")" ::: "memory")
#define PG8_WAIT_L(n) asm volatile("s_waitcnt lgkmcnt(" #n ")" ::: "memory")
#define PG8_BAR __builtin_amdgcn_s_barrier()
#define PG8_SCHED __builtin_amdgcn_sched_barrier(0)
    Unit cur, nxt; int ui = 0;
    if (!S.next(0, cur)) return;
    f32x4 acc[2][2][4][2];
#pragma unroll
    for (int a = 0; a < 2; ++a)
#pragma unroll
        for (int b = 0; b < 2; ++b)
#pragma unroll
            for (int m = 0; m < 4; ++m)
#pragma unroll
                for (int n = 0; n < 2; ++n) acc[a][b][m][n] = (f32x4){0.f, 0.f, 0.f, 0.f};
    bf16x8 At[4][2], B0[2][2], B1[2][2];
    const char* cA = (const char*)g.A + (size_t)cur.pm * tstepA; const char* cB = (const char*)g.Bt + (size_t)cur.pn * tstep;
    S.a_ready(cur, 0);
    if constexpr (SP2) {
        PG8_STAGE(PG8_SB(0, 0), cB, voffB); PG8_STAGE(PG8_SB(0, 1), cB + hstep, voffB); PG8_STAGE(PG8_SA(0, 0), cA, voffA); PG8_STAGE(PG8_SA(0, 1), cA + hstepA, voffA);
        if (wr == 1) PG8_BAR;
        PG8_WAIT_V(2); PG8_BAR;
        PG8_STAGE(PG8_SB(1, 0), cB + kstep, voffB); PG8_STAGE(PG8_SA(1, 0), cA + kstep, voffA); PG8_STAGE(PG8_SB(1, 1), cB + hstep + kstep, voffB);
        PG8_WAIT_V(6); PG8_BAR;
    } else {
        PG8_STAGE(PG8_SB(0, 0), cB, voffB); PG8_STAGE(PG8_SA(0, 0), cA, voffA); PG8_STAGE(PG8_SB(0, 1), cB + hstep, voffB); PG8_STAGE(PG8_SA(0, 1), cA + hstepA, voffA);
        if (wr == 1) PG8_BAR;
        PG8_WAIT_V(4); PG8_BAR;
        PG8_STAGE(PG8_SB(1, 0), cB + kstep, voffB); PG8_STAGE(PG8_SA(1, 0), cA + kstep, voffA); PG8_STAGE(PG8_SB(1, 1), cB + hstep + kstep, voffB);
        PG8_WAIT_V(6); PG8_BAR;
    }
    for (;;) {
        const bool has_next = S.next(ui + 1, nxt);
        const char* nA = has_next ? (const char*)g.A + (size_t)nxt.pm * tstepA : cA; const char* nB = has_next ? (const char*)g.Bt + (size_t)nxt.pn * tstep : cB;
        for (int t = 0; t < nt; t += 2) {
            const bool last = (t == nt - 2);
            const char* a1 = cA + (size_t)(t + 1) * kstep;
            const char* a2 = last ? nA : cA + (size_t)(t + 2) * kstep; const char* b2 = last ? nB : cB + (size_t)(t + 2) * kstep;
            const char* a3 = a2 + kstep; const char* b3 = b2 + kstep;
            if (last && has_next) S.a_ready(nxt, ui + 1);
            if constexpr (SP2) {
            PG8_LDB(B0, 0, 0); PG8_LDB(B1, 0, 1); PG8_SCHED; PG8_LDA(At, 0, 0); PG8_STAGE(PG8_SA(1, 1), a1 + hstepA, voffA);
            PG8_WAIT_V(8); PG8_WAIT_L(0); PG8_BAR; PG8_MMA(0, 0, At, B0); PG8_MMA(0, 1, At, B1); PG8_BAR; PG8_SCHED;
            PG8_LDA(At, 0, 1); PG8_STAGE(PG8_SB(0, 0), b2, voffB); PG8_STAGE(PG8_SB(0, 1), b2 + hstep, voffB); PG8_STAGE(PG8_SA(0, 0), a2, voffA);
            PG8_WAIT_V(8); PG8_WAIT_L(0); PG8_BAR; PG8_MMA(1, 0, At, B0); PG8_MMA(1, 1, At, B1); PG8_BAR; PG8_SCHED;
            PG8_LDB(B0, 1, 0); PG8_LDB(B1, 1, 1); PG8_SCHED; PG8_LDA(At, 1, 0); PG8_STAGE(PG8_SA(0, 1), a2 + hstepA, voffA);
            PG8_WAIT_V(8); PG8_WAIT_L(0); PG8_BAR; PG8_MMA(0, 0, At, B0); PG8_MMA(0, 1, At, B1); PG8_BAR; PG8_SCHED;
            PG8_LDA(At, 1, 1); PG8_STAGE(PG8_SB(1, 0), b3, voffB); PG8_STAGE(PG8_SB(1, 1), b3 + hstep, voffB); PG8_STAGE(PG8_SA(1, 0), a3, voffA);
            PG8_WAIT_V(8); PG8_WAIT_L(0); PG8_BAR; PG8_MMA(1, 0, At, B0); PG8_MMA(1, 1, At, B1); PG8_BAR; PG8_SCHED;
            } else {
            PG8_LDB(B0, 0, 0); PG8_SCHED; PG8_LDA(At, 0, 0); PG8_STAGE(PG8_SA(1, 1), a1 + hstepA, voffA);
            PG8_WAIT_L(8); PG8_BAR; PG8_WAIT_L(0); PG8_MMA(0, 0, At, B0); PG8_BAR; PG8_SCHED;
            PG8_LDB(B1, 0, 1); PG8_STAGE(PG8_SB(0, 0), b2, voffB);
            PG8_BAR; PG8_WAIT_L(0); PG8_MMA(0, 1, At, B1); PG8_BAR;
            PG8_LDA(At, 0, 1); PG8_STAGE(PG8_SA(0, 0), a2, voffA);
            PG8_BAR; PG8_WAIT_L(0); PG8_MMA(1, 0, At, B0); PG8_BAR; PG8_SCHED;
            PG8_STAGE(PG8_SB(0, 1), b2 + hstep, voffB);
            PG8_WAIT_V(6); PG8_BAR; PG8_MMA(1, 1, At, B1); PG8_BAR;
            PG8_LDB(B0, 1, 0); PG8_SCHED; PG8_LDA(At, 1, 0); PG8_STAGE(PG8_SA(0, 1), a2 + hstepA, voffA);
            PG8_WAIT_L(8); PG8_BAR; PG8_WAIT_L(0); PG8_MMA(0, 0, At, B0); PG8_BAR; PG8_SCHED;
            PG8_LDB(B1, 1, 1); PG8_STAGE(PG8_SB(1, 0), b3, voffB);
            PG8_BAR; PG8_WAIT_L(0); PG8_MMA(0, 1, At, B1); PG8_BAR;
            PG8_LDA(At, 1, 1); PG8_STAGE(PG8_SA(1, 0), a3, voffA);
            PG8_BAR; PG8_WAIT_L(0); PG8_MMA(1, 0, At, B0); PG8_BAR; PG8_SCHED;
            PG8_STAGE(PG8_SB(1, 1), b3 + hstep, voffB);
            PG8_WAIT_V(6); PG8_BAR; PG8_MMA(1, 1, At, B1); PG8_BAR;
            }
        }
        if constexpr (ALIGN_EPI) { if (wr == 0) PG8_BAR; }
        if constexpr (!Epi::AFTER_DRAIN) { E(acc, cur, wr, wc, fr, fq); S.done(cur); }
        if (!has_next) break;
#pragma unroll
        for (int a = 0; a < 2; ++a)
#pragma unroll
            for (int b = 0; b < 2; ++b)
#pragma unroll
                for (int m = 0; m < 4; ++m)
#pragma unroll
                    for (int n = 0; n < 2; ++n) acc[a][b][m][n] = (f32x4){0.f, 0.f, 0.f, 0.f};
        cur = nxt; cA = nA; cB = nB; ++ui;
        if constexpr (ALIGN_EPI) { if (wr == 1) PG8_BAR; }
    }
    PG8_WAIT_V(0);
    if constexpr (!ALIGN_EPI) { if (wr == 0) PG8_BAR; }
    PG8_BAR;
    if constexpr (Epi::AFTER_DRAIN) { E.fused(acc, cur, wr, wc, fr, fq, lds, wid, lane); S.done(cur); }
#undef PG8_SA
#undef PG8_SB
#undef PG8_STAGE
#undef PG8_LDA
#undef PG8_LDB
#undef PG8_MMA
#undef PG8_WAIT_V
#undef PG8_WAIT_L
#undef PG8_BAR
#undef PG8_SCHED
}
}
constexpr int SEQL = 8192, NSEQ = 3, NTOK = NSEQ * SEQL;
constexpr int DM = 4096, DRG = 2048, DHY = 2048, NIN = 10240, DFF = 11008;
constexpr int NHEAD = 16, HDIM = 128;
constexpr float EPSN = 1e-6f;
constexpr int FFT_N = 16384;
constexpr int LDK = DM;

#define GAS __attribute__((address_space(1)))
#define LAS __attribute__((address_space(3)))
typedef unsigned short bf16;
typedef unsigned v4u __attribute__((ext_vector_type(4)));
typedef unsigned v2u __attribute__((ext_vector_type(2)));
typedef float f32x4 __attribute__((ext_vector_type(4)));
typedef float f32x2 __attribute__((ext_vector_type(2)));
typedef short bf16x8 __attribute__((ext_vector_type(8)));

__device__ __forceinline__ void wg_sync() { __builtin_amdgcn_fence(__ATOMIC_RELEASE, "workgroup"); __builtin_amdgcn_s_barrier(); __builtin_amdgcn_fence(__ATOMIC_ACQUIRE, "workgroup"); }
__device__ __forceinline__ void lds_sync() { asm volatile("s_waitcnt lgkmcnt(0)" ::: "memory"); __builtin_amdgcn_s_barrier(); asm volatile("" ::: "memory"); }
__device__ __forceinline__ unsigned f2bf(float f) { unsigned u = __builtin_bit_cast(unsigned, f); return (u + 0x7fffu + ((u >> 16) & 1u)) >> 16; }
__device__ __forceinline__ unsigned pk2(float lo, float hi) { return f2bf(lo) | (f2bf(hi) << 16); }
__device__ __forceinline__ float bf2f(unsigned b) { return __builtin_bit_cast(float, b << 16); }
__device__ __forceinline__ float bflo(unsigned w) { return __builtin_bit_cast(float, w << 16); }
__device__ __forceinline__ float bfhi(unsigned w) { return __builtin_bit_cast(float, w & 0xffff0000u); }
__device__ __forceinline__ float wave_sum(float v) {
#pragma unroll
    for (int o = 1; o < 64; o <<= 1) v += __shfl_xor(v, o);
    return v;
}
__device__ __forceinline__ float frcp(float x) { return __builtin_amdgcn_rcpf(x); }
__device__ __forceinline__ float fexp(float x) { return __builtin_amdgcn_exp2f(x * 1.4426950408889634f); }
__device__ __forceinline__ float sigmoidf_(float x) { return frcp(1.0f + fexp(-x)); }
__device__ __forceinline__ float gelu_tanh(float x) { const float u = 1.5957691216057308f * (x + 0.044715f * x * x * x); return x * frcp(1.0f + fexp(-u)); }

constexpr size_t MiB = 1u << 20;
constexpr size_t WS_CTL = 0;
constexpr size_t WS_TW = 1 * MiB;
constexpr size_t WS_H3 = 2 * MiB;
constexpr size_t WS_RGW = 4 * MiB;
constexpr size_t WS_SUMM = 6 * MiB;
constexpr size_t WS_WIN = 16 * MiB;
constexpr size_t WS_WOUT = 98 * MiB;
constexpr size_t WS_WFI = 131 * MiB;
constexpr size_t WS_WFO = 306 * MiB;
constexpr size_t WS_XN = 392 * MiB;
constexpr size_t WS_PRG = 588 * MiB;
constexpr size_t WS_PHY = 780 * MiB;
constexpr size_t WS_HYY = 1068 * MiB;
constexpr size_t WS_RGY = 1164 * MiB;
constexpr size_t WS_ZK = 1260 * MiB;
constexpr size_t WS_H = WS_PHY;
constexpr size_t WS_SIDEG = 1296 * MiB;
constexpr size_t WS_SIDEU = 1329 * MiB;
constexpr size_t WS_END = 1346 * MiB;
static_assert(WS_WIN + (size_t)NIN * LDK * 2 <= WS_WOUT && WS_WOUT + (size_t)DM * LDK * 2 <= WS_WFI && WS_WFI + (size_t)2 * DFF * LDK * 2 <= WS_WFO && WS_WFO + (size_t)DM * DFF * 2 <= WS_XN &&
              WS_XN + (size_t)NTOK * LDK * 2 <= WS_PRG && WS_PRG + (size_t)NTOK * DM * 2 <= WS_PHY && WS_PHY + (size_t)3 * DHY * NTOK * 2 <= WS_HYY && WS_PHY + (size_t)NTOK * LDK * 2 <= WS_HYY &&
              WS_HYY + (size_t)DHY * NTOK * 2 <= WS_RGY && WS_RGY + (size_t)NTOK * DRG * 2 <= WS_ZK && WS_ZK + (size_t)256 * 2 * FFT_N * 8 <= WS_END && WS_H + (size_t)NTOK * DFF * 2 <= WS_SIDEG &&
              WS_SIDEG + (size_t)96 * 8 * DFF * 4 <= WS_SIDEU && WS_SIDEU + (size_t)96 * 4 * DFF * 4 <= WS_END, "d_ws map");
constexpr size_t WS_MIX = WS_PHY;
constexpr size_t WS_Y = WS_PRG;
constexpr size_t WS_F = WS_PRG;
#define XB_TMO      128
#define XB_XCNT(j)  (256  + 64 * (j))
#define XB_XSUB(j)  (1280 + 64 * (j))
#define XB_XGEN(j)  (2304 + 64 * (j))
#define XB_TOP      3328
#define XB_TOPGEN   3392
#define XCD_BAR_WORDS 3456
#define XB_SPIN_CAP (1u << 18)

__device__ __forceinline__ unsigned xb_ld(unsigned* p)              { return __hip_atomic_load(p, __ATOMIC_RELAXED, __HIP_MEMORY_SCOPE_AGENT); }
__device__ __forceinline__ unsigned xb_add(unsigned* p, unsigned v) { return __hip_atomic_fetch_add(p, v, __ATOMIC_RELAXED, __HIP_MEMORY_SCOPE_AGENT); }
__device__ __forceinline__ unsigned xb_xcc_id() { return (unsigned)__builtin_amdgcn_s_getreg((3 << 11) | 20) & 0xFu; }
#define XB_SPIN(cond, bar) do { unsigned _sp = 0; while (cond) { __builtin_amdgcn_s_sleep(1); \
    if ((++_sp & 255u) == 0u) { if (xb_ld(&(bar)[XB_TMO])) break; if (_sp > XB_SPIN_CAP) { atomicAdd(&(bar)[XB_TMO], 1u); break; } } } } while (0)

struct XcdBarrier {
    unsigned* bar; unsigned x;
    volatile LAS unsigned* st;
};

__device__ __forceinline__ XcdBarrier xcd_barrier_post(unsigned* bar, volatile LAS unsigned* st) {
    XcdBarrier b; b.bar = bar; b.x = xb_xcc_id(); b.st = st;
    if (threadIdx.x == 0) (void)xb_add(&bar[XB_XCNT(b.x)], 1u);
    return b;
}
__device__ __forceinline__ void xcd_barrier_complete(unsigned* bar, unsigned x, unsigned& nloc, unsigned& nx) {
    const unsigned G = gridDim.x * gridDim.y * gridDim.z;
    unsigned sum, cnt, mine, sp = 0u;
    for (;;) {
        sum = 0u; cnt = 0u; mine = 0u;
#pragma unroll
        for (unsigned j = 0; j < 16; ++j) { const unsigned c = xb_ld(&bar[XB_XCNT(j)]); sum += c; cnt += (c > 0u) ? 1u : 0u; mine = (j == x) ? c : mine; }
        if (sum == G) break;
        __builtin_amdgcn_s_sleep(1);
        if ((++sp & 255u) == 0u) { if (xb_ld(&bar[XB_TMO])) break; if (sp > XB_SPIN_CAP) { atomicAdd(&bar[XB_TMO], 1u); break; } }
    }
    nloc = mine > 0u ? mine : 1u; nx = cnt > 0u ? cnt : 1u;
}

__device__ __forceinline__ void xcd_barrier(const XcdBarrier& b) {
    asm volatile("s_waitcnt vmcnt(0)" ::: "memory");
    wg_sync();
    if (threadIdx.x == 0) {
        unsigned* bar = b.bar;
        __builtin_amdgcn_s_waitcnt(0);
        unsigned nloc = b.st[0], nx = b.st[1];
        if (nloc == 0u) { xcd_barrier_complete(bar, b.x, nloc, nx); b.st[0] = nloc; b.st[1] = nx; }
        const unsigned old = xb_add(&bar[XB_XSUB(b.x)], 1u);
        const unsigned gen = old / nloc;
        if (old + 1u == (gen + 1u) * nloc) {
            __builtin_amdgcn_fence(__ATOMIC_RELEASE, "agent");
            asm volatile("s_waitcnt vmcnt(0)" ::: "memory");
            const unsigned og = xb_add(&bar[XB_TOP], 1u);
            const unsigned tg = og / nx;
            if (og + 1u == (tg + 1u) * nx) xb_add(&bar[XB_TOPGEN], 1u);
            else XB_SPIN(xb_ld(&bar[XB_TOPGEN]) == tg, bar);
            __builtin_amdgcn_fence(__ATOMIC_ACQUIRE, "agent");
            xb_add(&bar[XB_XGEN(b.x)], 1u);
            asm volatile("s_waitcnt vmcnt(0)" ::: "memory");
        } else {
            XB_SPIN(xb_ld(&bar[XB_XGEN(b.x)]) == gen, bar);
            __builtin_amdgcn_fence(__ATOMIC_ACQUIRE, "agent");
            asm volatile("s_waitcnt vmcnt(0)" ::: "memory");
        }
    }
    wg_sync();
}
struct TrItem { const float* W; bf16* WT; int K, N, k0, n0, drow0, ldt; };
__device__ __forceinline__ void tr_load(const TrItem& t, int lane, f32x4 (&v)[8]) {
    const float* p = t.W + (size_t)(t.k0 + (lane >> 3)) * t.N + t.n0 + (lane & 7) * 4;
#pragma unroll
    for (int ii = 0; ii < 8; ++ii) v[ii] = __builtin_nontemporal_load((const f32x4*)(p + (size_t)8 * ii * t.N));
}
__device__ __forceinline__ void tr_store(const TrItem& t, int lane, const f32x4 (&v)[8], LAS float* scr) {
    LAS float* w = scr + (lane >> 3) * 33 + (lane & 7) * 4;
#pragma unroll
    for (int ii = 0; ii < 8; ++ii) { w[ii * 8 * 33 + 0] = v[ii].x; w[ii * 8 * 33 + 1] = v[ii].y; w[ii * 8 * 33 + 2] = v[ii].z; w[ii * 8 * 33 + 3] = v[ii].w; }
    asm volatile("s_waitcnt lgkmcnt(0)" ::: "memory");
    const int c = lane & 7;
#pragma unroll
    for (int j = 0; j < 4; ++j) { const int n = (lane >> 3) + 8 * j; const LAS float* s = scr + (8 * c) * 33 + n;
        v4u o; o.x = pk2(s[0 * 33], s[1 * 33]); o.y = pk2(s[2 * 33], s[3 * 33]); o.z = pk2(s[4 * 33], s[5 * 33]); o.w = pk2(s[6 * 33], s[7 * 33]);
        *(v4u*)(t.WT + (size_t)(t.drow0 + n) * t.ldt + t.k0 + 8 * c) = o; }
    asm volatile("s_waitcnt lgkmcnt(0)" ::: "memory");
}
template <bool INTER> __device__ __forceinline__ int ffi_drow(int n) {
    if (!INTER) return n;
    const int up = n >= DFF ? 1 : 0, c = n - up * DFF; return (c >> 7) * 256 + up * 128 + (c & 127);
}
struct ProArgs {
    const float *xp, *xs, *g_premix;
    const float *w_in, *w_out, *w_ffi, *w_ffo;
    const float *rg_a_w, *rg_x_w;
    const float *hy_w1, *hy_b1, *hy_w2, *hy_b2, *hy_w3, *hy_b3, *hy_freq;
    unsigned char* ws;
};
__device__ __forceinline__ const float* xrow_ptr(const float* xp, const float* xs, int m) { return m < SEQL ? xp + (size_t)m * DM : xs + (size_t)(m - SEQL) * DM; }

template <bool INTER> __device__ __forceinline__ void p0_prologue(const ProArgs& a, LAS unsigned char* lds, int gw, int NGW, int wave, int lane) {
    bf16* WIN = (bf16*)(a.ws + WS_WIN); bf16* WOUT = (bf16*)(a.ws + WS_WOUT); bf16* WFI = (bf16*)(a.ws + WS_WFI); bf16* WFO = (bf16*)(a.ws + WS_WFO);
    LAS float* scr = (LAS float*)(lds + wave * 16384);
    constexpr int I_IN = (DM / 64) * (NIN / 32), I_OUT = (DM / 64) * (DM / 32), I_FI = (DM / 64) * (2 * DFF / 32), I_FO = (DFF / 64) * (DM / 32);
    constexpr int NITEMS = I_IN + I_OUT + I_FI + I_FO;
    auto decode = [&](int it) -> TrItem {
        TrItem t; int r = it;
        if (r < I_IN) { const int nb = NIN / 32, kb = r / nb, n0 = (r % nb) * 32; t.W = a.w_in; t.WT = WIN; t.K = DM; t.N = NIN; t.k0 = kb * 64; t.n0 = n0; t.drow0 = n0; t.ldt = LDK; return t; } r -= I_IN;
        if (r < I_OUT) { const int nb = DM / 32, kb = r / nb, n0 = (r % nb) * 32; t.W = a.w_out; t.WT = WOUT; t.K = DM; t.N = DM; t.k0 = kb * 64; t.n0 = n0; t.drow0 = n0; t.ldt = LDK; return t; } r -= I_OUT;
        if (r < I_FI) { const int nb = 2 * DFF / 32, kb = r / nb, n0 = (r % nb) * 32; t.W = a.w_ffi; t.WT = WFI; t.K = DM; t.N = 2 * DFF; t.k0 = kb * 64; t.n0 = n0; t.drow0 = ffi_drow<INTER>(n0); t.ldt = LDK; return t; } r -= I_FI;
        { const int nb = DM / 32, kb = r / nb, n0 = (r % nb) * 32; t.W = a.w_ffo; t.WT = WFO; t.K = DFF; t.N = DM; t.k0 = kb * 64; t.n0 = n0; t.drow0 = n0; t.ldt = DFF; return t; }
    };
    {
        int it = gw; TrItem cur; f32x4 vc[8], vn[8];
        if (it < NITEMS) { cur = decode(it); tr_load(cur, lane, vc); }
        while (it < NITEMS) {
            const int nx = it + NGW; TrItem nxt = cur;
            if (nx < NITEMS) { nxt = decode(nx); tr_load(nxt, lane, vn); }
            tr_store(cur, lane, vc, scr);
            cur = nxt; it = nx;
#pragma unroll
            for (int ii = 0; ii < 8; ++ii) vc[ii] = vn[ii];
        }
    }
    bf16* XN = (bf16*)(a.ws + WS_XN);
    for (int m = gw; m < NTOK; m += NGW) {
        const float* xr = xrow_ptr(a.xp, a.xs, m);
        f32x4 v[16]; float s = 0.f;
#pragma unroll
        for (int j = 0; j < 8; ++j) { const f32x4* p = (const f32x4*)(xr + (j * 64 + lane) * 8); v[2 * j] = p[0]; v[2 * j + 1] = p[1];
            s += (v[2 * j].x * v[2 * j].x + v[2 * j].y * v[2 * j].y) + (v[2 * j].z * v[2 * j].z + v[2 * j].w * v[2 * j].w);
            s += (v[2 * j + 1].x * v[2 * j + 1].x + v[2 * j + 1].y * v[2 * j + 1].y) + (v[2 * j + 1].z * v[2 * j + 1].z + v[2 * j + 1].w * v[2 * j + 1].w); }
        const float rs = 1.0f / sqrtf(wave_sum(s) * (1.0f / DM) + EPSN);
#pragma unroll
        for (int j = 0; j < 8; ++j) { const int c0 = (j * 64 + lane) * 8; const f32x4 g0 = *(const f32x4*)(a.g_premix + c0), g1 = *(const f32x4*)(a.g_premix + c0 + 4);
            const f32x4 a0 = v[2 * j] * rs * g0, a1 = v[2 * j + 1] * rs * g1;
            v4u o; o.x = pk2(a0.x, a0.y); o.y = pk2(a0.z, a0.w); o.z = pk2(a1.x, a1.y); o.w = pk2(a1.z, a1.w);
            *(v4u*)(XN + (size_t)m * LDK + c0) = o; }
    }
    bf16* RGW = (bf16*)(a.ws + WS_RGW);
    for (int idx = gw * 64 + lane; idx < 2 * 2 * NHEAD * HDIM * HDIM; idx += NGW * 64) {
        const int i = idx & 127, j = (idx >> 7) & 127, h = (idx >> 14) & 15, gate = (idx >> 18) & 1, dir = idx >> 19;
        const float* W = gate ? a.rg_x_w : a.rg_a_w;
        RGW[idx] = (bf16)f2bf(W[(((size_t)dir * NHEAD + h) * HDIM + i) * HDIM + j]);
    }
    f32x2* TW = (f32x2*)(a.ws + WS_TW);
    for (int k = gw * 64 + lane; k < FFT_N; k += NGW * 64) { float sn, cs; sincospif((float)k * (1.0f / 8192.0f), &sn, &cs); TW[k] = (f32x2){cs, -sn}; }
    bf16* H3H = (bf16*)(a.ws + WS_H3); bf16* H3L = H3H + SEQL * 64;
    const float fr = a.hy_freq[lane], b1 = a.hy_b1[lane], b2 = a.hy_b2[lane], b3 = a.hy_b3[lane];
    for (int n = gw; n < SEQL; n += NGW) {
        float zv = 0.f;
        if (lane == 0) zv = (float)n * (1.0f / (float)(SEQL - 1));
        else if (lane < 33) { const int k = (lane - 1) & 15; const float band = 1e-4f + (float)k * ((15.0f - 1e-4f) / 15.0f);
            const float ang = (6.283185307179586f / (float)SEQL) * (float)n * band; zv = lane < 17 ? cosf(ang) : -sinf(ang); }
        float acc = b1;
        for (int e = 0; e < 33; ++e) acc += __shfl(zv, e) * a.hy_w1[e * 64 + lane];
        float h = sinf(fr * acc);
        acc = b2;
        for (int e = 0; e < 64; ++e) acc += __shfl(h, e) * a.hy_w2[e * 64 + lane];
        h = sinf(fr * acc);
        acc = b3;
        for (int e = 0; e < 64; ++e) acc += __shfl(h, e) * a.hy_w3[e * 64 + lane];
        h = sinf(fr * acc);
        { const unsigned hi = f2bf(h); H3H[n * 64 + lane] = (bf16)hi; H3L[n * 64 + lane] = (bf16)f2bf(h - bf2f(hi)); }
    }
}
constexpr int FFT_LDS_BYTES = (FFT_N + FFT_N / 32) * 8;
constexpr int HY_W4_OFF = FFT_LDS_BYTES;
constexpr int HY_PRM_OFF = FFT_LDS_BYTES + 1024;
constexpr int HY_LDS_BYTES = FFT_LDS_BYTES + 1024 + 256;
__device__ __forceinline__ int PH(int i) { return i + (i >> 5); }
__device__ __forceinline__ f32x2 cmul(f32x2 a, f32x2 b) { return (f32x2){a.x * b.x - a.y * b.y, a.x * b.y + a.y * b.x}; }
__device__ __forceinline__ constexpr int bitrev_c(int r, int bits) { int o = 0; for (int i = 0; i < bits; ++i) o |= ((r >> i) & 1) << (bits - 1 - i); return o; }

__device__ __forceinline__ f32x2 mul_w32(f32x2 d, int idx) {
    constexpr float C[16] = {1.0f, 0.98078528040323043f, 0.92387953251128674f, 0.83146961230254524f, 0.70710678118654752f, 0.55557023301960218f, 0.38268343236508977f, 0.19509032201612825f,
                             0.0f, -0.19509032201612825f, -0.38268343236508977f, -0.55557023301960218f, -0.70710678118654752f, -0.83146961230254524f, -0.92387953251128674f, -0.98078528040323043f};
    constexpr float S[16] = {0.0f, 0.19509032201612825f, 0.38268343236508977f, 0.55557023301960218f, 0.70710678118654752f, 0.83146961230254524f, 0.92387953251128674f, 0.98078528040323043f,
                             1.0f, 0.98078528040323043f, 0.92387953251128674f, 0.83146961230254524f, 0.70710678118654752f, 0.55557023301960218f, 0.38268343236508977f, 0.19509032201612825f};
    if (idx == 0) return d;
    if (idx == 8) return (f32x2){d.y, -d.x};
    const float c = C[idx], s = S[idx];
    return (f32x2){d.x * c + d.y * s, d.y * c - d.x * s};
}
template <int R> __device__ __forceinline__ void dft_inreg(f32x2 (&a)[R]) {
    constexpr int LOGR = (R == 32) ? 5 : 4;
#pragma unroll
    for (int t = 0; t < LOGR; ++t) {
        const int half = R >> (t + 1);
#pragma unroll
        for (int g = 0; g < R; g += 2 * half)
#pragma unroll
            for (int i = 0; i < half; ++i) {
                const f32x2 u = a[g + i], v = a[g + i + half];
                a[g + i] = u + v;
                a[g + i + half] = mul_w32(u - v, i * (16 / half));
            }
    }
}
template <int R, int S, bool TW, bool ZPAD = false, bool HALFOUT = false> __device__ __forceinline__ void fft_pass(LAS f32x2* lds, const f32x2* tw, int tid) {
    constexpr int NB = FFT_N / R, PER = NB / 512, LOGR = (R == 32) ? 5 : 4;
    constexpr int RSTEP = NB + NB / 32;
    constexpr int WSTEP = (S == 1) ? 1 : (S + S / 32);
    f32x2 a[PER][R];
#pragma unroll
    for (int b = 0; b < PER; ++b) { const LAS f32x2* rp = lds + PH(tid + 512 * b);
#pragma unroll
        for (int k = 0; k < R; ++k) a[b][k] = (ZPAD && k >= R / 2) ? (f32x2){0.f, 0.f} : rp[k * RSTEP]; }
    lds_sync();
#pragma unroll
    for (int b = 0; b < PER; ++b) {
        const int beta = tid + 512 * b, q = beta & (S - 1), p = beta / S, base = q + R * S * p;
        dft_inreg<R>(a[b]);
        f32x2 w1 = (f32x2){1.f, 0.f}, wj = (f32x2){1.f, 0.f};
        if (TW) { w1 = tw[p * S]; wj = w1; }
        LAS f32x2* wp = lds + PH(base);
        wp[0] = a[b][0];
#pragma unroll
        for (int j = 1; j < (HALFOUT ? R / 2 : R); ++j) {
            f32x2 v = a[b][bitrev_c(j, LOGR)];
            if (TW) { v = cmul(v, wj); wj = cmul(wj, w1); }
            wp[j * WSTEP] = v;
        }
    }
    lds_sync();
}
template <bool ZPAD = false, bool HALFOUT = false> __device__ __forceinline__ void fft16k(LAS f32x2* lds, const f32x2* tw, int tid) {
    asm volatile("" : "+v"(tid));
    fft_pass<32, 1, true, ZPAD, false>(lds, tw, tid);
    fft_pass<32, 32, true>(lds, tw, tid);
    fft_pass<16, 1024, false, false, HALFOUT>(lds, tw, tid);
}
__device__ __forceinline__ void spec_pair(LAS f32x2* lds, const f32x2* ZK, int p) {
    const int f = p, f2 = (FFT_N - p) & (FFT_N - 1);
    const f32x2 A = ZK[f], A2 = ZK[f2], Z = lds[PH(f)], Z2 = lds[PH(f2)];
    const float kcx = 0.5f * (A.x + A2.x), kcy = 0.5f * (A.y - A2.y);
    const float dx = 0.5f * (A.x - A2.x), dy = 0.5f * (A.y + A2.y);
    const float k1x = dy, k1y = -dx;
    const float px = 0.5f * (kcx + k1x), py = 0.5f * (kcy + k1y), qx = 0.5f * (kcx - k1x), qy = 0.5f * (kcy - k1y);
    const float wx = Z.x * px - Z.y * py + (Z2.x * qx + Z2.y * qy);
    const float wy = Z.x * py + Z.y * px + (Z2.x * qy - Z2.y * qx);
    const float w2x = Z2.x * px + Z2.y * py + (Z.x * qx - Z.y * qy);
    const float w2y = Z2.y * px - Z2.x * py - (Z.x * qy + Z.y * qx);
    lds[PH(f)] = (f32x2){wx, -wy}; lds[PH(f2)] = (f32x2){w2x, -w2y};
}
__device__ __forceinline__ void spec_mul(LAS f32x2* lds, const f32x2* ZK, int tid) {
    asm volatile("" : "+v"(tid));
#pragma unroll 8
    for (int i = 0; i < 16; ++i) spec_pair(lds, ZK, tid + 512 * i);
    if (tid == 0) spec_pair(lds, ZK, 8192);
    lds_sync();
}
struct HyArgs {
    const bf16* phy;
    const float *conv_w, *conv_b;
    const float* w4;
    const float* hy_bias;
    const bf16* h3h;
    const f32x2* tw;
    f32x2* zk;
    bf16* hyy;
};
__device__ __forceinline__ void load_conv3_16(const bf16* row, int t0, float w0, float w1, float w2, float bias, float (&out)[16]) {
    const v4u r0 = *(const v4u*)(row + t0), r1 = *(const v4u*)(row + t0 + 8);
    float u[18];
    u[0] = t0 > 0 ? bf2f(row[t0 - 1]) : 0.f;
    u[17] = (t0 + 16 < SEQL) ? bf2f(row[t0 + 16]) : 0.f;
    u[1] = bflo(r0.x); u[2] = bfhi(r0.x); u[3] = bflo(r0.y); u[4] = bfhi(r0.y); u[5] = bflo(r0.z); u[6] = bfhi(r0.z); u[7] = bflo(r0.w); u[8] = bfhi(r0.w);
    u[9] = bflo(r1.x); u[10] = bfhi(r1.x); u[11] = bflo(r1.y); u[12] = bfhi(r1.y); u[13] = bflo(r1.z); u[14] = bfhi(r1.z); u[15] = bflo(r1.w); u[16] = bfhi(r1.w);
#pragma unroll
    for (int e = 0; e < 16; ++e) out[e] = bias + w0 * u[e] + w1 * u[e + 1] + w2 * u[e + 2];
}
__device__ __forceinline__ void store16_bf16(bf16* dst, const float (&v)[16]) {
    v4u o0, o1; o0.x = pk2(v[0], v[1]); o0.y = pk2(v[2], v[3]); o0.z = pk2(v[4], v[5]); o0.w = pk2(v[6], v[7]);
    o1.x = pk2(v[8], v[9]); o1.y = pk2(v[10], v[11]); o1.z = pk2(v[12], v[13]); o1.w = pk2(v[14], v[15]);
    *(v4u*)dst = o0; *(v4u*)(dst + 8) = o1;
}
__device__ __forceinline__ void hyena_unit(const HyArgs& a, LAS unsigned char* ldsb_, int cp, int wgslot, int tid) {
    unsigned lzero; asm volatile("v_mov_b32 %0, 0" : "=v"(lzero));
    LAS unsigned char* ldsb = ldsb_ + lzero;
    LAS f32x2* lds = (LAS f32x2*)ldsb;
    const int c0 = 2 * cp, c1 = c0 + 1;
    f32x2* zk = a.zk + (size_t)wgslot * 2 * FFT_N;
    constexpr float MIN_DECAY = -3.0701134573253945f, MAX_DECAY = -15.350567286626973f;
    const float ad0 = fabsf(MIN_DECAY + (float)c0 * ((MAX_DECAY - MIN_DECAY) / (float)(DHY - 1)));
    const float ad1 = fabsf(MIN_DECAY + (float)c1 * ((MAX_DECAY - MIN_DECAY) / (float)(DHY - 1)));
    LAS float* prm = (LAS float*)(ldsb + HY_PRM_OFF);
    wg_sync();
    if (tid < 24) { const int k = tid & 3, sc = tid >> 2, st = sc >> 1, chn = st * DHY + c0 + (sc & 1); prm[tid] = k < 3 ? a.conv_w[k * 6144 + chn] : a.conv_b[chn]; }
    if (tid >= 32 && tid < 36) { const int j = tid - 32; prm[tid] = a.hy_bias[(j >> 1) * DHY + c0 + (j & 1)]; }
#pragma unroll 1
    for (int o = 0; o < 2; ++o) {
        int tq = tid; asm volatile("" : "+v"(tq)); const int t0 = 16 * tq;
        wg_sync();
        {
            const int lane = tq & 63, wv = tq >> 6, fr = lane & 15, fq = lane >> 4;
            const int colidx = o * 4096 + ((fr >> 1) & 1) * 2048 + c0 + (fr & 1);
            bf16x8 Bh[2], Bl[2];
#pragma unroll
            for (int kk = 0; kk < 2; ++kk)
#pragma unroll
                for (int i = 0; i < 8; ++i) { const float w = fr < 4 ? a.w4[(size_t)(32 * kk + 8 * fq + i) * 8192 + colidx] : 0.f; const unsigned hi = f2bf(w);
                    Bh[kk][i] = (short)hi; Bl[kk][i] = (short)f2bf(w - bf2f(hi)); }
            const float adl = (fr & 1) ? ad1 : ad0;
            LAS float* ldsf = (LAS float*)lds;
            if (tq == 0) lds[PH(SEQL)] = (f32x2){0.f, 0.f};
            const bf16* apw = a.h3h + (size_t)(wv * 1024 + fr) * 64 + 8 * fq;
            bf16x8 fc[4][4], fn[4][4];
#pragma unroll
            for (int q = 0; q < 4; ++q) { const bf16* ap = apw + (size_t)q * 16 * 64;
                fc[q][0] = *(const bf16x8*)ap; fc[q][1] = *(const bf16x8*)(ap + 32); fc[q][2] = *(const bf16x8*)(ap + SEQL * 64); fc[q][3] = *(const bf16x8*)(ap + SEQL * 64 + 32); }
#pragma unroll 1
            for (int gq = 0; gq < 16; ++gq) {
                const int gnx = gq < 15 ? gq + 1 : gq;
#pragma unroll
                for (int q = 0; q < 4; ++q) { const bf16* ap = apw + (size_t)(gnx * 4 + q) * 16 * 64;
                    fn[q][0] = *(const bf16x8*)ap; fn[q][1] = *(const bf16x8*)(ap + 32); fn[q][2] = *(const bf16x8*)(ap + SEQL * 64); fn[q][3] = *(const bf16x8*)(ap + SEQL * 64 + 32); }
#pragma unroll
                for (int q = 0; q < 4; ++q) {
                    const int row0 = wv * 1024 + (gq * 4 + q) * 16;
                    f32x4 acc = (f32x4){0.f, 0.f, 0.f, 0.f};
                    acc = __builtin_amdgcn_mfma_f32_16x16x32_bf16(fc[q][2], Bh[0], acc, 0, 0, 0); acc = __builtin_amdgcn_mfma_f32_16x16x32_bf16(fc[q][3], Bh[1], acc, 0, 0, 0);
                    acc = __builtin_amdgcn_mfma_f32_16x16x32_bf16(fc[q][0], Bl[0], acc, 0, 0, 0); acc = __builtin_amdgcn_mfma_f32_16x16x32_bf16(fc[q][1], Bl[1], acc, 0, 0, 0);
                    acc = __builtin_amdgcn_mfma_f32_16x16x32_bf16(fc[q][0], Bh[0], acc, 0, 0, 0); acc = __builtin_amdgcn_mfma_f32_16x16x32_bf16(fc[q][1], Bh[1], acc, 0, 0, 0);
                    if (fr < 4) {
#pragma unroll
                        for (int e = 0; e < 4; ++e) {
                            const int n = row0 + 4 * fq + e;
                            const float val = acc[e] * fexp(-(float)n * (1.0f / (float)(SEQL - 1)) * adl);
                            if (fr < 2) ldsf[2 * PH(n) + (fr & 1)] = val;
                            else if (n >= 1) ldsf[2 * PH(FFT_N - n) + (fr & 1)] = val;
                        }
                    }
                }
#pragma unroll
                for (int q = 0; q < 4; ++q)
#pragma unroll
                    for (int z = 0; z < 4; ++z) fc[q][z] = fn[q][z];
            }
        }
        wg_sync();
        fft16k(lds, a.tw, tid);
#pragma unroll 4
        for (int i = 0; i < 32; ++i) zk[(size_t)o * FFT_N + tq + 512 * i] = lds[PH(tq + 512 * i)];
    }
    const float inv_n = 1.0f / (float)FFT_N;
    asm volatile("s_waitcnt vmcnt(0)" ::: "memory");
    wg_sync();
#pragma unroll 1
    for (int s = 0; s < NSEQ; ++s) {
        const size_t m0 = (size_t)s * SEQL;
        int tq = tid; asm volatile("" : "+v"(tq)); const int t0 = 16 * tq;
        {
            float v0[16], v1[16];
            load_conv3_16(a.phy + (size_t)(0 * DHY + c0) * NTOK + m0, t0, prm[0], prm[1], prm[2], prm[3], v0);
            load_conv3_16(a.phy + (size_t)(0 * DHY + c1) * NTOK + m0, t0, prm[4], prm[5], prm[6], prm[7], v1);
            wg_sync();
#pragma unroll
            for (int e = 0; e < 16; ++e) { lds[PH(t0 + e)] = (f32x2){v0[e], v1[e]}; }
        }
        wg_sync();
        fft16k<true, false>(lds, a.tw, tid);
        spec_mul(lds, zk, tid);
        fft16k<false, true>(lds, a.tw, tid);
        float z0[16], z1[16];
        {
            float x0[16], x1[16];
            load_conv3_16(a.phy + (size_t)(0 * DHY + c0) * NTOK + m0, t0, prm[0], prm[1], prm[2], prm[3], x0);
            load_conv3_16(a.phy + (size_t)(0 * DHY + c1) * NTOK + m0, t0, prm[4], prm[5], prm[6], prm[7], x1);
#pragma unroll
            for (int e = 0; e < 16; ++e) { const f32x2 r = lds[PH(t0 + e)]; z0[e] = r.x * inv_n + prm[32] * x0[e]; z1[e] = -r.y * inv_n + prm[33] * x1[e]; }
            load_conv3_16(a.phy + (size_t)(1 * DHY + c0) * NTOK + m0, t0, prm[8], prm[9], prm[10], prm[11], x0);
            load_conv3_16(a.phy + (size_t)(1 * DHY + c1) * NTOK + m0, t0, prm[12], prm[13], prm[14], prm[15], x1);
#pragma unroll
            for (int e = 0; e < 16; ++e) { z0[e] *= x0[e]; z1[e] *= x1[e]; }
        }
#pragma unroll
        for (int e = 0; e < 16; ++e) { lds[PH(t0 + e)] = (f32x2){z0[e], z1[e]}; }
        wg_sync();
        fft16k<true, false>(lds, a.tw, tid);
        spec_mul(lds, zk + FFT_N, tid);
        fft16k<false, true>(lds, a.tw, tid);
        {
            float x0[16], x1[16];
            load_conv3_16(a.phy + (size_t)(2 * DHY + c0) * NTOK + m0, t0, prm[16], prm[17], prm[18], prm[19], x0);
            load_conv3_16(a.phy + (size_t)(2 * DHY + c1) * NTOK + m0, t0, prm[20], prm[21], prm[22], prm[23], x1);
#pragma unroll
            for (int e = 0; e < 16; ++e) { const f32x2 r = lds[PH(t0 + e)];
                x0[e] = x0[e] * (r.x * inv_n + prm[34] * z0[e]); x1[e] = x1[e] * (-r.y * inv_n + prm[35] * z1[e]); }
            store16_bf16(a.hyy + (size_t)c0 * NTOK + m0 + t0, x0);
            store16_bf16(a.hyy + (size_t)c1 * NTOK + m0 + t0, x1);
        }
    }
}
constexpr int RG_T = 128, RG_NT = SEQL / RG_T;
constexpr int RG_XC_STRIDE = 272;
constexpr int RG_G_OFF = RG_T * RG_XC_STRIDE;
constexpr int RG_HF_OFF = 2 * RG_T * RG_XC_STRIDE;
constexpr int RG_LDS_BYTES = RG_HF_OFF + (RG_T / 4) * 512 * 4;
constexpr int RG_UNITS = NSEQ * RG_NT * NHEAD;
struct RgArgs {
    const bf16* prg;
    const float *conv_w, *conv_b;
    const bf16* rgw;
    const float *a_b, *x_b;
    const float* lam;
    f32x2* summ;
    bf16* rgy;
};
template <int PASS> __device__ __forceinline__ void rg_unit(const RgArgs& a, LAS unsigned char* lds, int unit, int tid) {
    const int wave = tid >> 6, lane = tid & 63, fr = lane & 15, fq = lane >> 4;
    const int h = unit % NHEAD, tt = (unit / NHEAD) % RG_NT, s = unit / (NHEAD * RG_NT);
    const int tok0 = tt * RG_T;
    const size_t mrow0 = (size_t)s * SEQL;
    wg_sync();
    {
        const int cg = h * HDIM + 2 * lane;
        float w0[4], w1[4];
#pragma unroll
        for (int k = 0; k < 4; ++k) { w0[k] = a.conv_w[k * DRG + cg]; w1[k] = a.conv_w[k * DRG + cg + 1]; }
        const float cb0 = a.conv_b[cg], cb1 = a.conv_b[cg + 1];
        const int tb = tok0 + 16 * wave;
        unsigned raw[19], graw[16];
#pragma unroll
        for (int q = 0; q < 19; ++q) { const int t = tb - 2 + q, tc = t < 0 ? 0 : (t > SEQL - 1 ? SEQL - 1 : t); raw[q] = *(const unsigned*)(a.prg + (mrow0 + tc) * DM + cg); }
        if (PASS == 2) {
#pragma unroll
            for (int i = 0; i < 16; ++i) graw[i] = *(const unsigned*)(a.prg + (mrow0 + tb + i) * DM + DRG + cg);
        }
#pragma unroll
        for (int q = 0; q < 19; ++q) { const int t = tb - 2 + q; if (t < 0 || t > SEQL - 1) raw[q] = 0u; }
#pragma unroll
        for (int i = 0; i < 16; ++i) {
            const float y0 = cb0 + w0[0] * bflo(raw[i]) + w0[1] * bflo(raw[i + 1]) + w0[2] * bflo(raw[i + 2]) + w0[3] * bflo(raw[i + 3]);
            const float y1 = cb1 + w1[0] * bfhi(raw[i]) + w1[1] * bfhi(raw[i + 1]) + w1[2] * bfhi(raw[i + 2]) + w1[3] * bfhi(raw[i + 3]);
            *(LAS unsigned*)(lds + (16 * wave + i) * RG_XC_STRIDE + lane * 4) = pk2(y0, y1);
            if (PASS == 2) *(LAS unsigned*)(lds + RG_G_OFF + (16 * wave + i) * RG_XC_STRIDE + lane * 4) = graw[i];
        }
    }
    wg_sync();
    const int ch = h * HDIM + 16 * wave + fr;
    LAS float* hfl = (LAS float*)(lds + RG_HF_OFF) + tid;
#pragma unroll
    for (int dir = 0; dir < 2; ++dir) {
        bf16x8 Br[4], Bi[4];
#pragma unroll
        for (int kk = 0; kk < 4; ++kk) {
            Br[kk] = *(const bf16x8*)(a.rgw + ((((size_t)dir * 2 + 0) * NHEAD + h) * HDIM + 16 * wave + fr) * HDIM + 32 * kk + 8 * fq);
            Bi[kk] = *(const bf16x8*)(a.rgw + ((((size_t)dir * 2 + 1) * NHEAD + h) * HDIM + 16 * wave + fr) * HDIM + 32 * kk + 8 * fq);
        }
        const float ba = a.a_b[dir * DRG + ch], bx = a.x_b[dir * DRG + ch];
        const float sp = log1pf(expf(-a.lam[dir * DRG + ch]));
        float carry = 0.f, ptot = 1.f;
        if (PASS == 2) {
            const f32x2* sm = a.summ + ((size_t)dir * NSEQ + s) * RG_NT * DRG + ch;
            const int cnt = dir == 0 ? tt : RG_NT - 1 - tt;
            for (int j0 = 0; j0 < cnt; j0 += 16) {
                f32x2 pb[16];
#pragma unroll
                for (int q = 0; q < 16; ++q) { const int jj = j0 + q, j = dir == 0 ? jj : RG_NT - 1 - jj, jc = jj < cnt ? j : tt; pb[q] = sm[(size_t)jc * DRG]; if (jj >= cnt) pb[q] = (f32x2){1.f, 0.f}; }
#pragma unroll
                for (int q = 0; q < 16; ++q) carry = pb[q].x * carry + pb[q].y;
            }
        }
        for (int bi = 0; bi < RG_T / 16; ++bi) {
            const int blk = dir == 0 ? bi : (RG_T / 16 - 1 - bi);
            f32x4 accR = (f32x4){0.f, 0.f, 0.f, 0.f}, accI = (f32x4){0.f, 0.f, 0.f, 0.f};
#pragma unroll
            for (int kk = 0; kk < 4; ++kk) {
                const bf16x8 af = *(const LAS bf16x8*)(lds + (16 * blk + fr) * RG_XC_STRIDE + (32 * kk + 8 * fq) * 2);
                accR = __builtin_amdgcn_mfma_f32_16x16x32_bf16(af, Br[kk], accR, 0, 0, 0);
                accI = __builtin_amdgcn_mfma_f32_16x16x32_bf16(af, Bi[kk], accI, 0, 0, 0);
            }
            float av[4], bv[4];
#pragma unroll
            for (int e = 0; e < 4; ++e) {
                const float r = sigmoidf_(accR[e] + ba), ig = sigmoidf_(accI[e] + bx);
                const float log_a = -8.0f * r * sp;
                av[e] = fexp(log_a);
                const float x2 = 2.0f * log_a;
                const float em = -x2 * (1.0f + x2 * (0.5f + x2 * (0.16666667f + x2 * (0.041666668f + x2 * (0.0083333338f + x2 * (0.0013888889f + x2 * (0.0001984127f + x2 * 0.0000248016f)))))));
                const float em2 = x2 < -0.25f ? (1.0f - av[e] * av[e]) : em;
                const float mult = __builtin_amdgcn_sqrtf(fmaxf(em2, 0.f));
                const float xcv = bf2f(*(const LAS unsigned short*)(lds + (16 * blk + 4 * fq + e) * RG_XC_STRIDE + (16 * wave + fr) * 2));
                bv[e] = mult * ig * xcv;
            }
            float A = 1.f, B = 0.f;
            if (dir == 0) {
#pragma unroll
                for (int e = 0; e < 4; ++e) { B = av[e] * B + bv[e]; A *= av[e]; }
            } else {
#pragma unroll
                for (int e = 3; e >= 0; --e) { B = av[e] * B + bv[e]; A *= av[e]; }
            }
            float hin;
            if (dir == 0) {
                float Ap = __shfl_up(A, 16), Bp = __shfl_up(B, 16);
                if (fq >= 1) { B = A * Bp + B; A = Ap * A; }
                Ap = __shfl_up(A, 32); Bp = __shfl_up(B, 32);
                if (fq >= 2) { B = A * Bp + B; A = Ap * A; }
                const float hend = A * carry + B;
                const float hprev = __shfl_up(hend, 16);
                hin = fq == 0 ? carry : hprev;
                carry = __shfl(hend, 48 + fr);
                if (PASS == 1) ptot *= __shfl(A, 48 + fr);
            } else {
                float Ap = __shfl_down(A, 16), Bp = __shfl_down(B, 16);
                if (fq <= 2) { B = A * Bp + B; A = Ap * A; }
                Ap = __shfl_down(A, 32); Bp = __shfl_down(B, 32);
                if (fq <= 1) { B = A * Bp + B; A = Ap * A; }
                const float hend = A * carry + B;
                const float hprev = __shfl_down(hend, 16);
                hin = fq == 3 ? carry : hprev;
                carry = __shfl(hend, fr);
                if (PASS == 1) ptot *= __shfl(A, fr);
            }
            if (PASS == 2) {
                if (dir == 0) {
                    float hh = hin;
#pragma unroll
                    for (int e = 0; e < 4; ++e) { hh = av[e] * hh + bv[e]; hfl[(blk * 4 + e) * 512] = hh; }
                } else {
                    float hh = hin, hb[4];
#pragma unroll
                    for (int e = 3; e >= 0; --e) { hh = av[e] * hh + bv[e]; hb[e] = hh; }
#pragma unroll
                    for (int e = 0; e < 4; ++e) {
                        const size_t m = mrow0 + tok0 + 16 * blk + 4 * fq + e;
                        const float g = bf2f(*(const LAS unsigned short*)(lds + RG_G_OFF + (16 * blk + 4 * fq + e) * RG_XC_STRIDE + (16 * wave + fr) * 2));
                        a.rgy[m * DRG + ch] = (bf16)f2bf((hfl[(blk * 4 + e) * 512] + hb[e]) * gelu_tanh(g));
                    }
                }
            }
        }
        if (PASS == 1 && fq == 0) a.summ[(((size_t)dir * NSEQ + s) * RG_NT + tt) * DRG + ch] = (f32x2){ptot, carry};
    }
}
__device__ __forceinline__ void mixnorm_rg_row(const bf16* rgy, const float* g_rg, bf16* mix, int m, int lane) {
    v4u r[4]; float s = 0.f;
#pragma unroll
    for (int j = 0; j < 4; ++j) { r[j] = *(const v4u*)(rgy + (size_t)m * DRG + (j * 64 + lane) * 8);
        const float a0 = bflo(r[j].x), a1 = bfhi(r[j].x), a2 = bflo(r[j].y), a3 = bfhi(r[j].y), a4 = bflo(r[j].z), a5 = bfhi(r[j].z), a6 = bflo(r[j].w), a7 = bfhi(r[j].w);
        s += (a0 * a0 + a1 * a1) + (a2 * a2 + a3 * a3) + (a4 * a4 + a5 * a5) + (a6 * a6 + a7 * a7); }
    const float rs = 1.0f / sqrtf(wave_sum(s) * (1.0f / DRG) + EPSN);
#pragma unroll
    for (int j = 0; j < 4; ++j) { const int c0 = (j * 64 + lane) * 8; const f32x4 g0 = *(const f32x4*)(g_rg + c0), g1 = *(const f32x4*)(g_rg + c0 + 4);
        v4u o; o.x = pk2(bflo(r[j].x) * rs * g0.x, bfhi(r[j].x) * rs * g0.y); o.y = pk2(bflo(r[j].y) * rs * g0.z, bfhi(r[j].y) * rs * g0.w);
        o.z = pk2(bflo(r[j].z) * rs * g1.x, bfhi(r[j].z) * rs * g1.y); o.w = pk2(bflo(r[j].w) * rs * g1.z, bfhi(r[j].w) * rs * g1.w);
        *(v4u*)(mix + (size_t)m * LDK + c0) = o; }
}
constexpr int MN_TILE_STRIDE = 66;
constexpr int MN_LDS_BYTES = 8 * 64 * MN_TILE_STRIDE * 2 + 8 * 64 * 4 + 64 * 4;
__device__ __forceinline__ void mixnorm_hy_tile(const bf16* hyy, const float* g_hy, bf16* mix, LAS unsigned char* lds, int tile, int tid) {
    const int wave = tid >> 6, lane = tid & 63, m0 = tile * 64;
    LAS unsigned short* tl = (LAS unsigned short*)(lds + wave * 64 * MN_TILE_STRIDE * 2);
    LAS float* part = (LAS float*)(lds + 8 * 64 * MN_TILE_STRIDE * 2);
    LAS float* scl = part + 8 * 64;
    wg_sync();
    float s = 0.f;
    for (int c = wave * 256; c < wave * 256 + 256; ++c) { const float v = bf2f(hyy[(size_t)c * NTOK + m0 + lane]); s += v * v; }
    part[wave * 64 + lane] = s;
    wg_sync();
    if (tid < 64) { float t = 0.f;
#pragma unroll
        for (int w = 0; w < 8; ++w) t += part[w * 64 + tid];
        scl[tid] = 1.0f / sqrtf(t * (1.0f / DHY) + EPSN); }
    wg_sync();
    for (int cb = wave; cb < DHY / 64; cb += 8) {
        for (int ci = 0; ci < 64; ++ci) tl[ci * MN_TILE_STRIDE + lane] = hyy[(size_t)(cb * 64 + ci) * NTOK + m0 + lane];
        asm volatile("s_waitcnt lgkmcnt(0)" ::: "memory");
        const float g = g_hy[cb * 64 + lane];
        for (int tk = 0; tk < 64; ++tk) mix[(size_t)(m0 + tk) * LDK + DRG + cb * 64 + lane] = (bf16)f2bf(bf2f(tl[lane * MN_TILE_STRIDE + tk]) * scl[tk] * g);
        asm volatile("s_waitcnt lgkmcnt(0)" ::: "memory");
    }
}
__device__ __forceinline__ void rowpass1(const float* xr, const bf16* yr, const float* g_post, const float* g_pre, float* outr, bf16* xnr, int lane) {
    float v[64]; float s = 0.f;
#pragma unroll
    for (int j = 0; j < 8; ++j) { const v4u r = *(const v4u*)(yr + (j * 64 + lane) * 8);
        v[8 * j + 0] = bflo(r.x); v[8 * j + 1] = bfhi(r.x); v[8 * j + 2] = bflo(r.y); v[8 * j + 3] = bfhi(r.y); v[8 * j + 4] = bflo(r.z); v[8 * j + 5] = bfhi(r.z); v[8 * j + 6] = bflo(r.w); v[8 * j + 7] = bfhi(r.w);
#pragma unroll
        for (int e = 0; e < 8; ++e) s += v[8 * j + e] * v[8 * j + e]; }
    const float rs = 1.0f / sqrtf(wave_sum(s) * (1.0f / DM) + EPSN);
    float s2 = 0.f;
#pragma unroll
    for (int j = 0; j < 8; ++j) { const int c0 = (j * 64 + lane) * 8;
        const f32x4 x0 = *(const f32x4*)(xr + c0), x1 = *(const f32x4*)(xr + c0 + 4), g0 = *(const f32x4*)(g_post + c0), g1 = *(const f32x4*)(g_post + c0 + 4);
        f32x4 o0, o1;
        o0.x = x0.x + v[8 * j + 0] * rs * g0.x; o0.y = x0.y + v[8 * j + 1] * rs * g0.y; o0.z = x0.z + v[8 * j + 2] * rs * g0.z; o0.w = x0.w + v[8 * j + 3] * rs * g0.w;
        o1.x = x1.x + v[8 * j + 4] * rs * g1.x; o1.y = x1.y + v[8 * j + 5] * rs * g1.y; o1.z = x1.z + v[8 * j + 6] * rs * g1.z; o1.w = x1.w + v[8 * j + 7] * rs * g1.w;
        *(f32x4*)(outr + c0) = o0; *(f32x4*)(outr + c0 + 4) = o1;
        v[8 * j + 0] = o0.x; v[8 * j + 1] = o0.y; v[8 * j + 2] = o0.z; v[8 * j + 3] = o0.w; v[8 * j + 4] = o1.x; v[8 * j + 5] = o1.y; v[8 * j + 6] = o1.z; v[8 * j + 7] = o1.w;
        s2 += (o0.x * o0.x + o0.y * o0.y) + (o0.z * o0.z + o0.w * o0.w) + (o1.x * o1.x + o1.y * o1.y) + (o1.z * o1.z + o1.w * o1.w); }
    const float rs2 = 1.0f / sqrtf(wave_sum(s2) * (1.0f / DM) + EPSN);
#pragma unroll
    for (int j = 0; j < 8; ++j) { const int c0 = (j * 64 + lane) * 8; const f32x4 g0 = *(const f32x4*)(g_pre + c0), g1 = *(const f32x4*)(g_pre + c0 + 4);
        v4u o; o.x = pk2(v[8 * j + 0] * rs2 * g0.x, v[8 * j + 1] * rs2 * g0.y); o.y = pk2(v[8 * j + 2] * rs2 * g0.z, v[8 * j + 3] * rs2 * g0.w);
        o.z = pk2(v[8 * j + 4] * rs2 * g1.x, v[8 * j + 5] * rs2 * g1.y); o.w = pk2(v[8 * j + 6] * rs2 * g1.z, v[8 * j + 7] * rs2 * g1.w);
        *(v4u*)(xnr + c0) = o; }
}
__device__ __forceinline__ void rowpass2(const bf16* fr_, const float* g, float* outr, int lane) {
    float v[64]; float s = 0.f;
#pragma unroll
    for (int j = 0; j < 8; ++j) { const v4u r = *(const v4u*)(fr_ + (j * 64 + lane) * 8);
        v[8 * j + 0] = bflo(r.x); v[8 * j + 1] = bfhi(r.x); v[8 * j + 2] = bflo(r.y); v[8 * j + 3] = bfhi(r.y); v[8 * j + 4] = bflo(r.z); v[8 * j + 5] = bfhi(r.z); v[8 * j + 6] = bflo(r.w); v[8 * j + 7] = bfhi(r.w);
#pragma unroll
        for (int e = 0; e < 8; ++e) s += v[8 * j + e] * v[8 * j + e]; }
    const float rs = 1.0f / sqrtf(wave_sum(s) * (1.0f / DM) + EPSN);
#pragma unroll
    for (int j = 0; j < 8; ++j) { const int c0 = (j * 64 + lane) * 8;
        const f32x4 x0 = *(const f32x4*)(outr + c0), x1 = *(const f32x4*)(outr + c0 + 4), g0 = *(const f32x4*)(g + c0), g1 = *(const f32x4*)(g + c0 + 4);
        f32x4 o0, o1;
        o0.x = x0.x + v[8 * j + 0] * rs * g0.x; o0.y = x0.y + v[8 * j + 1] * rs * g0.y; o0.z = x0.z + v[8 * j + 2] * rs * g0.z; o0.w = x0.w + v[8 * j + 3] * rs * g0.w;
        o1.x = x1.x + v[8 * j + 4] * rs * g1.x; o1.y = x1.y + v[8 * j + 5] * rs * g1.y; o1.z = x1.z + v[8 * j + 6] * rs * g1.z; o1.w = x1.w + v[8 * j + 7] * rs * g1.w;
        *(f32x4*)(outr + c0) = o0; *(f32x4*)(outr + c0 + 4) = o1; }
}
constexpr int SIDE_G_ROWS = 8, SIDE_U_ROWS = 4;
__device__ __forceinline__ float dpp_prev(float x, float xprevblk) {
    const int old = __builtin_amdgcn_update_dpp(0, __builtin_bit_cast(int, xprevblk), 0x121  , 0xf, 0xf, false);
    return __builtin_bit_cast(float, __builtin_amdgcn_update_dpp(old, __builtin_bit_cast(int, x), 0x111  , 0xf, 0xf, false));
}
__device__ __forceinline__ float dpp_next(float x, float xnextblk) {
    const int old = __builtin_amdgcn_update_dpp(0, __builtin_bit_cast(int, xnextblk), 0x12F  , 0xf, 0xf, false);
    return __builtin_bit_cast(float, __builtin_amdgcn_update_dpp(old, __builtin_bit_cast(int, x), 0x101  , 0xf, 0xf, false));
}
struct EpiGate {
    static constexpr bool PERM = true, AFTER_DRAIN = false, AROWPERM = true;
    bf16* H; const float* cw; const float* cb; float* sideG; float* sideU;
    __device__ __forceinline__ void operator()(const pg8::f32x4 (&acc)[2][2][4][2], const pg8::Unit& u, int wr, int wc, int fr, int fq) const {
        const int hc0 = u.pn * 128 + wc * 32 + 8 * fq;
        f32x4 w0[2], w1[2], w2[2], bb[2];
#pragma unroll
        for (int n = 0; n < 2; ++n) { w0[n] = *(const f32x4*)(cw + hc0 + 4 * n); w1[n] = *(const f32x4*)(cw + DFF + hc0 + 4 * n); w2[n] = *(const f32x4*)(cw + 2 * DFF + hc0 + 4 * n); bb[n] = *(const f32x4*)(cb + hc0 + 4 * n); }
        const size_t row0 = (size_t)u.pm * 256 + wr * 128 + fr;
        const f32x4 zero4 = (f32x4){0.f, 0.f, 0.f, 0.f};
#pragma unroll
        for (int blk = 0; blk < 8; ++blk) {
            const int ai = blk >> 2, m = blk & 3;
            float r[8];
#pragma unroll
            for (int n = 0; n < 2; ++n) {
                const f32x4 x = acc[ai][0][m][n];
                const f32x4 xp = blk > 0 ? acc[(blk - 1) >> 2][0][(blk - 1) & 3][n] : zero4;
                const f32x4 xn = blk < 7 ? acc[(blk + 1) >> 2][0][(blk + 1) & 3][n] : zero4;
                const f32x4 uu = acc[ai][1][m][n];
#pragma unroll
                for (int j = 0; j < 4; ++j) {
                    const float pre = bb[n][j] + w0[n][j] * dpp_prev(x[j], xp[j]) + w1[n][j] * x[j] + w2[n][j] * dpp_next(x[j], xn[j]);
                    r[4 * n + j] = gelu_tanh(pre) * uu[j];
                }
            }
            v4u o; o.x = pk2(r[0], r[1]); o.y = pk2(r[2], r[3]); o.z = pk2(r[4], r[5]); o.w = pk2(r[6], r[7]);
            *(v4u*)(H + (row0 + 16 * blk) * DFF + hc0) = o;
        }
        float* sg = sideG + ((size_t)u.pm * SIDE_G_ROWS + 4 * wr) * DFF + hc0;
        float* su = sideU + ((size_t)u.pm * SIDE_U_ROWS + 2 * wr) * DFF + hc0;
        if (fr < 2) { *(f32x4*)(sg + (size_t)fr * DFF) = acc[0][0][0][0]; *(f32x4*)(sg + (size_t)fr * DFF + 4) = acc[0][0][0][1]; }
        if (fr >= 14) { *(f32x4*)(sg + (size_t)(fr - 12) * DFF) = acc[1][0][3][0]; *(f32x4*)(sg + (size_t)(fr - 12) * DFF + 4) = acc[1][0][3][1]; }
        if (fr == 0) { *(f32x4*)su = acc[0][1][0][0]; *(f32x4*)(su + 4) = acc[0][1][0][1]; }
        if (fr == 15) { *(f32x4*)(su + DFF) = acc[1][1][3][0]; *(f32x4*)(su + DFF + 4) = acc[1][1][3][1]; }
    }
};
__device__ __forceinline__ void gate_fixup(const float* sideG, const float* sideU, const float* cw, const float* cb, bf16* H, int gtid, int nthreads) {
    constexpr int C4 = DFF / 4, NT = NTOK / 256;
    for (int idx = gtid; idx < NT * 4 * C4; idx += nthreads) {
        const int c = (idx % C4) * 4, k = (idx / C4) & 3, pm = idx / (4 * C4);
        const float* g = sideG + (size_t)pm * SIDE_G_ROWS * DFF + c;
        f32x4 prev, cur, next; int row;
        const f32x4 z = (f32x4){0.f, 0.f, 0.f, 0.f};
        if (k == 0) { row = 0; prev = (pm % 32 == 0) ? z : *(const f32x4*)(g - (size_t)SIDE_G_ROWS * DFF + 7 * (size_t)DFF); cur = *(const f32x4*)g; next = *(const f32x4*)(g + DFF); }
        else if (k == 1) { row = 127; prev = *(const f32x4*)(g + 2 * (size_t)DFF); cur = *(const f32x4*)(g + 3 * (size_t)DFF); next = *(const f32x4*)(g + 4 * (size_t)DFF); }
        else if (k == 2) { row = 128; prev = *(const f32x4*)(g + 3 * (size_t)DFF); cur = *(const f32x4*)(g + 4 * (size_t)DFF); next = *(const f32x4*)(g + 5 * (size_t)DFF); }
        else { row = 255; prev = *(const f32x4*)(g + 6 * (size_t)DFF); cur = *(const f32x4*)(g + 7 * (size_t)DFF); next = (pm % 32 == 31) ? z : *(const f32x4*)(g + (size_t)SIDE_G_ROWS * DFF); }
        const f32x4 uu = *(const f32x4*)(sideU + ((size_t)pm * SIDE_U_ROWS + k) * DFF + c);
        const f32x4 w0 = *(const f32x4*)(cw + c), w1 = *(const f32x4*)(cw + DFF + c), w2 = *(const f32x4*)(cw + 2 * DFF + c), b = *(const f32x4*)(cb + c);
        float r[4];
#pragma unroll
        for (int j = 0; j < 4; ++j) r[j] = gelu_tanh(b[j] + w0[j] * prev[j] + w1[j] * cur[j] + w2[j] * next[j]) * uu[j];
        v2u o; o.x = pk2(r[0], r[1]); o.y = pk2(r[2], r[3]);
        *(v2u*)(H + ((size_t)pm * 256 + row) * DFF + c) = o;
    }
}
constexpr int LDS_PHASE_BYTES = 143360;
constexpr int LDSCTL_OFF = LDS_PHASE_BYTES, LDS_BYTES = 147456;
constexpr int CW_BAR = 4096;
constexpr size_t CTL_ZERO_BYTES = 64 * 1024;
static_assert(HY_LDS_BYTES <= LDS_PHASE_BYTES && RG_LDS_BYTES <= LDS_PHASE_BYTES && MN_LDS_BYTES <= LDS_PHASE_BYTES && pg8::STAGE_BYTES <= LDS_PHASE_BYTES, "LDS map");
static_assert((CW_BAR + XCD_BAR_WORDS) * 4 <= (int)CTL_ZERO_BYTES, "control words inside the memset region");

struct MkArgs { const float* in[32]; float* out; unsigned char* ws; };
__device__ __forceinline__ pg8::Gemm dgemm(const bf16* A, const bf16* Bt, int M, int N, int K, int lda, int ldb) { pg8::Gemm g; g.A = A; g.Bt = Bt; g.M = M; g.N = N; g.K = K; g.lda = lda; g.ldb = ldb; return g; }
__device__ __forceinline__ pg8::EpiBf16<0> depi(bf16* O, int ldc) { pg8::EpiBf16<0> e; e.O = O; e.ldc = ldc; e.bias = nullptr; e.split_cols = 0; e.split_stride = 0; e.scale0 = 1.f; return e; }

__device__ __forceinline__ void gate_seq(const bf16* gu, const float* cw, const float* cb, bf16* h, int gtid, int nthreads) {
    constexpr int CG = DFF / 8;
    for (int idx = gtid; idx < SEQL * CG; idx += nthreads) {
        const int m = idx / CG, c0 = (idx % CG) * 8;
        const v4u z = (v4u){0u, 0u, 0u, 0u};
        const v4u gm = m > 0 ? *(const v4u*)(gu + (size_t)(m - 1) * 2 * DFF + c0) : z;
        const v4u g0 = *(const v4u*)(gu + (size_t)m * 2 * DFF + c0);
        const v4u gp = m < SEQL - 1 ? *(const v4u*)(gu + (size_t)(m + 1) * 2 * DFF + c0) : z;
        const v4u uu = *(const v4u*)(gu + (size_t)m * 2 * DFF + DFF + c0);
        float r[8];
#pragma unroll
        for (int e = 0; e < 8; ++e) {
            const unsigned wm = e < 2 ? gm.x : e < 4 ? gm.y : e < 6 ? gm.z : gm.w, w0 = e < 2 ? g0.x : e < 4 ? g0.y : e < 6 ? g0.z : g0.w, wp = e < 2 ? gp.x : e < 4 ? gp.y : e < 6 ? gp.z : gp.w, wu = e < 2 ? uu.x : e < 4 ? uu.y : e < 6 ? uu.z : uu.w;
            const float a = (e & 1) ? bfhi(wm) : bflo(wm), b = (e & 1) ? bfhi(w0) : bflo(w0), c = (e & 1) ? bfhi(wp) : bflo(wp), u = (e & 1) ? bfhi(wu) : bflo(wu);
            const float pre = cb[c0 + e] + cw[c0 + e] * a + cw[DFF + c0 + e] * b + cw[2 * DFF + c0 + e] * c;
            r[e] = gelu_tanh(pre) * u;
        }
        v4u o; o.x = pk2(r[0], r[1]); o.y = pk2(r[2], r[3]); o.z = pk2(r[4], r[5]); o.w = pk2(r[6], r[7]);
        *(v4u*)(h + (size_t)m * DFF + c0) = o;
    }
}

#if defined(__HIP_DEVICE_COMPILE__)
#define MK_NOPK __attribute__((target("no-packed-fp32-ops")))
#else
#define MK_NOPK
#endif
__global__ void __launch_bounds__(512, 2) MK_NOPK mk_fwd(MkArgs args) {
    extern __shared__ __attribute__((aligned(16))) unsigned char lds_raw[];
    LAS unsigned char* lds = (LAS unsigned char*)lds_raw;
    const int tid = threadIdx.x, lane = tid & 63, wave = __builtin_amdgcn_readfirstlane(tid >> 6);
    const int G = gridDim.x, bx = blockIdx.x;
    unsigned char* ws = args.ws;
    const float* const* in = args.in;
    volatile LAS unsigned* MISC = (volatile LAS unsigned*)(lds + LDSCTL_OFF);
    for (int u = tid; u < (LDS_BYTES - LDSCTL_OFF) / 4; u += 512) ((LAS unsigned*)(lds + LDSCTL_OFF))[u] = 0u;
    wg_sync();
    XcdBarrier bar = xcd_barrier_post((unsigned*)(ws + WS_CTL) + CW_BAR, MISC + 8);

    bf16* XN = (bf16*)(ws + WS_XN); bf16* WIN = (bf16*)(ws + WS_WIN);
    {
        ProArgs pa; pa.xp = in[0]; pa.xs = in[1]; pa.g_premix = in[2]; pa.w_in = in[3]; pa.w_out = in[24]; pa.w_ffi = in[27]; pa.w_ffo = in[30]; pa.rg_a_w = in[6]; pa.rg_x_w = in[8];
        pa.hy_w1 = in[13]; pa.hy_b1 = in[14]; pa.hy_w2 = in[15]; pa.hy_b2 = in[16]; pa.hy_w3 = in[17]; pa.hy_b3 = in[18]; pa.hy_freq = in[20]; pa.ws = ws;
        p0_prologue<true>(pa, lds, bx * 8 + wave, G * 8, wave, lane);
    }
    xcd_barrier(bar);
    {
        pg8::StaticOrder S; S.init(NTOK, 2 * DRG, G, bx);
        pg8::gemm_phase<pg8::EpiBf16<0>, pg8::StaticOrder, true, true>(lds, dgemm(XN, WIN, NTOK, 2 * DRG, DM, LDK, LDK), S, depi((bf16*)(ws + WS_PRG), 2 * DRG));
    }
    {
        pg8::StaticOrder S; S.init(3 * DHY, NTOK, G, bx);
        pg8::gemm_phase<pg8::EpiBf16<0>, pg8::StaticOrder, true, true>(lds, dgemm(WIN + (size_t)2 * DRG * LDK, XN, 3 * DHY, NTOK, DM, LDK, LDK), S, depi((bf16*)(ws + WS_PHY), NTOK));
    }
    xcd_barrier(bar);
    RgArgs ra; ra.prg = (const bf16*)(ws + WS_PRG); ra.conv_w = in[4]; ra.conv_b = in[5]; ra.rgw = (const bf16*)(ws + WS_RGW); ra.a_b = in[7]; ra.x_b = in[9]; ra.lam = in[10];
    ra.summ = (f32x2*)(ws + WS_SUMM); ra.rgy = (bf16*)(ws + WS_RGY);
    {
        HyArgs a; a.phy = (const bf16*)(ws + WS_PHY); a.conv_w = in[11]; a.conv_b = in[12]; a.w4 = in[19]; a.hy_bias = in[21]; a.h3h = (const bf16*)(ws + WS_H3); a.tw = (const f32x2*)(ws + WS_TW);
        a.zk = (f32x2*)(ws + WS_ZK); a.hyy = (bf16*)(ws + WS_HYY);
        for (int cp = bx; cp < DHY / 2; cp += G) hyena_unit(a, lds, cp, bx, tid);
    }
    for (int u = bx; u < RG_UNITS; u += G) rg_unit<1>(ra, lds, u, tid);
    xcd_barrier(bar);
    for (int u = bx; u < RG_UNITS; u += G) rg_unit<2>(ra, lds, u, tid);
    xcd_barrier(bar);
    for (int m = bx * 8 + wave; m < NTOK; m += G * 8) mixnorm_rg_row((const bf16*)(ws + WS_RGY), in[22], (bf16*)(ws + WS_MIX), m, lane);
    for (int t = bx; t < NTOK / 64; t += G) mixnorm_hy_tile((const bf16*)(ws + WS_HYY), in[23], (bf16*)(ws + WS_MIX), lds, t, tid);
    xcd_barrier(bar);
    {
        pg8::StaticOrder S; S.init(NTOK, DM, G, bx);
        pg8::gemm_phase<pg8::EpiBf16<0>, pg8::StaticOrder, true, true>(lds, dgemm((bf16*)(ws + WS_MIX), (bf16*)(ws + WS_WOUT), NTOK, DM, DM, LDK, LDK), S, depi((bf16*)(ws + WS_Y), DM));
    }
    xcd_barrier(bar);
    for (int m = bx * 8 + wave; m < NTOK; m += G * 8) rowpass1(xrow_ptr(in[0], in[1], m), (const bf16*)(ws + WS_Y) + (size_t)m * DM, in[25], in[26], args.out + (size_t)m * DM, XN + (size_t)m * LDK, lane);
    xcd_barrier(bar);
    bf16* HB = (bf16*)(ws + WS_H);
    {
        pg8::StaticOrder S; S.init(NTOK, 2 * DFF, G, bx);
        EpiGate E; E.H = HB; E.cw = in[28]; E.cb = in[29]; E.sideG = (float*)(ws + WS_SIDEG); E.sideU = (float*)(ws + WS_SIDEU);
        pg8::gemm_phase<EpiGate, pg8::StaticOrder, true, true>(lds, dgemm(XN, (bf16*)(ws + WS_WFI), NTOK, 2 * DFF, DM, LDK, LDK), S, E);
    }
    xcd_barrier(bar);
    { int tq = tid; asm volatile("" : "+v"(tq)); gate_fixup((const float*)(ws + WS_SIDEG), (const float*)(ws + WS_SIDEU), in[28], in[29], HB, bx * 512 + tq, G * 512); }
    xcd_barrier(bar);
    {
        pg8::StaticOrder S; S.init(NTOK, DM, G, bx);
        pg8::gemm_phase<pg8::EpiBf16<0>, pg8::StaticOrder, true, true>(lds, dgemm(HB, (bf16*)(ws + WS_WFO), NTOK, DM, DFF, DFF, DFF), S, depi((bf16*)(ws + WS_F), DM));
    }
    xcd_barrier(bar);
    for (int m = bx * 8 + wave; m < NTOK; m += G * 8) rowpass2((const bf16*)(ws + WS_F) + (size_t)m * DM, in[31], args.out + (size_t)m * DM, lane);
}

extern "C" void kernel_launch(void* const* d_in, const int* in_sizes, int n_in, void* d_out, int out_size, void* d_ws, size_t ws_size, hipStream_t stream) {
    static int grid = 0;
    if (grid == 0) {
        grid = -1;
        if (n_in != 32 || out_size != NTOK * DM || ws_size < WS_END) { fprintf(stderr, "kernel_launch: unexpected sizes n_in %d out %d ws %zu (need %zu)\n", n_in, out_size, ws_size, (size_t)WS_END); return; }
        int dev = 0, cus = 0, per_cu = 0;
        if (hipGetDevice(&dev) != hipSuccess || hipDeviceGetAttribute(&cus, hipDeviceAttributeMultiprocessorCount, dev) != hipSuccess) return;
        if (hipFuncSetAttribute((const void*)mk_fwd, hipFuncAttributeMaxDynamicSharedMemorySize, LDS_BYTES) != hipSuccess) { fprintf(stderr, "kernel_launch: hipFuncSetAttribute failed\n"); return; }
        if (hipOccupancyMaxActiveBlocksPerMultiprocessor(&per_cu, (const void*)mk_fwd, 512, LDS_BYTES) != hipSuccess || per_cu < 1) { fprintf(stderr, "kernel_launch: occupancy query says %d blocks per CU\n", per_cu); (void)hipGetLastError(); return; }
        grid = cus;
    }
    if (grid < 0) return;
    if (hipMemsetAsync((char*)d_ws + WS_CTL, 0, CTL_ZERO_BYTES, stream) != hipSuccess) return;
    MkArgs a; memset(&a, 0, sizeof a);
    for (int i = 0; i < 32; ++i) a.in[i] = (const float*)d_in[i];
    a.out = (float*)d_out; a.ws = (unsigned char*)d_ws;
    hipLaunchKernelGGL(mk_fwd, dim3(grid), dim3(512), LDS_BYTES, stream, a);
}
```

```cpp
#include <hip/hip_runtime.h>
#include <cstdio>
#include <cstdint>
#include <cstring>
namespace pg8 {
#define PG8_LAS __attribute__((address_space(3)))
typedef unsigned short bf16_t;
typedef short bf16x8 __attribute__((ext_vector_type(8)));
typedef float f32x4 __attribute__((ext_vector_type(4)));
typedef unsigned u32x4 __attribute__((ext_vector_type(4)));
constexpr int BM = 256, BK = 64, HALF = 128, HTB = HALF * BK * 2  , STAGE_BYTES = 8 * HTB, NXCD = 8, WGM = 8;

__host__ __device__ __forceinline__ int lds_byte(int r, int c) { const int st = (r >> 4) * 2 + (c >> 5), rr = r & 15, cc = c & 31, ob = rr * 64 + cc * 2; return st * 1024 + (ob ^ (((ob >> 9) & 1) << 5)); }
__host__ __device__ __forceinline__ void stage_rc(int b, int& R, int& C) { const int st = b / 1024, sb = b % 1024, swz = sb ^ (((sb >> 9) & 1) << 5); R = (st >> 1) * 16 + swz / 64; C = (st & 1) * 32 + (swz % 64) / 2; }
__host__ __device__ __forceinline__ int perm32(int rho) { const int n = rho >> 4, i = rho & 15; return 8 * (i >> 2) + 4 * n + (i & 3); }

struct Unit { int pm, pn; };
struct Gemm { const bf16_t* A; const bf16_t* Bt; int M, N, K, lda, ldb; };

struct StaticOrder {
    int nM, nN, nwg, G, c;
    __host__ __device__ __forceinline__ void init(int M, int N, int G_, int c_) { nM = M / BM; nN = N / BM; nwg = nM * nN; G = G_; c = c_; }
    __host__ __device__ __forceinline__ bool next(int i, Unit& u) const {
        const long L = (long)i * G + c; if (L >= nwg) return false;
        int wgid = (int)L; { const int q = nwg / NXCD, r = nwg % NXCD, xcd = wgid % NXCD, off = wgid / NXCD; wgid = (xcd < r ? xcd * (q + 1) : r * (q + 1) + (xcd - r) * q) + off; }
        const int nig = WGM * nN, gid = wgid / nig, fm = gid * WGM, gsz = (nM - fm) < WGM ? (nM - fm) : WGM;
        u.pm = fm + ((wgid % nig) % gsz); u.pn = (wgid % nig) / gsz; return true;
    }
    __device__ __forceinline__ void a_ready(const Unit&, int) const {}
    __device__ __forceinline__ void done(const Unit&) const {}
};

__device__ __forceinline__ unsigned cvt_pk_bf16(float lo, float hi) { unsigned r; asm volatile("v_cvt_pk_bf16_f32 %0, %1, %2" : "=v"(r) : "v"(lo), "v"(hi)); return r; }
typedef float f32x2 __attribute__((ext_vector_type(2)));
__device__ __forceinline__ f32x2 gelu_pk(f32x2 v) {
    const f32x2 av = __builtin_elementwise_abs(v), d = av * 0.2316418882f + 1.0f;
    f32x2 t; t.x = __builtin_amdgcn_rcpf(d.x); t.y = __builtin_amdgcn_rcpf(d.y);
    f32x2 q = t * 0.5307027145f + (-0.7265760135f); q = q * t + 0.7107068705f; q = q * t + (-0.142248368f); q = q * t + 0.127414796f; q = q * t;
    const f32x2 s = (v * v) * (-0.72134752044f);
    f32x2 e; e.x = __builtin_amdgcn_exp2f(s.x); e.y = __builtin_amdgcn_exp2f(s.y);
    const f32x2 m = v * (q * e), r = v - m;
    f32x2 o; o.x = v.x < 0.f ? m.x : r.x; o.y = v.y < 0.f ? m.y : r.y; return o;
}

template <int ACT  > struct EpiBf16 {
    static constexpr bool PERM = true, AFTER_DRAIN = false, AROWPERM = false; static_assert(ACT == 0 || ACT == 1, "EpiBf16: ACT is 0 (none) or 1 (gelu_pk)");
    bf16_t* O; int ldc; const float* bias; int split_cols; size_t split_stride; float scale0;
    __device__ __forceinline__ void operator()(const f32x4 (&acc)[2][2][4][2], const Unit& u, int wr, int wc, int fr, int fq) const {
        const int row0 = u.pm * BM + wr * 64 + fr; int colt = u.pn * BM; bf16_t* base = O;
        float sc = 1.f; if (split_cols) { const int t = colt / split_cols; base += (size_t)t * split_stride; colt -= t * split_cols; if (t == 0) sc = scale0; }
        const int col0 = colt + wc * 32 + 8 * fq, bcol0 = u.pn * BM + wc * 32 + 8 * fq;
        f32x4 bv[2][2];
#pragma unroll
        for (int bj = 0; bj < 2; ++bj)
#pragma unroll
            for (int n = 0; n < 2; ++n) bv[bj][n] = bias ? *(const f32x4*)(bias + bcol0 + bj * HALF + 4 * n) : (f32x4){0.f, 0.f, 0.f, 0.f};
#pragma unroll
        for (int ai = 0; ai < 2; ++ai)
#pragma unroll
            for (int m = 0; m < 4; ++m) { bf16_t* rowp = base + (size_t)(row0 + ai * HALF + m * 16) * ldc + col0;
#pragma unroll
                for (int bj = 0; bj < 2; ++bj) { f32x4 v0 = acc[ai][bj][m][0] + bv[bj][0], v1 = acc[ai][bj][m][1] + bv[bj][1];
                    if (ACT == 1) { f32x2 a = gelu_pk((f32x2){v0[0], v0[1]}), b = gelu_pk((f32x2){v0[2], v0[3]}), c = gelu_pk((f32x2){v1[0], v1[1]}), d = gelu_pk((f32x2){v1[2], v1[3]});
                        v0 = (f32x4){a.x, a.y, b.x, b.y}; v1 = (f32x4){c.x, c.y, d.x, d.y}; }
                    v0 = v0 * sc; v1 = v1 * sc; u32x4 w; w.x = cvt_pk_bf16(v0[0], v0[1]); w.y = cvt_pk_bf16(v0[2], v0[3]); w.z = cvt_pk_bf16(v1[0], v1[1]); w.w = cvt_pk_bf16(v1[2], v1[3]);
                    *(u32x4*)(rowp + bj * HALF) = w; } }
    }
};
template <class Epi, class Sched, bool ALIGN_EPI = false, bool SP2 = false>
__device__ __forceinline__ void gemm_phase(PG8_LAS unsigned char* lds, const Gemm g, const Sched& S, const Epi& E) {
    int tid_ = threadIdx.x; asm volatile("" : "+v"(tid_));
    const int tid = tid_, wid = __builtin_amdgcn_readfirstlane(tid >> 6), lane = tid & 63, wr = wid >> 2, wc = wid & 3, fr = lane & 15, fq = lane >> 4;
    const int K = g.K, nt = K / BK;
    unsigned voffA[2], voffB[2];
#pragma unroll
    for (int i = 0; i < 2; ++i) { int R, C; stage_rc(tid * 16 + i * 8192, R, C); const int Rb = Epi::PERM ? ((R & ~31) + perm32(R & 31)) : R; const int Ra = Epi::AROWPERM ? (128 * (R >> 6) + (R & 63)) : R;
        voffA[i] = (unsigned)(Ra * g.lda + C) * 2u; voffB[i] = (unsigned)(Rb * g.ldb + C) * 2u; }
    const size_t kstep = (size_t)(BK * 2);
    const size_t hstep = (size_t)HALF * g.ldb * 2;
    const size_t hstepA = (size_t)(Epi::AROWPERM ? 64 : HALF) * g.lda * 2;
    const size_t tstep = 2 * hstep, tstepA = (size_t)BM * g.lda * 2;
    const unsigned ldsw = (unsigned)wid * 1024u;
    const int aoff = lds_byte(wr * 64 + fr, fq * 8), boff = lds_byte(wc * 32 + fr, fq * 8);
#define PG8_SA(b, h) (((b) * 2 + (h)) * HTB)
#define PG8_SB(b, h) ((4 + (b) * 2 + (h)) * HTB)
#define PG8_STAGE(bufoff, gbase, voff) do { _Pragma("unroll") for (int _i = 0; _i < 2; ++_i) \
        __builtin_amdgcn_global_load_lds((const unsigned*)((const char*)(gbase) + (voff)[_i]), (PG8_LAS unsigned*)(lds + (bufoff) + ldsw + _i * 8192), 16, 0, 0); } while (0)
#define PG8_LDA(dst, b, h) do { _Pragma("unroll") for (int m = 0; m < 4; ++m) _Pragma("unroll") for (int k = 0; k < 2; ++k) dst[m][k] = *(const PG8_LAS bf16x8*)(lds + PG8_SA(b, h) + aoff + m * 2048 + k * 1024); } while (0)
#define PG8_LDB(dst, b, h) do { _Pragma("unroll") for (int n = 0; n < 2; ++n) _Pragma("unroll") for (int k = 0; k < 2; ++k) dst[n][k] = *(const PG8_LAS bf16x8*)(lds + PG8_SB(b, h) + boff + n * 2048 + k * 1024); } while (0)
#define PG8_MMA(ai, bj, At, Bt) do { __builtin_amdgcn_s_setprio(1); _Pragma("unroll") for (int m = 0; m < 4; ++m) _Pragma("unroll") for (int n = 0; n < 2; ++n) _Pragma("unroll") for (int k = 0; k < 2; ++k) \
        acc[ai][bj][m][n] = __builtin_amdgcn_mfma_f32_16x16x32_bf16(Bt[n][k], At[m][k], acc[ai][bj][m][n], 0, 0, 0); __builtin_amdgcn_s_setprio(0); } while (0)
#define PG8_WAIT_V(n) asm volatile("s_waitcnt vmcnt(" #n ")" ::: "memory")
#define PG8_WAIT_L(n) asm volatile("s_waitcnt lgkmcnt(" #n ")" ::: "memory")
#define PG8_BAR __builtin_amdgcn_s_barrier()
#define PG8_SCHED __builtin_amdgcn_sched_barrier(0)
    Unit cur, nxt; int ui = 0;
    if (!S.next(0, cur)) return;
    f32x4 acc[2][2][4][2];
#pragma unroll
    for (int a = 0; a < 2; ++a)
#pragma unroll
        for (int b = 0; b < 2; ++b)
#pragma unroll
            for (int m = 0; m < 4; ++m)
#pragma unroll
                for (int n = 0; n < 2; ++n) acc[a][b][m][n] = (f32x4){0.f, 0.f, 0.f, 0.f};
    bf16x8 At[4][2], B0[2][2], B1[2][2];
    const char* cA = (const char*)g.A + (size_t)cur.pm * tstepA; const char* cB = (const char*)g.Bt + (size_t)cur.pn * tstep;
    S.a_ready(cur, 0);
    if constexpr (SP2) {
        PG8_STAGE(PG8_SB(0, 0), cB, voffB); PG8_STAGE(PG8_SB(0, 1), cB + hstep, voffB); PG8_STAGE(PG8_SA(0, 0), cA, voffA); PG8_STAGE(PG8_SA(0, 1), cA + hstepA, voffA);
        if (wr == 1) PG8_BAR;
        PG8_WAIT_V(2); PG8_BAR;
        PG8_STAGE(PG8_SB(1, 0), cB + kstep, voffB); PG8_STAGE(PG8_SA(1, 0), cA + kstep, voffA); PG8_STAGE(PG8_SB(1, 1), cB + hstep + kstep, voffB);
        PG8_WAIT_V(6); PG8_BAR;
    } else {
        PG8_STAGE(PG8_SB(0, 0), cB, voffB); PG8_STAGE(PG8_SA(0, 0), cA, voffA); PG8_STAGE(PG8_SB(0, 1), cB + hstep, voffB); PG8_STAGE(PG8_SA(0, 1), cA + hstepA, voffA);
        if (wr == 1) PG8_BAR;
        PG8_WAIT_V(4); PG8_BAR;
        PG8_STAGE(PG8_SB(1, 0), cB + kstep, voffB); PG8_STAGE(PG8_SA(1, 0), cA + kstep, voffA); PG8_STAGE(PG8_SB(1, 1), cB + hstep + kstep, voffB);
        PG8_WAIT_V(6); PG8_BAR;
    }
    for (;;) {
        const bool has_next = S.next(ui + 1, nxt);
        const char* nA = has_next ? (const char*)g.A + (size_t)nxt.pm * tstepA : cA; const char* nB = has_next ? (const char*)g.Bt + (size_t)nxt.pn * tstep : cB;
        for (int t = 0; t < nt; t += 2) {
            const bool last = (t == nt - 2);
            const char* a1 = cA + (size_t)(t + 1) * kstep;
            const char* a2 = last ? nA : cA + (size_t)(t + 2) * kstep; const char* b2 = last ? nB : cB + (size_t)(t + 2) * kstep;
            const char* a3 = a2 + kstep; const char* b3 = b2 + kstep;
            if (last && has_next) S.a_ready(nxt, ui + 1);
            if constexpr (SP2) {
            PG8_LDB(B0, 0, 0); PG8_LDB(B1, 0, 1); PG8_SCHED; PG8_LDA(At, 0, 0); PG8_STAGE(PG8_SA(1, 1), a1 + hstepA, voffA);
            PG8_WAIT_V(8); PG8_WAIT_L(0); PG8_BAR; PG8_MMA(0, 0, At, B0); PG8_MMA(0, 1, At, B1); PG8_BAR; PG8_SCHED;
            PG8_LDA(At, 0, 1); PG8_STAGE(PG8_SB(0, 0), b2, voffB); PG8_STAGE(PG8_SB(0, 1), b2 + hstep, voffB); PG8_STAGE(PG8_SA(0, 0), a2, voffA);
            PG8_WAIT_V(8); PG8_WAIT_L(0); PG8_BAR; PG8_MMA(1, 0, At, B0); PG8_MMA(1, 1, At, B1); PG8_BAR; PG8_SCHED;
            PG8_LDB(B0, 1, 0); PG8_LDB(B1, 1, 1); PG8_SCHED; PG8_LDA(At, 1, 0); PG8_STAGE(PG8_SA(0, 1), a2 + hstepA, voffA);
            PG8_WAIT_V(8); PG8_WAIT_L(0); PG8_BAR; PG8_MMA(0, 0, At, B0); PG8_MMA(0, 1, At, B1); PG8_BAR; PG8_SCHED;
            PG8_LDA(At, 1, 1); PG8_STAGE(PG8_SB(1, 0), b3, voffB); PG8_STAGE(PG8_SB(1, 1), b3 + hstep, voffB); PG8_STAGE(PG8_SA(1, 0), a3, voffA);
            PG8_WAIT_V(8); PG8_WAIT_L(0); PG8_BAR; PG8_MMA(1, 0, At, B0); PG8_MMA(1, 1, At, B1); PG8_BAR; PG8_SCHED;
            } else {
            PG8_LDB(B0, 0, 0); PG8_SCHED; PG8_LDA(At, 0, 0); PG8_STAGE(PG8_SA(1, 1), a1 + hstepA, voffA);
            PG8_WAIT_L(8); PG8_BAR; PG8_WAIT_L(0); PG8_MMA(0, 0, At, B0); PG8_BAR; PG8_SCHED;
            PG8_LDB(B1, 0, 1); PG8_STAGE(PG8_SB(0, 0), b2, voffB);
            PG8_BAR; PG8_WAIT_L(0); PG8_MMA(0, 1, At, B1); PG8_BAR;
            PG8_LDA(At, 0, 1); PG8_STAGE(PG8_SA(0, 0), a2, voffA);
            PG8_BAR; PG8_WAIT_L(0); PG8_MMA(1, 0, At, B0); PG8_BAR; PG8_SCHED;
            PG8_STAGE(PG8_SB(0, 1), b2 + hstep, voffB);
            PG8_WAIT_V(6); PG8_BAR; PG8_MMA(1, 1, At, B1); PG8_BAR;
            PG8_LDB(B0, 1, 0); PG8_SCHED; PG8_LDA(At, 1, 0); PG8_STAGE(PG8_SA(0, 1), a2 + hstepA, voffA);
            PG8_WAIT_L(8); PG8_BAR; PG8_WAIT_L(0); PG8_MMA(0, 0, At, B0); PG8_BAR; PG8_SCHED;
            PG8_LDB(B1, 1, 1); PG8_STAGE(PG8_SB(1, 0), b3, voffB);
            PG8_BAR; PG8_WAIT_L(0); PG8_MMA(0, 1, At, B1); PG8_BAR;
            PG8_LDA(At, 1, 1); PG8_STAGE(PG8_SA(1, 0), a3, voffA);
            PG8_BAR; PG8_WAIT_L(0); PG8_MMA(1, 0, At, B0); PG8_BAR; PG8_SCHED;
            PG8_STAGE(PG8_SB(1, 1), b3 + hstep, voffB);
            PG8_WAIT_V(6); PG8_BAR; PG8_MMA(1, 1, At, B1); PG8_BAR;
            }
        }
        if constexpr (ALIGN_EPI) { if (wr == 0) PG8_BAR; }
        if constexpr (!Epi::AFTER_DRAIN) { E(acc, cur, wr, wc, fr, fq); S.done(cur); }
        if (!has_next) break;
#pragma unroll
        for (int a = 0; a < 2; ++a)
#pragma unroll
            for (int b = 0; b < 2; ++b)
#pragma unroll
                for (int m = 0; m < 4; ++m)
#pragma unroll
                    for (int n = 0; n < 2; ++n) acc[a][b][m][n] = (f32x4){0.f, 0.f, 0.f, 0.f};
        cur = nxt; cA = nA; cB = nB; ++ui;
        if constexpr (ALIGN_EPI) { if (wr == 1) PG8_BAR; }
    }
    PG8_WAIT_V(0);
    if constexpr (!ALIGN_EPI) { if (wr == 0) PG8_BAR; }
    PG8_BAR;
    if constexpr (Epi::AFTER_DRAIN) { E.fused(acc, cur, wr, wc, fr, fq, lds, wid, lane); S.done(cur); }
#undef PG8_SA
#undef PG8_SB
#undef PG8_STAGE
#undef PG8_LDA
#undef PG8_LDB
#undef PG8_MMA
#undef PG8_WAIT_V
#undef PG8_WAIT_L
#undef PG8_BAR
#undef PG8_SCHED
}
}
constexpr int SEQL = 8192, NSEQ = 3, NTOK = NSEQ * SEQL;
constexpr int DM = 4096, DRG = 2048, DHY = 2048, NIN = 10240, DFF = 11008;
constexpr int NHEAD = 16, HDIM = 128;
constexpr float EPSN = 1e-6f;
constexpr int FFT_N = 16384;
constexpr int LDK = DM;

#define GAS __attribute__((address_space(1)))
#define LAS __attribute__((address_space(3)))
typedef unsigned short bf16;
typedef unsigned v4u __attribute__((ext_vector_type(4)));
typedef unsigned v2u __attribute__((ext_vector_type(2)));
typedef float f32x4 __attribute__((ext_vector_type(4)));
typedef float f32x2 __attribute__((ext_vector_type(2)));
typedef short bf16x8 __attribute__((ext_vector_type(8)));

__device__ __forceinline__ void wg_sync() { __builtin_amdgcn_fence(__ATOMIC_RELEASE, "workgroup"); __builtin_amdgcn_s_barrier(); __builtin_amdgcn_fence(__ATOMIC_ACQUIRE, "workgroup"); }
__device__ __forceinline__ void lds_sync() { asm volatile("s_waitcnt lgkmcnt(0)" ::: "memory"); __builtin_amdgcn_s_barrier(); asm volatile("" ::: "memory"); }
__device__ __forceinline__ unsigned f2bf(float f) { unsigned u = __builtin_bit_cast(unsigned, f); return (u + 0x7fffu + ((u >> 16) & 1u)) >> 16; }
__device__ __forceinline__ unsigned pk2(float lo, float hi) { return f2bf(lo) | (f2bf(hi) << 16); }
__device__ __forceinline__ float bf2f(unsigned b) { return __builtin_bit_cast(float, b << 16); }
__device__ __forceinline__ float bflo(unsigned w) { return __builtin_bit_cast(float, w << 16); }
__device__ __forceinline__ float bfhi(unsigned w) { return __builtin_bit_cast(float, w & 0xffff0000u); }
__device__ __forceinline__ float wave_sum(float v) {
#pragma unroll
    for (int o = 1; o < 64; o <<= 1) v += __shfl_xor(v, o);
    return v;
}
__device__ __forceinline__ float frcp(float x) { return __builtin_amdgcn_rcpf(x); }
__device__ __forceinline__ float fexp(float x) { return __builtin_amdgcn_exp2f(x * 1.4426950408889634f); }
__device__ __forceinline__ float sigmoidf_(float x) { return frcp(1.0f + fexp(-x)); }
__device__ __forceinline__ float gelu_tanh(float x) { const float u = 1.5957691216057308f * (x + 0.044715f * x * x * x); return x * frcp(1.0f + fexp(-u)); }

constexpr size_t MiB = 1u << 20;
constexpr size_t WS_CTL = 0;
constexpr size_t WS_TW = 1 * MiB;
constexpr size_t WS_H3 = 2 * MiB;
constexpr size_t WS_RGW = 4 * MiB;
constexpr size_t WS_SUMM = 6 * MiB;
constexpr size_t WS_WIN = 16 * MiB;
constexpr size_t WS_WOUT = 98 * MiB;
constexpr size_t WS_WFI = 131 * MiB;
constexpr size_t WS_WFO = 306 * MiB;
constexpr size_t WS_XN = 392 * MiB;
constexpr size_t WS_PRG = 588 * MiB;
constexpr size_t WS_PHY = 780 * MiB;
constexpr size_t WS_HYY = 1068 * MiB;
constexpr size_t WS_RGY = 1164 * MiB;
constexpr size_t WS_ZK = 1260 * MiB;
constexpr size_t WS_H = WS_PHY;
constexpr size_t WS_SIDEG = 1296 * MiB;
constexpr size_t WS_SIDEU = 1329 * MiB;
constexpr size_t WS_END = 1346 * MiB;
static_assert(WS_WIN + (size_t)NIN * LDK * 2 <= WS_WOUT && WS_WOUT + (size_t)DM * LDK * 2 <= WS_WFI && WS_WFI + (size_t)2 * DFF * LDK * 2 <= WS_WFO && WS_WFO + (size_t)DM * DFF * 2 <= WS_XN &&
              WS_XN + (size_t)NTOK * LDK * 2 <= WS_PRG && WS_PRG + (size_t)NTOK * DM * 2 <= WS_PHY && WS_PHY + (size_t)3 * DHY * NTOK * 2 <= WS_HYY && WS_PHY + (size_t)NTOK * LDK * 2 <= WS_HYY &&
              WS_HYY + (size_t)DHY * NTOK * 2 <= WS_RGY && WS_RGY + (size_t)NTOK * DRG * 2 <= WS_ZK && WS_ZK + (size_t)256 * 2 * FFT_N * 8 <= WS_END && WS_H + (size_t)NTOK * DFF * 2 <= WS_SIDEG &&
              WS_SIDEG + (size_t)96 * 8 * DFF * 4 <= WS_SIDEU && WS_SIDEU + (size_t)96 * 4 * DFF * 4 <= WS_END, "d_ws map");
constexpr size_t WS_MIX = WS_PHY;
constexpr size_t WS_Y = WS_PRG;
constexpr size_t WS_F = WS_PRG;
#define XB_TMO      128
#define XB_XCNT(j)  (256  + 64 * (j))
#define XB_XSUB(j)  (1280 + 64 * (j))
#define XB_XGEN(j)  (2304 + 64 * (j))
#define XB_TOP      3328
#define XB_TOPGEN   3392
#define XCD_BAR_WORDS 3456
#define XB_SPIN_CAP (1u << 18)

__device__ __forceinline__ unsigned xb_ld(unsigned* p)              { return __hip_atomic_load(p, __ATOMIC_RELAXED, __HIP_MEMORY_SCOPE_AGENT); }
__device__ __forceinline__ unsigned xb_add(unsigned* p, unsigned v) { return __hip_atomic_fetch_add(p, v, __ATOMIC_RELAXED, __HIP_MEMORY_SCOPE_AGENT); }
__device__ __forceinline__ unsigned xb_xcc_id() { return (unsigned)__builtin_amdgcn_s_getreg((3 << 11) | 20) & 0xFu; }
#define XB_SPIN(cond, bar) do { unsigned _sp = 0; while (cond) { __builtin_amdgcn_s_sleep(1); \
    if ((++_sp & 255u) == 0u) { if (xb_ld(&(bar)[XB_TMO])) break; if (_sp > XB_SPIN_CAP) { atomicAdd(&(bar)[XB_TMO], 1u); break; } } } } while (0)

struct XcdBarrier {
    unsigned* bar; unsigned x;
    volatile LAS unsigned* st;
};

__device__ __forceinline__ XcdBarrier xcd_barrier_post(unsigned* bar, volatile LAS unsigned* st) {
    XcdBarrier b; b.bar = bar; b.x = xb_xcc_id(); b.st = st;
    if (threadIdx.x == 0) (void)xb_add(&bar[XB_XCNT(b.x)], 1u);
    return b;
}
__device__ __forceinline__ void xcd_barrier_complete(unsigned* bar, unsigned x, unsigned& nloc, unsigned& nx) {
    const unsigned G = gridDim.x * gridDim.y * gridDim.z;
    unsigned sum, cnt, mine, sp = 0u;
    for (;;) {
        sum = 0u; cnt = 0u; mine = 0u;
#pragma unroll
        for (unsigned j = 0; j < 16; ++j) { const unsigned c = xb_ld(&bar[XB_XCNT(j)]); sum += c; cnt += (c > 0u) ? 1u : 0u; mine = (j == x) ? c : mine; }
        if (sum == G) break;
        __builtin_amdgcn_s_sleep(1);
        if ((++sp & 255u) == 0u) { if (xb_ld(&bar[XB_TMO])) break; if (sp > XB_SPIN_CAP) { atomicAdd(&bar[XB_TMO], 1u); break; } }
    }
    nloc = mine > 0u ? mine : 1u; nx = cnt > 0u ? cnt : 1u;
}

__device__ __forceinline__ void xcd_barrier(const XcdBarrier& b) {
    asm volatile("s_waitcnt vmcnt(0)" ::: "memory");
    wg_sync();
    if (threadIdx.x == 0) {
        unsigned* bar = b.bar;
        __builtin_amdgcn_s_waitcnt(0);
        unsigned nloc = b.st[0], nx = b.st[1];
        if (nloc == 0u) { xcd_barrier_complete(bar, b.x, nloc, nx); b.st[0] = nloc; b.st[1] = nx; }
        const unsigned old = xb_add(&bar[XB_XSUB(b.x)], 1u);
        const unsigned gen = old / nloc;
        if (old + 1u == (gen + 1u) * nloc) {
            __builtin_amdgcn_fence(__ATOMIC_RELEASE, "agent");
            asm volatile("s_waitcnt vmcnt(0)" ::: "memory");
            const unsigned og = xb_add(&bar[XB_TOP], 1u);
            const unsigned tg = og / nx;
            if (og + 1u == (tg + 1u) * nx) xb_add(&bar[XB_TOPGEN], 1u);
            else XB_SPIN(xb_ld(&bar[XB_TOPGEN]) == tg, bar);
            __builtin_amdgcn_fence(__ATOMIC_ACQUIRE, "agent");
            xb_add(&bar[XB_XGEN(b.x)], 1u);
            asm volatile("s_waitcnt vmcnt(0)" ::: "memory");
        } else {
            XB_SPIN(xb_ld(&bar[XB_XGEN(b.x)]) == gen, bar);
            __builtin_amdgcn_fence(__ATOMIC_ACQUIRE, "agent");
            asm volatile("s_waitcnt vmcnt(0)" ::: "memory");
        }
    }
    wg_sync();
}
struct TrItem { const float* W; bf16* WT; int K, N, k0, n0, drow0, ldt; };
__device__ __forceinline__ void tr_load(const TrItem& t, int lane, f32x4 (&v)[8]) {
    const float* p = t.W + (size_t)(t.k0 + (lane >> 3)) * t.N + t.n0 + (lane & 7) * 4;
#pragma unroll
    for (int ii = 0; ii < 8; ++ii) v[ii] = __builtin_nontemporal_load((const f32x4*)(p + (size_t)8 * ii * t.N));
}
__device__ __forceinline__ void tr_store(const TrItem& t, int lane, const f32x4 (&v)[8], LAS float* scr) {
    LAS float* w = scr + (lane >> 3) * 33 + (lane & 7) * 4;
#pragma unroll
    for (int ii = 0; ii < 8; ++ii) { w[ii * 8 * 33 + 0] = v[ii].x; w[ii * 8 * 33 + 1] = v[ii].y; w[ii * 8 * 33 + 2] = v[ii].z; w[ii * 8 * 33 + 3] = v[ii].w; }
    asm volatile("s_waitcnt lgkmcnt(0)" ::: "memory");
    const int c = lane & 7;
#pragma unroll
    for (int j = 0; j < 4; ++j) { const int n = (lane >> 3) + 8 * j; const LAS float* s = scr + (8 * c) * 33 + n;
        v4u o; o.x = pk2(s[0 * 33], s[1 * 33]); o.y = pk2(s[2 * 33], s[3 * 33]); o.z = pk2(s[4 * 33], s[5 * 33]); o.w = pk2(s[6 * 33], s[7 * 33]);
        *(v4u*)(t.WT + (size_t)(t.drow0 + n) * t.ldt + t.k0 + 8 * c) = o; }
    asm volatile("s_waitcnt lgkmcnt(0)" ::: "memory");
}
template <bool INTER> __device__ __forceinline__ int ffi_drow(int n) {
    if (!INTER) return n;
    const int up = n >= DFF ? 1 : 0, c = n - up * DFF; return (c >> 7) * 256 + up * 128 + (c & 127);
}
struct ProArgs {
    const float *xp, *xs, *g_premix;
    const float *w_in, *w_out, *w_ffi, *w_ffo;
    const float *rg_a_w, *rg_x_w;
    const float *hy_w1, *hy_b1, *hy_w2, *hy_b2, *hy_w3, *hy_b3, *hy_freq;
    unsigned char* ws;
};
__device__ __forceinline__ const float* xrow_ptr(const float* xp, const float* xs, int m) { return m < SEQL ? xp + (size_t)m * DM : xs + (size_t)(m - SEQL) * DM; }

template <bool INTER> __device__ __forceinline__ void p0_prologue(const ProArgs& a, LAS unsigned char* lds, int gw, int NGW, int wave, int lane) {
    bf16* WIN = (bf16*)(a.ws + WS_WIN); bf16* WOUT = (bf16*)(a.ws + WS_WOUT); bf16* WFI = (bf16*)(a.ws + WS_WFI); bf16* WFO = (bf16*)(a.ws + WS_WFO);
    LAS float* scr = (LAS float*)(lds + wave * 16384);
    constexpr int I_IN = (DM / 64) * (NIN / 32), I_OUT = (DM / 64) * (DM / 32), I_FI = (DM / 64) * (2 * DFF / 32), I_FO = (DFF / 64) * (DM / 32);
    constexpr int NITEMS = I_IN + I_OUT + I_FI + I_FO;
    auto decode = [&](int it) -> TrItem {
        TrItem t; int r = it;
        if (r < I_IN) { const int nb = NIN / 32, kb = r / nb, n0 = (r % nb) * 32; t.W = a.w_in; t.WT = WIN; t.K = DM; t.N = NIN; t.k0 = kb * 64; t.n0 = n0; t.drow0 = n0; t.ldt = LDK; return t; } r -= I_IN;
        if (r < I_OUT) { const int nb = DM / 32, kb = r / nb, n0 = (r % nb) * 32; t.W = a.w_out; t.WT = WOUT; t.K = DM; t.N = DM; t.k0 = kb * 64; t.n0 = n0; t.drow0 = n0; t.ldt = LDK; return t; } r -= I_OUT;
        if (r < I_FI) { const int nb = 2 * DFF / 32, kb = r / nb, n0 = (r % nb) * 32; t.W = a.w_ffi; t.WT = WFI; t.K = DM; t.N = 2 * DFF; t.k0 = kb * 64; t.n0 = n0; t.drow0 = ffi_drow<INTER>(n0); t.ldt = LDK; return t; } r -= I_FI;
        { const int nb = DM / 32, kb = r / nb, n0 = (r % nb) * 32; t.W = a.w_ffo; t.WT = WFO; t.K = DFF; t.N = DM; t.k0 = kb * 64; t.n0 = n0; t.drow0 = n0; t.ldt = DFF; return t; }
    };
    {
        int it = gw; TrItem cur; f32x4 vc[8], vn[8];
        if (it < NITEMS) { cur = decode(it); tr_load(cur, lane, vc); }
        while (it < NITEMS) {
            const int nx = it + NGW; TrItem nxt = cur;
            if (nx < NITEMS) { nxt = decode(nx); tr_load(nxt, lane, vn); }
            tr_store(cur, lane, vc, scr);
            cur = nxt; it = nx;
#pragma unroll
            for (int ii = 0; ii < 8; ++ii) vc[ii] = vn[ii];
        }
    }
    bf16* XN = (bf16*)(a.ws + WS_XN);
    for (int m = gw; m < NTOK; m += NGW) {
        const float* xr = xrow_ptr(a.xp, a.xs, m);
        f32x4 v[16]; float s = 0.f;
#pragma unroll
        for (int j = 0; j < 8; ++j) { const f32x4* p = (const f32x4*)(xr + (j * 64 + lane) * 8); v[2 * j] = p[0]; v[2 * j + 1] = p[1];
            s += (v[2 * j].x * v[2 * j].x + v[2 * j].y * v[2 * j].y) + (v[2 * j].z * v[2 * j].z + v[2 * j].w * v[2 * j].w);
            s += (v[2 * j + 1].x * v[2 * j + 1].x + v[2 * j + 1].y * v[2 * j + 1].y) + (v[2 * j + 1].z * v[2 * j + 1].z + v[2 * j + 1].w * v[2 * j + 1].w); }
        const float rs = 1.0f / sqrtf(wave_sum(s) * (1.0f / DM) + EPSN);
#pragma unroll
        for (int j = 0; j < 8; ++j) { const int c0 = (j * 64 + lane) * 8; const f32x4 g0 = *(const f32x4*)(a.g_premix + c0), g1 = *(const f32x4*)(a.g_premix + c0 + 4);
            const f32x4 a0 = v[2 * j] * rs * g0, a1 = v[2 * j + 1] * rs * g1;
            v4u o; o.x = pk2(a0.x, a0.y); o.y = pk2(a0.z, a0.w); o.z = pk2(a1.x, a1.y); o.w = pk2(a1.z, a1.w);
            *(v4u*)(XN + (size_t)m * LDK + c0) = o; }
    }
    bf16* RGW = (bf16*)(a.ws + WS_RGW);
    for (int idx = gw * 64 + lane; idx < 2 * 2 * NHEAD * HDIM * HDIM; idx += NGW * 64) {
        const int i = idx & 127, j = (idx >> 7) & 127, h = (idx >> 14) & 15, gate = (idx >> 18) & 1, dir = idx >> 19;
        const float* W = gate ? a.rg_x_w : a.rg_a_w;
        RGW[idx] = (bf16)f2bf(W[(((size_t)dir * NHEAD + h) * HDIM + i) * HDIM + j]);
    }
    f32x2* TW = (f32x2*)(a.ws + WS_TW);
    for (int k = gw * 64 + lane; k < FFT_N; k += NGW * 64) { float sn, cs; sincospif((float)k * (1.0f / 8192.0f), &sn, &cs); TW[k] = (f32x2){cs, -sn}; }
    bf16* H3H = (bf16*)(a.ws + WS_H3); bf16* H3L = H3H + SEQL * 64;
    const float fr = a.hy_freq[lane], b1 = a.hy_b1[lane], b2 = a.hy_b2[lane], b3 = a.hy_b3[lane];
    for (int n = gw; n < SEQL; n += NGW) {
        float zv = 0.f;
        if (lane == 0) zv = (float)n * (1.0f / (float)(SEQL - 1));
        else if (lane < 33) { const int k = (lane - 1) & 15; const float band = 1e-4f + (float)k * ((15.0f - 1e-4f) / 15.0f);
            const float ang = (6.283185307179586f / (float)SEQL) * (float)n * band; zv = lane < 17 ? cosf(ang) : -sinf(ang); }
        float acc = b1;
        for (int e = 0; e < 33; ++e) acc += __shfl(zv, e) * a.hy_w1[e * 64 + lane];
        float h = sinf(fr * acc);
        acc = b2;
        for (int e = 0; e < 64; ++e) acc += __shfl(h, e) * a.hy_w2[e * 64 + lane];
        h = sinf(fr * acc);
        acc = b3;
        for (int e = 0; e < 64; ++e) acc += __shfl(h, e) * a.hy_w3[e * 64 + lane];
        h = sinf(fr * acc);
        { const unsigned hi = f2bf(h); H3H[n * 64 + lane] = (bf16)hi; H3L[n * 64 + lane] = (bf16)f2bf(h - bf2f(hi)); }
    }
}
constexpr int FFT_LDS_BYTES = (FFT_N + FFT_N / 32) * 8;
constexpr int HY_W4_OFF = FFT_LDS_BYTES;
constexpr int HY_PRM_OFF = FFT_LDS_BYTES + 1024;
constexpr int HY_LDS_BYTES = FFT_LDS_BYTES + 1024 + 256;
__device__ __forceinline__ int PH(int i) { return i + (i >> 5); }
__device__ __forceinline__ f32x2 cmul(f32x2 a, f32x2 b) { return (f32x2){a.x * b.x - a.y * b.y, a.x * b.y + a.y * b.x}; }
__device__ __forceinline__ constexpr int bitrev_c(int r, int bits) { int o = 0; for (int i = 0; i < bits; ++i) o |= ((r >> i) & 1) << (bits - 1 - i); return o; }

__device__ __forceinline__ f32x2 mul_w32(f32x2 d, int idx) {
    constexpr float C[16] = {1.0f, 0.98078528040323043f, 0.92387953251128674f, 0.83146961230254524f, 0.70710678118654752f, 0.55557023301960218f, 0.38268343236508977f, 0.19509032201612825f,
                             0.0f, -0.19509032201612825f, -0.38268343236508977f, -0.55557023301960218f, -0.70710678118654752f, -0.83146961230254524f, -0.92387953251128674f, -0.98078528040323043f};
    constexpr float S[16] = {0.0f, 0.19509032201612825f, 0.38268343236508977f, 0.55557023301960218f, 0.70710678118654752f, 0.83146961230254524f, 0.92387953251128674f, 0.98078528040323043f,
                             1.0f, 0.98078528040323043f, 0.92387953251128674f, 0.83146961230254524f, 0.70710678118654752f, 0.55557023301960218f, 0.38268343236508977f, 0.19509032201612825f};
    if (idx == 0) return d;
    if (idx == 8) return (f32x2){d.y, -d.x};
    const float c = C[idx], s = S[idx];
    return (f32x2){d.x * c + d.y * s, d.y * c - d.x * s};
}
template <int R> __device__ __forceinline__ void dft_inreg(f32x2 (&a)[R]) {
    constexpr int LOGR = (R == 32) ? 5 : 4;
#pragma unroll
    for (int t = 0; t < LOGR; ++t) {
        const int half = R >> (t + 1);
#pragma unroll
        for (int g = 0; g < R; g += 2 * half)
#pragma unroll
            for (int i = 0; i < half; ++i) {
                const f32x2 u = a[g + i], v = a[g + i + half];
                a[g + i] = u + v;
                a[g + i + half] = mul_w32(u - v, i * (16 / half));
            }
    }
}
template <int R, int S, bool TW, bool ZPAD = false, bool HALFOUT = false> __device__ __forceinline__ void fft_pass(LAS f32x2* lds, const f32x2* tw, int tid) {
    constexpr int NB = FFT_N / R, PER = NB / 512, LOGR = (R == 32) ? 5 : 4;
    constexpr int RSTEP = NB + NB / 32;
    constexpr int WSTEP = (S == 1) ? 1 : (S + S / 32);
    f32x2 a[PER][R];
#pragma unroll
    for (int b = 0; b < PER; ++b) { const LAS f32x2* rp = lds + PH(tid + 512 * b);
#pragma unroll
        for (int k = 0; k < R; ++k) a[b][k] = (ZPAD && k >= R / 2) ? (f32x2){0.f, 0.f} : rp[k * RSTEP]; }
    lds_sync();
#pragma unroll
    for (int b = 0; b < PER; ++b) {
        const int beta = tid + 512 * b, q = beta & (S - 1), p = beta / S, base = q + R * S * p;
        dft_inreg<R>(a[b]);
        f32x2 w1 = (f32x2){1.f, 0.f}, wj = (f32x2){1.f, 0.f};
        if (TW) { w1 = tw[p * S]; wj = w1; }
        LAS f32x2* wp = lds + PH(base);
        wp[0] = a[b][0];
#pragma unroll
        for (int j = 1; j < (HALFOUT ? R / 2 : R); ++j) {
            f32x2 v = a[b][bitrev_c(j, LOGR)];
            if (TW) { v = cmul(v, wj); wj = cmul(wj, w1); }
            wp[j * WSTEP] = v;
        }
    }
    lds_sync();
}
template <bool ZPAD = false, bool HALFOUT = false> __device__ __forceinline__ void fft16k(LAS f32x2* lds, const f32x2* tw, int tid) {
    asm volatile("" : "+v"(tid));
    fft_pass<32, 1, true, ZPAD, false>(lds, tw, tid);
    fft_pass<32, 32, true>(lds, tw, tid);
    fft_pass<16, 1024, false, false, HALFOUT>(lds, tw, tid);
}
__device__ __forceinline__ void spec_pair(LAS f32x2* lds, const f32x2* ZK, int p) {
    const int f = p, f2 = (FFT_N - p) & (FFT_N - 1);
    const f32x2 A = ZK[f], A2 = ZK[f2], Z = lds[PH(f)], Z2 = lds[PH(f2)];
    const float kcx = 0.5f * (A.x + A2.x), kcy = 0.5f * (A.y - A2.y);
    const float dx = 0.5f * (A.x - A2.x), dy = 0.5f * (A.y + A2.y);
    const float k1x = dy, k1y = -dx;
    const float px = 0.5f * (kcx + k1x), py = 0.5f * (kcy + k1y), qx = 0.5f * (kcx - k1x), qy = 0.5f * (kcy - k1y);
    const float wx = Z.x * px - Z.y * py + (Z2.x * qx + Z2.y * qy);
    const float wy = Z.x * py + Z.y * px + (Z2.x * qy - Z2.y * qx);
    const float w2x = Z2.x * px + Z2.y * py + (Z.x * qx - Z.y * qy);
    const float w2y = Z2.y * px - Z2.x * py - (Z.x * qy + Z.y * qx);
    lds[PH(f)] = (f32x2){wx, -wy}; lds[PH(f2)] = (f32x2){w2x, -w2y};
}
__device__ __forceinline__ void spec_mul(LAS f32x2* lds, const f32x2* ZK, int tid) {
    asm volatile("" : "+v"(tid));
#pragma unroll 8
    for (int i = 0; i < 16; ++i) spec_pair(lds, ZK, tid + 512 * i);
    if (tid == 0) spec_pair(lds, ZK, 8192);
    lds_sync();
}
struct HyArgs {
    const bf16* phy;
    const float *conv_w, *conv_b;
    const float* w4;
    const float* hy_bias;
    const bf16* h3h;
    const f32x2* tw;
    f32x2* zk;
    bf16* hyy;
};
__device__ __forceinline__ void load_conv3_16(const bf16* row, int t0, float w0, float w1, float w2, float bias, float (&out)[16]) {
    const v4u r0 = *(const v4u*)(row + t0), r1 = *(const v4u*)(row + t0 + 8);
    float u[18];
    u[0] = t0 > 0 ? bf2f(row[t0 - 1]) : 0.f;
    u[17] = (t0 + 16 < SEQL) ? bf2f(row[t0 + 16]) : 0.f;
    u[1] = bflo(r0.x); u[2] = bfhi(r0.x); u[3] = bflo(r0.y); u[4] = bfhi(r0.y); u[5] = bflo(r0.z); u[6] = bfhi(r0.z); u[7] = bflo(r0.w); u[8] = bfhi(r0.w);
    u[9] = bflo(r1.x); u[10] = bfhi(r1.x); u[11] = bflo(r1.y); u[12] = bfhi(r1.y); u[13] = bflo(r1.z); u[14] = bfhi(r1.z); u[15] = bflo(r1.w); u[16] = bfhi(r1.w);
#pragma unroll
    for (int e = 0; e < 16; ++e) out[e] = bias + w0 * u[e] + w1 * u[e + 1] + w2 * u[e + 2];
}
__device__ __forceinline__ void store16_bf16(bf16* dst, const float (&v)[16]) {
    v4u o0, o1; o0.x = pk2(v[0], v[1]); o0.y = pk2(v[2], v[3]); o0.z = pk2(v[4], v[5]); o0.w = pk2(v[6], v[7]);
    o1.x = pk2(v[8], v[9]); o1.y = pk2(v[10], v[11]); o1.z = pk2(v[12], v[13]); o1.w = pk2(v[14], v[15]);
    *(v4u*)dst = o0; *(v4u*)(dst + 8) = o1;
}
__device__ __forceinline__ void hyena_unit(const HyArgs& a, LAS unsigned char* ldsb_, int cp, int wgslot, int tid) {
    unsigned lzero; asm volatile("v_mov_b32 %0, 0" : "=v"(lzero));
    LAS unsigned char* ldsb = ldsb_ + lzero;
    LAS f32x2* lds = (LAS f32x2*)ldsb;
    const int c0 = 2 * cp, c1 = c0 + 1;
    f32x2* zk = a.zk + (size_t)wgslot * 2 * FFT_N;
    constexpr float MIN_DECAY = -3.0701134573253945f, MAX_DECAY = -15.350567286626973f;
    const float ad0 = fabsf(MIN_DECAY + (float)c0 * ((MAX_DECAY - MIN_DECAY) / (float)(DHY - 1)));
    const float ad1 = fabsf(MIN_DECAY + (float)c1 * ((MAX_DECAY - MIN_DECAY) / (float)(DHY - 1)));
    LAS float* prm = (LAS float*)(ldsb + HY_PRM_OFF);
    wg_sync();
    if (tid < 24) { const int k = tid & 3, sc = tid >> 2, st = sc >> 1, chn = st * DHY + c0 + (sc & 1); prm[tid] = k < 3 ? a.conv_w[k * 6144 + chn] : a.conv_b[chn]; }
    if (tid >= 32 && tid < 36) { const int j = tid - 32; prm[tid] = a.hy_bias[(j >> 1) * DHY + c0 + (j & 1)]; }
#pragma unroll 1
    for (int o = 0; o < 2; ++o) {
        int tq = tid; asm volatile("" : "+v"(tq)); const int t0 = 16 * tq;
        wg_sync();
        {
            const int lane = tq & 63, wv = tq >> 6, fr = lane & 15, fq = lane >> 4;
            const int colidx = o * 4096 + ((fr >> 1) & 1) * 2048 + c0 + (fr & 1);
            bf16x8 Bh[2], Bl[2];
#pragma unroll
            for (int kk = 0; kk < 2; ++kk)
#pragma unroll
                for (int i = 0; i < 8; ++i) { const float w = fr < 4 ? a.w4[(size_t)(32 * kk + 8 * fq + i) * 8192 + colidx] : 0.f; const unsigned hi = f2bf(w);
                    Bh[kk][i] = (short)hi; Bl[kk][i] = (short)f2bf(w - bf2f(hi)); }
            const float adl = (fr & 1) ? ad1 : ad0;
            LAS float* ldsf = (LAS float*)lds;
            if (tq == 0) lds[PH(SEQL)] = (f32x2){0.f, 0.f};
            const bf16* apw = a.h3h + (size_t)(wv * 1024 + fr) * 64 + 8 * fq;
            bf16x8 fc[4][4], fn[4][4];
#pragma unroll
            for (int q = 0; q < 4; ++q) { const bf16* ap = apw + (size_t)q * 16 * 64;
                fc[q][0] = *(const bf16x8*)ap; fc[q][1] = *(const bf16x8*)(ap + 32); fc[q][2] = *(const bf16x8*)(ap + SEQL * 64); fc[q][3] = *(const bf16x8*)(ap + SEQL * 64 + 32); }
#pragma unroll 1
            for (int gq = 0; gq < 16; ++gq) {
                const int gnx = gq < 15 ? gq + 1 : gq;
#pragma unroll
                for (int q = 0; q < 4; ++q) { const bf16* ap = apw + (size_t)(gnx * 4 + q) * 16 * 64;
                    fn[q][0] = *(const bf16x8*)ap; fn[q][1] = *(const bf16x8*)(ap + 32); fn[q][2] = *(const bf16x8*)(ap + SEQL * 64); fn[q][3] = *(const bf16x8*)(ap + SEQL * 64 + 32); }
#pragma unroll
                for (int q = 0; q < 4; ++q) {
                    const int row0 = wv * 1024 + (gq * 4 + q) * 16;
                    f32x4 acc = (f32x4){0.f, 0.f, 0.f, 0.f};
                    acc = __builtin_amdgcn_mfma_f32_16x16x32_bf16(fc[q][2], Bh[0], acc, 0, 0, 0); acc = __builtin_amdgcn_mfma_f32_16x16x32_bf16(fc[q][3], Bh[1], acc, 0, 0, 0);
                    acc = __builtin_amdgcn_mfma_f32_16x16x32_bf16(fc[q][0], Bl[0], acc, 0, 0, 0); acc = __builtin_amdgcn_mfma_f32_16x16x32_bf16(fc[q][1], Bl[1], acc, 0, 0, 0);
                    acc = __builtin_amdgcn_mfma_f32_16x16x32_bf16(fc[q][0], Bh[0], acc, 0, 0, 0); acc = __builtin_amdgcn_mfma_f32_16x16x32_bf16(fc[q][1], Bh[1], acc, 0, 0, 0);
                    if (fr < 4) {
#pragma unroll
                        for (int e = 0; e < 4; ++e) {
                            const int n = row0 + 4 * fq + e;
                            const float val = acc[e] * fexp(-(float)n * (1.0f / (float)(SEQL - 1)) * adl);
                            if (fr < 2) ldsf[2 * PH(n) + (fr & 1)] = val;
                            else if (n >= 1) ldsf[2 * PH(FFT_N - n) + (fr & 1)] = val;
                        }
                    }
                }
#pragma unroll
                for (int q = 0; q < 4; ++q)
#pragma unroll
                    for (int z = 0; z < 4; ++z) fc[q][z] = fn[q][z];
            }
        }
        wg_sync();
        fft16k(lds, a.tw, tid);
#pragma unroll 4
        for (int i = 0; i < 32; ++i) zk[(size_t)o * FFT_N + tq + 512 * i] = lds[PH(tq + 512 * i)];
    }
    const float inv_n = 1.0f / (float)FFT_N;
    asm volatile("s_waitcnt vmcnt(0)" ::: "memory");
    wg_sync();
#pragma unroll 1
    for (int s = 0; s < NSEQ; ++s) {
        const size_t m0 = (size_t)s * SEQL;
        int tq = tid; asm volatile("" : "+v"(tq)); const int t0 = 16 * tq;
        {
            float v0[16], v1[16];
            load_conv3_16(a.phy + (size_t)(0 * DHY + c0) * NTOK + m0, t0, prm[0], prm[1], prm[2], prm[3], v0);
            load_conv3_16(a.phy + (size_t)(0 * DHY + c1) * NTOK + m0, t0, prm[4], prm[5], prm[6], prm[7], v1);
            wg_sync();
#pragma unroll
            for (int e = 0; e < 16; ++e) { lds[PH(t0 + e)] = (f32x2){v0[e], v1[e]}; }
        }
        wg_sync();
        fft16k<true, false>(lds, a.tw, tid);
        spec_mul(lds, zk, tid);
        fft16k<false, true>(lds, a.tw, tid);
        float z0[16], z1[16];
        {
            float x0[16], x1[16];
            load_conv3_16(a.phy + (size_t)(0 * DHY + c0) * NTOK + m0, t0, prm[0], prm[1], prm[2], prm[3], x0);
            load_conv3_16(a.phy + (size_t)(0 * DHY + c1) * NTOK + m0, t0, prm[4], prm[5], prm[6], prm[7], x1);
#pragma unroll
            for (int e = 0; e < 16; ++e) { const f32x2 r = lds[PH(t0 + e)]; z0[e] = r.x * inv_n + prm[32] * x0[e]; z1[e] = -r.y * inv_n + prm[33] * x1[e]; }
            load_conv3_16(a.phy + (size_t)(1 * DHY + c0) * NTOK + m0, t0, prm[8], prm[9], prm[10], prm[11], x0);
            load_conv3_16(a.phy + (size_t)(1 * DHY + c1) * NTOK + m0, t0, prm[12], prm[13], prm[14], prm[15], x1);
#pragma unroll
            for (int e = 0; e < 16; ++e) { z0[e] *= x0[e]; z1[e] *= x1[e]; }
        }
#pragma unroll
        for (int e = 0; e < 16; ++e) { lds[PH(t0 + e)] = (f32x2){z0[e], z1[e]}; }
        wg_sync();
        fft16k<true, false>(lds, a.tw, tid);
        spec_mul(lds, zk + FFT_N, tid);
        fft16k<false, true>(lds, a.tw, tid);
        {
            float x0[16], x1[16];
            load_conv3_16(a.phy + (size_t)(2 * DHY + c0) * NTOK + m0, t0, prm[16], prm[17], prm[18], prm[19], x0);
            load_conv3_16(a.phy + (size_t)(2 * DHY + c1) * NTOK + m0, t0, prm[20], prm[21], prm[22], prm[23], x1);
#pragma unroll
            for (int e = 0; e < 16; ++e) { const f32x2 r = lds[PH(t0 + e)];
                x0[e] = x0[e] * (r.x * inv_n + prm[34] * z0[e]); x1[e] = x1[e] * (-r.y * inv_n + prm[35] * z1[e]); }
            store16_bf16(a.hyy + (size_t)c0 * NTOK + m0 + t0, x0);
            store16_bf16(a.hyy + (size_t)c1 * NTOK + m0 + t0, x1);
        }
    }
}
constexpr int RG_T = 128, RG_NT = SEQL / RG_T;
constexpr int RG_XC_STRIDE = 272;
constexpr int RG_G_OFF = RG_T * RG_XC_STRIDE;
constexpr int RG_HF_OFF = 2 * RG_T * RG_XC_STRIDE;
constexpr int RG_LDS_BYTES = RG_HF_OFF + (RG_T / 4) * 512 * 4;
constexpr int RG_UNITS = NSEQ * RG_NT * NHEAD;
struct RgArgs {
    const bf16* prg;
    const float *conv_w, *conv_b;
    const bf16* rgw;
    const float *a_b, *x_b;
    const float* lam;
    f32x2* summ;
    bf16* rgy;
};
template <int PASS> __device__ __forceinline__ void rg_unit(const RgArgs& a, LAS unsigned char* lds, int unit, int tid) {
    const int wave = tid >> 6, lane = tid & 63, fr = lane & 15, fq = lane >> 4;
    const int h = unit % NHEAD, tt = (unit / NHEAD) % RG_NT, s = unit / (NHEAD * RG_NT);
    const int tok0 = tt * RG_T;
    const size_t mrow0 = (size_t)s * SEQL;
    wg_sync();
    {
        const int cg = h * HDIM + 2 * lane;
        float w0[4], w1[4];
#pragma unroll
        for (int k = 0; k < 4; ++k) { w0[k] = a.conv_w[k * DRG + cg]; w1[k] = a.conv_w[k * DRG + cg + 1]; }
        const float cb0 = a.conv_b[cg], cb1 = a.conv_b[cg + 1];
        const int tb = tok0 + 16 * wave;
        unsigned raw[19], graw[16];
#pragma unroll
        for (int q = 0; q < 19; ++q) { const int t = tb - 2 + q, tc = t < 0 ? 0 : (t > SEQL - 1 ? SEQL - 1 : t); raw[q] = *(const unsigned*)(a.prg + (mrow0 + tc) * DM + cg); }
        if (PASS == 2) {
#pragma unroll
            for (int i = 0; i < 16; ++i) graw[i] = *(const unsigned*)(a.prg + (mrow0 + tb + i) * DM + DRG + cg);
        }
#pragma unroll
        for (int q = 0; q < 19; ++q) { const int t = tb - 2 + q; if (t < 0 || t > SEQL - 1) raw[q] = 0u; }
#pragma unroll
        for (int i = 0; i < 16; ++i) {
            const float y0 = cb0 + w0[0] * bflo(raw[i]) + w0[1] * bflo(raw[i + 1]) + w0[2] * bflo(raw[i + 2]) + w0[3] * bflo(raw[i + 3]);
            const float y1 = cb1 + w1[0] * bfhi(raw[i]) + w1[1] * bfhi(raw[i + 1]) + w1[2] * bfhi(raw[i + 2]) + w1[3] * bfhi(raw[i + 3]);
            *(LAS unsigned*)(lds + (16 * wave + i) * RG_XC_STRIDE + lane * 4) = pk2(y0, y1);
            if (PASS == 2) *(LAS unsigned*)(lds + RG_G_OFF + (16 * wave + i) * RG_XC_STRIDE + lane * 4) = graw[i];
        }
    }
    wg_sync();
    const int ch = h * HDIM + 16 * wave + fr;
    LAS float* hfl = (LAS float*)(lds + RG_HF_OFF) + tid;
#pragma unroll
    for (int dir = 0; dir < 2; ++dir) {
        bf16x8 Br[4], Bi[4];
#pragma unroll
        for (int kk = 0; kk < 4; ++kk) {
            Br[kk] = *(const bf16x8*)(a.rgw + ((((size_t)dir * 2 + 0) * NHEAD + h) * HDIM + 16 * wave + fr) * HDIM + 32 * kk + 8 * fq);
            Bi[kk] = *(const bf16x8*)(a.rgw + ((((size_t)dir * 2 + 1) * NHEAD + h) * HDIM + 16 * wave + fr) * HDIM + 32 * kk + 8 * fq);
        }
        const float ba = a.a_b[dir * DRG + ch], bx = a.x_b[dir * DRG + ch];
        const float sp = log1pf(expf(-a.lam[dir * DRG + ch]));
        float carry = 0.f, ptot = 1.f;
        if (PASS == 2) {
            const f32x2* sm = a.summ + ((size_t)dir * NSEQ + s) * RG_NT * DRG + ch;
            const int cnt = dir == 0 ? tt : RG_NT - 1 - tt;
            for (int j0 = 0; j0 < cnt; j0 += 16) {
                f32x2 pb[16];
#pragma unroll
                for (int q = 0; q < 16; ++q) { const int jj = j0 + q, j = dir == 0 ? jj : RG_NT - 1 - jj, jc = jj < cnt ? j : tt; pb[q] = sm[(size_t)jc * DRG]; if (jj >= cnt) pb[q] = (f32x2){1.f, 0.f}; }
#pragma unroll
                for (int q = 0; q < 16; ++q) carry = pb[q].x * carry + pb[q].y;
            }
        }
        for (int bi = 0; bi < RG_T / 16; ++bi) {
            const int blk = dir == 0 ? bi : (RG_T / 16 - 1 - bi);
            f32x4 accR = (f32x4){0.f, 0.f, 0.f, 0.f}, accI = (f32x4){0.f, 0.f, 0.f, 0.f};
#pragma unroll
            for (int kk = 0; kk < 4; ++kk) {
                const bf16x8 af = *(const LAS bf16x8*)(lds + (16 * blk + fr) * RG_XC_STRIDE + (32 * kk + 8 * fq) * 2);
                accR = __builtin_amdgcn_mfma_f32_16x16x32_bf16(af, Br[kk], accR, 0, 0, 0);
                accI = __builtin_amdgcn_mfma_f32_16x16x32_bf16(af, Bi[kk], accI, 0, 0, 0);
            }
            float av[4], bv[4];
#pragma unroll
            for (int e = 0; e < 4; ++e) {
                const float r = sigmoidf_(accR[e] + ba), ig = sigmoidf_(accI[e] + bx);
                const float log_a = -8.0f * r * sp;
                av[e] = fexp(log_a);
                const float x2 = 2.0f * log_a;
                const float em = -x2 * (1.0f + x2 * (0.5f + x2 * (0.16666667f + x2 * (0.041666668f + x2 * (0.0083333338f + x2 * (0.0013888889f + x2 * (0.0001984127f + x2 * 0.0000248016f)))))));
                const float em2 = x2 < -0.25f ? (1.0f - av[e] * av[e]) : em;
                const float mult = __builtin_amdgcn_sqrtf(fmaxf(em2, 0.f));
                const float xcv = bf2f(*(const LAS unsigned short*)(lds + (16 * blk + 4 * fq + e) * RG_XC_STRIDE + (16 * wave + fr) * 2));
                bv[e] = mult * ig * xcv;
            }
            float A = 1.f, B = 0.f;
            if (dir == 0) {
#pragma unroll
                for (int e = 0; e < 4; ++e) { B = av[e] * B + bv[e]; A *= av[e]; }
            } else {
#pragma unroll
                for (int e = 3; e >= 0; --e) { B = av[e] * B + bv[e]; A *= av[e]; }
            }
            float hin;
            if (dir == 0) {
                float Ap = __shfl_up(A, 16), Bp = __shfl_up(B, 16);
                if (fq >= 1) { B = A * Bp + B; A = Ap * A; }
                Ap = __shfl_up(A, 32); Bp = __shfl_up(B, 32);
                if (fq >= 2) { B = A * Bp + B; A = Ap * A; }
                const float hend = A * carry + B;
                const float hprev = __shfl_up(hend, 16);
                hin = fq == 0 ? carry : hprev;
                carry = __shfl(hend, 48 + fr);
                if (PASS == 1) ptot *= __shfl(A, 48 + fr);
            } else {
                float Ap = __shfl_down(A, 16), Bp = __shfl_down(B, 16);
                if (fq <= 2) { B = A * Bp + B; A = Ap * A; }
                Ap = __shfl_down(A, 32); Bp = __shfl_down(B, 32);
                if (fq <= 1) { B = A * Bp + B; A = Ap * A; }
                const float hend = A * carry + B;
                const float hprev = __shfl_down(hend, 16);
                hin = fq == 3 ? carry : hprev;
                carry = __shfl(hend, fr);
                if (PASS == 1) ptot *= __shfl(A, fr);
            }
            if (PASS == 2) {
                if (dir == 0) {
                    float hh = hin;
#pragma unroll
                    for (int e = 0; e < 4; ++e) { hh = av[e] * hh + bv[e]; hfl[(blk * 4 + e) * 512] = hh; }
                } else {
                    float hh = hin, hb[4];
#pragma unroll
                    for (int e = 3; e >= 0; --e) { hh = av[e] * hh + bv[e]; hb[e] = hh; }
#pragma unroll
                    for (int e = 0; e < 4; ++e) {
                        const size_t m = mrow0 + tok0 + 16 * blk + 4 * fq + e;
                        const float g = bf2f(*(const LAS unsigned short*)(lds + RG_G_OFF + (16 * blk + 4 * fq + e) * RG_XC_STRIDE + (16 * wave + fr) * 2));
                        a.rgy[m * DRG + ch] = (bf16)f2bf((hfl[(blk * 4 + e) * 512] + hb[e]) * gelu_tanh(g));
                    }
                }
            }
        }
        if (PASS == 1 && fq == 0) a.summ[(((size_t)dir * NSEQ + s) * RG_NT + tt) * DRG + ch] = (f32x2){ptot, carry};
    }
}
__device__ __forceinline__ void mixnorm_rg_row(const bf16* rgy, const float* g_rg, bf16* mix, int m, int lane) {
    v4u r[4]; float s = 0.f;
#pragma unroll
    for (int j = 0; j < 4; ++j) { r[j] = *(const v4u*)(rgy + (size_t)m * DRG + (j * 64 + lane) * 8);
        const float a0 = bflo(r[j].x), a1 = bfhi(r[j].x), a2 = bflo(r[j].y), a3 = bfhi(r[j].y), a4 = bflo(r[j].z), a5 = bfhi(r[j].z), a6 = bflo(r[j].w), a7 = bfhi(r[j].w);
        s += (a0 * a0 + a1 * a1) + (a2 * a2 + a3 * a3) + (a4 * a4 + a5 * a5) + (a6 * a6 + a7 * a7); }
    const float rs = 1.0f / sqrtf(wave_sum(s) * (1.0f / DRG) + EPSN);
#pragma unroll
    for (int j = 0; j < 4; ++j) { const int c0 = (j * 64 + lane) * 8; const f32x4 g0 = *(const f32x4*)(g_rg + c0), g1 = *(const f32x4*)(g_rg + c0 + 4);
        v4u o; o.x = pk2(bflo(r[j].x) * rs * g0.x, bfhi(r[j].x) * rs * g0.y); o.y = pk2(bflo(r[j].y) * rs * g0.z, bfhi(r[j].y) * rs * g0.w);
        o.z = pk2(bflo(r[j].z) * rs * g1.x, bfhi(r[j].z) * rs * g1.y); o.w = pk2(bflo(r[j].w) * rs * g1.z, bfhi(r[j].w) * rs * g1.w);
        *(v4u*)(mix + (size_t)m * LDK + c0) = o; }
}
constexpr int MN_TILE_STRIDE = 66;
constexpr int MN_LDS_BYTES = 8 * 64 * MN_TILE_STRIDE * 2 + 8 * 64 * 4 + 64 * 4;
__device__ __forceinline__ void mixnorm_hy_tile(const bf16* hyy, const float* g_hy, bf16* mix, LAS unsigned char* lds, int tile, int tid) {
    const int wave = tid >> 6, lane = tid & 63, m0 = tile * 64;
    LAS unsigned short* tl = (LAS unsigned short*)(lds + wave * 64 * MN_TILE_STRIDE * 2);
    LAS float* part = (LAS float*)(lds + 8 * 64 * MN_TILE_STRIDE * 2);
    LAS float* scl = part + 8 * 64;
    wg_sync();
    float s = 0.f;
    for (int c = wave * 256; c < wave * 256 + 256; ++c) { const float v = bf2f(hyy[(size_t)c * NTOK + m0 + lane]); s += v * v; }
    part[wave * 64 + lane] = s;
    wg_sync();
    if (tid < 64) { float t = 0.f;
#pragma unroll
        for (int w = 0; w < 8; ++w) t += part[w * 64 + tid];
        scl[tid] = 1.0f / sqrtf(t * (1.0f / DHY) + EPSN); }
    wg_sync();
    for (int cb = wave; cb < DHY / 64; cb += 8) {
        for (int ci = 0; ci < 64; ++ci) tl[ci * MN_TILE_STRIDE + lane] = hyy[(size_t)(cb * 64 + ci) * NTOK + m0 + lane];
        asm volatile("s_waitcnt lgkmcnt(0)" ::: "memory");
        const float g = g_hy[cb * 64 + lane];
        for (int tk = 0; tk < 64; ++tk) mix[(size_t)(m0 + tk) * LDK + DRG + cb * 64 + lane] = (bf16)f2bf(bf2f(tl[lane * MN_TILE_STRIDE + tk]) * scl[tk] * g);
        asm volatile("s_waitcnt lgkmcnt(0)" ::: "memory");
    }
}
__device__ __forceinline__ void rowpass1(const float* xr, const bf16* yr, const float* g_post, const float* g_pre, float* outr, bf16* xnr, int lane) {
    float v[64]; float s = 0.f;
#pragma unroll
    for (int j = 0; j < 8; ++j) { const v4u r = *(const v4u*)(yr + (j * 64 + lane) * 8);
        v[8 * j + 0] = bflo(r.x); v[8 * j + 1] = bfhi(r.x); v[8 * j + 2] = bflo(r.y); v[8 * j + 3] = bfhi(r.y); v[8 * j + 4] = bflo(r.z); v[8 * j + 5] = bfhi(r.z); v[8 * j + 6] = bflo(r.w); v[8 * j + 7] = bfhi(r.w);
#pragma unroll
        for (int e = 0; e < 8; ++e) s += v[8 * j + e] * v[8 * j + e]; }
    const float rs = 1.0f / sqrtf(wave_sum(s) * (1.0f / DM) + EPSN);
    float s2 = 0.f;
#pragma unroll
    for (int j = 0; j < 8; ++j) { const int c0 = (j * 64 + lane) * 8;
        const f32x4 x0 = *(const f32x4*)(xr + c0), x1 = *(const f32x4*)(xr + c0 + 4), g0 = *(const f32x4*)(g_post + c0), g1 = *(const f32x4*)(g_post + c0 + 4);
        f32x4 o0, o1;
        o0.x = x0.x + v[8 * j + 0] * rs * g0.x; o0.y = x0.y + v[8 * j + 1] * rs * g0.y; o0.z = x0.z + v[8 * j + 2] * rs * g0.z; o0.w = x0.w + v[8 * j + 3] * rs * g0.w;
        o1.x = x1.x + v[8 * j + 4] * rs * g1.x; o1.y = x1.y + v[8 * j + 5] * rs * g1.y; o1.z = x1.z + v[8 * j + 6] * rs * g1.z; o1.w = x1.w + v[8 * j + 7] * rs * g1.w;
        *(f32x4*)(outr + c0) = o0; *(f32x4*)(outr + c0 + 4) = o1;
        v[8 * j + 0] = o0.x; v[8 * j + 1] = o0.y; v[8 * j + 2] = o0.z; v[8 * j + 3] = o0.w; v[8 * j + 4] = o1.x; v[8 * j + 5] = o1.y; v[8 * j + 6] = o1.z; v[8 * j + 7] = o1.w;
        s2 += (o0.x * o0.x + o0.y * o0.y) + (o0.z * o0.z + o0.w * o0.w) + (o1.x * o1.x + o1.y * o1.y) + (o1.z * o1.z + o1.w * o1.w); }
    const float rs2 = 1.0f / sqrtf(wave_sum(s2) * (1.0f / DM) + EPSN);
#pragma unroll
    for (int j = 0; j < 8; ++j) { const int c0 = (j * 64 + lane) * 8; const f32x4 g0 = *(const f32x4*)(g_pre + c0), g1 = *(const f32x4*)(g_pre + c0 + 4);
        v4u o; o.x = pk2(v[8 * j + 0] * rs2 * g0.x, v[8 * j + 1] * rs2 * g0.y); o.y = pk2(v[8 * j + 2] * rs2 * g0.z, v[8 * j + 3] * rs2 * g0.w);
        o.z = pk2(v[8 * j + 4] * rs2 * g1.x, v[8 * j + 5] * rs2 * g1.y); o.w = pk2(v[8 * j + 6] * rs2 * g1.z, v[8 * j + 7] * rs2 * g1.w);
        *(v4u*)(xnr + c0) = o; }
}
__device__ __forceinline__ void rowpass2(const bf16* fr_, const float* g, float* outr, int lane) {
    float v[64]; float s = 0.f;
#pragma unroll
    for (int j = 0; j < 8; ++j) { const v4u r = *(const v4u*)(fr_ + (j * 64 + lane) * 8);
        v[8 * j + 0] = bflo(r.x); v[8 * j + 1] = bfhi(r.x); v[8 * j + 2] = bflo(r.y); v[8 * j + 3] = bfhi(r.y); v[8 * j + 4] = bflo(r.z); v[8 * j + 5] = bfhi(r.z); v[8 * j + 6] = bflo(r.w); v[8 * j + 7] = bfhi(r.w);
#pragma unroll
        for (int e = 0; e < 8; ++e) s += v[8 * j + e] * v[8 * j + e]; }
    const float rs = 1.0f / sqrtf(wave_sum(s) * (1.0f / DM) + EPSN);
#pragma unroll
    for (int j = 0; j < 8; ++j) { const int c0 = (j * 64 + lane) * 8;
        const f32x4 x0 = *(const f32x4*)(outr + c0), x1 = *(const f32x4*)(outr + c0 + 4), g0 = *(const f32x4*)(g + c0), g1 = *(const f32x4*)(g + c0 + 4);
        f32x4 o0, o1;
        o0.x = x0.x + v[8 * j + 0] * rs * g0.x; o0.y = x0.y + v[8 * j + 1] * rs * g0.y; o0.z = x0.z + v[8 * j + 2] * rs * g0.z; o0.w = x0.w + v[8 * j + 3] * rs * g0.w;
        o1.x = x1.x + v[8 * j + 4] * rs * g1.x; o1.y = x1.y + v[8 * j + 5] * rs * g1.y; o1.z = x1.z + v[8 * j + 6] * rs * g1.z; o1.w = x1.w + v[8 * j + 7] * rs * g1.w;
        *(f32x4*)(outr + c0) = o0; *(f32x4*)(outr + c0 + 4) = o1; }
}
constexpr int SIDE_G_ROWS = 8, SIDE_U_ROWS = 4;
__device__ __forceinline__ float dpp_prev(float x, float xprevblk) {
    const int old = __builtin_amdgcn_update_dpp(0, __builtin_bit_cast(int, xprevblk), 0x121  , 0xf, 0xf, false);
    return __builtin_bit_cast(float, __builtin_amdgcn_update_dpp(old, __builtin_bit_cast(int, x), 0x111  , 0xf, 0xf, false));
}
__device__ __forceinline__ float dpp_next(float x, float xnextblk) {
    const int old = __builtin_amdgcn_update_dpp(0, __builtin_bit_cast(int, xnextblk), 0x12F  , 0xf, 0xf, false);
    return __builtin_bit_cast(float, __builtin_amdgcn_update_dpp(old, __builtin_bit_cast(int, x), 0x101  , 0xf, 0xf, false));
}
struct EpiGate {
    static constexpr bool PERM = true, AFTER_DRAIN = false, AROWPERM = true;
    bf16* H; const float* cw; const float* cb; float* sideG; float* sideU;
    __device__ __forceinline__ void operator()(const pg8::f32x4 (&acc)[2][2][4][2], const pg8::Unit& u, int wr, int wc, int fr, int fq) const {
        const int hc0 = u.pn * 128 + wc * 32 + 8 * fq;
        f32x4 w0[2], w1[2], w2[2], bb[2];
#pragma unroll
        for (int n = 0; n < 2; ++n) { w0[n] = *(const f32x4*)(cw + hc0 + 4 * n); w1[n] = *(const f32x4*)(cw + DFF + hc0 + 4 * n); w2[n] = *(const f32x4*)(cw + 2 * DFF + hc0 + 4 * n); bb[n] = *(const f32x4*)(cb + hc0 + 4 * n); }
        const size_t row0 = (size_t)u.pm * 256 + wr * 128 + fr;
        const f32x4 zero4 = (f32x4){0.f, 0.f, 0.f, 0.f};
#pragma unroll
        for (int blk = 0; blk < 8; ++blk) {
            const int ai = blk >> 2, m = blk & 3;
            float r[8];
#pragma unroll
            for (int n = 0; n < 2; ++n) {
                const f32x4 x = acc[ai][0][m][n];
                const f32x4 xp = blk > 0 ? acc[(blk - 1) >> 2][0][(blk - 1) & 3][n] : zero4;
                const f32x4 xn = blk < 7 ? acc[(blk + 1) >> 2][0][(blk + 1) & 3][n] : zero4;
                const f32x4 uu = acc[ai][1][m][n];
#pragma unroll
                for (int j = 0; j < 4; ++j) {
                    const float pre = bb[n][j] + w0[n][j] * dpp_prev(x[j], xp[j]) + w1[n][j] * x[j] + w2[n][j] * dpp_next(x[j], xn[j]);
                    r[4 * n + j] = gelu_tanh(pre) * uu[j];
                }
            }
            v4u o; o.x = pk2(r[0], r[1]); o.y = pk2(r[2], r[3]); o.z = pk2(r[4], r[5]); o.w = pk2(r[6], r[7]);
            *(v4u*)(H + (row0 + 16 * blk) * DFF + hc0) = o;
        }
        float* sg = sideG + ((size_t)u.pm * SIDE_G_ROWS + 4 * wr) * DFF + hc0;
        float* su = sideU + ((size_t)u.pm * SIDE_U_ROWS + 2 * wr) * DFF + hc0;
        if (fr < 2) { *(f32x4*)(sg + (size_t)fr * DFF) = acc[0][0][0][0]; *(f32x4*)(sg + (size_t)fr * DFF + 4) = acc[0][0][0][1]; }
        if (fr >= 14) { *(f32x4*)(sg + (size_t)(fr - 12) * DFF) = acc[1][0][3][0]; *(f32x4*)(sg + (size_t)(fr - 12) * DFF + 4) = acc[1][0][3][1]; }
        if (fr == 0) { *(f32x4*)su = acc[0][1][0][0]; *(f32x4*)(su + 4) = acc[0][1][0][1]; }
        if (fr == 15) { *(f32x4*)(su + DFF) = acc[1][1][3][0]; *(f32x4*)(su + DFF + 4) = acc[1][1][3][1]; }
    }
};
__device__ __forceinline__ void gate_fixup(const float* sideG, const float* sideU, const float* cw, const float* cb, bf16* H, int gtid, int nthreads) {
    constexpr int C4 = DFF / 4, NT = NTOK / 256;
    for (int idx = gtid; idx < NT * 4 * C4; idx += nthreads) {
        const int c = (idx % C4) * 4, k = (idx / C4) & 3, pm = idx / (4 * C4);
        const float* g = sideG + (size_t)pm * SIDE_G_ROWS * DFF + c;
        f32x4 prev, cur, next; int row;
        const f32x4 z = (f32x4){0.f, 0.f, 0.f, 0.f};
        if (k == 0) { row = 0; prev = (pm % 32 == 0) ? z : *(const f32x4*)(g - (size_t)SIDE_G_ROWS * DFF + 7 * (size_t)DFF); cur = *(const f32x4*)g; next = *(const f32x4*)(g + DFF); }
        else if (k == 1) { row = 127; prev = *(const f32x4*)(g + 2 * (size_t)DFF); cur = *(const f32x4*)(g + 3 * (size_t)DFF); next = *(const f32x4*)(g + 4 * (size_t)DFF); }
        else if (k == 2) { row = 128; prev = *(const f32x4*)(g + 3 * (size_t)DFF); cur = *(const f32x4*)(g + 4 * (size_t)DFF); next = *(const f32x4*)(g + 5 * (size_t)DFF); }
        else { row = 255; prev = *(const f32x4*)(g + 6 * (size_t)DFF); cur = *(const f32x4*)(g + 7 * (size_t)DFF); next = (pm % 32 == 31) ? z : *(const f32x4*)(g + (size_t)SIDE_G_ROWS * DFF); }
        const f32x4 uu = *(const f32x4*)(sideU + ((size_t)pm * SIDE_U_ROWS + k) * DFF + c);
        const f32x4 w0 = *(const f32x4*)(cw + c), w1 = *(const f32x4*)(cw + DFF + c), w2 = *(const f32x4*)(cw + 2 * DFF + c), b = *(const f32x4*)(cb + c);
        float r[4];
#pragma unroll
        for (int j = 0; j < 4; ++j) r[j] = gelu_tanh(b[j] + w0[j] * prev[j] + w1[j] * cur[j] + w2[j] * next[j]) * uu[j];
        v2u o; o.x = pk2(r[0], r[1]); o.y = pk2(r[2], r[3]);
        *(v2u*)(H + ((size_t)pm * 256 + row) * DFF + c) = o;
    }
}
constexpr int LDS_PHASE_BYTES = 143360;
constexpr int LDSCTL_OFF = LDS_PHASE_BYTES, LDS_BYTES = 147456;
constexpr int CW_BAR = 4096;
constexpr size_t CTL_ZERO_BYTES = 64 * 1024;
static_assert(HY_LDS_BYTES <= LDS_PHASE_BYTES && RG_LDS_BYTES <= LDS_PHASE_BYTES && MN_LDS_BYTES <= LDS_PHASE_BYTES && pg8::STAGE_BYTES <= LDS_PHASE_BYTES, "LDS map");
static_assert((CW_BAR + XCD_BAR_WORDS) * 4 <= (int)CTL_ZERO_BYTES, "control words inside the memset region");

struct MkArgs { const float* in[32]; float* out; unsigned char* ws; };
__device__ __forceinline__ pg8::Gemm dgemm(const bf16* A, const bf16* Bt, int M, int N, int K, int lda, int ldb) { pg8::Gemm g; g.A = A; g.Bt = Bt; g.M = M; g.N = N; g.K = K; g.lda = lda; g.ldb = ldb; return g; }
__device__ __forceinline__ pg8::EpiBf16<0> depi(bf16* O, int ldc) { pg8::EpiBf16<0> e; e.O = O; e.ldc = ldc; e.bias = nullptr; e.split_cols = 0; e.split_stride = 0; e.scale0 = 1.f; return e; }

__device__ __forceinline__ void gate_seq(const bf16* gu, const float* cw, const float* cb, bf16* h, int gtid, int nthreads) {
    constexpr int CG = DFF / 8;
    for (int idx = gtid; idx < SEQL * CG; idx += nthreads) {
        const int m = idx / CG, c0 = (idx % CG) * 8;
        const v4u z = (v4u){0u, 0u, 0u, 0u};
        const v4u gm = m > 0 ? *(const v4u*)(gu + (size_t)(m - 1) * 2 * DFF + c0) : z;
        const v4u g0 = *(const v4u*)(gu + (size_t)m * 2 * DFF + c0);
        const v4u gp = m < SEQL - 1 ? *(const v4u*)(gu + (size_t)(m + 1) * 2 * DFF + c0) : z;
        const v4u uu = *(const v4u*)(gu + (size_t)m * 2 * DFF + DFF + c0);
        float r[8];
#pragma unroll
        for (int e = 0; e < 8; ++e) {
            const unsigned wm = e < 2 ? gm.x : e < 4 ? gm.y : e < 6 ? gm.z : gm.w, w0 = e < 2 ? g0.x : e < 4 ? g0.y : e < 6 ? g0.z : g0.w, wp = e < 2 ? gp.x : e < 4 ? gp.y : e < 6 ? gp.z : gp.w, wu = e < 2 ? uu.x : e < 4 ? uu.y : e < 6 ? uu.z : uu.w;
            const float a = (e & 1) ? bfhi(wm) : bflo(wm), b = (e & 1) ? bfhi(w0) : bflo(w0), c = (e & 1) ? bfhi(wp) : bflo(wp), u = (e & 1) ? bfhi(wu) : bflo(wu);
            const float pre = cb[c0 + e] + cw[c0 + e] * a + cw[DFF + c0 + e] * b + cw[2 * DFF + c0 + e] * c;
            r[e] = gelu_tanh(pre) * u;
        }
        v4u o; o.x = pk2(r[0], r[1]); o.y = pk2(r[2], r[3]); o.z = pk2(r[4], r[5]); o.w = pk2(r[6], r[7]);
        *(v4u*)(h + (size_t)m * DFF + c0) = o;
    }
}

#if defined(__HIP_DEVICE_COMPILE__)
#define MK_NOPK __attribute__((target("no-packed-fp32-ops")))
#else
#define MK_NOPK
#endif
__global__ void __launch_bounds__(512, 2) MK_NOPK mk_fwd(MkArgs args) {
    extern __shared__ __attribute__((aligned(16))) unsigned char lds_raw[];
    LAS unsigned char* lds = (LAS unsigned char*)lds_raw;
    const int tid = threadIdx.x, lane = tid & 63, wave = __builtin_amdgcn_readfirstlane(tid >> 6);
    const int G = gridDim.x, bx = blockIdx.x;
    unsigned char* ws = args.ws;
    const float* const* in = args.in;
    volatile LAS unsigned* MISC = (volatile LAS unsigned*)(lds + LDSCTL_OFF);
    for (int u = tid; u < (LDS_BYTES - LDSCTL_OFF) / 4; u += 512) ((LAS unsigned*)(lds + LDSCTL_OFF))[u] = 0u;
    wg_sync();
    XcdBarrier bar = xcd_barrier_post((unsigned*)(ws + WS_CTL) + CW_BAR, MISC + 8);

    bf16* XN = (bf16*)(ws + WS_XN); bf16* WIN = (bf16*)(ws + WS_WIN);
    {
        ProArgs pa; pa.xp = in[0]; pa.xs = in[1]; pa.g_premix = in[2]; pa.w_in = in[3]; pa.w_out = in[24]; pa.w_ffi = in[27]; pa.w_ffo = in[30]; pa.rg_a_w = in[6]; pa.rg_x_w = in[8];
        pa.hy_w1 = in[13]; pa.hy_b1 = in[14]; pa.hy_w2 = in[15]; pa.hy_b2 = in[16]; pa.hy_w3 = in[17]; pa.hy_b3 = in[18]; pa.hy_freq = in[20]; pa.ws = ws;
        p0_prologue<true>(pa, lds, bx * 8 + wave, G * 8, wave, lane);
    }
    xcd_barrier(bar);
    {
        pg8::StaticOrder S; S.init(NTOK, 2 * DRG, G, bx);
        pg8::gemm_phase<pg8::EpiBf16<0>, pg8::StaticOrder, true, true>(lds, dgemm(XN, WIN, NTOK, 2 * DRG, DM, LDK, LDK), S, depi((bf16*)(ws + WS_PRG), 2 * DRG));
    }
    {
        pg8::StaticOrder S; S.init(3 * DHY, NTOK, G, bx);
        pg8::gemm_phase<pg8::EpiBf16<0>, pg8::StaticOrder, true, true>(lds, dgemm(WIN + (size_t)2 * DRG * LDK, XN, 3 * DHY, NTOK, DM, LDK, LDK), S, depi((bf16*)(ws + WS_PHY), NTOK));
    }
    xcd_barrier(bar);
    RgArgs ra; ra.prg = (const bf16*)(ws + WS_PRG); ra.conv_w = in[4]; ra.conv_b = in[5]; ra.rgw = (const bf16*)(ws + WS_RGW); ra.a_b = in[7]; ra.x_b = in[9]; ra.lam = in[10];
    ra.summ = (f32x2*)(ws + WS_SUMM); ra.rgy = (bf16*)(ws + WS_RGY);
    {
        HyArgs a; a.phy = (const bf16*)(ws + WS_PHY); a.conv_w = in[11]; a.conv_b = in[12]; a.w4 = in[19]; a.hy_bias = in[21]; a.h3h = (const bf16*)(ws + WS_H3); a.tw = (const f32x2*)(ws + WS_TW);
        a.zk = (f32x2*)(ws + WS_ZK); a.hyy = (bf16*)(ws + WS_HYY);
        for (int cp = bx; cp < DHY / 2; cp += G) hyena_unit(a, lds, cp, bx, tid);
    }
    for (int u = bx; u < RG_UNITS; u += G) rg_unit<1>(ra, lds, u, tid);
    xcd_barrier(bar);
    for (int u = bx; u < RG_UNITS; u += G) rg_unit<2>(ra, lds, u, tid);
    xcd_barrier(bar);
    for (int m = bx * 8 + wave; m < NTOK; m += G * 8) mixnorm_rg_row((const bf16*)(ws + WS_RGY), in[22], (bf16*)(ws + WS_MIX), m, lane);
    for (int t = bx; t < NTOK / 64; t += G) mixnorm_hy_tile((const bf16*)(ws + WS_HYY), in[23], (bf16*)(ws + WS_MIX), lds, t, tid);
    xcd_barrier(bar);
    {
        pg8::StaticOrder S; S.init(NTOK, DM, G, bx);
        pg8::gemm_phase<pg8::EpiBf16<0>, pg8::StaticOrder, true, true>(lds, dgemm((bf16*)(ws + WS_MIX), (bf16*)(ws + WS_WOUT), NTOK, DM, DM, LDK, LDK), S, depi((bf16*)(ws + WS_Y), DM));
    }
    xcd_barrier(bar);
    for (int m = bx * 8 + wave; m < NTOK; m += G * 8) rowpass1(xrow_ptr(in[0], in[1], m), (const bf16*)(ws + WS_Y) + (size_t)m * DM, in[25], in[26], args.out + (size_t)m * DM, XN + (size_t)m * LDK, lane);
    xcd_barrier(bar);
    bf16* HB = (bf16*)(ws + WS_H);
    {
        pg8::StaticOrder S; S.init(NTOK, 2 * DFF, G, bx);
        EpiGate E; E.H = HB; E.cw = in[28]; E.cb = in[29]; E.sideG = (float*)(ws + WS_SIDEG); E.sideU = (float*)(ws + WS_SIDEU);
        pg8::gemm_phase<EpiGate, pg8::StaticOrder, true, true>(lds, dgemm(XN, (bf16*)(ws + WS_WFI), NTOK, 2 * DFF, DM, LDK, LDK), S, E);
    }
    xcd_barrier(bar);
    { int tq = tid; asm volatile("" : "+v"(tq)); gate_fixup((const float*)(ws + WS_SIDEG), (const float*)(ws + WS_SIDEU), in[28], in[29], HB, bx * 512 + tq, G * 512); }
    xcd_barrier(bar);
    {
        pg8::StaticOrder S; S.init(NTOK, DM, G, bx);
        pg8::gemm_phase<pg8::EpiBf16<0>, pg8::StaticOrder, true, true>(lds, dgemm(HB, (bf16*)(ws + WS_WFO), NTOK, DM, DFF, DFF, DFF), S, depi((bf16*)(ws + WS_F), DM));
    }
    xcd_barrier(bar);
    for (int m = bx * 8 + wave; m < NTOK; m += G * 8) rowpass2((const bf16*)(ws + WS_F) + (size_t)m * DM, in[31], args.out + (size_t)m * DM, lane);
}

extern "C" void kernel_launch(void* const* d_in, const int* in_sizes, int n_in, void* d_out, int out_size, void* d_ws, size_t ws_size, hipStream_t stream) {
    static int grid = 0;
    if (grid == 0) {
        grid = -1;
        if (n_in != 32 || out_size != NTOK * DM || ws_size < WS_END) { fprintf(stderr, "kernel_launch: unexpected sizes n_in %d out %d ws %zu (need %zu)\n", n_in, out_size, ws_size, (size_t)WS_END); return; }
        int dev = 0, cus = 0, per_cu = 0;
        if (hipGetDevice(&dev) != hipSuccess || hipDeviceGetAttribute(&cus, hipDeviceAttributeMultiprocessorCount, dev) != hipSuccess) return;
        if (hipFuncSetAttribute((const void*)mk_fwd, hipFuncAttributeMaxDynamicSharedMemorySize, LDS_BYTES) != hipSuccess) { fprintf(stderr, "kernel_launch: hipFuncSetAttribute failed\n"); return; }
        if (hipOccupancyMaxActiveBlocksPerMultiprocessor(&per_cu, (const void*)mk_fwd, 512, LDS_BYTES) != hipSuccess || per_cu < 1) { fprintf(stderr, "kernel_launch: occupancy query says %d blocks per CU\n", per_cu); (void)hipGetLastError(); return; }
        grid = cus;
    }
    if (grid < 0) return;
    if (hipMemsetAsync((char*)d_ws + WS_CTL, 0, CTL_ZERO_BYTES, stream) != hipSuccess) return;
    MkArgs a; memset(&a, 0, sizeof a);
    for (int i = 0; i < 32; ++i) a.in[i] = (const float*)d_in[i];
    a.out = (float*)d_out; a.ws = (unsigned char*)d_ws;
    hipLaunchKernelGGL(mk_fwd, dim3(grid), dim3(512), LDS_BYTES, stream, a);
}
```

```cpp
#include <hip/hip_runtime.h>
#include <cstdio>
#include <cstdint>
#include <cstring>
namespace pg8 {
#define PG8_LAS __attribute__((address_space(3)))
typedef unsigned short bf16_t;
typedef short bf16x8 __attribute__((ext_vector_type(8)));
typedef float f32x4 __attribute__((ext_vector_type(4)));
typedef unsigned u32x4 __attribute__((ext_vector_type(4)));
constexpr int BM = 256, BK = 64, HALF = 128, HTB = HALF * BK * 2  , STAGE_BYTES = 8 * HTB, NXCD = 8, WGM = 8;

__host__ __device__ __forceinline__ int lds_byte(int r, int c) { const int st = (r >> 4) * 2 + (c >> 5), rr = r & 15, cc = c & 31, ob = rr * 64 + cc * 2; return st * 1024 + (ob ^ (((ob >> 9) & 1) << 5)); }
__host__ __device__ __forceinline__ void stage_rc(int b, int& R, int& C) { const int st = b / 1024, sb = b % 1024, swz = sb ^ (((sb >> 9) & 1) << 5); R = (st >> 1) * 16 + swz / 64; C = (st & 1) * 32 + (swz % 64) / 2; }
__host__ __device__ __forceinline__ int perm32(int rho) { const int n = rho >> 4, i = rho & 15; return 8 * (i >> 2) + 4 * n + (i & 3); }

struct Unit { int pm, pn; };
struct Gemm { const bf16_t* A; const bf16_t* Bt; int M, N, K, lda, ldb; };

struct StaticOrder {
    int nM, nN, nwg, G, c;
    __host__ __device__ __forceinline__ void init(int M, int N, int G_, int c_) { nM = M / BM; nN = N / BM; nwg = nM * nN; G = G_; c = c_; }
    __host__ __device__ __forceinline__ bool next(int i, Unit& u) const {
        const long L = (long)i * G + c; if (L >= nwg) return false;
        int wgid = (int)L; { const int q = nwg / NXCD, r = nwg % NXCD, xcd = wgid % NXCD, off = wgid / NXCD; wgid = (xcd < r ? xcd * (q + 1) : r * (q + 1) + (xcd - r) * q) + off; }
        const int nig = WGM * nN, gid = wgid / nig, fm = gid * WGM, gsz = (nM - fm) < WGM ? (nM - fm) : WGM;
        u.pm = fm + ((wgid % nig) % gsz); u.pn = (wgid % nig) / gsz; return true;
    }
    __device__ __forceinline__ void a_ready(const Unit&, int) const {}
    __device__ __forceinline__ void done(const Unit&) const {}
};

__device__ __forceinline__ unsigned cvt_pk_bf16(float lo, float hi) { unsigned r; asm volatile("v_cvt_pk_bf16_f32 %0, %1, %2" : "=v"(r) : "v"(lo), "v"(hi)); return r; }
typedef float f32x2 __attribute__((ext_vector_type(2)));
__device__ __forceinline__ f32x2 gelu_pk(f32x2 v) {
    const f32x2 av = __builtin_elementwise_abs(v), d = av * 0.2316418882f + 1.0f;
    f32x2 t; t.x = __builtin_amdgcn_rcpf(d.x); t.y = __builtin_amdgcn_rcpf(d.y);
    f32x2 q = t * 0.5307027145f + (-0.7265760135f); q = q * t + 0.7107068705f; q = q * t + (-0.142248368f); q = q * t + 0.127414796f; q = q * t;
    const f32x2 s = (v * v) * (-0.72134752044f);
    f32x2 e; e.x = __builtin_amdgcn_exp2f(s.x); e.y = __builtin_amdgcn_exp2f(s.y);
    const f32x2 m = v * (q * e), r = v - m;
    f32x2 o; o.x = v.x < 0.f ? m.x : r.x; o.y = v.y < 0.f ? m.y : r.y; return o;
}

template <int ACT  > struct EpiBf16 {
    static constexpr bool PERM = true, AFTER_DRAIN = false, AROWPERM = false; static_assert(ACT == 0 || ACT == 1, "EpiBf16: ACT is 0 (none) or 1 (gelu_pk)");
    bf16_t* O; int ldc; const float* bias; int split_cols; size_t split_stride; float scale0;
    __device__ __forceinline__ void operator()(const f32x4 (&acc)[2][2][4][2], const Unit& u, int wr, int wc, int fr, int fq) const {
        const int row0 = u.pm * BM + wr * 64 + fr; int colt = u.pn * BM; bf16_t* base = O;
        float sc = 1.f; if (split_cols) { const int t = colt / split_cols; base += (size_t)t * split_stride; colt -= t * split_cols; if (t == 0) sc = scale0; }
        const int col0 = colt + wc * 32 + 8 * fq, bcol0 = u.pn * BM + wc * 32 + 8 * fq;
        f32x4 bv[2][2];
#pragma unroll
        for (int bj = 0; bj < 2; ++bj)
#pragma unroll
            for (int n = 0; n < 2; ++n) bv[bj][n] = bias ? *(const f32x4*)(bias + bcol0 + bj * HALF + 4 * n) : (f32x4){0.f, 0.f, 0.f, 0.f};
#pragma unroll
        for (int ai = 0; ai < 2; ++ai)
#pragma unroll
            for (int m = 0; m < 4; ++m) { bf16_t* rowp = base + (size_t)(row0 + ai * HALF + m * 16) * ldc + col0;
#pragma unroll
                for (int bj = 0; bj < 2; ++bj) { f32x4 v0 = acc[ai][bj][m][0] + bv[bj][0], v1 = acc[ai][bj][m][1] + bv[bj][1];
                    if (ACT == 1) { f32x2 a = gelu_pk((f32x2){v0[0], v0[1]}), b = gelu_pk((f32x2){v0[2], v0[3]}), c = gelu_pk((f32x2){v1[0], v1[1]}), d = gelu_pk((f32x2){v1[2], v1[3]});
                        v0 = (f32x4){a.x, a.y, b.x, b.y}; v1 = (f32x4){c.x, c.y, d.x, d.y}; }
                    v0 = v0 * sc; v1 = v1 * sc; u32x4 w; w.x = cvt_pk_bf16(v0[0], v0[1]); w.y = cvt_pk_bf16(v0[2], v0[3]); w.z = cvt_pk_bf16(v1[0], v1[1]); w.w = cvt_pk_bf16(v1[2], v1[3]);
                    *(u32x4*)(rowp + bj * HALF) = w; } }
    }
};
template <class Epi, class Sched, bool ALIGN_EPI = false, bool SP2 = false>
__device__ __forceinline__ void gemm_phase(PG8_LAS unsigned char* lds, const Gemm g, const Sched& S, const Epi& E) {
    int tid_ = threadIdx.x; asm volatile("" : "+v"(tid_));
    const int tid = tid_, wid = __builtin_amdgcn_readfirstlane(tid >> 6), lane = tid & 63, wr = wid >> 2, wc = wid & 3, fr = lane & 15, fq = lane >> 4;
    const int K = g.K, nt = K / BK;
    unsigned voffA[2], voffB[2];
#pragma unroll
    for (int i = 0; i < 2; ++i) { int R, C; stage_rc(tid * 16 + i * 8192, R, C); const int Rb = Epi::PERM ? ((R & ~31) + perm32(R & 31)) : R; const int Ra = Epi::AROWPERM ? (128 * (R >> 6) + (R & 63)) : R;
        voffA[i] = (unsigned)(Ra * g.lda + C) * 2u; voffB[i] = (unsigned)(Rb * g.ldb + C) * 2u; }
    const size_t kstep = (size_t)(BK * 2);
    const size_t hstep = (size_t)HALF * g.ldb * 2;
    const size_t hstepA = (size_t)(Epi::AROWPERM ? 64 : HALF) * g.lda * 2;
    const size_t tstep = 2 * hstep, tstepA = (size_t)BM * g.lda * 2;
    const unsigned ldsw = (unsigned)wid * 1024u;
    const int aoff = lds_byte(wr * 64 + fr, fq * 8), boff = lds_byte(wc * 32 + fr, fq * 8);
#define PG8_SA(b, h) (((b) * 2 + (h)) * HTB)
#define PG8_SB(b, h) ((4 + (b) * 2 + (h)) * HTB)
#define PG8_STAGE(bufoff, gbase, voff) do { _Pragma("unroll") for (int _i = 0; _i < 2; ++_i) \
        __builtin_amdgcn_global_load_lds((const unsigned*)((const char*)(gbase) + (voff)[_i]), (PG8_LAS unsigned*)(lds + (bufoff) + ldsw + _i * 8192), 16, 0, 0); } while (0)
#define PG8_LDA(dst, b, h) do { _Pragma("unroll") for (int m = 0; m < 4; ++m) _Pragma("unroll") for (int k = 0; k < 2; ++k) dst[m][k] = *(const PG8_LAS bf16x8*)(lds + PG8_SA(b, h) + aoff + m * 2048 + k * 1024); } while (0)
#define PG8_LDB(dst, b, h) do { _Pragma("unroll") for (int n = 0; n < 2; ++n) _Pragma("unroll") for (int k = 0; k < 2; ++k) dst[n][k] = *(const PG8_LAS bf16x8*)(lds + PG8_SB(b, h) + boff + n * 2048 + k * 1024); } while (0)
#define PG8_MMA(ai, bj, At, Bt) do { __builtin_amdgcn_s_setprio(1); _Pragma("unroll") for (int m = 0; m < 4; ++m) _Pragma("unroll") for (int n = 0; n < 2; ++n) _Pragma("unroll") for (int k = 0; k < 2; ++k) \
        acc[ai][bj][m][n] = __builtin_amdgcn_mfma_f32_16x16x32_bf16(Bt[n][k], At[m][k], acc[ai][bj][m][n], 0, 0, 0); __builtin_amdgcn_s_setprio(0); } while (0)
#define PG8_WAIT_V(n) asm volatile("s_waitcnt vmcnt(" #n ")" ::: "memory")
#define PG8_WAIT_L(n) asm volatile("s_waitcnt lgkmcnt(" #n ")" ::: "memory")
#define PG8_BAR __builtin_amdgcn_s_barrier()
#define PG8_SCHED __builtin_amdgcn_sched_barrier(0)
    Unit cur, nxt; int ui = 0;
    if (!S.next(0, cur)) return;
    f32x4 acc[2][2][4][2];
#pragma unroll
    for (int a = 0; a < 2; ++a)
#pragma unroll
        for (int b = 0; b < 2; ++b)
#pragma unroll
            for (int m = 0; m < 4; ++m)
#pragma unroll
                for (int n = 0; n < 2; ++n) acc[a][b][m][n] = (f32x4){0.f, 0.f, 0.f, 0.f};
    bf16x8 At[4][2], B0[2][2], B1[2][2];
    const char* cA = (const char*)g.A + (size_t)cur.pm * tstepA; const char* cB = (const char*)g.Bt + (size_t)cur.pn * tstep;
    S.a_ready(cur, 0);
    if constexpr (SP2) {
        PG8_STAGE(PG8_SB(0, 0), cB, voffB); PG8_STAGE(PG8_SB(0, 1), cB + hstep, voffB); PG8_STAGE(PG8_SA(0, 0), cA, voffA); PG8_STAGE(PG8_SA(0, 1), cA + hstepA, voffA);
        if (wr == 1) PG8_BAR;
        PG8_WAIT_V(2); PG8_BAR;
        PG8_STAGE(PG8_SB(1, 0), cB + kstep, voffB); PG8_STAGE(PG8_SA(1, 0), cA + kstep, voffA); PG8_STAGE(PG8_SB(1, 1), cB + hstep + kstep, voffB);
        PG8_WAIT_V(6); PG8_BAR;
    } else {
        PG8_STAGE(PG8_SB(0, 0), cB, voffB); PG8_STAGE(PG8_SA(0, 0), cA, voffA); PG8_STAGE(PG8_SB(0, 1), cB + hstep, voffB); PG8_STAGE(PG8_SA(0, 1), cA + hstepA, voffA);
        if (wr == 1) PG8_BAR;
        PG8_WAIT_V(4); PG8_BAR;
        PG8_STAGE(PG8_SB(1, 0), cB + kstep, voffB); PG8_STAGE(PG8_SA(1, 0), cA + kstep, voffA); PG8_STAGE(PG8_SB(1, 1), cB + hstep + kstep, voffB);
        PG8_WAIT_V(6); PG8_BAR;
    }
    for (;;) {
        const bool has_next = S.next(ui + 1, nxt);
        const char* nA = has_next ? (const char*)g.A + (size_t)nxt.pm * tstepA : cA; const char* nB = has_next ? (const char*)g.Bt + (size_t)nxt.pn * tstep : cB;
        for (int t = 0; t < nt; t += 2) {
            const bool last = (t == nt - 2);
            const char* a1 = cA + (size_t)(t + 1) * kstep;
            const char* a2 = last ? nA : cA + (size_t)(t + 2) * kstep; const char* b2 = last ? nB : cB + (size_t)(t + 2) * kstep;
            const char* a3 = a2 + kstep; const char* b3 = b2 + kstep;
            if (last && has_next) S.a_ready(nxt, ui + 1);
            if constexpr (SP2) {
            PG8_LDB(B0, 0, 0); PG8_LDB(B1, 0, 1); PG8_SCHED; PG8_LDA(At, 0, 0); PG8_STAGE(PG8_SA(1, 1), a1 + hstepA, voffA);
            PG8_WAIT_V(8); PG8_WAIT_L(0); PG8_BAR; PG8_MMA(0, 0, At, B0); PG8_MMA(0, 1, At, B1); PG8_BAR; PG8_SCHED;
            PG8_LDA(At, 0, 1); PG8_STAGE(PG8_SB(0, 0), b2, voffB); PG8_STAGE(PG8_SB(0, 1), b2 + hstep, voffB); PG8_STAGE(PG8_SA(0, 0), a2, voffA);
            PG8_WAIT_V(8); PG8_WAIT_L(0); PG8_BAR; PG8_MMA(1, 0, At, B0); PG8_MMA(1, 1, At, B1); PG8_BAR; PG8_SCHED;
            PG8_LDB(B0, 1, 0); PG8_LDB(B1, 1, 1); PG8_SCHED; PG8_LDA(At, 1, 0); PG8_STAGE(PG8_SA(0, 1), a2 + hstepA, voffA);
            PG8_WAIT_V(8); PG8_WAIT_L(0); PG8_BAR; PG8_MMA(0, 0, At, B0); PG8_MMA(0, 1, At, B1); PG8_BAR; PG8_SCHED;
            PG8_LDA(At, 1, 1); PG8_STAGE(PG8_SB(1, 0), b3, voffB); PG8_STAGE(PG8_SB(1, 1), b3 + hstep, voffB); PG8_STAGE(PG8_SA(1, 0), a3, voffA);
            PG8_WAIT_V(8); PG8_WAIT_L(0); PG8_BAR; PG8_MMA(1, 0, At, B0); PG8_MMA(1, 1, At, B1); PG8_BAR; PG8_SCHED;
            } else {
            PG8_LDB(B0, 0, 0); PG8_SCHED; PG8_LDA(At, 0, 0); PG8_STAGE(PG8_SA(1, 1), a1 + hstepA, voffA);
            PG8_WAIT_L(8); PG8_BAR; PG8_WAIT_L(0); PG8_MMA(0, 0, At, B0); PG8_BAR; PG8_SCHED;
            PG8_LDB(B1, 0, 1); PG8_STAGE(PG8_SB(0, 0), b2, voffB);
            PG8_BAR; PG8_WAIT_L(0); PG8_MMA(0, 1, At, B1); PG8_BAR;
            PG8_LDA(At, 0, 1); PG8_STAGE(PG8_SA(0, 0), a2, voffA);
            PG8_BAR; PG8_WAIT_L(0); PG8_MMA(1, 0, At, B0); PG8_BAR; PG8_SCHED;
            PG8_STAGE(PG8_SB(0, 1), b2 + hstep, voffB);
            PG8_WAIT_V(6); PG8_BAR; PG8_MMA(1, 1, At, B1); PG8_BAR;
            PG8_LDB(B0, 1, 0); PG8_SCHED; PG8_LDA(At, 1, 0); PG8_STAGE(PG8_SA(0, 1), a2 + hstepA, voffA);
            PG8_WAIT_L(8); PG8_BAR; PG8_WAIT_L(0); PG8_MMA(0, 0, At, B0); PG8_BAR; PG8_SCHED;
            PG8_LDB(B1, 1, 1); PG8_STAGE(PG8_SB(1, 0), b3, voffB);
            PG8_BAR; PG8_WAIT_L(0); PG8_MMA(0, 1, At, B1); PG8_BAR;
            PG8_LDA(At, 1, 1); PG8_STAGE(PG8_SA(1, 0), a3, voffA);
            PG8_BAR; PG8_WAIT_L(0); PG8_MMA(1, 0, At, B0); PG8_BAR; PG8_SCHED;
            PG8_STAGE(PG8_SB(1, 1), b3 + hstep, voffB);
            PG8_WAIT_V(6); PG8_BAR; PG8_MMA(1, 1, At, B1); PG8_BAR;
            }
        }
        if constexpr (ALIGN_EPI) { if (wr == 0) PG8_BAR; }
        if constexpr (!Epi::AFTER_DRAIN) { E(acc, cur, wr, wc, fr, fq); S.done(cur); }
        if (!has_next) break;
#pragma unroll
        for (int a = 0; a < 2; ++a)
#pragma unroll
            for (int b = 0; b < 2; ++b)
#pragma unroll
                for (int m = 0; m < 4; ++m)
#pragma unroll
                    for (int n = 0; n < 2; ++n) acc[a][b][m][n] = (f32x4){0.f, 0.f, 0.f, 0.f};
        cur = nxt; cA = nA; cB = nB; ++ui;
        if constexpr (ALIGN_EPI) { if (wr == 1) PG8_BAR; }
    }
    PG8_WAIT_V(0);
    if constexpr (!ALIGN_EPI) { if (wr == 0) PG8_BAR; }
    PG8_BAR;
    if constexpr (Epi::AFTER_DRAIN) { E.fused(acc, cur, wr, wc, fr, fq, lds, wid, lane); S.done(cur); }
#undef PG8_SA
#undef PG8_SB
#undef PG8_STAGE
#undef PG8_LDA
#undef PG8_LDB
#undef PG8_MMA
#undef PG8_WAIT_V
#undef PG8_WAIT_L
#undef PG8_BAR
#undef PG8_SCHED
}
}
constexpr int SEQL = 8192, NSEQ = 3, NTOK = NSEQ * SEQL;
constexpr int DM = 4096, DRG = 2048, DHY = 2048, NIN = 10240, DFF = 11008;
constexpr int NHEAD = 16, HDIM = 128;
constexpr float EPSN = 1e-6f;
constexpr int FFT_N = 16384;
constexpr int LDK = DM;

#define GAS __attribute__((address_space(1)))
#define LAS __attribute__((address_space(3)))
typedef unsigned short bf16;
typedef unsigned v4u __attribute__((ext_vector_type(4)));
typedef unsigned v2u __attribute__((ext_vector_type(2)));
typedef float f32x4 __attribute__((ext_vector_type(4)));
typedef float f32x2 __attribute__((ext_vector_type(2)));
typedef short bf16x8 __attribute__((ext_vector_type(8)));

__device__ __forceinline__ void wg_sync() { __builtin_amdgcn_fence(__ATOMIC_RELEASE, "workgroup"); __builtin_amdgcn_s_barrier(); __builtin_amdgcn_fence(__ATOMIC_ACQUIRE, "workgroup"); }
__device__ __forceinline__ void lds_sync() { asm volatile("s_waitcnt lgkmcnt(0)" ::: "memory"); __builtin_amdgcn_s_barrier(); asm volatile("" ::: "memory"); }
__device__ __forceinline__ unsigned f2bf(float f) { unsigned u = __builtin_bit_cast(unsigned, f); return (u + 0x7fffu + ((u >> 16) & 1u)) >> 16; }
__device__ __forceinline__ unsigned pk2(float lo, float hi) { return f2bf(lo) | (f2bf(hi) << 16); }
__device__ __forceinline__ float bf2f(unsigned b) { return __builtin_bit_cast(float, b << 16); }
__device__ __forceinline__ float bflo(unsigned w) { return __builtin_bit_cast(float, w << 16); }
__device__ __forceinline__ float bfhi(unsigned w) { return __builtin_bit_cast(float, w & 0xffff0000u); }
__device__ __forceinline__ float wave_sum(float v) {
#pragma unroll
    for (int o = 1; o < 64; o <<= 1) v += __shfl_xor(v, o);
    return v;
}
__device__ __forceinline__ float frcp(float x) { return __builtin_amdgcn_rcpf(x); }
__device__ __forceinline__ float fexp(float x) { return __builtin_amdgcn_exp2f(x * 1.4426950408889634f); }
__device__ __forceinline__ float sigmoidf_(float x) { return frcp(1.0f + fexp(-x)); }
__device__ __forceinline__ float gelu_tanh(float x) { const float u = 1.5957691216057308f * (x + 0.044715f * x * x * x); return x * frcp(1.0f + fexp(-u)); }

constexpr size_t MiB = 1u << 20;
constexpr size_t WS_CTL = 0;
constexpr size_t WS_TW = 1 * MiB;
constexpr size_t WS_H3 = 2 * MiB;
constexpr size_t WS_RGW = 4 * MiB;
constexpr size_t WS_SUMM = 6 * MiB;
constexpr size_t WS_WIN = 16 * MiB;
constexpr size_t WS_WOUT = 98 * MiB;
constexpr size_t WS_WFI = 131 * MiB;
constexpr size_t WS_WFO = 306 * MiB;
constexpr size_t WS_XN = 392 * MiB;
constexpr size_t WS_PRG = 588 * MiB;
constexpr size_t WS_PHY = 780 * MiB;
constexpr size_t WS_HYY = 1068 * MiB;
constexpr size_t WS_RGY = 1164 * MiB;
constexpr size_t WS_ZK = WS_WIN;
constexpr size_t WS_KF = 1164 * MiB;
constexpr size_t WS_H = WS_PHY;
constexpr size_t WS_SIDEG = 1296 * MiB;
constexpr size_t WS_SIDEU = 1329 * MiB;
constexpr size_t WS_END = 1346 * MiB;
static_assert(WS_WIN + (size_t)NIN * LDK * 2 <= WS_WOUT && WS_WOUT + (size_t)DM * LDK * 2 <= WS_WFI && WS_WFI + (size_t)2 * DFF * LDK * 2 <= WS_WFO && WS_WFO + (size_t)DM * DFF * 2 <= WS_XN &&
              WS_XN + (size_t)NTOK * LDK * 2 <= WS_PRG && WS_PRG + (size_t)NTOK * DM * 2 <= WS_PHY && WS_PHY + (size_t)3 * DHY * NTOK * 2 <= WS_HYY && WS_PHY + (size_t)NTOK * LDK * 2 <= WS_HYY &&
              WS_HYY + (size_t)DHY * NTOK * 2 <= WS_RGY && WS_RGY + (size_t)NTOK * DRG * 2 <= WS_SIDEG && WS_ZK + (size_t)256 * 2 * FFT_N * 8 <= WS_WOUT && WS_KF + (size_t)8192 * 8192 * 2 <= WS_SIDEG && WS_H + (size_t)NTOK * DFF * 2 <= WS_SIDEG &&
              WS_SIDEG + (size_t)96 * 8 * DFF * 4 <= WS_SIDEU && WS_SIDEU + (size_t)96 * 4 * DFF * 4 <= WS_END, "d_ws map");
constexpr size_t WS_MIX = WS_PHY;
constexpr size_t WS_Y = WS_PRG;
constexpr size_t WS_F = WS_PRG;
#define XB_TMO      128
#define XB_XCNT(j)  (256  + 64 * (j))
#define XB_XSUB(j)  (1280 + 64 * (j))
#define XB_XGEN(j)  (2304 + 64 * (j))
#define XB_TOP      3328
#define XB_TOPGEN   3392
#define XCD_BAR_WORDS 3456
#define XB_SPIN_CAP (1u << 18)

__device__ __forceinline__ unsigned xb_ld(unsigned* p)              { return __hip_atomic_load(p, __ATOMIC_RELAXED, __HIP_MEMORY_SCOPE_AGENT); }
__device__ __forceinline__ unsigned xb_add(unsigned* p, unsigned v) { return __hip_atomic_fetch_add(p, v, __ATOMIC_RELAXED, __HIP_MEMORY_SCOPE_AGENT); }
__device__ __forceinline__ unsigned xb_xcc_id() { return (unsigned)__builtin_amdgcn_s_getreg((3 << 11) | 20) & 0xFu; }
#define XB_SPIN(cond, bar) do { unsigned _sp = 0; while (cond) { __builtin_amdgcn_s_sleep(1); \
    if ((++_sp & 255u) == 0u) { if (xb_ld(&(bar)[XB_TMO])) break; if (_sp > XB_SPIN_CAP) { atomicAdd(&(bar)[XB_TMO], 1u); break; } } } } while (0)

struct XcdBarrier {
    unsigned* bar; unsigned x;
    volatile LAS unsigned* st;
};

__device__ __forceinline__ XcdBarrier xcd_barrier_post(unsigned* bar, volatile LAS unsigned* st) {
    XcdBarrier b; b.bar = bar; b.x = xb_xcc_id(); b.st = st;
    if (threadIdx.x == 0) (void)xb_add(&bar[XB_XCNT(b.x)], 1u);
    return b;
}
__device__ __forceinline__ void xcd_barrier_complete(unsigned* bar, unsigned x, unsigned& nloc, unsigned& nx) {
    const unsigned G = gridDim.x * gridDim.y * gridDim.z;
    unsigned sum, cnt, mine, sp = 0u;
    for (;;) {
        sum = 0u; cnt = 0u; mine = 0u;
#pragma unroll
        for (unsigned j = 0; j < 16; ++j) { const unsigned c = xb_ld(&bar[XB_XCNT(j)]); sum += c; cnt += (c > 0u) ? 1u : 0u; mine = (j == x) ? c : mine; }
        if (sum == G) break;
        __builtin_amdgcn_s_sleep(1);
        if ((++sp & 255u) == 0u) { if (xb_ld(&bar[XB_TMO])) break; if (sp > XB_SPIN_CAP) { atomicAdd(&bar[XB_TMO], 1u); break; } }
    }
    nloc = mine > 0u ? mine : 1u; nx = cnt > 0u ? cnt : 1u;
}

__device__ __forceinline__ void xcd_barrier(const XcdBarrier& b) {
    asm volatile("s_waitcnt vmcnt(0)" ::: "memory");
    wg_sync();
    if (threadIdx.x == 0) {
        unsigned* bar = b.bar;
        __builtin_amdgcn_s_waitcnt(0);
        unsigned nloc = b.st[0], nx = b.st[1];
        if (nloc == 0u) { xcd_barrier_complete(bar, b.x, nloc, nx); b.st[0] = nloc; b.st[1] = nx; }
        const unsigned old = xb_add(&bar[XB_XSUB(b.x)], 1u);
        const unsigned gen = old / nloc;
        if (old + 1u == (gen + 1u) * nloc) {
            __builtin_amdgcn_fence(__ATOMIC_RELEASE, "agent");
            asm volatile("s_waitcnt vmcnt(0)" ::: "memory");
            const unsigned og = xb_add(&bar[XB_TOP], 1u);
            const unsigned tg = og / nx;
            if (og + 1u == (tg + 1u) * nx) xb_add(&bar[XB_TOPGEN], 1u);
            else XB_SPIN(xb_ld(&bar[XB_TOPGEN]) == tg, bar);
            __builtin_amdgcn_fence(__ATOMIC_ACQUIRE, "agent");
            xb_add(&bar[XB_XGEN(b.x)], 1u);
            asm volatile("s_waitcnt vmcnt(0)" ::: "memory");
        } else {
            XB_SPIN(xb_ld(&bar[XB_XGEN(b.x)]) == gen, bar);
            __builtin_amdgcn_fence(__ATOMIC_ACQUIRE, "agent");
            asm volatile("s_waitcnt vmcnt(0)" ::: "memory");
        }
    }
    wg_sync();
}
struct TrItem { const float* W; bf16* WT; int K, N, k0, n0, drow0, ldt; };
__device__ __forceinline__ void tr_load(const TrItem& t, int lane, f32x4 (&v)[8]) {
    const float* p = t.W + (size_t)(t.k0 + (lane >> 3)) * t.N + t.n0 + (lane & 7) * 4;
#pragma unroll
    for (int ii = 0; ii < 8; ++ii) v[ii] = __builtin_nontemporal_load((const f32x4*)(p + (size_t)8 * ii * t.N));
}
__device__ __forceinline__ void tr_store(const TrItem& t, int lane, const f32x4 (&v)[8], LAS float* scr) {
    LAS float* w = scr + (lane >> 3) * 33 + (lane & 7) * 4;
#pragma unroll
    for (int ii = 0; ii < 8; ++ii) { w[ii * 8 * 33 + 0] = v[ii].x; w[ii * 8 * 33 + 1] = v[ii].y; w[ii * 8 * 33 + 2] = v[ii].z; w[ii * 8 * 33 + 3] = v[ii].w; }
    asm volatile("s_waitcnt lgkmcnt(0)" ::: "memory");
    const int c = lane & 7;
#pragma unroll
    for (int j = 0; j < 4; ++j) { const int n = (lane >> 3) + 8 * j; const LAS float* s = scr + (8 * c) * 33 + n;
        v4u o; o.x = pk2(s[0 * 33], s[1 * 33]); o.y = pk2(s[2 * 33], s[3 * 33]); o.z = pk2(s[4 * 33], s[5 * 33]); o.w = pk2(s[6 * 33], s[7 * 33]);
        *(v4u*)(t.WT + (size_t)(t.drow0 + n) * t.ldt + t.k0 + 8 * c) = o; }
    asm volatile("s_waitcnt lgkmcnt(0)" ::: "memory");
}
template <bool INTER> __device__ __forceinline__ int ffi_drow(int n) {
    if (!INTER) return n;
    const int up = n >= DFF ? 1 : 0, c = n - up * DFF; return (c >> 7) * 256 + up * 128 + (c & 127);
}
struct ProArgs {
    const float *xp, *xs, *g_premix;
    const float *w_in, *w_out, *w_ffi, *w_ffo;
    const float *rg_a_w, *rg_x_w;
    const float *hy_w1, *hy_b1, *hy_w2, *hy_b2, *hy_w3, *hy_b3, *hy_freq;
    unsigned char* ws;
};
__device__ __forceinline__ const float* xrow_ptr(const float* xp, const float* xs, int m) { return m < SEQL ? xp + (size_t)m * DM : xs + (size_t)(m - SEQL) * DM; }

template <bool INTER> __device__ __forceinline__ void p0_prologue(const ProArgs& a, LAS unsigned char* lds, int gw, int NGW, int wave, int lane) {
    bf16* WIN = (bf16*)(a.ws + WS_WIN); bf16* WOUT = (bf16*)(a.ws + WS_WOUT); bf16* WFI = (bf16*)(a.ws + WS_WFI); bf16* WFO = (bf16*)(a.ws + WS_WFO);
    LAS float* scr = (LAS float*)(lds + wave * 16384);
    constexpr int I_IN = (DM / 64) * (NIN / 32), I_OUT = (DM / 64) * (DM / 32), I_FI = (DM / 64) * (2 * DFF / 32), I_FO = (DFF / 64) * (DM / 32);
    constexpr int NITEMS = I_IN + I_OUT + I_FI + I_FO;
    auto decode = [&](int it) -> TrItem {
        TrItem t; int r = it;
        if (r < I_IN) { const int nb = NIN / 32, kb = r / nb, n0 = (r % nb) * 32; t.W = a.w_in; t.WT = WIN; t.K = DM; t.N = NIN; t.k0 = kb * 64; t.n0 = n0; t.drow0 = n0; t.ldt = LDK; return t; } r -= I_IN;
        if (r < I_OUT) { const int nb = DM / 32, kb = r / nb, n0 = (r % nb) * 32; t.W = a.w_out; t.WT = WOUT; t.K = DM; t.N = DM; t.k0 = kb * 64; t.n0 = n0; t.drow0 = n0; t.ldt = LDK; return t; } r -= I_OUT;
        if (r < I_FI) { const int nb = 2 * DFF / 32, kb = r / nb, n0 = (r % nb) * 32; t.W = a.w_ffi; t.WT = WFI; t.K = DM; t.N = 2 * DFF; t.k0 = kb * 64; t.n0 = n0; t.drow0 = ffi_drow<INTER>(n0); t.ldt = LDK; return t; } r -= I_FI;
        { const int nb = DM / 32, kb = r / nb, n0 = (r % nb) * 32; t.W = a.w_ffo; t.WT = WFO; t.K = DFF; t.N = DM; t.k0 = kb * 64; t.n0 = n0; t.drow0 = n0; t.ldt = DFF; return t; }
    };
    {
        int it = gw; TrItem cur; f32x4 vc[8], vn[8];
        if (it < NITEMS) { cur = decode(it); tr_load(cur, lane, vc); }
        while (it < NITEMS) {
            const int nx = it + NGW; TrItem nxt = cur;
            if (nx < NITEMS) { nxt = decode(nx); tr_load(nxt, lane, vn); }
            tr_store(cur, lane, vc, scr);
            cur = nxt; it = nx;
#pragma unroll
            for (int ii = 0; ii < 8; ++ii) vc[ii] = vn[ii];
        }
    }
    bf16* XN = (bf16*)(a.ws + WS_XN);
    for (int m = gw; m < NTOK; m += NGW) {
        const float* xr = xrow_ptr(a.xp, a.xs, m);
        f32x4 v[16]; float s = 0.f;
#pragma unroll
        for (int j = 0; j < 8; ++j) { const f32x4* p = (const f32x4*)(xr + (j * 64 + lane) * 8); v[2 * j] = p[0]; v[2 * j + 1] = p[1];
            s += (v[2 * j].x * v[2 * j].x + v[2 * j].y * v[2 * j].y) + (v[2 * j].z * v[2 * j].z + v[2 * j].w * v[2 * j].w);
            s += (v[2 * j + 1].x * v[2 * j + 1].x + v[2 * j + 1].y * v[2 * j + 1].y) + (v[2 * j + 1].z * v[2 * j + 1].z + v[2 * j + 1].w * v[2 * j + 1].w); }
        const float rs = 1.0f / sqrtf(wave_sum(s) * (1.0f / DM) + EPSN);
#pragma unroll
        for (int j = 0; j < 8; ++j) { const int c0 = (j * 64 + lane) * 8; const f32x4 g0 = *(const f32x4*)(a.g_premix + c0), g1 = *(const f32x4*)(a.g_premix + c0 + 4);
            const f32x4 a0 = v[2 * j] * rs * g0, a1 = v[2 * j + 1] * rs * g1;
            v4u o; o.x = pk2(a0.x, a0.y); o.y = pk2(a0.z, a0.w); o.z = pk2(a1.x, a1.y); o.w = pk2(a1.z, a1.w);
            *(v4u*)(XN + (size_t)m * LDK + c0) = o; }
    }
    bf16* RGW = (bf16*)(a.ws + WS_RGW);
    for (int idx = gw * 64 + lane; idx < 2 * 2 * NHEAD * HDIM * HDIM; idx += NGW * 64) {
        const int i = idx & 127, j = (idx >> 7) & 127, h = (idx >> 14) & 15, gate = (idx >> 18) & 1, dir = idx >> 19;
        const float* W = gate ? a.rg_x_w : a.rg_a_w;
        RGW[idx] = (bf16)f2bf(W[(((size_t)dir * NHEAD + h) * HDIM + i) * HDIM + j]);
    }
    f32x2* TW = (f32x2*)(a.ws + WS_TW);
    for (int k = gw * 64 + lane; k < FFT_N; k += NGW * 64) { float sn, cs; sincospif((float)k * (1.0f / 8192.0f), &sn, &cs); TW[k] = (f32x2){cs, -sn}; }
    bf16* H3H = (bf16*)(a.ws + WS_H3); bf16* H3L = H3H + SEQL * 64;
    const float fr = a.hy_freq[lane], b1 = a.hy_b1[lane], b2 = a.hy_b2[lane], b3 = a.hy_b3[lane];
    for (int n = gw; n < SEQL; n += NGW) {
        float zv = 0.f;
        if (lane == 0) zv = (float)n * (1.0f / (float)(SEQL - 1));
        else if (lane < 33) { const int k = (lane - 1) & 15; const float band = 1e-4f + (float)k * ((15.0f - 1e-4f) / 15.0f);
            const float ang = (6.283185307179586f / (float)SEQL) * (float)n * band; zv = lane < 17 ? cosf(ang) : -sinf(ang); }
        float acc = b1;
        for (int e = 0; e < 33; ++e) acc += __shfl(zv, e) * a.hy_w1[e * 64 + lane];
        float h = sinf(fr * acc);
        acc = b2;
        for (int e = 0; e < 64; ++e) acc += __shfl(h, e) * a.hy_w2[e * 64 + lane];
        h = sinf(fr * acc);
        acc = b3;
        for (int e = 0; e < 64; ++e) acc += __shfl(h, e) * a.hy_w3[e * 64 + lane];
        h = sinf(fr * acc);
        { const unsigned hi = f2bf(h); H3H[n * 64 + lane] = (bf16)hi; H3L[n * 64 + lane] = (bf16)f2bf(h - bf2f(hi)); }
    }
}
constexpr int FFT_LDS_BYTES = (FFT_N + FFT_N / 32) * 8;
constexpr int HY_W4_OFF = FFT_LDS_BYTES;
constexpr int HY_PRM_OFF = FFT_LDS_BYTES + 1024;
constexpr int HY_LDS_BYTES = FFT_LDS_BYTES + 1024 + 256;
__device__ __forceinline__ int PH(int i) { return i + (i >> 5); }
__device__ __forceinline__ f32x2 cmul(f32x2 a, f32x2 b) { return (f32x2){a.x * b.x - a.y * b.y, a.x * b.y + a.y * b.x}; }
__device__ __forceinline__ constexpr int bitrev_c(int r, int bits) { int o = 0; for (int i = 0; i < bits; ++i) o |= ((r >> i) & 1) << (bits - 1 - i); return o; }

__device__ __forceinline__ f32x2 mul_w32(f32x2 d, int idx) {
    constexpr float C[16] = {1.0f, 0.98078528040323043f, 0.92387953251128674f, 0.83146961230254524f, 0.70710678118654752f, 0.55557023301960218f, 0.38268343236508977f, 0.19509032201612825f,
                             0.0f, -0.19509032201612825f, -0.38268343236508977f, -0.55557023301960218f, -0.70710678118654752f, -0.83146961230254524f, -0.92387953251128674f, -0.98078528040323043f};
    constexpr float S[16] = {0.0f, 0.19509032201612825f, 0.38268343236508977f, 0.55557023301960218f, 0.70710678118654752f, 0.83146961230254524f, 0.92387953251128674f, 0.98078528040323043f,
                             1.0f, 0.98078528040323043f, 0.92387953251128674f, 0.83146961230254524f, 0.70710678118654752f, 0.55557023301960218f, 0.38268343236508977f, 0.19509032201612825f};
    if (idx == 0) return d;
    if (idx == 8) return (f32x2){d.y, -d.x};
    const float c = C[idx], s = S[idx];
    return (f32x2){d.x * c + d.y * s, d.y * c - d.x * s};
}
template <int R> __device__ __forceinline__ void dft_inreg(f32x2 (&a)[R]) {
    constexpr int LOGR = (R == 32) ? 5 : 4;
#pragma unroll
    for (int t = 0; t < LOGR; ++t) {
        const int half = R >> (t + 1);
#pragma unroll
        for (int g = 0; g < R; g += 2 * half)
#pragma unroll
            for (int i = 0; i < half; ++i) {
                const f32x2 u = a[g + i], v = a[g + i + half];
                a[g + i] = u + v;
                a[g + i + half] = mul_w32(u - v, i * (16 / half));
            }
    }
}
template <int R, int S, bool TW, bool ZPAD = false, bool HALFOUT = false> __device__ __forceinline__ void fft_pass(LAS f32x2* lds, const f32x2* tw, int tid) {
    constexpr int NB = FFT_N / R, PER = NB / 512, LOGR = (R == 32) ? 5 : 4;
    constexpr int RSTEP = NB + NB / 32;
    constexpr int WSTEP = (S == 1) ? 1 : (S + S / 32);
    f32x2 a[PER][R];
#pragma unroll
    for (int b = 0; b < PER; ++b) { const LAS f32x2* rp = lds + PH(tid + 512 * b);
#pragma unroll
        for (int k = 0; k < R; ++k) a[b][k] = (ZPAD && k >= R / 2) ? (f32x2){0.f, 0.f} : rp[k * RSTEP]; }
    lds_sync();
#pragma unroll
    for (int b = 0; b < PER; ++b) {
        const int beta = tid + 512 * b, q = beta & (S - 1), p = beta / S, base = q + R * S * p;
        dft_inreg<R>(a[b]);
        f32x2 w1 = (f32x2){1.f, 0.f}, wj = (f32x2){1.f, 0.f};
        if (TW) { w1 = tw[p * S]; wj = w1; }
        LAS f32x2* wp = lds + PH(base);
        wp[0] = a[b][0];
#pragma unroll
        for (int j = 1; j < (HALFOUT ? R / 2 : R); ++j) {
            f32x2 v = a[b][bitrev_c(j, LOGR)];
            if (TW) { v = cmul(v, wj); wj = cmul(wj, w1); }
            wp[j * WSTEP] = v;
        }
    }
    lds_sync();
}
template <bool ZPAD = false, bool HALFOUT = false> __device__ __forceinline__ void fft16k(LAS f32x2* lds, const f32x2* tw, int tid) {
    asm volatile("" : "+v"(tid));
    fft_pass<32, 1, true, ZPAD, false>(lds, tw, tid);
    fft_pass<32, 32, true>(lds, tw, tid);
    fft_pass<16, 1024, false, false, HALFOUT>(lds, tw, tid);
}
__device__ __forceinline__ void spec_pair(LAS f32x2* lds, const f32x2* ZK, int p) {
    const int f = p, f2 = (FFT_N - p) & (FFT_N - 1);
    const f32x2 A = ZK[f], A2 = ZK[f2], Z = lds[PH(f)], Z2 = lds[PH(f2)];
    const float kcx = 0.5f * (A.x + A2.x), kcy = 0.5f * (A.y - A2.y);
    const float dx = 0.5f * (A.x - A2.x), dy = 0.5f * (A.y + A2.y);
    const float k1x = dy, k1y = -dx;
    const float px = 0.5f * (kcx + k1x), py = 0.5f * (kcy + k1y), qx = 0.5f * (kcx - k1x), qy = 0.5f * (kcy - k1y);
    const float wx = Z.x * px - Z.y * py + (Z2.x * qx + Z2.y * qy);
    const float wy = Z.x * py + Z.y * px + (Z2.x * qy - Z2.y * qx);
    const float w2x = Z2.x * px + Z2.y * py + (Z.x * qx - Z.y * qy);
    const float w2y = Z2.y * px - Z2.x * py - (Z.x * qy + Z.y * qx);
    lds[PH(f)] = (f32x2){wx, -wy}; lds[PH(f2)] = (f32x2){w2x, -w2y};
}
__device__ __forceinline__ void spec_mul(LAS f32x2* lds, const f32x2* ZK, int tid) {
    asm volatile("" : "+v"(tid));
#pragma unroll 8
    for (int i = 0; i < 16; ++i) spec_pair(lds, ZK, tid + 512 * i);
    if (tid == 0) spec_pair(lds, ZK, 8192);
    lds_sync();
}
typedef _Float16 f16x4 __attribute__((ext_vector_type(4)));
__device__ __forceinline__ void filter_gemm(const bf16* h3h, const float* w4, _Float16* KF, int wgi, int nwg, int tid) {
    const int lane = tid & 63, wv = tid >> 6, fr = lane & 15, fq = lane >> 4;
    constexpr float MIN_DECAY = -3.0701134573253945f, MAX_DECAY = -15.350567286626973f;
    for (int cb = wgi; cb < 8192 / 32; cb += nwg) {
        bf16x8 Bh[2][2], Bl[2][2]; float adl[2];
#pragma unroll
        for (int ct = 0; ct < 2; ++ct) {
            const int col = 32 * cb + 16 * ct + fr;
            adl[ct] = fabsf(MIN_DECAY + (float)(col & (DHY - 1)) * ((MAX_DECAY - MIN_DECAY) / (float)(DHY - 1))) * (1.0f / (float)(SEQL - 1));
#pragma unroll
            for (int kk = 0; kk < 2; ++kk)
#pragma unroll
                for (int i = 0; i < 8; ++i) { const float w = w4[(size_t)(32 * kk + 8 * fq + i) * 8192 + col]; const unsigned hi = f2bf(w); Bh[ct][kk][i] = (short)hi; Bl[ct][kk][i] = (short)f2bf(w - bf2f(hi)); }
        }
        const bf16* apw = h3h + (size_t)(wv * 1024 + fr) * 64 + 8 * fq;
        _Float16* kout = KF + (size_t)(32 * cb + fr) * SEQL + wv * 1024 + 4 * fq;
        bf16x8 fa[4][4], fb[4][4];
        auto loadg = [&](bf16x8 (&f)[4][4], int g) {
#pragma unroll
            for (int q = 0; q < 4; ++q) { const bf16* ap = apw + (size_t)(g * 4 + q) * 16 * 64;
                f[q][0] = *(const bf16x8*)ap; f[q][1] = *(const bf16x8*)(ap + 32); f[q][2] = *(const bf16x8*)(ap + SEQL * 64); f[q][3] = *(const bf16x8*)(ap + SEQL * 64 + 32); }
        };
        auto compg = [&](const bf16x8 (&f)[4][4], int g) {
#pragma unroll
            for (int q = 0; q < 4; ++q) {
                const int blk = g * 4 + q, n0 = wv * 1024 + blk * 16 + 4 * fq;
#pragma unroll
                for (int ct = 0; ct < 2; ++ct) {
                    f32x4 acc = (f32x4){0.f, 0.f, 0.f, 0.f};
                    acc = __builtin_amdgcn_mfma_f32_16x16x32_bf16(f[q][2], Bh[ct][0], acc, 0, 0, 0); acc = __builtin_amdgcn_mfma_f32_16x16x32_bf16(f[q][3], Bh[ct][1], acc, 0, 0, 0);
                    acc = __builtin_amdgcn_mfma_f32_16x16x32_bf16(f[q][0], Bl[ct][0], acc, 0, 0, 0); acc = __builtin_amdgcn_mfma_f32_16x16x32_bf16(f[q][1], Bl[ct][1], acc, 0, 0, 0);
                    acc = __builtin_amdgcn_mfma_f32_16x16x32_bf16(f[q][0], Bh[ct][0], acc, 0, 0, 0); acc = __builtin_amdgcn_mfma_f32_16x16x32_bf16(f[q][1], Bh[ct][1], acc, 0, 0, 0);
                    f16x4 o;
#pragma unroll
                    for (int e = 0; e < 4; ++e) o[e] = (_Float16)(acc[e] * fexp(-(float)(n0 + e) * adl[ct]));
                    *(f16x4*)(kout + (size_t)16 * ct * SEQL + blk * 16) = o;
                }
            }
        };
        loadg(fa, 0);
#pragma unroll 1
        for (int gg = 0; gg < 8; ++gg) {
            loadg(fb, 2 * gg + 1); compg(fa, 2 * gg);
            loadg(fa, 2 * gg + 2 < 16 ? 2 * gg + 2 : 15); compg(fb, 2 * gg + 1);
        }
    }
}
struct HyArgs {
    const bf16* phy;
    const float *conv_w, *conv_b;
    const float* hy_bias;
    const _Float16* kf;
    const f32x2* tw;
    f32x2* zk;
    bf16* hyy;
};
__device__ __forceinline__ void load_conv3_16(const bf16* row, int t0, float w0, float w1, float w2, float bias, float (&out)[16]) {
    const v4u r0 = *(const v4u*)(row + t0), r1 = *(const v4u*)(row + t0 + 8);
    float u[18];
    u[0] = t0 > 0 ? bf2f(row[t0 - 1]) : 0.f;
    u[17] = (t0 + 16 < SEQL) ? bf2f(row[t0 + 16]) : 0.f;
    u[1] = bflo(r0.x); u[2] = bfhi(r0.x); u[3] = bflo(r0.y); u[4] = bfhi(r0.y); u[5] = bflo(r0.z); u[6] = bfhi(r0.z); u[7] = bflo(r0.w); u[8] = bfhi(r0.w);
    u[9] = bflo(r1.x); u[10] = bfhi(r1.x); u[11] = bflo(r1.y); u[12] = bfhi(r1.y); u[13] = bflo(r1.z); u[14] = bfhi(r1.z); u[15] = bflo(r1.w); u[16] = bfhi(r1.w);
#pragma unroll
    for (int e = 0; e < 16; ++e) out[e] = bias + w0 * u[e] + w1 * u[e + 1] + w2 * u[e + 2];
}
__device__ __forceinline__ void store16_bf16(bf16* dst, const float (&v)[16]) {
    v4u o0, o1; o0.x = pk2(v[0], v[1]); o0.y = pk2(v[2], v[3]); o0.z = pk2(v[4], v[5]); o0.w = pk2(v[6], v[7]);
    o1.x = pk2(v[8], v[9]); o1.y = pk2(v[10], v[11]); o1.z = pk2(v[12], v[13]); o1.w = pk2(v[14], v[15]);
    *(v4u*)dst = o0; *(v4u*)(dst + 8) = o1;
}
__device__ __forceinline__ void hyena_unit(const HyArgs& a, LAS unsigned char* ldsb_, int cp, int wgslot, int tid) {
    unsigned lzero; asm volatile("v_mov_b32 %0, 0" : "=v"(lzero));
    LAS unsigned char* ldsb = ldsb_ + lzero;
    LAS f32x2* lds = (LAS f32x2*)ldsb;
    const int c0 = 2 * cp, c1 = c0 + 1;
    f32x2* zk = a.zk + (size_t)wgslot * 2 * FFT_N;
    constexpr float MIN_DECAY = -3.0701134573253945f, MAX_DECAY = -15.350567286626973f;
    const float ad0 = fabsf(MIN_DECAY + (float)c0 * ((MAX_DECAY - MIN_DECAY) / (float)(DHY - 1)));
    const float ad1 = fabsf(MIN_DECAY + (float)c1 * ((MAX_DECAY - MIN_DECAY) / (float)(DHY - 1)));
    LAS float* prm = (LAS float*)(ldsb + HY_PRM_OFF);
    wg_sync();
    if (tid < 24) { const int k = tid & 3, sc = tid >> 2, st = sc >> 1, chn = st * DHY + c0 + (sc & 1); prm[tid] = k < 3 ? a.conv_w[k * 6144 + chn] : a.conv_b[chn]; }
    if (tid >= 32 && tid < 36) { const int j = tid - 32; prm[tid] = a.hy_bias[(j >> 1) * DHY + c0 + (j & 1)]; }
#pragma unroll 1
    for (int o = 0; o < 2; ++o) {
        int tq = tid; asm volatile("" : "+v"(tq)); const int t0 = 16 * tq;
        wg_sync();
        {
            const _Float16* kr = a.kf + (size_t)(o * 4096 + c0) * SEQL + t0;
            const v4u f0a = *(const v4u*)kr, f0b = *(const v4u*)(kr + 8), f1a = *(const v4u*)(kr + SEQL), f1b = *(const v4u*)(kr + SEQL + 8);
            const v4u b0a = *(const v4u*)(kr + (size_t)2048 * SEQL), b0b = *(const v4u*)(kr + (size_t)2048 * SEQL + 8), b1a = *(const v4u*)(kr + (size_t)2049 * SEQL), b1b = *(const v4u*)(kr + (size_t)2049 * SEQL + 8);
            typedef _Float16 h2 __attribute__((ext_vector_type(2)));
            const unsigned F0[8] = {f0a.x, f0a.y, f0a.z, f0a.w, f0b.x, f0b.y, f0b.z, f0b.w}, F1[8] = {f1a.x, f1a.y, f1a.z, f1a.w, f1b.x, f1b.y, f1b.z, f1b.w};
            const unsigned B0[8] = {b0a.x, b0a.y, b0a.z, b0a.w, b0b.x, b0b.y, b0b.z, b0b.w}, B1[8] = {b1a.x, b1a.y, b1a.z, b1a.w, b1b.x, b1b.y, b1b.z, b1b.w};
            if (tq == 0) lds[PH(SEQL)] = (f32x2){0.f, 0.f};
#pragma unroll
            for (int e2 = 0; e2 < 8; ++e2) {
                const h2 x0 = __builtin_bit_cast(h2, F0[e2]), x1 = __builtin_bit_cast(h2, F1[e2]), y0 = __builtin_bit_cast(h2, B0[e2]), y1 = __builtin_bit_cast(h2, B1[e2]);
                const int n = t0 + 2 * e2;
                lds[PH(n)] = (f32x2){(float)x0.x, (float)x1.x}; lds[PH(n + 1)] = (f32x2){(float)x0.y, (float)x1.y};
                if (n >= 1) lds[PH(FFT_N - n)] = (f32x2){(float)y0.x, (float)y1.x};
                lds[PH(FFT_N - n - 1)] = (f32x2){(float)y0.y, (float)y1.y};
            }
        }
        wg_sync();
        fft16k(lds, a.tw, tid);
#pragma unroll 4
        for (int i = 0; i < 32; ++i) zk[(size_t)o * FFT_N + tq + 512 * i] = lds[PH(tq + 512 * i)];
    }
    const float inv_n = 1.0f / (float)FFT_N;
    asm volatile("s_waitcnt vmcnt(0)" ::: "memory");
    wg_sync();
#pragma unroll 1
    for (int s = 0; s < NSEQ; ++s) {
        const size_t m0 = (size_t)s * SEQL;
        int tq = tid; asm volatile("" : "+v"(tq)); const int t0 = 16 * tq;
        {
            float v0[16], v1[16];
            load_conv3_16(a.phy + (size_t)(0 * DHY + c0) * NTOK + m0, t0, prm[0], prm[1], prm[2], prm[3], v0);
            load_conv3_16(a.phy + (size_t)(0 * DHY + c1) * NTOK + m0, t0, prm[4], prm[5], prm[6], prm[7], v1);
            wg_sync();
#pragma unroll
            for (int e = 0; e < 16; ++e) { lds[PH(t0 + e)] = (f32x2){v0[e], v1[e]}; }
        }
        wg_sync();
        fft16k<true, false>(lds, a.tw, tid);
        spec_mul(lds, zk, tid);
        fft16k<false, true>(lds, a.tw, tid);
        float z0[16], z1[16];
        {
            float x0[16], x1[16];
            load_conv3_16(a.phy + (size_t)(0 * DHY + c0) * NTOK + m0, t0, prm[0], prm[1], prm[2], prm[3], x0);
            load_conv3_16(a.phy + (size_t)(0 * DHY + c1) * NTOK + m0, t0, prm[4], prm[5], prm[6], prm[7], x1);
#pragma unroll
            for (int e = 0; e < 16; ++e) { const f32x2 r = lds[PH(t0 + e)]; z0[e] = r.x * inv_n + prm[32] * x0[e]; z1[e] = -r.y * inv_n + prm[33] * x1[e]; }
            load_conv3_16(a.phy + (size_t)(1 * DHY + c0) * NTOK + m0, t0, prm[8], prm[9], prm[10], prm[11], x0);
            load_conv3_16(a.phy + (size_t)(1 * DHY + c1) * NTOK + m0, t0, prm[12], prm[13], prm[14], prm[15], x1);
#pragma unroll
            for (int e = 0; e < 16; ++e) { z0[e] *= x0[e]; z1[e] *= x1[e]; }
        }
#pragma unroll
        for (int e = 0; e < 16; ++e) { lds[PH(t0 + e)] = (f32x2){z0[e], z1[e]}; }
        wg_sync();
        fft16k<true, false>(lds, a.tw, tid);
        spec_mul(lds, zk + FFT_N, tid);
        fft16k<false, true>(lds, a.tw, tid);
        {
            float x0[16], x1[16];
            load_conv3_16(a.phy + (size_t)(2 * DHY + c0) * NTOK + m0, t0, prm[16], prm[17], prm[18], prm[19], x0);
            load_conv3_16(a.phy + (size_t)(2 * DHY + c1) * NTOK + m0, t0, prm[20], prm[21], prm[22], prm[23], x1);
#pragma unroll
            for (int e = 0; e < 16; ++e) { const f32x2 r = lds[PH(t0 + e)];
                x0[e] = x0[e] * (r.x * inv_n + prm[34] * z0[e]); x1[e] = x1[e] * (-r.y * inv_n + prm[35] * z1[e]); }
            store16_bf16(a.hyy + (size_t)c0 * NTOK + m0 + t0, x0);
            store16_bf16(a.hyy + (size_t)c1 * NTOK + m0 + t0, x1);
        }
    }
}
constexpr int RG_T = 128, RG_NT = SEQL / RG_T;
constexpr int RG_XC_STRIDE = 272;
constexpr int RG_G_OFF = RG_T * RG_XC_STRIDE;
constexpr int RG_HF_OFF = 2 * RG_T * RG_XC_STRIDE;
constexpr int RG_LDS_BYTES = RG_HF_OFF + (RG_T / 4) * 512 * 4;
constexpr int RG_UNITS = NSEQ * RG_NT * NHEAD;
struct RgArgs {
    const bf16* prg;
    const float *conv_w, *conv_b;
    const bf16* rgw;
    const float *a_b, *x_b;
    const float* lam;
    f32x2* summ;
    bf16* rgy;
};
template <int PASS> __device__ __forceinline__ void rg_unit(const RgArgs& a, LAS unsigned char* lds, int unit, int tid) {
    const int wave = tid >> 6, lane = tid & 63, fr = lane & 15, fq = lane >> 4;
    const int h = unit % NHEAD, tt = (unit / NHEAD) % RG_NT, s = unit / (NHEAD * RG_NT);
    const int tok0 = tt * RG_T;
    const size_t mrow0 = (size_t)s * SEQL;
    wg_sync();
    {
        const int cg = h * HDIM + 2 * lane;
        float w0[4], w1[4];
#pragma unroll
        for (int k = 0; k < 4; ++k) { w0[k] = a.conv_w[k * DRG + cg]; w1[k] = a.conv_w[k * DRG + cg + 1]; }
        const float cb0 = a.conv_b[cg], cb1 = a.conv_b[cg + 1];
        const int tb = tok0 + 16 * wave;
        unsigned raw[19], graw[16];
#pragma unroll
        for (int q = 0; q < 19; ++q) { const int t = tb - 2 + q, tc = t < 0 ? 0 : (t > SEQL - 1 ? SEQL - 1 : t); raw[q] = *(const unsigned*)(a.prg + (mrow0 + tc) * DM + cg); }
        if (PASS == 2) {
#pragma unroll
            for (int i = 0; i < 16; ++i) graw[i] = *(const unsigned*)(a.prg + (mrow0 + tb + i) * DM + DRG + cg);
        }
#pragma unroll
        for (int q = 0; q < 19; ++q) { const int t = tb - 2 + q; if (t < 0 || t > SEQL - 1) raw[q] = 0u; }
#pragma unroll
        for (int i = 0; i < 16; ++i) {
            const float y0 = cb0 + w0[0] * bflo(raw[i]) + w0[1] * bflo(raw[i + 1]) + w0[2] * bflo(raw[i + 2]) + w0[3] * bflo(raw[i + 3]);
            const float y1 = cb1 + w1[0] * bfhi(raw[i]) + w1[1] * bfhi(raw[i + 1]) + w1[2] * bfhi(raw[i + 2]) + w1[3] * bfhi(raw[i + 3]);
            *(LAS unsigned*)(lds + (16 * wave + i) * RG_XC_STRIDE + lane * 4) = pk2(y0, y1);
            if (PASS == 2) *(LAS unsigned*)(lds + RG_G_OFF + (16 * wave + i) * RG_XC_STRIDE + lane * 4) = graw[i];
        }
    }
    wg_sync();
    const int ch = h * HDIM + 16 * wave + fr;
    LAS float* hfl = (LAS float*)(lds + RG_HF_OFF) + tid;
#pragma unroll
    for (int dir = 0; dir < 2; ++dir) {
        bf16x8 Br[4], Bi[4];
#pragma unroll
        for (int kk = 0; kk < 4; ++kk) {
            Br[kk] = *(const bf16x8*)(a.rgw + ((((size_t)dir * 2 + 0) * NHEAD + h) * HDIM + 16 * wave + fr) * HDIM + 32 * kk + 8 * fq);
            Bi[kk] = *(const bf16x8*)(a.rgw + ((((size_t)dir * 2 + 1) * NHEAD + h) * HDIM + 16 * wave + fr) * HDIM + 32 * kk + 8 * fq);
        }
        const float ba = a.a_b[dir * DRG + ch], bx = a.x_b[dir * DRG + ch];
        const float sp = log1pf(expf(-a.lam[dir * DRG + ch]));
        float carry = 0.f, ptot = 1.f;
        if (PASS == 2) {
            const f32x2* sm = a.summ + ((size_t)dir * NSEQ + s) * RG_NT * DRG + ch;
            const int cnt = dir == 0 ? tt : RG_NT - 1 - tt;
            for (int j0 = 0; j0 < cnt; j0 += 16) {
                f32x2 pb[16];
#pragma unroll
                for (int q = 0; q < 16; ++q) { const int jj = j0 + q, j = dir == 0 ? jj : RG_NT - 1 - jj, jc = jj < cnt ? j : tt; pb[q] = sm[(size_t)jc * DRG]; if (jj >= cnt) pb[q] = (f32x2){1.f, 0.f}; }
#pragma unroll
                for (int q = 0; q < 16; ++q) carry = pb[q].x * carry + pb[q].y;
            }
        }
        for (int bi = 0; bi < RG_T / 16; ++bi) {
            const int blk = dir == 0 ? bi : (RG_T / 16 - 1 - bi);
            f32x4 accR = (f32x4){0.f, 0.f, 0.f, 0.f}, accI = (f32x4){0.f, 0.f, 0.f, 0.f};
#pragma unroll
            for (int kk = 0; kk < 4; ++kk) {
                const bf16x8 af = *(const LAS bf16x8*)(lds + (16 * blk + fr) * RG_XC_STRIDE + (32 * kk + 8 * fq) * 2);
                accR = __builtin_amdgcn_mfma_f32_16x16x32_bf16(af, Br[kk], accR, 0, 0, 0);
                accI = __builtin_amdgcn_mfma_f32_16x16x32_bf16(af, Bi[kk], accI, 0, 0, 0);
            }
            float av[4], bv[4];
#pragma unroll
            for (int e = 0; e < 4; ++e) {
                const float r = sigmoidf_(accR[e] + ba), ig = sigmoidf_(accI[e] + bx);
                const float log_a = -8.0f * r * sp;
                av[e] = fexp(log_a);
                const float x2 = 2.0f * log_a;
                const float em = -x2 * (1.0f + x2 * (0.5f + x2 * (0.16666667f + x2 * (0.041666668f + x2 * (0.0083333338f + x2 * (0.0013888889f + x2 * (0.0001984127f + x2 * 0.0000248016f)))))));
                const float em2 = x2 < -0.25f ? (1.0f - av[e] * av[e]) : em;
                const float mult = __builtin_amdgcn_sqrtf(fmaxf(em2, 0.f));
                const float xcv = bf2f(*(const LAS unsigned short*)(lds + (16 * blk + 4 * fq + e) * RG_XC_STRIDE + (16 * wave + fr) * 2));
                bv[e] = mult * ig * xcv;
            }
            float A = 1.f, B = 0.f;
            if (dir == 0) {
#pragma unroll
                for (int e = 0; e < 4; ++e) { B = av[e] * B + bv[e]; A *= av[e]; }
            } else {
#pragma unroll
                for (int e = 3; e >= 0; --e) { B = av[e] * B + bv[e]; A *= av[e]; }
            }
            float hin;
            if (dir == 0) {
                float Ap = __shfl_up(A, 16), Bp = __shfl_up(B, 16);
                if (fq >= 1) { B = A * Bp + B; A = Ap * A; }
                Ap = __shfl_up(A, 32); Bp = __shfl_up(B, 32);
                if (fq >= 2) { B = A * Bp + B; A = Ap * A; }
                const float hend = A * carry + B;
                const float hprev = __shfl_up(hend, 16);
                hin = fq == 0 ? carry : hprev;
                carry = __shfl(hend, 48 + fr);
                if (PASS == 1) ptot *= __shfl(A, 48 + fr);
            } else {
                float Ap = __shfl_down(A, 16), Bp = __shfl_down(B, 16);
                if (fq <= 2) { B = A * Bp + B; A = Ap * A; }
                Ap = __shfl_down(A, 32); Bp = __shfl_down(B, 32);
                if (fq <= 1) { B = A * Bp + B; A = Ap * A; }
                const float hend = A * carry + B;
                const float hprev = __shfl_down(hend, 16);
                hin = fq == 3 ? carry : hprev;
                carry = __shfl(hend, fr);
                if (PASS == 1) ptot *= __shfl(A, fr);
            }
            if (PASS == 2) {
                if (dir == 0) {
                    float hh = hin;
#pragma unroll
                    for (int e = 0; e < 4; ++e) { hh = av[e] * hh + bv[e]; hfl[(blk * 4 + e) * 512] = hh; }
                } else {
                    float hh = hin, hb[4];
#pragma unroll
                    for (int e = 3; e >= 0; --e) { hh = av[e] * hh + bv[e]; hb[e] = hh; }
#pragma unroll
                    for (int e = 0; e < 4; ++e) {
                        const size_t m = mrow0 + tok0 + 16 * blk + 4 * fq + e;
                        const float g = bf2f(*(const LAS unsigned short*)(lds + RG_G_OFF + (16 * blk + 4 * fq + e) * RG_XC_STRIDE + (16 * wave + fr) * 2));
                        a.rgy[m * DRG + ch] = (bf16)f2bf((hfl[(blk * 4 + e) * 512] + hb[e]) * gelu_tanh(g));
                    }
                }
            }
        }
        if (PASS == 1 && fq == 0) a.summ[(((size_t)dir * NSEQ + s) * RG_NT + tt) * DRG + ch] = (f32x2){ptot, carry};
    }
}
__device__ __forceinline__ void mixnorm_rg_row(const bf16* rgy, const float* g_rg, bf16* mix, int m, int lane) {
    v4u r[4]; float s = 0.f;
#pragma unroll
    for (int j = 0; j < 4; ++j) { r[j] = *(const v4u*)(rgy + (size_t)m * DRG + (j * 64 + lane) * 8);
        const float a0 = bflo(r[j].x), a1 = bfhi(r[j].x), a2 = bflo(r[j].y), a3 = bfhi(r[j].y), a4 = bflo(r[j].z), a5 = bfhi(r[j].z), a6 = bflo(r[j].w), a7 = bfhi(r[j].w);
        s += (a0 * a0 + a1 * a1) + (a2 * a2 + a3 * a3) + (a4 * a4 + a5 * a5) + (a6 * a6 + a7 * a7); }
    const float rs = 1.0f / sqrtf(wave_sum(s) * (1.0f / DRG) + EPSN);
#pragma unroll
    for (int j = 0; j < 4; ++j) { const int c0 = (j * 64 + lane) * 8; const f32x4 g0 = *(const f32x4*)(g_rg + c0), g1 = *(const f32x4*)(g_rg + c0 + 4);
        v4u o; o.x = pk2(bflo(r[j].x) * rs * g0.x, bfhi(r[j].x) * rs * g0.y); o.y = pk2(bflo(r[j].y) * rs * g0.z, bfhi(r[j].y) * rs * g0.w);
        o.z = pk2(bflo(r[j].z) * rs * g1.x, bfhi(r[j].z) * rs * g1.y); o.w = pk2(bflo(r[j].w) * rs * g1.z, bfhi(r[j].w) * rs * g1.w);
        *(v4u*)(mix + (size_t)m * LDK + c0) = o; }
}
constexpr int MN_TILE_STRIDE = 66;
constexpr int MN_LDS_BYTES = 8 * 64 * MN_TILE_STRIDE * 2 + 8 * 64 * 4 + 64 * 4;
__device__ __forceinline__ void mixnorm_hy_tile(const bf16* hyy, const float* g_hy, bf16* mix, LAS unsigned char* lds, int tile, int tid) {
    const int wave = tid >> 6, lane = tid & 63, m0 = tile * 64;
    LAS unsigned short* tl = (LAS unsigned short*)(lds + wave * 64 * MN_TILE_STRIDE * 2);
    LAS float* part = (LAS float*)(lds + 8 * 64 * MN_TILE_STRIDE * 2);
    LAS float* scl = part + 8 * 64;
    wg_sync();
    float s = 0.f;
    for (int c = wave * 256; c < wave * 256 + 256; ++c) { const float v = bf2f(hyy[(size_t)c * NTOK + m0 + lane]); s += v * v; }
    part[wave * 64 + lane] = s;
    wg_sync();
    if (tid < 64) { float t = 0.f;
#pragma unroll
        for (int w = 0; w < 8; ++w) t += part[w * 64 + tid];
        scl[tid] = 1.0f / sqrtf(t * (1.0f / DHY) + EPSN); }
    wg_sync();
    for (int cb = wave; cb < DHY / 64; cb += 8) {
        for (int ci = 0; ci < 64; ++ci) tl[ci * MN_TILE_STRIDE + lane] = hyy[(size_t)(cb * 64 + ci) * NTOK + m0 + lane];
        asm volatile("s_waitcnt lgkmcnt(0)" ::: "memory");
        const float g = g_hy[cb * 64 + lane];
        for (int tk = 0; tk < 64; ++tk) mix[(size_t)(m0 + tk) * LDK + DRG + cb * 64 + lane] = (bf16)f2bf(bf2f(tl[lane * MN_TILE_STRIDE + tk]) * scl[tk] * g);
        asm volatile("s_waitcnt lgkmcnt(0)" ::: "memory");
    }
}
__device__ __forceinline__ void rowpass1(const float* xr, const bf16* yr, const float* g_post, const float* g_pre, float* outr, bf16* xnr, int lane) {
    float v[64]; float s = 0.f;
#pragma unroll
    for (int j = 0; j < 8; ++j) { const v4u r = *(const v4u*)(yr + (j * 64 + lane) * 8);
        v[8 * j + 0] = bflo(r.x); v[8 * j + 1] = bfhi(r.x); v[8 * j + 2] = bflo(r.y); v[8 * j + 3] = bfhi(r.y); v[8 * j + 4] = bflo(r.z); v[8 * j + 5] = bfhi(r.z); v[8 * j + 6] = bflo(r.w); v[8 * j + 7] = bfhi(r.w);
#pragma unroll
        for (int e = 0; e < 8; ++e) s += v[8 * j + e] * v[8 * j + e]; }
    const float rs = 1.0f / sqrtf(wave_sum(s) * (1.0f / DM) + EPSN);
    float s2 = 0.f;
#pragma unroll
    for (int j = 0; j < 8; ++j) { const int c0 = (j * 64 + lane) * 8;
        const f32x4 x0 = *(const f32x4*)(xr + c0), x1 = *(const f32x4*)(xr + c0 + 4), g0 = *(const f32x4*)(g_post + c0), g1 = *(const f32x4*)(g_post + c0 + 4);
        f32x4 o0, o1;
        o0.x = x0.x + v[8 * j + 0] * rs * g0.x; o0.y = x0.y + v[8 * j + 1] * rs * g0.y; o0.z = x0.z + v[8 * j + 2] * rs * g0.z; o0.w = x0.w + v[8 * j + 3] * rs * g0.w;
        o1.x = x1.x + v[8 * j + 4] * rs * g1.x; o1.y = x1.y + v[8 * j + 5] * rs * g1.y; o1.z = x1.z + v[8 * j + 6] * rs * g1.z; o1.w = x1.w + v[8 * j + 7] * rs * g1.w;
        *(f32x4*)(outr + c0) = o0; *(f32x4*)(outr + c0 + 4) = o1;
        v[8 * j + 0] = o0.x; v[8 * j + 1] = o0.y; v[8 * j + 2] = o0.z; v[8 * j + 3] = o0.w; v[8 * j + 4] = o1.x; v[8 * j + 5] = o1.y; v[8 * j + 6] = o1.z; v[8 * j + 7] = o1.w;
        s2 += (o0.x * o0.x + o0.y * o0.y) + (o0.z * o0.z + o0.w * o0.w) + (o1.x * o1.x + o1.y * o1.y) + (o1.z * o1.z + o1.w * o1.w); }
    const float rs2 = 1.0f / sqrtf(wave_sum(s2) * (1.0f / DM) + EPSN);
#pragma unroll
    for (int j = 0; j < 8; ++j) { const int c0 = (j * 64 + lane) * 8; const f32x4 g0 = *(const f32x4*)(g_pre + c0), g1 = *(const f32x4*)(g_pre + c0 + 4);
        v4u o; o.x = pk2(v[8 * j + 0] * rs2 * g0.x, v[8 * j + 1] * rs2 * g0.y); o.y = pk2(v[8 * j + 2] * rs2 * g0.z, v[8 * j + 3] * rs2 * g0.w);
        o.z = pk2(v[8 * j + 4] * rs2 * g1.x, v[8 * j + 5] * rs2 * g1.y); o.w = pk2(v[8 * j + 6] * rs2 * g1.z, v[8 * j + 7] * rs2 * g1.w);
        *(v4u*)(xnr + c0) = o; }
}
__device__ __forceinline__ void rowpass2(const bf16* fr_, const float* g, float* outr, int lane) {
    float v[64]; float s = 0.f;
#pragma unroll
    for (int j = 0; j < 8; ++j) { const v4u r = *(const v4u*)(fr_ + (j * 64 + lane) * 8);
        v[8 * j + 0] = bflo(r.x); v[8 * j + 1] = bfhi(r.x); v[8 * j + 2] = bflo(r.y); v[8 * j + 3] = bfhi(r.y); v[8 * j + 4] = bflo(r.z); v[8 * j + 5] = bfhi(r.z); v[8 * j + 6] = bflo(r.w); v[8 * j + 7] = bfhi(r.w);
#pragma unroll
        for (int e = 0; e < 8; ++e) s += v[8 * j + e] * v[8 * j + e]; }
    const float rs = 1.0f / sqrtf(wave_sum(s) * (1.0f / DM) + EPSN);
#pragma unroll
    for (int j = 0; j < 8; ++j) { const int c0 = (j * 64 + lane) * 8;
        const f32x4 x0 = *(const f32x4*)(outr + c0), x1 = *(const f32x4*)(outr + c0 + 4), g0 = *(const f32x4*)(g + c0), g1 = *(const f32x4*)(g + c0 + 4);
        f32x4 o0, o1;
        o0.x = x0.x + v[8 * j + 0] * rs * g0.x; o0.y = x0.y + v[8 * j + 1] * rs * g0.y; o0.z = x0.z + v[8 * j + 2] * rs * g0.z; o0.w = x0.w + v[8 * j + 3] * rs * g0.w;
        o1.x = x1.x + v[8 * j + 4] * rs * g1.x; o1.y = x1.y + v[8 * j + 5] * rs * g1.y; o1.z = x1.z + v[8 * j + 6] * rs * g1.z; o1.w = x1.w + v[8 * j + 7] * rs * g1.w;
        *(f32x4*)(outr + c0) = o0; *(f32x4*)(outr + c0 + 4) = o1; }
}
constexpr int SIDE_G_ROWS = 8, SIDE_U_ROWS = 4;
__device__ __forceinline__ float dpp_prev(float x, float xprevblk) {
    const int old = __builtin_amdgcn_update_dpp(0, __builtin_bit_cast(int, xprevblk), 0x121  , 0xf, 0xf, false);
    return __builtin_bit_cast(float, __builtin_amdgcn_update_dpp(old, __builtin_bit_cast(int, x), 0x111  , 0xf, 0xf, false));
}
__device__ __forceinline__ float dpp_next(float x, float xnextblk) {
    const int old = __builtin_amdgcn_update_dpp(0, __builtin_bit_cast(int, xnextblk), 0x12F  , 0xf, 0xf, false);
    return __builtin_bit_cast(float, __builtin_amdgcn_update_dpp(old, __builtin_bit_cast(int, x), 0x101  , 0xf, 0xf, false));
}
struct EpiGate {
    static constexpr bool PERM = true, AFTER_DRAIN = false, AROWPERM = true;
    bf16* H; const float* cw; const float* cb; float* sideG; float* sideU;
    __device__ __forceinline__ void operator()(const pg8::f32x4 (&acc)[2][2][4][2], const pg8::Unit& u, int wr, int wc, int fr, int fq) const {
        const int hc0 = u.pn * 128 + wc * 32 + 8 * fq;
        f32x4 w0[2], w1[2], w2[2], bb[2];
#pragma unroll
        for (int n = 0; n < 2; ++n) { w0[n] = *(const f32x4*)(cw + hc0 + 4 * n); w1[n] = *(const f32x4*)(cw + DFF + hc0 + 4 * n); w2[n] = *(const f32x4*)(cw + 2 * DFF + hc0 + 4 * n); bb[n] = *(const f32x4*)(cb + hc0 + 4 * n); }
        const size_t row0 = (size_t)u.pm * 256 + wr * 128 + fr;
        const f32x4 zero4 = (f32x4){0.f, 0.f, 0.f, 0.f};
#pragma unroll
        for (int blk = 0; blk < 8; ++blk) {
            const int ai = blk >> 2, m = blk & 3;
            float r[8];
#pragma unroll
            for (int n = 0; n < 2; ++n) {
                const f32x4 x = acc[ai][0][m][n];
                const f32x4 xp = blk > 0 ? acc[(blk - 1) >> 2][0][(blk - 1) & 3][n] : zero4;
                const f32x4 xn = blk < 7 ? acc[(blk + 1) >> 2][0][(blk + 1) & 3][n] : zero4;
                const f32x4 uu = acc[ai][1][m][n];
#pragma unroll
                for (int j = 0; j < 4; ++j) {
                    const float pre = bb[n][j] + w0[n][j] * dpp_prev(x[j], xp[j]) + w1[n][j] * x[j] + w2[n][j] * dpp_next(x[j], xn[j]);
                    r[4 * n + j] = gelu_tanh(pre) * uu[j];
                }
            }
            v4u o; o.x = pk2(r[0], r[1]); o.y = pk2(r[2], r[3]); o.z = pk2(r[4], r[5]); o.w = pk2(r[6], r[7]);
            *(v4u*)(H + (row0 + 16 * blk) * DFF + hc0) = o;
        }
        float* sg = sideG + ((size_t)u.pm * SIDE_G_ROWS + 4 * wr) * DFF + hc0;
        float* su = sideU + ((size_t)u.pm * SIDE_U_ROWS + 2 * wr) * DFF + hc0;
        if (fr < 2) { *(f32x4*)(sg + (size_t)fr * DFF) = acc[0][0][0][0]; *(f32x4*)(sg + (size_t)fr * DFF + 4) = acc[0][0][0][1]; }
        if (fr >= 14) { *(f32x4*)(sg + (size_t)(fr - 12) * DFF) = acc[1][0][3][0]; *(f32x4*)(sg + (size_t)(fr - 12) * DFF + 4) = acc[1][0][3][1]; }
        if (fr == 0) { *(f32x4*)su = acc[0][1][0][0]; *(f32x4*)(su + 4) = acc[0][1][0][1]; }
        if (fr == 15) { *(f32x4*)(su + DFF) = acc[1][1][3][0]; *(f32x4*)(su + DFF + 4) = acc[1][1][3][1]; }
    }
};
__device__ __forceinline__ void gate_fixup(const float* sideG, const float* sideU, const float* cw, const float* cb, bf16* H, int gtid, int nthreads) {
    constexpr int C4 = DFF / 4, NT = NTOK / 256;
    for (int idx = gtid; idx < NT * 4 * C4; idx += nthreads) {
        const int c = (idx % C4) * 4, k = (idx / C4) & 3, pm = idx / (4 * C4);
        const float* g = sideG + (size_t)pm * SIDE_G_ROWS * DFF + c;
        f32x4 prev, cur, next; int row;
        const f32x4 z = (f32x4){0.f, 0.f, 0.f, 0.f};
        if (k == 0) { row = 0; prev = (pm % 32 == 0) ? z : *(const f32x4*)(g - (size_t)SIDE_G_ROWS * DFF + 7 * (size_t)DFF); cur = *(const f32x4*)g; next = *(const f32x4*)(g + DFF); }
        else if (k == 1) { row = 127; prev = *(const f32x4*)(g + 2 * (size_t)DFF); cur = *(const f32x4*)(g + 3 * (size_t)DFF); next = *(const f32x4*)(g + 4 * (size_t)DFF); }
        else if (k == 2) { row = 128; prev = *(const f32x4*)(g + 3 * (size_t)DFF); cur = *(const f32x4*)(g + 4 * (size_t)DFF); next = *(const f32x4*)(g + 5 * (size_t)DFF); }
        else { row = 255; prev = *(const f32x4*)(g + 6 * (size_t)DFF); cur = *(const f32x4*)(g + 7 * (size_t)DFF); next = (pm % 32 == 31) ? z : *(const f32x4*)(g + (size_t)SIDE_G_ROWS * DFF); }
        const f32x4 uu = *(const f32x4*)(sideU + ((size_t)pm * SIDE_U_ROWS + k) * DFF + c);
        const f32x4 w0 = *(const f32x4*)(cw + c), w1 = *(const f32x4*)(cw + DFF + c), w2 = *(const f32x4*)(cw + 2 * DFF + c), b = *(const f32x4*)(cb + c);
        float r[4];
#pragma unroll
        for (int j = 0; j < 4; ++j) r[j] = gelu_tanh(b[j] + w0[j] * prev[j] + w1[j] * cur[j] + w2[j] * next[j]) * uu[j];
        v2u o; o.x = pk2(r[0], r[1]); o.y = pk2(r[2], r[3]);
        *(v2u*)(H + ((size_t)pm * 256 + row) * DFF + c) = o;
    }
}
constexpr int LDS_PHASE_BYTES = 143360;
constexpr int LDSCTL_OFF = LDS_PHASE_BYTES, LDS_BYTES = 147456;
constexpr int CW_BAR = 4096;
constexpr size_t CTL_ZERO_BYTES = 64 * 1024;
static_assert(HY_LDS_BYTES <= LDS_PHASE_BYTES && RG_LDS_BYTES <= LDS_PHASE_BYTES && MN_LDS_BYTES <= LDS_PHASE_BYTES && pg8::STAGE_BYTES <= LDS_PHASE_BYTES, "LDS map");
static_assert((CW_BAR + XCD_BAR_WORDS) * 4 <= (int)CTL_ZERO_BYTES, "control words inside the memset region");

struct MkArgs { const float* in[32]; float* out; unsigned char* ws; };
__device__ __forceinline__ pg8::Gemm dgemm(const bf16* A, const bf16* Bt, int M, int N, int K, int lda, int ldb) { pg8::Gemm g; g.A = A; g.Bt = Bt; g.M = M; g.N = N; g.K = K; g.lda = lda; g.ldb = ldb; return g; }
__device__ __forceinline__ pg8::EpiBf16<0> depi(bf16* O, int ldc) { pg8::EpiBf16<0> e; e.O = O; e.ldc = ldc; e.bias = nullptr; e.split_cols = 0; e.split_stride = 0; e.scale0 = 1.f; return e; }

__device__ __forceinline__ void gate_seq(const bf16* gu, const float* cw, const float* cb, bf16* h, int gtid, int nthreads) {
    constexpr int CG = DFF / 8;
    for (int idx = gtid; idx < SEQL * CG; idx += nthreads) {
        const int m = idx / CG, c0 = (idx % CG) * 8;
        const v4u z = (v4u){0u, 0u, 0u, 0u};
        const v4u gm = m > 0 ? *(const v4u*)(gu + (size_t)(m - 1) * 2 * DFF + c0) : z;
        const v4u g0 = *(const v4u*)(gu + (size_t)m * 2 * DFF + c0);
        const v4u gp = m < SEQL - 1 ? *(const v4u*)(gu + (size_t)(m + 1) * 2 * DFF + c0) : z;
        const v4u uu = *(const v4u*)(gu + (size_t)m * 2 * DFF + DFF + c0);
        float r[8];
#pragma unroll
        for (int e = 0; e < 8; ++e) {
            const unsigned wm = e < 2 ? gm.x : e < 4 ? gm.y : e < 6 ? gm.z : gm.w, w0 = e < 2 ? g0.x : e < 4 ? g0.y : e < 6 ? g0.z : g0.w, wp = e < 2 ? gp.x : e < 4 ? gp.y : e < 6 ? gp.z : gp.w, wu = e < 2 ? uu.x : e < 4 ? uu.y : e < 6 ? uu.z : uu.w;
            const float a = (e & 1) ? bfhi(wm) : bflo(wm), b = (e & 1) ? bfhi(w0) : bflo(w0), c = (e & 1) ? bfhi(wp) : bflo(wp), u = (e & 1) ? bfhi(wu) : bflo(wu);
            const float pre = cb[c0 + e] + cw[c0 + e] * a + cw[DFF + c0 + e] * b + cw[2 * DFF + c0 + e] * c;
            r[e] = gelu_tanh(pre) * u;
        }
        v4u o; o.x = pk2(r[0], r[1]); o.y = pk2(r[2], r[3]); o.z = pk2(r[4], r[5]); o.w = pk2(r[6], r[7]);
        *(v4u*)(h + (size_t)m * DFF + c0) = o;
    }
}

#if defined(__HIP_DEVICE_COMPILE__)
#define MK_NOPK __attribute__((target("no-packed-fp32-ops")))
#else
#define MK_NOPK
#endif
__global__ void __launch_bounds__(512, 2) MK_NOPK mk_fwd(MkArgs args) {
    extern __shared__ __attribute__((aligned(16))) unsigned char lds_raw[];
    LAS unsigned char* lds = (LAS unsigned char*)lds_raw;
    const int tid = threadIdx.x, lane = tid & 63, wave = __builtin_amdgcn_readfirstlane(tid >> 6);
    const int G = gridDim.x, bx = blockIdx.x;
    unsigned char* ws = args.ws;
    const float* const* in = args.in;
    volatile LAS unsigned* MISC = (volatile LAS unsigned*)(lds + LDSCTL_OFF);
    for (int u = tid; u < (LDS_BYTES - LDSCTL_OFF) / 4; u += 512) ((LAS unsigned*)(lds + LDSCTL_OFF))[u] = 0u;
    wg_sync();
    XcdBarrier bar = xcd_barrier_post((unsigned*)(ws + WS_CTL) + CW_BAR, MISC + 8);

    bf16* XN = (bf16*)(ws + WS_XN); bf16* WIN = (bf16*)(ws + WS_WIN);
    {
        ProArgs pa; pa.xp = in[0]; pa.xs = in[1]; pa.g_premix = in[2]; pa.w_in = in[3]; pa.w_out = in[24]; pa.w_ffi = in[27]; pa.w_ffo = in[30]; pa.rg_a_w = in[6]; pa.rg_x_w = in[8];
        pa.hy_w1 = in[13]; pa.hy_b1 = in[14]; pa.hy_w2 = in[15]; pa.hy_b2 = in[16]; pa.hy_w3 = in[17]; pa.hy_b3 = in[18]; pa.hy_freq = in[20]; pa.ws = ws;
        p0_prologue<true>(pa, lds, bx * 8 + wave, G * 8, wave, lane);
    }
    xcd_barrier(bar);
    {
        pg8::StaticOrder S; S.init(NTOK, 2 * DRG, G, bx);
        pg8::gemm_phase<pg8::EpiBf16<0>, pg8::StaticOrder, true, true>(lds, dgemm(XN, WIN, NTOK, 2 * DRG, DM, LDK, LDK), S, depi((bf16*)(ws + WS_PRG), 2 * DRG));
    }
    {
        pg8::StaticOrder S; S.init(3 * DHY, NTOK, G, bx);
        pg8::gemm_phase<pg8::EpiBf16<0>, pg8::StaticOrder, true, true>(lds, dgemm(WIN + (size_t)2 * DRG * LDK, XN, 3 * DHY, NTOK, DM, LDK, LDK), S, depi((bf16*)(ws + WS_PHY), NTOK));
    }
    { int tq = tid; asm volatile("" : "+v"(tq)); filter_gemm((const bf16*)(ws + WS_H3), in[19], (_Float16*)(ws + WS_KF), bx, G, tq); }
    xcd_barrier(bar);
    RgArgs ra; ra.prg = (const bf16*)(ws + WS_PRG); ra.conv_w = in[4]; ra.conv_b = in[5]; ra.rgw = (const bf16*)(ws + WS_RGW); ra.a_b = in[7]; ra.x_b = in[9]; ra.lam = in[10];
    ra.summ = (f32x2*)(ws + WS_SUMM); ra.rgy = (bf16*)(ws + WS_RGY);
    {
        HyArgs a; a.phy = (const bf16*)(ws + WS_PHY); a.conv_w = in[11]; a.conv_b = in[12]; a.hy_bias = in[21]; a.kf = (const _Float16*)(ws + WS_KF); a.tw = (const f32x2*)(ws + WS_TW);
        a.zk = (f32x2*)(ws + WS_ZK); a.hyy = (bf16*)(ws + WS_HYY);
        for (int cp = bx; cp < DHY / 2; cp += G) hyena_unit(a, lds, cp, bx, tid);
    }
    for (int u = bx; u < RG_UNITS; u += G) rg_unit<1>(ra, lds, u, tid);
    xcd_barrier(bar);
    for (int u = bx; u < RG_UNITS; u += G) rg_unit<2>(ra, lds, u, tid);
    xcd_barrier(bar);
    for (int m = bx * 8 + wave; m < NTOK; m += G * 8) mixnorm_rg_row((const bf16*)(ws + WS_RGY), in[22], (bf16*)(ws + WS_MIX), m, lane);
    for (int t = bx; t < NTOK / 64; t += G) mixnorm_hy_tile((const bf16*)(ws + WS_HYY), in[23], (bf16*)(ws + WS_MIX), lds, t, tid);
    xcd_barrier(bar);
    {
        pg8::StaticOrder S; S.init(NTOK, DM, G, bx);
        pg8::gemm_phase<pg8::EpiBf16<0>, pg8::StaticOrder, true, true>(lds, dgemm((bf16*)(ws + WS_MIX), (bf16*)(ws + WS_WOUT), NTOK, DM, DM, LDK, LDK), S, depi((bf16*)(ws + WS_Y), DM));
    }
    xcd_barrier(bar);
    for (int m = bx * 8 + wave; m < NTOK; m += G * 8) rowpass1(xrow_ptr(in[0], in[1], m), (const bf16*)(ws + WS_Y) + (size_t)m * DM, in[25], in[26], args.out + (size_t)m * DM, XN + (size_t)m * LDK, lane);
    xcd_barrier(bar);
    bf16* HB = (bf16*)(ws + WS_H);
    {
        pg8::StaticOrder S; S.init(NTOK, 2 * DFF, G, bx);
        EpiGate E; E.H = HB; E.cw = in[28]; E.cb = in[29]; E.sideG = (float*)(ws + WS_SIDEG); E.sideU = (float*)(ws + WS_SIDEU);
        pg8::gemm_phase<EpiGate, pg8::StaticOrder, true, true>(lds, dgemm(XN, (bf16*)(ws + WS_WFI), NTOK, 2 * DFF, DM, LDK, LDK), S, E);
    }
    xcd_barrier(bar);
    { int tq = tid; asm volatile("" : "+v"(tq)); gate_fixup((const float*)(ws + WS_SIDEG), (const float*)(ws + WS_SIDEU), in[28], in[29], HB, bx * 512 + tq, G * 512); }
    xcd_barrier(bar);
    {
        pg8::StaticOrder S; S.init(NTOK, DM, G, bx);
        pg8::gemm_phase<pg8::EpiBf16<0>, pg8::StaticOrder, true, true>(lds, dgemm(HB, (bf16*)(ws + WS_WFO), NTOK, DM, DFF, DFF, DFF), S, depi((bf16*)(ws + WS_F), DM));
    }
    xcd_barrier(bar);
    for (int m = bx * 8 + wave; m < NTOK; m += G * 8) rowpass2((const bf16*)(ws + WS_F) + (size_t)m * DM, in[31], args.out + (size_t)m * DM, lane);
}

extern "C" void kernel_launch(void* const* d_in, const int* in_sizes, int n_in, void* d_out, int out_size, void* d_ws, size_t ws_size, hipStream_t stream) {
    static int grid = 0;
    if (grid == 0) {
        grid = -1;
        if (n_in != 32 || out_size != NTOK * DM || ws_size < WS_END) { fprintf(stderr, "kernel_launch: unexpected sizes n_in %d out %d ws %zu (need %zu)\n", n_in, out_size, ws_size, (size_t)WS_END); return; }
        int dev = 0, cus = 0, per_cu = 0;
        if (hipGetDevice(&dev) != hipSuccess || hipDeviceGetAttribute(&cus, hipDeviceAttributeMultiprocessorCount, dev) != hipSuccess) return;
        if (hipFuncSetAttribute((const void*)mk_fwd, hipFuncAttributeMaxDynamicSharedMemorySize, LDS_BYTES) != hipSuccess) { fprintf(stderr, "kernel_launch: hipFuncSetAttribute failed\n"); return; }
        if (hipOccupancyMaxActiveBlocksPerMultiprocessor(&per_cu, (const void*)mk_fwd, 512, LDS_BYTES) != hipSuccess || per_cu < 1) { fprintf(stderr, "kernel_launch: occupancy query says %d blocks per CU\n", per_cu); (void)hipGetLastError(); return; }
        grid = cus;
    }
    if (grid < 0) return;
    if (hipMemsetAsync((char*)d_ws + WS_CTL, 0, CTL_ZERO_BYTES, stream) != hipSuccess) return;
    MkArgs a; memset(&a, 0, sizeof a);
    for (int i = 0; i < 32; ++i) a.in[i] = (const float*)d_in[i];
    a.out = (float*)d_out; a.ws = (unsigned char*)d_ws;
    hipLaunchKernelGGL(mk_fwd, dim3(grid), dim3(512), LDS_BYTES, stream, a);
}
```

```cpp
#include <hip/hip_runtime.h>
#include <cstdio>
#include <cstdint>
#ifndef PROBE_BLK
#define PROBE_BLK 0
#endif
#ifndef PROBE_MASK
#define PROBE_MASK 0ull
#endif
#if (PROBE_MASK >> 50) & 1
__device__ unsigned long long g_probe_epi;
#define PG8_PROBE_B() unsigned long long pg8_t0_ = 0; if (blockIdx.x == PROBE_BLK && threadIdx.x == 0) pg8_t0_ = __builtin_amdgcn_s_memrealtime()
#define PG8_PROBE_E() if (blockIdx.x == PROBE_BLK && threadIdx.x == 0) g_probe_epi += __builtin_amdgcn_s_memrealtime() - pg8_t0_
#else
#define PG8_PROBE_B()
#define PG8_PROBE_E()
#endif
#include <cstring>
namespace pg8 {
#define PG8_LAS __attribute__((address_space(3)))
typedef unsigned short bf16_t;
typedef short bf16x8 __attribute__((ext_vector_type(8)));
typedef float f32x4 __attribute__((ext_vector_type(4)));
typedef unsigned u32x4 __attribute__((ext_vector_type(4)));
constexpr int BM = 256, BK = 64, HALF = 128, HTB = HALF * BK * 2  , STAGE_BYTES = 8 * HTB, NXCD = 8, WGM = 8;

__host__ __device__ __forceinline__ int lds_byte(int r, int c) { const int st = (r >> 4) * 2 + (c >> 5), rr = r & 15, cc = c & 31, ob = rr * 64 + cc * 2; return st * 1024 + (ob ^ (((ob >> 9) & 1) << 5)); }
__host__ __device__ __forceinline__ void stage_rc(int b, int& R, int& C) { const int st = b / 1024, sb = b % 1024, swz = sb ^ (((sb >> 9) & 1) << 5); R = (st >> 1) * 16 + swz / 64; C = (st & 1) * 32 + (swz % 64) / 2; }
__host__ __device__ __forceinline__ int perm32(int rho) { const int n = rho >> 4, i = rho & 15; return 8 * (i >> 2) + 4 * n + (i & 3); }

struct Unit { int pm, pn; };
struct Gemm { const bf16_t* A; const bf16_t* Bt; int M, N, K, lda, ldb; };

struct StaticOrder {
    int nM, nN, nwg, G, c;
    __host__ __device__ __forceinline__ void init(int M, int N, int G_, int c_) { nM = M / BM; nN = N / BM; nwg = nM * nN; G = G_; c = c_; }
    __host__ __device__ __forceinline__ bool next(int i, Unit& u) const {
        const long L = (long)i * G + c; if (L >= nwg) return false;
        int wgid = (int)L; { const int q = nwg / NXCD, r = nwg % NXCD, xcd = wgid % NXCD, off = wgid / NXCD; wgid = (xcd < r ? xcd * (q + 1) : r * (q + 1) + (xcd - r) * q) + off; }
        const int nig = WGM * nN, gid = wgid / nig, fm = gid * WGM, gsz = (nM - fm) < WGM ? (nM - fm) : WGM;
        u.pm = fm + ((wgid % nig) % gsz); u.pn = (wgid % nig) / gsz; return true;
    }
    __device__ __forceinline__ void a_ready(const Unit&, int) const {}
    __device__ __forceinline__ void done(const Unit&) const {}
};

__device__ __forceinline__ unsigned cvt_pk_bf16(float lo, float hi) { unsigned r; asm volatile("v_cvt_pk_bf16_f32 %0, %1, %2" : "=v"(r) : "v"(lo), "v"(hi)); return r; }
typedef float f32x2 __attribute__((ext_vector_type(2)));
__device__ __forceinline__ f32x2 gelu_pk(f32x2 v) {
    const f32x2 av = __builtin_elementwise_abs(v), d = av * 0.2316418882f + 1.0f;
    f32x2 t; t.x = __builtin_amdgcn_rcpf(d.x); t.y = __builtin_amdgcn_rcpf(d.y);
    f32x2 q = t * 0.5307027145f + (-0.7265760135f); q = q * t + 0.7107068705f; q = q * t + (-0.142248368f); q = q * t + 0.127414796f; q = q * t;
    const f32x2 s = (v * v) * (-0.72134752044f);
    f32x2 e; e.x = __builtin_amdgcn_exp2f(s.x); e.y = __builtin_amdgcn_exp2f(s.y);
    const f32x2 m = v * (q * e), r = v - m;
    f32x2 o; o.x = v.x < 0.f ? m.x : r.x; o.y = v.y < 0.f ? m.y : r.y; return o;
}

template <int ACT  > struct EpiBf16 {
    static constexpr bool PERM = true, AFTER_DRAIN = false, AROWPERM = false; static_assert(ACT == 0 || ACT == 1, "EpiBf16: ACT is 0 (none) or 1 (gelu_pk)");
    bf16_t* O; int ldc; const float* bias; int split_cols; size_t split_stride; float scale0;
    __device__ __forceinline__ void operator()(const f32x4 (&acc)[2][2][4][2], const Unit& u, int wr, int wc, int fr, int fq) const {
        const int row0 = u.pm * BM + wr * 64 + fr; int colt = u.pn * BM; bf16_t* base = O;
        float sc = 1.f; if (split_cols) { const int t = colt / split_cols; base += (size_t)t * split_stride; colt -= t * split_cols; if (t == 0) sc = scale0; }
        const int col0 = colt + wc * 32 + 8 * fq, bcol0 = u.pn * BM + wc * 32 + 8 * fq;
        f32x4 bv[2][2];
#pragma unroll
        for (int bj = 0; bj < 2; ++bj)
#pragma unroll
            for (int n = 0; n < 2; ++n) bv[bj][n] = bias ? *(const f32x4*)(bias + bcol0 + bj * HALF + 4 * n) : (f32x4){0.f, 0.f, 0.f, 0.f};
#pragma unroll
        for (int ai = 0; ai < 2; ++ai)
#pragma unroll
            for (int m = 0; m < 4; ++m) { bf16_t* rowp = base + (size_t)(row0 + ai * HALF + m * 16) * ldc + col0;
#pragma unroll
                for (int bj = 0; bj < 2; ++bj) { f32x4 v0 = acc[ai][bj][m][0] + bv[bj][0], v1 = acc[ai][bj][m][1] + bv[bj][1];
                    if (ACT == 1) { f32x2 a = gelu_pk((f32x2){v0[0], v0[1]}), b = gelu_pk((f32x2){v0[2], v0[3]}), c = gelu_pk((f32x2){v1[0], v1[1]}), d = gelu_pk((f32x2){v1[2], v1[3]});
                        v0 = (f32x4){a.x, a.y, b.x, b.y}; v1 = (f32x4){c.x, c.y, d.x, d.y}; }
                    v0 = v0 * sc; v1 = v1 * sc; u32x4 w; w.x = cvt_pk_bf16(v0[0], v0[1]); w.y = cvt_pk_bf16(v0[2], v0[3]); w.z = cvt_pk_bf16(v1[0], v1[1]); w.w = cvt_pk_bf16(v1[2], v1[3]);
                    *(u32x4*)(rowp + bj * HALF) = w; } }
    }
};
template <class Epi, class Sched, bool ALIGN_EPI = false, bool SP2 = false>
__device__ __forceinline__ void gemm_phase(PG8_LAS unsigned char* lds, const Gemm g, const Sched& S, const Epi& E) {
    int tid_ = threadIdx.x; asm volatile("" : "+v"(tid_));
    const int tid = tid_, wid = __builtin_amdgcn_readfirstlane(tid >> 6), lane = tid & 63, wr = wid >> 2, wc = wid & 3, fr = lane & 15, fq = lane >> 4;
    const int K = g.K, nt = K / BK;
    unsigned voffA[2], voffB[2];
#pragma unroll
    for (int i = 0; i < 2; ++i) { int R, C; stage_rc(tid * 16 + i * 8192, R, C); const int Rb = Epi::PERM ? ((R & ~31) + perm32(R & 31)) : R; const int Ra = Epi::AROWPERM ? (128 * (R >> 6) + (R & 63)) : R;
        voffA[i] = (unsigned)(Ra * g.lda + C) * 2u; voffB[i] = (unsigned)(Rb * g.ldb + C) * 2u; }
    const size_t kstep = (size_t)(BK * 2);
    const size_t hstep = (size_t)HALF * g.ldb * 2;
    const size_t hstepA = (size_t)(Epi::AROWPERM ? 64 : HALF) * g.lda * 2;
    const size_t tstep = 2 * hstep, tstepA = (size_t)BM * g.lda * 2;
    const unsigned ldsw = (unsigned)wid * 1024u;
    const int aoff = lds_byte(wr * 64 + fr, fq * 8), boff = lds_byte(wc * 32 + fr, fq * 8);
#define PG8_SA(b, h) (((b) * 2 + (h)) * HTB)
#define PG8_SB(b, h) ((4 + (b) * 2 + (h)) * HTB)
#define PG8_STAGE(bufoff, gbase, voff) do { _Pragma("unroll") for (int _i = 0; _i < 2; ++_i) \
        __builtin_amdgcn_global_load_lds((const unsigned*)((const char*)(gbase) + (voff)[_i]), (PG8_LAS unsigned*)(lds + (bufoff) + ldsw + _i * 8192), 16, 0, 0); } while (0)
#define PG8_LDA(dst, b, h) do { _Pragma("unroll") for (int m = 0; m < 4; ++m) _Pragma("unroll") for (int k = 0; k < 2; ++k) dst[m][k] = *(const PG8_LAS bf16x8*)(lds + PG8_SA(b, h) + aoff + m * 2048 + k * 1024); } while (0)
#define PG8_LDB(dst, b, h) do { _Pragma("unroll") for (int n = 0; n < 2; ++n) _Pragma("unroll") for (int k = 0; k < 2; ++k) dst[n][k] = *(const PG8_LAS bf16x8*)(lds + PG8_SB(b, h) + boff + n * 2048 + k * 1024); } while (0)
#define PG8_MMA(ai, bj, At, Bt) do { __builtin_amdgcn_s_setprio(1); _Pragma("unroll") for (int m = 0; m < 4; ++m) _Pragma("unroll") for (int n = 0; n < 2; ++n) _Pragma("unroll") for (int k = 0; k < 2; ++k) \
        acc[ai][bj][m][n] = __builtin_amdgcn_mfma_f32_16x16x32_bf16(Bt[n][k], At[m][k], acc[ai][bj][m][n], 0, 0, 0); __builtin_amdgcn_s_setprio(0); } while (0)
#define PG8_WAIT_V(n) asm volatile("s_waitcnt vmcnt(" #n ")" ::: "memory")
#define PG8_WAIT_L(n) asm volatile("s_waitcnt lgkmcnt(" #n ")" ::: "memory")
#define PG8_BAR __builtin_amdgcn_s_barrier()
#define PG8_SCHED __builtin_amdgcn_sched_barrier(0)
    Unit cur, nxt; int ui = 0;
    if (!S.next(0, cur)) return;
    f32x4 acc[2][2][4][2];
#pragma unroll
    for (int a = 0; a < 2; ++a)
#pragma unroll
        for (int b = 0; b < 2; ++b)
#pragma unroll
            for (int m = 0; m < 4; ++m)
#pragma unroll
                for (int n = 0; n < 2; ++n) acc[a][b][m][n] = (f32x4){0.f, 0.f, 0.f, 0.f};
    bf16x8 At[4][2], B0[2][2], B1[2][2];
    const char* cA = (const char*)g.A + (size_t)cur.pm * tstepA; const char* cB = (const char*)g.Bt + (size_t)cur.pn * tstep;
    S.a_ready(cur, 0);
    if constexpr (SP2) {
        PG8_STAGE(PG8_SB(0, 0), cB, voffB); PG8_STAGE(PG8_SB(0, 1), cB + hstep, voffB); PG8_STAGE(PG8_SA(0, 0), cA, voffA); PG8_STAGE(PG8_SA(0, 1), cA + hstepA, voffA);
        if (wr == 1) PG8_BAR;
        PG8_WAIT_V(2); PG8_BAR;
        PG8_STAGE(PG8_SB(1, 0), cB + kstep, voffB); PG8_STAGE(PG8_SA(1, 0), cA + kstep, voffA); PG8_STAGE(PG8_SB(1, 1), cB + hstep + kstep, voffB);
        PG8_WAIT_V(6); PG8_BAR;
    } else {
        PG8_STAGE(PG8_SB(0, 0), cB, voffB); PG8_STAGE(PG8_SA(0, 0), cA, voffA); PG8_STAGE(PG8_SB(0, 1), cB + hstep, voffB); PG8_STAGE(PG8_SA(0, 1), cA + hstepA, voffA);
        if (wr == 1) PG8_BAR;
        PG8_WAIT_V(4); PG8_BAR;
        PG8_STAGE(PG8_SB(1, 0), cB + kstep, voffB); PG8_STAGE(PG8_SA(1, 0), cA + kstep, voffA); PG8_STAGE(PG8_SB(1, 1), cB + hstep + kstep, voffB);
        PG8_WAIT_V(6); PG8_BAR;
    }
    for (;;) {
        const bool has_next = S.next(ui + 1, nxt);
        const char* nA = has_next ? (const char*)g.A + (size_t)nxt.pm * tstepA : cA; const char* nB = has_next ? (const char*)g.Bt + (size_t)nxt.pn * tstep : cB;
        for (int t = 0; t < nt; t += 2) {
            const bool last = (t == nt - 2);
            const char* a1 = cA + (size_t)(t + 1) * kstep;
            const char* a2 = last ? nA : cA + (size_t)(t + 2) * kstep; const char* b2 = last ? nB : cB + (size_t)(t + 2) * kstep;
            const char* a3 = a2 + kstep; const char* b3 = b2 + kstep;
            if (last && has_next) S.a_ready(nxt, ui + 1);
            if constexpr (SP2) {
            PG8_LDB(B0, 0, 0); PG8_LDB(B1, 0, 1); PG8_SCHED; PG8_LDA(At, 0, 0); PG8_STAGE(PG8_SA(1, 1), a1 + hstepA, voffA);
            PG8_WAIT_V(8); PG8_WAIT_L(0); PG8_BAR; PG8_MMA(0, 0, At, B0); PG8_MMA(0, 1, At, B1); PG8_BAR; PG8_SCHED;
            PG8_LDA(At, 0, 1); PG8_STAGE(PG8_SB(0, 0), b2, voffB); PG8_STAGE(PG8_SB(0, 1), b2 + hstep, voffB); PG8_STAGE(PG8_SA(0, 0), a2, voffA);
            PG8_WAIT_V(8); PG8_WAIT_L(0); PG8_BAR; PG8_MMA(1, 0, At, B0); PG8_MMA(1, 1, At, B1); PG8_BAR; PG8_SCHED;
            PG8_LDB(B0, 1, 0); PG8_LDB(B1, 1, 1); PG8_SCHED; PG8_LDA(At, 1, 0); PG8_STAGE(PG8_SA(0, 1), a2 + hstepA, voffA);
            PG8_WAIT_V(8); PG8_WAIT_L(0); PG8_BAR; PG8_MMA(0, 0, At, B0); PG8_MMA(0, 1, At, B1); PG8_BAR; PG8_SCHED;
            PG8_LDA(At, 1, 1); PG8_STAGE(PG8_SB(1, 0), b3, voffB); PG8_STAGE(PG8_SB(1, 1), b3 + hstep, voffB); PG8_STAGE(PG8_SA(1, 0), a3, voffA);
            PG8_WAIT_V(8); PG8_WAIT_L(0); PG8_BAR; PG8_MMA(1, 0, At, B0); PG8_MMA(1, 1, At, B1); PG8_BAR; PG8_SCHED;
            } else {
            PG8_LDB(B0, 0, 0); PG8_SCHED; PG8_LDA(At, 0, 0); PG8_STAGE(PG8_SA(1, 1), a1 + hstepA, voffA);
            PG8_WAIT_L(8); PG8_BAR; PG8_WAIT_L(0); PG8_MMA(0, 0, At, B0); PG8_BAR; PG8_SCHED;
            PG8_LDB(B1, 0, 1); PG8_STAGE(PG8_SB(0, 0), b2, voffB);
            PG8_BAR; PG8_WAIT_L(0); PG8_MMA(0, 1, At, B1); PG8_BAR;
            PG8_LDA(At, 0, 1); PG8_STAGE(PG8_SA(0, 0), a2, voffA);
            PG8_BAR; PG8_WAIT_L(0); PG8_MMA(1, 0, At, B0); PG8_BAR; PG8_SCHED;
            PG8_STAGE(PG8_SB(0, 1), b2 + hstep, voffB);
            PG8_WAIT_V(6); PG8_BAR; PG8_MMA(1, 1, At, B1); PG8_BAR;
            PG8_LDB(B0, 1, 0); PG8_SCHED; PG8_LDA(At, 1, 0); PG8_STAGE(PG8_SA(0, 1), a2 + hstepA, voffA);
            PG8_WAIT_L(8); PG8_BAR; PG8_WAIT_L(0); PG8_MMA(0, 0, At, B0); PG8_BAR; PG8_SCHED;
            PG8_LDB(B1, 1, 1); PG8_STAGE(PG8_SB(1, 0), b3, voffB);
            PG8_BAR; PG8_WAIT_L(0); PG8_MMA(0, 1, At, B1); PG8_BAR;
            PG8_LDA(At, 1, 1); PG8_STAGE(PG8_SA(1, 0), a3, voffA);
            PG8_BAR; PG8_WAIT_L(0); PG8_MMA(1, 0, At, B0); PG8_BAR; PG8_SCHED;
            PG8_STAGE(PG8_SB(1, 1), b3 + hstep, voffB);
            PG8_WAIT_V(6); PG8_BAR; PG8_MMA(1, 1, At, B1); PG8_BAR;
            }
        }
        if constexpr (ALIGN_EPI) { if (wr == 0) PG8_BAR; }
        PG8_PROBE_B(); if constexpr (!Epi::AFTER_DRAIN) { E(acc, cur, wr, wc, fr, fq); S.done(cur); } PG8_PROBE_E();
        if (!has_next) break;
#pragma unroll
        for (int a = 0; a < 2; ++a)
#pragma unroll
            for (int b = 0; b < 2; ++b)
#pragma unroll
                for (int m = 0; m < 4; ++m)
#pragma unroll
                    for (int n = 0; n < 2; ++n) acc[a][b][m][n] = (f32x4){0.f, 0.f, 0.f, 0.f};
        cur = nxt; cA = nA; cB = nB; ++ui;
        if constexpr (ALIGN_EPI) { if (wr == 1) PG8_BAR; }
    }
    PG8_WAIT_V(0);
    if constexpr (!ALIGN_EPI) { if (wr == 0) PG8_BAR; }
    PG8_BAR;
    if constexpr (Epi::AFTER_DRAIN) { E.fused(acc, cur, wr, wc, fr, fq, lds, wid, lane); S.done(cur); }
#undef PG8_SA
#undef PG8_SB
#undef PG8_STAGE
#undef PG8_LDA
#undef PG8_LDB
#undef PG8_MMA
#undef PG8_WAIT_V
#undef PG8_WAIT_L
#undef PG8_BAR
#undef PG8_SCHED
}
}
constexpr int SEQL = 8192, NSEQ = 3, NTOK = NSEQ * SEQL;
constexpr int DM = 4096, DRG = 2048, DHY = 2048, NIN = 10240, DFF = 11008;
constexpr int NHEAD = 16, HDIM = 128;
constexpr float EPSN = 1e-6f;
constexpr int FFT_N = 16384;
constexpr int LDK = DM;

#define GAS __attribute__((address_space(1)))
#define LAS __attribute__((address_space(3)))
typedef unsigned short bf16;
typedef unsigned v4u __attribute__((ext_vector_type(4)));
typedef unsigned v2u __attribute__((ext_vector_type(2)));
typedef float f32x4 __attribute__((ext_vector_type(4)));
typedef float f32x2 __attribute__((ext_vector_type(2)));
typedef short bf16x8 __attribute__((ext_vector_type(8)));

__device__ __forceinline__ void wg_sync() { __builtin_amdgcn_fence(__ATOMIC_RELEASE, "workgroup"); __builtin_amdgcn_s_barrier(); __builtin_amdgcn_fence(__ATOMIC_ACQUIRE, "workgroup"); }
__device__ __forceinline__ void lds_sync() { asm volatile("s_waitcnt lgkmcnt(0)" ::: "memory"); __builtin_amdgcn_s_barrier(); asm volatile("" ::: "memory"); }
__device__ __forceinline__ unsigned f2bf(float f) { unsigned u = __builtin_bit_cast(unsigned, f); return (u + 0x7fffu + ((u >> 16) & 1u)) >> 16; }
__device__ __forceinline__ unsigned pk2(float lo, float hi) { return f2bf(lo) | (f2bf(hi) << 16); }
__device__ __forceinline__ float bf2f(unsigned b) { return __builtin_bit_cast(float, b << 16); }
__device__ __forceinline__ float bflo(unsigned w) { return __builtin_bit_cast(float, w << 16); }
__device__ __forceinline__ float bfhi(unsigned w) { return __builtin_bit_cast(float, w & 0xffff0000u); }
__device__ __forceinline__ float wave_sum(float v) {
#pragma unroll
    for (int o = 1; o < 64; o <<= 1) v += __shfl_xor(v, o);
    return v;
}
__device__ __forceinline__ float frcp(float x) { return __builtin_amdgcn_rcpf(x); }
__device__ __forceinline__ float fexp(float x) { return __builtin_amdgcn_exp2f(x * 1.4426950408889634f); }
__device__ __forceinline__ float sigmoidf_(float x) { return frcp(1.0f + fexp(-x)); }
__device__ __forceinline__ float gelu_tanh(float x) { const float u = 1.5957691216057308f * (x + 0.044715f * x * x * x); return x * frcp(1.0f + fexp(-u)); }

constexpr size_t MiB = 1u << 20;
constexpr size_t WS_CTL = 0;
constexpr size_t WS_TW = 1 * MiB;
constexpr size_t WS_H3 = 2 * MiB;
constexpr size_t WS_RGW = 4 * MiB;
constexpr size_t WS_SUMM = 6 * MiB;
constexpr size_t WS_WIN = 16 * MiB;
constexpr size_t WS_WOUT = 98 * MiB;
constexpr size_t WS_WFI = 131 * MiB;
constexpr size_t WS_WFO = 306 * MiB;
constexpr size_t WS_XN = 392 * MiB;
constexpr size_t WS_PRG = 588 * MiB;
constexpr size_t WS_PHY = 780 * MiB;
constexpr size_t WS_HYY = 1068 * MiB;
constexpr size_t WS_RGY = 1164 * MiB;
constexpr size_t WS_ZK = WS_WIN;
constexpr size_t WS_KF = 1164 * MiB;
constexpr size_t WS_H = WS_PHY;
constexpr size_t WS_SIDEG = 1296 * MiB;
constexpr size_t WS_SIDEU = 1329 * MiB;
constexpr size_t WS_END = 1346 * MiB;
static_assert(WS_WIN + (size_t)NIN * LDK * 2 <= WS_WOUT && WS_WOUT + (size_t)DM * LDK * 2 <= WS_WFI && WS_WFI + (size_t)2 * DFF * LDK * 2 <= WS_WFO && WS_WFO + (size_t)DM * DFF * 2 <= WS_XN &&
              WS_XN + (size_t)NTOK * LDK * 2 <= WS_PRG && WS_PRG + (size_t)NTOK * DM * 2 <= WS_PHY && WS_PHY + (size_t)3 * DHY * NTOK * 2 <= WS_HYY && WS_PHY + (size_t)NTOK * LDK * 2 <= WS_HYY &&
              WS_HYY + (size_t)DHY * NTOK * 2 <= WS_RGY && WS_RGY + (size_t)NTOK * DRG * 2 <= WS_SIDEG && WS_ZK + (size_t)256 * 2 * 8256 * 16 <= WS_WOUT && WS_KF + (size_t)8192 * 8192 * 2 <= WS_SIDEG && WS_H + (size_t)NTOK * DFF * 2 <= WS_SIDEG &&
              WS_SIDEG + (size_t)96 * 8 * DFF * 4 <= WS_SIDEU && WS_SIDEU + (size_t)96 * 4 * DFF * 4 <= WS_END, "d_ws map");
constexpr size_t WS_MIX = WS_PHY;
constexpr size_t WS_Y = WS_PRG;
constexpr size_t WS_F = WS_PRG;
#define XB_TMO      128
#define XB_XCNT(j)  (256  + 64 * (j))
#define XB_XSUB(j)  (1280 + 64 * (j))
#define XB_XGEN(j)  (2304 + 64 * (j))
#define XB_TOP      3328
#define XB_TOPGEN   3392
#define XCD_BAR_WORDS 3456
#define XB_SPIN_CAP (1u << 18)

__device__ __forceinline__ unsigned xb_ld(unsigned* p)              { return __hip_atomic_load(p, __ATOMIC_RELAXED, __HIP_MEMORY_SCOPE_AGENT); }
__device__ __forceinline__ unsigned xb_add(unsigned* p, unsigned v) { return __hip_atomic_fetch_add(p, v, __ATOMIC_RELAXED, __HIP_MEMORY_SCOPE_AGENT); }
__device__ __forceinline__ unsigned xb_xcc_id() { return (unsigned)__builtin_amdgcn_s_getreg((3 << 11) | 20) & 0xFu; }
#define XB_SPIN(cond, bar) do { unsigned _sp = 0; while (cond) { __builtin_amdgcn_s_sleep(1); \
    if ((++_sp & 255u) == 0u) { if (xb_ld(&(bar)[XB_TMO])) break; if (_sp > XB_SPIN_CAP) { atomicAdd(&(bar)[XB_TMO], 1u); break; } } } } while (0)

struct XcdBarrier {
    unsigned* bar; unsigned x;
    volatile LAS unsigned* st;
};

__device__ __forceinline__ XcdBarrier xcd_barrier_post(unsigned* bar, volatile LAS unsigned* st) {
    XcdBarrier b; b.bar = bar; b.x = xb_xcc_id(); b.st = st;
    if (threadIdx.x == 0) (void)xb_add(&bar[XB_XCNT(b.x)], 1u);
    return b;
}
__device__ __forceinline__ void xcd_barrier_complete(unsigned* bar, unsigned x, unsigned& nloc, unsigned& nx) {
    const unsigned G = gridDim.x * gridDim.y * gridDim.z;
    unsigned sum, cnt, mine, sp = 0u;
    for (;;) {
        sum = 0u; cnt = 0u; mine = 0u;
#pragma unroll
        for (unsigned j = 0; j < 16; ++j) { const unsigned c = xb_ld(&bar[XB_XCNT(j)]); sum += c; cnt += (c > 0u) ? 1u : 0u; mine = (j == x) ? c : mine; }
        if (sum == G) break;
        __builtin_amdgcn_s_sleep(1);
        if ((++sp & 255u) == 0u) { if (xb_ld(&bar[XB_TMO])) break; if (sp > XB_SPIN_CAP) { atomicAdd(&bar[XB_TMO], 1u); break; } }
    }
    nloc = mine > 0u ? mine : 1u; nx = cnt > 0u ? cnt : 1u;
}

__device__ __forceinline__ void xcd_barrier(const XcdBarrier& b) {
    asm volatile("s_waitcnt vmcnt(0)" ::: "memory");
    wg_sync();
    if (threadIdx.x == 0) {
        unsigned* bar = b.bar;
        __builtin_amdgcn_s_waitcnt(0);
        unsigned nloc = b.st[0], nx = b.st[1];
        if (nloc == 0u) { xcd_barrier_complete(bar, b.x, nloc, nx); b.st[0] = nloc; b.st[1] = nx; }
        const unsigned old = xb_add(&bar[XB_XSUB(b.x)], 1u);
        const unsigned gen = old / nloc;
        if (old + 1u == (gen + 1u) * nloc) {
            __builtin_amdgcn_fence(__ATOMIC_RELEASE, "agent");
            asm volatile("s_waitcnt vmcnt(0)" ::: "memory");
            const unsigned og = xb_add(&bar[XB_TOP], 1u);
            const unsigned tg = og / nx;
            if (og + 1u == (tg + 1u) * nx) xb_add(&bar[XB_TOPGEN], 1u);
            else XB_SPIN(xb_ld(&bar[XB_TOPGEN]) == tg, bar);
            __builtin_amdgcn_fence(__ATOMIC_ACQUIRE, "agent");
            xb_add(&bar[XB_XGEN(b.x)], 1u);
            asm volatile("s_waitcnt vmcnt(0)" ::: "memory");
        } else {
            XB_SPIN(xb_ld(&bar[XB_XGEN(b.x)]) == gen, bar);
            __builtin_amdgcn_fence(__ATOMIC_ACQUIRE, "agent");
            asm volatile("s_waitcnt vmcnt(0)" ::: "memory");
        }
    }
    wg_sync();
}
struct TrItem { const float* W; bf16* WT; int K, N, k0, n0, drow0, ldt; };
__device__ __forceinline__ void tr_load(const TrItem& t, int lane, f32x4 (&v)[8]) {
    const float* p = t.W + (size_t)(t.k0 + (lane >> 3)) * t.N + t.n0 + (lane & 7) * 4;
#pragma unroll
    for (int ii = 0; ii < 8; ++ii) v[ii] = __builtin_nontemporal_load((const f32x4*)(p + (size_t)8 * ii * t.N));
}
__device__ __forceinline__ void tr_store(const TrItem& t, int lane, const f32x4 (&v)[8], LAS float* scr) {
    LAS float* w = scr + (lane >> 3) * 33 + (lane & 7) * 4;
#pragma unroll
    for (int ii = 0; ii < 8; ++ii) { w[ii * 8 * 33 + 0] = v[ii].x; w[ii * 8 * 33 + 1] = v[ii].y; w[ii * 8 * 33 + 2] = v[ii].z; w[ii * 8 * 33 + 3] = v[ii].w; }
    asm volatile("s_waitcnt lgkmcnt(0)" ::: "memory");
    const int c = lane & 7;
#pragma unroll
    for (int j = 0; j < 4; ++j) { const int n = (lane >> 3) + 8 * j; const LAS float* s = scr + (8 * c) * 33 + n;
        v4u o; o.x = pk2(s[0 * 33], s[1 * 33]); o.y = pk2(s[2 * 33], s[3 * 33]); o.z = pk2(s[4 * 33], s[5 * 33]); o.w = pk2(s[6 * 33], s[7 * 33]);
        *(v4u*)(t.WT + (size_t)(t.drow0 + n) * t.ldt + t.k0 + 8 * c) = o; }
    asm volatile("s_waitcnt lgkmcnt(0)" ::: "memory");
}
template <bool INTER> __device__ __forceinline__ int ffi_drow(int n) {
    if (!INTER) return n;
    const int up = n >= DFF ? 1 : 0, c = n - up * DFF; return (c >> 7) * 256 + up * 128 + (c & 127);
}
struct ProArgs {
    const float *xp, *xs, *g_premix;
    const float *w_in, *w_out, *w_ffi, *w_ffo;
    const float *rg_a_w, *rg_x_w;
    const float *hy_w1, *hy_b1, *hy_w2, *hy_b2, *hy_w3, *hy_b3, *hy_freq;
    unsigned char* ws;
};
__device__ __forceinline__ const float* xrow_ptr(const float* xp, const float* xs, int m) { return m < SEQL ? xp + (size_t)m * DM : xs + (size_t)(m - SEQL) * DM; }

constexpr int TR_I_IN = (DM / 64) * (NIN / 32), TR_I_OUT = (DM / 64) * (DM / 32), TR_I_FI = (DM / 64) * (2 * DFF / 32), TR_I_FO = (DFF / 64) * (DM / 32);
template <bool INTER> __device__ __forceinline__ TrItem tr_decode(const ProArgs& a, int it) {
    bf16* WIN = (bf16*)(a.ws + WS_WIN); bf16* WOUT = (bf16*)(a.ws + WS_WOUT); bf16* WFI = (bf16*)(a.ws + WS_WFI); bf16* WFO = (bf16*)(a.ws + WS_WFO);
    TrItem t; int r = it;
    if (r < TR_I_IN) { const int nb = NIN / 32, kb = r / nb, n0 = (r % nb) * 32; t.W = a.w_in; t.WT = WIN; t.K = DM; t.N = NIN; t.k0 = kb * 64; t.n0 = n0; t.drow0 = n0; t.ldt = LDK; return t; } r -= TR_I_IN;
    if (r < TR_I_OUT) { const int nb = DM / 32, kb = r / nb, n0 = (r % nb) * 32; t.W = a.w_out; t.WT = WOUT; t.K = DM; t.N = DM; t.k0 = kb * 64; t.n0 = n0; t.drow0 = n0; t.ldt = LDK; return t; } r -= TR_I_OUT;
    if (r < TR_I_FI) { const int nb = 2 * DFF / 32, kb = r / nb, n0 = (r % nb) * 32; t.W = a.w_ffi; t.WT = WFI; t.K = DM; t.N = 2 * DFF; t.k0 = kb * 64; t.n0 = n0; t.drow0 = ffi_drow<INTER>(n0); t.ldt = LDK; return t; } r -= TR_I_FI;
    { const int nb = DM / 32, kb = r / nb, n0 = (r % nb) * 32; t.W = a.w_ffo; t.WT = WFO; t.K = DFF; t.N = DM; t.k0 = kb * 64; t.n0 = n0; t.drow0 = n0; t.ldt = DFF; return t; }
}
template <bool INTER> __device__ __forceinline__ void p0_transposes(const ProArgs& a, LAS float* scr, int lane, int gw, int NGW, int it0, int it1) {
    {
        int it = it0 + gw; TrItem cur; f32x4 vc[8], vn[8];
        if (it < it1) { cur = tr_decode<INTER>(a, it); tr_load(cur, lane, vc); }
        while (it < it1) {
            const int nx = it + NGW; TrItem nxt = cur;
            if (nx < it1) { nxt = tr_decode<INTER>(a, nx); tr_load(nxt, lane, vn); }
            tr_store(cur, lane, vc, scr);
            cur = nxt; it = nx;
#pragma unroll
            for (int ii = 0; ii < 8; ++ii) vc[ii] = vn[ii];
        }
    }
}
constexpr int BG_GRP = 1056, BG_SCR = 8 * BG_GRP;
struct BgConv { int it, nleft, step; };
__device__ __forceinline__ void bg_issue(const TrItem& t, int lane, LAS unsigned char* scr) {
    const float* p = t.W + (size_t)(t.k0 + (lane >> 3)) * t.N + t.n0 + (lane & 7) * 4;
#pragma unroll
    for (int ii = 0; ii < 8; ++ii) __builtin_amdgcn_global_load_lds((const unsigned*)(p + (size_t)8 * ii * t.N), (LAS unsigned*)(scr + ii * BG_GRP), 16, 0, 0);
}
template <int NY> __device__ __forceinline__ void bg_finish(const TrItem& t, int lane, const LAS unsigned char* scr) {
    static_assert(NY >= 0 && NY < 64, "vmcnt is a 6-bit counter");
    __builtin_amdgcn_s_waitcnt((NY & 15) | (7 << 4) | (15 << 8) | ((NY >> 4) << 14));
    asm volatile("" ::: "memory");
    const int c = lane & 7; const LAS float* s0 = (const LAS float*)scr + c * (BG_GRP / 4) + (lane >> 3);
#pragma unroll
    for (int j = 0; j < 4; ++j) { const LAS float* s = s0 + 8 * j; const int n = (lane >> 3) + 8 * j;
        v4u o; o.x = pk2(s[0], s[32]); o.y = pk2(s[64], s[96]); o.z = pk2(s[128], s[160]); o.w = pk2(s[192], s[224]);
        *(v4u*)(t.WT + (size_t)(t.drow0 + n) * t.ldt + t.k0 + 8 * c) = o; }
    asm volatile("s_waitcnt lgkmcnt(0)" ::: "memory");
}
template <bool INTER> __device__ __forceinline__ int bg_begin(const ProArgs& a, BgConv& bg, int lane, LAS unsigned char* scr) {
    if (bg.nleft <= 0) return -1;
    const int it = bg.it; bg.it += bg.step; --bg.nleft; bg_issue(tr_decode<INTER>(a, it), lane, scr); return it;
}
template <bool INTER, int NY> __device__ __forceinline__ void bg_end(const ProArgs& a, int it, int lane, LAS unsigned char* scr) {
    __builtin_amdgcn_s_waitcnt((NY & 15) | (7 << 4) | (15 << 8) | ((NY >> 4) << 14));
    if (it >= 0) bg_finish<NY>(tr_decode<INTER>(a, it), lane, scr); }
template <bool INTER> __device__ __forceinline__ void p0_prologue(const ProArgs& a, LAS unsigned char* lds, int gw, int NGW, int wave, int lane, int bg_slots) {
    bf16* WIN = (bf16*)(a.ws + WS_WIN); bf16* WOUT = (bf16*)(a.ws + WS_WOUT); bf16* WFI = (bf16*)(a.ws + WS_WFI); bf16* WFO = (bf16*)(a.ws + WS_WFO);
    LAS float* scr = (LAS float*)(lds + wave * 16384);
    p0_transposes<INTER>(a, scr, lane, gw, NGW, 0, TR_I_IN);
    { const long first = (long)TR_I_IN + (long)bg_slots * NGW, tot = TR_I_IN + TR_I_OUT + TR_I_FI; if (first < tot) p0_transposes<INTER>(a, scr, lane, gw, NGW, (int)first, (int)tot); }
    bf16* XN = (bf16*)(a.ws + WS_XN);
    for (int m = gw; m < NTOK; m += NGW) {
        const float* xr = xrow_ptr(a.xp, a.xs, m);
        f32x4 v[16]; float s = 0.f;
#pragma unroll
        for (int j = 0; j < 8; ++j) { const f32x4* p = (const f32x4*)(xr + (j * 64 + lane) * 8); v[2 * j] = p[0]; v[2 * j + 1] = p[1];
            s += (v[2 * j].x * v[2 * j].x + v[2 * j].y * v[2 * j].y) + (v[2 * j].z * v[2 * j].z + v[2 * j].w * v[2 * j].w);
            s += (v[2 * j + 1].x * v[2 * j + 1].x + v[2 * j + 1].y * v[2 * j + 1].y) + (v[2 * j + 1].z * v[2 * j + 1].z + v[2 * j + 1].w * v[2 * j + 1].w); }
        const float rs = 1.0f / sqrtf(wave_sum(s) * (1.0f / DM) + EPSN);
#pragma unroll
        for (int j = 0; j < 8; ++j) { const int c0 = (j * 64 + lane) * 8; const f32x4 g0 = *(const f32x4*)(a.g_premix + c0), g1 = *(const f32x4*)(a.g_premix + c0 + 4);
            const f32x4 a0 = v[2 * j] * rs * g0, a1 = v[2 * j + 1] * rs * g1;
            v4u o; o.x = pk2(a0.x, a0.y); o.y = pk2(a0.z, a0.w); o.z = pk2(a1.x, a1.y); o.w = pk2(a1.z, a1.w);
            *(v4u*)(XN + (size_t)m * LDK + c0) = o; }
    }
    bf16* RGW = (bf16*)(a.ws + WS_RGW);
    for (int base = gw * 64 + lane; base < 2 * 2 * NHEAD * HDIM * HDIM; base += NGW * 64 * 8) {
        float v[8];
#pragma unroll
        for (int q = 0; q < 8; ++q) { const int idx = base + q * NGW * 64; v[q] = 0.f;
            if (idx < 2 * 2 * NHEAD * HDIM * HDIM) { const int gate = (idx >> 18) & 1, dir = idx >> 19; const float* W = gate ? a.rg_x_w : a.rg_a_w; v[q] = W[(size_t)dir * (NHEAD * HDIM * HDIM) + (idx & (NHEAD * HDIM * HDIM - 1))]; } }
#pragma unroll
        for (int q = 0; q < 8; ++q) { const int idx = base + q * NGW * 64;
            if (idx < 2 * 2 * NHEAD * HDIM * HDIM) { const int j = idx & 127, i = (idx >> 7) & 127, hg = idx >> 14; RGW[((size_t)hg * HDIM + j) * HDIM + i] = (bf16)f2bf(v[q]); } }
    }
    f32x2* TW = (f32x2*)(a.ws + WS_TW);
    for (int k = gw * 64 + lane; k < FFT_N; k += NGW * 64) { float sn, cs; sincospif((float)k * (1.0f / 8192.0f), &sn, &cs); TW[k] = (f32x2){cs, -sn}; }
    bf16* H3H = (bf16*)(a.ws + WS_H3); bf16* H3L = H3H + SEQL * 64;
    const float fr = a.hy_freq[lane], b1 = a.hy_b1[lane], b2 = a.hy_b2[lane], b3 = a.hy_b3[lane];
    for (int n0 = gw; n0 < SEQL; n0 += 4 * NGW) {
        float zv[4], acc[4], h[4];
#pragma unroll
        for (int p = 0; p < 4; ++p) { const int nn = n0 + p * NGW, n = nn < SEQL ? nn : n0;
            zv[p] = 0.f;
            if (lane == 0) zv[p] = (float)n * (1.0f / (float)(SEQL - 1));
            else if (lane < 33) { const int k = (lane - 1) & 15; const float band = 1e-4f + (float)k * ((15.0f - 1e-4f) / 15.0f);
                const float ang = (6.283185307179586f / (float)SEQL) * (float)n * band; zv[p] = lane < 17 ? cosf(ang) : -sinf(ang); }
            acc[p] = b1; }
        for (int e = 0; e < 33; ++e) { const float w = a.hy_w1[e * 64 + lane];
#pragma unroll
            for (int p = 0; p < 4; ++p) acc[p] += __shfl(zv[p], e) * w; }
#pragma unroll
        for (int p = 0; p < 4; ++p) { h[p] = sinf(fr * acc[p]); acc[p] = b2; }
        for (int e = 0; e < 64; ++e) { const float w = a.hy_w2[e * 64 + lane];
#pragma unroll
            for (int p = 0; p < 4; ++p) acc[p] += __shfl(h[p], e) * w; }
#pragma unroll
        for (int p = 0; p < 4; ++p) { h[p] = sinf(fr * acc[p]); acc[p] = b3; }
        for (int e = 0; e < 64; ++e) { const float w = a.hy_w3[e * 64 + lane];
#pragma unroll
            for (int p = 0; p < 4; ++p) acc[p] += __shfl(h[p], e) * w; }
#pragma unroll
        for (int p = 0; p < 4; ++p) { const int n = n0 + p * NGW; const float hv = sinf(fr * acc[p]);
            if (n < SEQL) { const unsigned hi = f2bf(hv); H3H[n * 64 + lane] = (bf16)hi; H3L[n * 64 + lane] = (bf16)f2bf(hv - bf2f(hi)); } }
    }
}
constexpr int FFT_LDS_BYTES = (FFT_N + FFT_N / 32) * 8;
constexpr int HY_W4_OFF = FFT_LDS_BYTES;
constexpr int HY_PRM_OFF = FFT_LDS_BYTES + 1024;
constexpr int HY_TWT_OFF = FFT_LDS_BYTES + 1024 + 256;
constexpr int HY_LDS_BYTES = FFT_LDS_BYTES + 1024 + 256 + 4096;
__device__ __forceinline__ int PH(int i) { return i + (i >> 5); }
__device__ __forceinline__ f32x2 cmul(f32x2 a, f32x2 b) { return (f32x2){a.x * b.x - a.y * b.y, a.x * b.y + a.y * b.x}; }
__device__ __forceinline__ constexpr int bitrev_c(int r, int bits) { int o = 0; for (int i = 0; i < bits; ++i) o |= ((r >> i) & 1) << (bits - 1 - i); return o; }

__device__ __forceinline__ f32x2 mul_w32(f32x2 d, int idx) {
    constexpr float C[16] = {1.0f, 0.98078528040323043f, 0.92387953251128674f, 0.83146961230254524f, 0.70710678118654752f, 0.55557023301960218f, 0.38268343236508977f, 0.19509032201612825f,
                             0.0f, -0.19509032201612825f, -0.38268343236508977f, -0.55557023301960218f, -0.70710678118654752f, -0.83146961230254524f, -0.92387953251128674f, -0.98078528040323043f};
    constexpr float S[16] = {0.0f, 0.19509032201612825f, 0.38268343236508977f, 0.55557023301960218f, 0.70710678118654752f, 0.83146961230254524f, 0.92387953251128674f, 0.98078528040323043f,
                             1.0f, 0.98078528040323043f, 0.92387953251128674f, 0.83146961230254524f, 0.70710678118654752f, 0.55557023301960218f, 0.38268343236508977f, 0.19509032201612825f};
    if (idx == 0) return d;
    if (idx == 8) return (f32x2){d.y, -d.x};
    const float c = C[idx], s = S[idx];
    return (f32x2){d.x * c + d.y * s, d.y * c - d.x * s};
}
template <int R> __device__ __forceinline__ void dft_inreg(f32x2 (&a)[R]) {
    constexpr int LOGR = (R == 32) ? 5 : 4;
#pragma unroll
    for (int t = 0; t < LOGR; ++t) {
        const int half = R >> (t + 1);
#pragma unroll
        for (int g = 0; g < R; g += 2 * half)
#pragma unroll
            for (int i = 0; i < half; ++i) {
                const f32x2 u = a[g + i], v = a[g + i + half];
                a[g + i] = u + v;
                a[g + i + half] = mul_w32(u - v, i * (16 / half));
            }
    }
}
template <int R, int S, bool TW, bool ZPAD = false, bool HALFOUT = false, int TWMODE = 0> __device__ __forceinline__ void fft_pass(LAS f32x2* lds, const f32x2* tw, int tid) {
    static_assert(TWMODE != 1 || (S == 32 && R == 32), "the LDS twiddle table is the second pass's");
    constexpr int NB = FFT_N / R, PER = NB / 512, LOGR = (R == 32) ? 5 : 4;
    constexpr int RSTEP = NB + NB / 32;
    constexpr int WSTEP = (S == 1) ? 1 : (S + S / 32);
    f32x2 a[PER][R];
#pragma unroll
    for (int b = 0; b < PER; ++b) { const LAS f32x2* rp = lds + PH(tid + 512 * b);
#pragma unroll
        for (int k = 0; k < R; ++k) a[b][k] = (ZPAD && k >= R / 2) ? (f32x2){0.f, 0.f} : rp[k * RSTEP]; }
    lds_sync();
#pragma unroll
    for (int b = 0; b < PER; ++b) {
        const int beta = tid + 512 * b, q = beta & (S - 1), p = beta / S, base = q + R * S * p;
        dft_inreg<R>(a[b]);
        f32x2 w1 = (f32x2){1.f, 0.f}, wj = (f32x2){1.f, 0.f}, wm = (f32x2){1.f, 0.f};
        if (TW && TWMODE != 1) { w1 = tw[p * S]; wj = w1; }
        const float kc = 2.0f * w1.x;
        const LAS f32x2* tab = lds + (HY_TWT_OFF / 8) + p * 32;
        LAS f32x2* wp = lds + PH(base);
        wp[0] = a[b][0];
#pragma unroll
        for (int j = 1; j < (HALFOUT ? R / 2 : R); ++j) {
            f32x2 v = a[b][bitrev_c(j, LOGR)];
            if (TW) {
                if (TWMODE == 1) v = cmul(v, tab[j]);
                else { v = cmul(v, wj);
                    if (TWMODE == 2) { const f32x2 nx = (f32x2){kc * wj.x - wm.x, kc * wj.y - wm.y}; wm = wj; wj = nx; }
                    else wj = cmul(wj, w1); }
            }
            wp[j * WSTEP] = v;
        }
    }
    lds_sync();
}
template <bool ZPAD = false, bool HALFOUT = false> __device__ __forceinline__ void fft16k(LAS f32x2* lds, const f32x2* tw, int tid) {
    asm volatile("" : "+v"(tid));
    fft_pass<32, 1, true, ZPAD, false, 2>(lds, tw, tid);
    fft_pass<32, 32, true, false, false, 1>(lds, tw, tid);
    fft_pass<16, 1024, false, false, HALFOUT>(lds, tw, tid);
}
__device__ __forceinline__ void spec_pair(LAS f32x2* lds, const f32x2* ZK, int p) {
    const int f = p, f2 = (FFT_N - p) & (FFT_N - 1);
    const f32x2 A = ZK[f], A2 = ZK[f2], Z = lds[PH(f)], Z2 = lds[PH(f2)];
    const float kcx = 0.5f * (A.x + A2.x), kcy = 0.5f * (A.y - A2.y);
    const float dx = 0.5f * (A.x - A2.x), dy = 0.5f * (A.y + A2.y);
    const float k1x = dy, k1y = -dx;
    const float px = 0.5f * (kcx + k1x), py = 0.5f * (kcy + k1y), qx = 0.5f * (kcx - k1x), qy = 0.5f * (kcy - k1y);
    const float wx = Z.x * px - Z.y * py + (Z2.x * qx + Z2.y * qy);
    const float wy = Z.x * py + Z.y * px + (Z2.x * qy - Z2.y * qx);
    const float w2x = Z2.x * px + Z2.y * py + (Z.x * qx - Z.y * qy);
    const float w2y = Z2.y * px - Z2.x * py - (Z.x * qy + Z.y * qx);
    lds[PH(f)] = (f32x2){wx, -wy}; lds[PH(f2)] = (f32x2){w2x, -w2y};
}
__device__ __forceinline__ void spec_mul(LAS f32x2* lds, const f32x2* ZK, int tid) {
    asm volatile("" : "+v"(tid));
#pragma unroll 8
    for (int i = 0; i < 16; ++i) spec_pair(lds, ZK, tid + 512 * i);
    if (tid == 0) spec_pair(lds, ZK, 8192);
    lds_sync();
}
constexpr int PQ_STRIDE = 8256;
__device__ __forceinline__ f32x4 spec_pq(f32x2 A, f32x2 A2) {
    const float kcx = 0.5f * (A.x + A2.x), kcy = 0.5f * (A.y - A2.y), dx = 0.5f * (A.x - A2.x), dy = 0.5f * (A.y + A2.y), k1x = dy, k1y = -dx;
    return (f32x4){0.5f * (kcx + k1x), 0.5f * (kcy + k1y), 0.5f * (kcx - k1x), 0.5f * (kcy - k1y)};
}
__device__ __forceinline__ void spec_pair_pq(LAS f32x2* lds, f32x4 pq, int p) {
    const int f = p, f2 = (FFT_N - p) & (FFT_N - 1);
    const f32x2 Z = lds[PH(f)], Z2 = lds[PH(f2)];
    const float px = pq.x, py = pq.y, qx = pq.z, qy = pq.w;
    const float wx = Z.x * px - Z.y * py + (Z2.x * qx + Z2.y * qy);
    const float wy = Z.x * py + Z.y * px + (Z2.x * qy - Z2.y * qx);
    const float w2x = Z2.x * px + Z2.y * py + (Z.x * qx - Z.y * qy);
    const float w2y = Z2.y * px - Z2.x * py - (Z.x * qy + Z.y * qx);
    lds[PH(f)] = (f32x2){wx, -wy}; lds[PH(f2)] = (f32x2){w2x, -w2y};
}
__device__ __forceinline__ void spec_prefetch(const f32x4* PQ, int tid, f32x4 (&A)[8]) {
#pragma unroll
    for (int i = 0; i < 8; ++i) A[i] = PQ[tid + 512 * i];
}
__device__ __forceinline__ void spec_mul_pre(LAS f32x2* lds, const f32x4* PQ, int tid, const f32x4 (&A)[8]) {
    asm volatile("" : "+v"(tid));
    f32x4 B[8];
#pragma unroll
    for (int i = 0; i < 8; ++i) B[i] = PQ[tid + 512 * (i + 8)];
#pragma unroll
    for (int i = 0; i < 8; ++i) spec_pair_pq(lds, A[i], tid + 512 * i);
#pragma unroll
    for (int i = 0; i < 8; ++i) spec_pair_pq(lds, B[i], tid + 512 * (i + 8));
    if (tid == 0) spec_pair_pq(lds, PQ[8192], 8192);
    lds_sync();
}
typedef _Float16 f16x4 __attribute__((ext_vector_type(4)));
__device__ __forceinline__ void filter_gemm(const bf16* h3h, const float* w4, _Float16* KF, int wgi, int nwg, int tid) {
    const int lane = tid & 63, wv = tid >> 6, fr = lane & 15, fq = lane >> 4;
    constexpr float MIN_DECAY = -3.0701134573253945f, MAX_DECAY = -15.350567286626973f;
    for (int cb = wgi; cb < 8192 / 32; cb += nwg) {
        bf16x8 Bh[2][2], Bl[2][2]; float adl[2];
#pragma unroll
        for (int ct = 0; ct < 2; ++ct) {
            const int col = 32 * cb + 16 * ct + fr;
            adl[ct] = fabsf(MIN_DECAY + (float)(col & (DHY - 1)) * ((MAX_DECAY - MIN_DECAY) / (float)(DHY - 1))) * (1.0f / (float)(SEQL - 1));
#pragma unroll
            for (int kk = 0; kk < 2; ++kk)
#pragma unroll
                for (int i = 0; i < 8; ++i) { const float w = w4[(size_t)(32 * kk + 8 * fq + i) * 8192 + col]; const unsigned hi = f2bf(w); Bh[ct][kk][i] = (short)hi; Bl[ct][kk][i] = (short)f2bf(w - bf2f(hi)); }
        }
        const bf16* apw = h3h + (size_t)(wv * 1024 + fr) * 64 + 8 * fq;
        _Float16* kout = KF + (size_t)(32 * cb + fr) * SEQL + wv * 1024 + 4 * fq;
        bf16x8 fa[4][4], fb[4][4];
        auto loadg = [&](bf16x8 (&f)[4][4], int g) {
#pragma unroll
            for (int q = 0; q < 4; ++q) { const bf16* ap = apw + (size_t)(g * 4 + q) * 16 * 64;
                f[q][0] = *(const bf16x8*)ap; f[q][1] = *(const bf16x8*)(ap + 32); f[q][2] = *(const bf16x8*)(ap + SEQL * 64); f[q][3] = *(const bf16x8*)(ap + SEQL * 64 + 32); }
        };
        auto compg = [&](const bf16x8 (&f)[4][4], int g) {
#pragma unroll
            for (int q = 0; q < 4; ++q) {
                const int blk = g * 4 + q, n0 = wv * 1024 + blk * 16 + 4 * fq;
#pragma unroll
                for (int ct = 0; ct < 2; ++ct) {
                    f32x4 acc = (f32x4){0.f, 0.f, 0.f, 0.f};
                    acc = __builtin_amdgcn_mfma_f32_16x16x32_bf16(f[q][2], Bh[ct][0], acc, 0, 0, 0); acc = __builtin_amdgcn_mfma_f32_16x16x32_bf16(f[q][3], Bh[ct][1], acc, 0, 0, 0);
                    acc = __builtin_amdgcn_mfma_f32_16x16x32_bf16(f[q][0], Bl[ct][0], acc, 0, 0, 0); acc = __builtin_amdgcn_mfma_f32_16x16x32_bf16(f[q][1], Bl[ct][1], acc, 0, 0, 0);
                    acc = __builtin_amdgcn_mfma_f32_16x16x32_bf16(f[q][0], Bh[ct][0], acc, 0, 0, 0); acc = __builtin_amdgcn_mfma_f32_16x16x32_bf16(f[q][1], Bh[ct][1], acc, 0, 0, 0);
                    f16x4 o;
#pragma unroll
                    for (int e = 0; e < 4; ++e) o[e] = (_Float16)(acc[e] * fexp(-(float)(n0 + e) * adl[ct]));
                    *(f16x4*)(kout + (size_t)16 * ct * SEQL + blk * 16) = o;
                }
            }
        };
        loadg(fa, 0);
#pragma unroll 1
        for (int gg = 0; gg < 8; ++gg) {
            loadg(fb, 2 * gg + 1); compg(fa, 2 * gg);
            loadg(fa, 2 * gg + 2 < 16 ? 2 * gg + 2 : 15); compg(fb, 2 * gg + 1);
        }
    }
}
struct HyArgs {
    const bf16* phy;
    const float *conv_w, *conv_b;
    const float* hy_bias;
    const _Float16* kf;
    const f32x2* tw;
    f32x2* zk;
    bf16* hyy;
};
__device__ __forceinline__ void load_conv3_16(const bf16* row, int t0, float w0, float w1, float w2, float bias, float (&out)[16]) {
    const v4u r0 = *(const v4u*)(row + t0), r1 = *(const v4u*)(row + t0 + 8);
    float u[18];
    u[0] = t0 > 0 ? bf2f(row[t0 - 1]) : 0.f;
    u[17] = (t0 + 16 < SEQL) ? bf2f(row[t0 + 16]) : 0.f;
    u[1] = bflo(r0.x); u[2] = bfhi(r0.x); u[3] = bflo(r0.y); u[4] = bfhi(r0.y); u[5] = bflo(r0.z); u[6] = bfhi(r0.z); u[7] = bflo(r0.w); u[8] = bfhi(r0.w);
    u[9] = bflo(r1.x); u[10] = bfhi(r1.x); u[11] = bflo(r1.y); u[12] = bfhi(r1.y); u[13] = bflo(r1.z); u[14] = bfhi(r1.z); u[15] = bflo(r1.w); u[16] = bfhi(r1.w);
#pragma unroll
    for (int e = 0; e < 16; ++e) out[e] = bias + w0 * u[e] + w1 * u[e + 1] + w2 * u[e + 2];
}
struct Raw16 { v4u a, b; unsigned lo, hi; };
__device__ __forceinline__ Raw16 load_raw16(const bf16* row, int t0) {
    Raw16 r; r.a = *(const v4u*)(row + t0); r.b = *(const v4u*)(row + t0 + 8);
    r.lo = t0 > 0 ? (unsigned)row[t0 - 1] : 0u; r.hi = (t0 + 16 < SEQL) ? (unsigned)row[t0 + 16] : 0u; return r;
}
__device__ __forceinline__ void conv3_raw16(const Raw16& r, float w0, float w1, float w2, float bias, float (&out)[16]) {
    float u[18];
    u[0] = bf2f(r.lo); u[17] = bf2f(r.hi);
    u[1] = bflo(r.a.x); u[2] = bfhi(r.a.x); u[3] = bflo(r.a.y); u[4] = bfhi(r.a.y); u[5] = bflo(r.a.z); u[6] = bfhi(r.a.z); u[7] = bflo(r.a.w); u[8] = bfhi(r.a.w);
    u[9] = bflo(r.b.x); u[10] = bfhi(r.b.x); u[11] = bflo(r.b.y); u[12] = bfhi(r.b.y); u[13] = bflo(r.b.z); u[14] = bfhi(r.b.z); u[15] = bflo(r.b.w); u[16] = bfhi(r.b.w);
#pragma unroll
    for (int e = 0; e < 16; ++e) out[e] = bias + w0 * u[e] + w1 * u[e + 1] + w2 * u[e + 2];
}
__device__ __forceinline__ void store16_bf16(bf16* dst, const float (&v)[16]) {
    v4u o0, o1; o0.x = pk2(v[0], v[1]); o0.y = pk2(v[2], v[3]); o0.z = pk2(v[4], v[5]); o0.w = pk2(v[6], v[7]);
    o1.x = pk2(v[8], v[9]); o1.y = pk2(v[10], v[11]); o1.z = pk2(v[12], v[13]); o1.w = pk2(v[14], v[15]);
    *(v4u*)dst = o0; *(v4u*)(dst + 8) = o1;
}
#ifndef PROBE_MASK
#define PROBE_MASK 0ull
#endif
#define HPB(bit) do { if ((PROBE_MASK >> (bit)) & 1ull) { if (blockIdx.x == PROBE_BLK && threadIdx.x == 0) pt0 = __builtin_amdgcn_s_memrealtime(); } } while (0)
#define HPE(bit) do { if ((PROBE_MASK >> (bit)) & 1ull) { if (blockIdx.x == PROBE_BLK && threadIdx.x == 0) pacc += __builtin_amdgcn_s_memrealtime() - pt0; } } while (0)
__device__ __forceinline__ void hyena_unit(const HyArgs& a, LAS unsigned char* ldsb_, int cp, int wgslot, int tid, unsigned long long& pt0, unsigned long long& pacc) {
    unsigned lzero; asm volatile("v_mov_b32 %0, 0" : "=v"(lzero));
    LAS unsigned char* ldsb = ldsb_ + lzero;
    LAS f32x2* lds = (LAS f32x2*)ldsb;
    const int c0 = 2 * cp, c1 = c0 + 1;
    f32x4* pqw = (f32x4*)a.zk + (size_t)wgslot * 2 * PQ_STRIDE;
    constexpr float MIN_DECAY = -3.0701134573253945f, MAX_DECAY = -15.350567286626973f;
    const float ad0 = fabsf(MIN_DECAY + (float)c0 * ((MAX_DECAY - MIN_DECAY) / (float)(DHY - 1)));
    const float ad1 = fabsf(MIN_DECAY + (float)c1 * ((MAX_DECAY - MIN_DECAY) / (float)(DHY - 1)));
    LAS float* prm = (LAS float*)(ldsb + HY_PRM_OFF);
    wg_sync();
    ((LAS f32x2*)(ldsb + HY_TWT_OFF))[tid] = a.tw[32 * (tid >> 5) * (tid & 31)];
    if (tid < 24) { const int k = tid & 3, sc = tid >> 2, st = sc >> 1, chn = st * DHY + c0 + (sc & 1); prm[tid] = k < 3 ? a.conv_w[k * 6144 + chn] : a.conv_b[chn]; }
    if (tid >= 32 && tid < 36) { const int j = tid - 32; prm[tid] = a.hy_bias[(j >> 1) * DHY + c0 + (j & 1)]; }
    HPB(12);
#pragma unroll 1
    for (int o = 0; o < 2; ++o) {
        int tq = tid; asm volatile("" : "+v"(tq)); const int t0 = 16 * tq;
        wg_sync();
        {
            const _Float16* kr = a.kf + (size_t)(o * 4096 + c0) * SEQL + t0;
            const v4u f0a = *(const v4u*)kr, f0b = *(const v4u*)(kr + 8), f1a = *(const v4u*)(kr + SEQL), f1b = *(const v4u*)(kr + SEQL + 8);
            const v4u b0a = *(const v4u*)(kr + (size_t)2048 * SEQL), b0b = *(const v4u*)(kr + (size_t)2048 * SEQL + 8), b1a = *(const v4u*)(kr + (size_t)2049 * SEQL), b1b = *(const v4u*)(kr + (size_t)2049 * SEQL + 8);
            typedef _Float16 h2 __attribute__((ext_vector_type(2)));
            const unsigned F0[8] = {f0a.x, f0a.y, f0a.z, f0a.w, f0b.x, f0b.y, f0b.z, f0b.w}, F1[8] = {f1a.x, f1a.y, f1a.z, f1a.w, f1b.x, f1b.y, f1b.z, f1b.w};
            const unsigned B0[8] = {b0a.x, b0a.y, b0a.z, b0a.w, b0b.x, b0b.y, b0b.z, b0b.w}, B1[8] = {b1a.x, b1a.y, b1a.z, b1a.w, b1b.x, b1b.y, b1b.z, b1b.w};
            if (tq == 0) lds[PH(SEQL)] = (f32x2){0.f, 0.f};
#pragma unroll
            for (int e2 = 0; e2 < 8; ++e2) {
                const h2 x0 = __builtin_bit_cast(h2, F0[e2]), x1 = __builtin_bit_cast(h2, F1[e2]), y0 = __builtin_bit_cast(h2, B0[e2]), y1 = __builtin_bit_cast(h2, B1[e2]);
                const int n = t0 + 2 * e2;
                lds[PH(n)] = (f32x2){(float)x0.x, (float)x1.x}; lds[PH(n + 1)] = (f32x2){(float)x0.y, (float)x1.y};
                if (n >= 1) lds[PH(FFT_N - n)] = (f32x2){(float)y0.x, (float)y1.x};
                lds[PH(FFT_N - n - 1)] = (f32x2){(float)y0.y, (float)y1.y};
            }
        }
        wg_sync();
        fft16k(lds, a.tw, tid);
#pragma unroll 4
        for (int i = 0; i < 16; ++i) { const int p = tq + 512 * i; pqw[(size_t)o * PQ_STRIDE + p] = spec_pq(lds[PH(p)], lds[PH((FFT_N - p) & (FFT_N - 1))]); }
        if (tq == 0) pqw[(size_t)o * PQ_STRIDE + 8192] = spec_pq(lds[PH(8192)], lds[PH(8192)]);
    }
    HPE(12);
    const float inv_n = 1.0f / (float)FFT_N;
    asm volatile("s_waitcnt vmcnt(0)" ::: "memory");
    wg_sync();
#pragma unroll 1
    for (int s = 0; s < NSEQ; ++s) {
        const size_t m0 = (size_t)s * SEQL;
        int tq = tid; asm volatile("" : "+v"(tq)); const int t0 = 16 * tq;
        const Raw16 rv0 = load_raw16(a.phy + (size_t)(0 * DHY + c0) * NTOK + m0, t0), rv1 = load_raw16(a.phy + (size_t)(0 * DHY + c1) * NTOK + m0, t0);
        {
            float v0[16], v1[16];
            conv3_raw16(rv0, prm[0], prm[1], prm[2], prm[3], v0); conv3_raw16(rv1, prm[4], prm[5], prm[6], prm[7], v1);
            wg_sync();
#pragma unroll
            for (int e = 0; e < 16; ++e) { lds[PH(t0 + e)] = (f32x2){v0[e], v1[e]}; }
        }
        wg_sync();
        { f32x4 zA[8]; spec_prefetch(pqw, tid, zA);
        HPB(13); fft16k<true, false>(lds, a.tw, tid); HPE(13);
        HPB(14); spec_mul_pre(lds, pqw, tid, zA); HPE(14); }
        const Raw16 rx0 = load_raw16(a.phy + (size_t)(1 * DHY + c0) * NTOK + m0, t0), rx1 = load_raw16(a.phy + (size_t)(1 * DHY + c1) * NTOK + m0, t0);
        HPB(15); fft16k<false, true>(lds, a.tw, tid); HPE(15);
        float z0[16], z1[16];
        {
            float x0[16], x1[16];
            conv3_raw16(rv0, prm[0], prm[1], prm[2], prm[3], x0); conv3_raw16(rv1, prm[4], prm[5], prm[6], prm[7], x1);
#pragma unroll
            for (int e = 0; e < 16; ++e) { const f32x2 r = lds[PH(t0 + e)]; z0[e] = r.x * inv_n + prm[32] * x0[e]; z1[e] = -r.y * inv_n + prm[33] * x1[e]; }
            conv3_raw16(rx0, prm[8], prm[9], prm[10], prm[11], x0); conv3_raw16(rx1, prm[12], prm[13], prm[14], prm[15], x1);
#pragma unroll
            for (int e = 0; e < 16; ++e) { z0[e] *= x0[e]; z1[e] *= x1[e]; }
        }
#pragma unroll
        for (int e = 0; e < 16; ++e) { lds[PH(t0 + e)] = (f32x2){z0[e], z1[e]}; }
        wg_sync();
        { f32x4 zA[8]; spec_prefetch(pqw + PQ_STRIDE, tid, zA);
        HPB(13); fft16k<true, false>(lds, a.tw, tid); HPE(13);
        HPB(14); spec_mul_pre(lds, pqw + PQ_STRIDE, tid, zA); HPE(14); }
        const Raw16 ry0 = load_raw16(a.phy + (size_t)(2 * DHY + c0) * NTOK + m0, t0), ry1 = load_raw16(a.phy + (size_t)(2 * DHY + c1) * NTOK + m0, t0);
        HPB(15); fft16k<false, true>(lds, a.tw, tid); HPE(15);
        {
            float x0[16], x1[16];
            conv3_raw16(ry0, prm[16], prm[17], prm[18], prm[19], x0); conv3_raw16(ry1, prm[20], prm[21], prm[22], prm[23], x1);
#pragma unroll
            for (int e = 0; e < 16; ++e) { const f32x2 r = lds[PH(t0 + e)];
                x0[e] = x0[e] * (r.x * inv_n + prm[34] * z0[e]); x1[e] = x1[e] * (-r.y * inv_n + prm[35] * z1[e]); }
            store16_bf16(a.hyy + (size_t)c0 * NTOK + m0 + t0, x0);
            store16_bf16(a.hyy + (size_t)c1 * NTOK + m0 + t0, x1);
        }
    }
}
constexpr int RG_T = 128, RG_NT = SEQL / RG_T;
constexpr int RG_XC_STRIDE = 272;
constexpr int RG_G_OFF = RG_T * RG_XC_STRIDE;
constexpr int RG_HF_OFF = 2 * RG_T * RG_XC_STRIDE;
constexpr int RG_LDS_BYTES = RG_HF_OFF + 8 * BG_SCR;
constexpr int RG_UNITS = NSEQ * RG_NT * NHEAD;
struct RgArgs {
    const bf16* prg;
    const float *conv_w, *conv_b;
    const bf16* rgw;
    const float *a_b, *x_b;
    const float* lam;
    f32x2* summ;
    bf16* rgy;
    v4u* ab[2];
};
struct RgW { bf16x8 Br[2][4], Bi[2][4]; float ba[2], bx[2], sp[2]; };
__device__ __forceinline__ void rg_load_w(const RgArgs& a, int h, int tid, RgW& w) {
    const int wave = tid >> 6, lane = tid & 63, fr = lane & 15, fq = lane >> 4, ch = h * HDIM + 16 * wave + fr;
#pragma unroll
    for (int dir = 0; dir < 2; ++dir) {
#pragma unroll
        for (int kk = 0; kk < 4; ++kk) {
            w.Br[dir][kk] = *(const bf16x8*)(a.rgw + ((((size_t)dir * 2 + 0) * NHEAD + h) * HDIM + 16 * wave + fr) * HDIM + 32 * kk + 8 * fq);
            w.Bi[dir][kk] = *(const bf16x8*)(a.rgw + ((((size_t)dir * 2 + 1) * NHEAD + h) * HDIM + 16 * wave + fr) * HDIM + 32 * kk + 8 * fq);
        }
        w.ba[dir] = a.a_b[dir * DRG + ch]; w.bx[dir] = a.x_b[dir * DRG + ch];
        w.sp[dir] = log1pf(expf(-a.lam[dir * DRG + ch]));
    }
}
constexpr int RG_CIN_OFF = 0;
static_assert(8 * 512 * 4 <= RG_T * RG_XC_STRIDE, "RG carry table inside the xc tile");
__device__ __forceinline__ void rg_carry_table(const RgArgs& a, LAS unsigned char* lds, int h, int tt0, int s, int tid) {
    const int wave = tid >> 6, lane = tid & 63, fr = lane & 15, ch = h * HDIM + 16 * wave + fr;
    LAS float* tab = (LAS float*)(lds + RG_CIN_OFF) + tid;
#pragma unroll 1
    for (int dir = 0; dir < 2; ++dir) {
        const f32x2* sm = a.summ + ((size_t)dir * NSEQ + s) * RG_NT * DRG + ch;
        float carry = 0.f;
#pragma unroll 1
        for (int j0 = 0; j0 < RG_NT; j0 += 32) {
            f32x2 pb[32];
#pragma unroll
            for (int q = 0; q < 32; ++q) { const int jj = j0 + q, j = dir == 0 ? jj : RG_NT - 1 - jj; pb[q] = sm[(size_t)j * DRG]; }
#pragma unroll
            for (int q = 0; q < 32; ++q) { const int jj = j0 + q, j = dir == 0 ? jj : RG_NT - 1 - jj, d = j - tt0;
                if (d >= 0 && (d & 15) == 0) tab[(dir * 4 + (d >> 4)) * 512] = carry;
                carry = pb[q].x * carry + pb[q].y; }
        }
    }
}
template <int PASS> __device__ __forceinline__ void rg_unit(const RgArgs& a, LAS unsigned char* lds, int unit, int tid, const RgW& W, const ProArgs& pa, BgConv& bg, bool use_tab, unsigned long long& pt0, unsigned long long& pacc) {
    const int wave = tid >> 6, lane = tid & 63, fr = lane & 15, fq = lane >> 4;
    LAS unsigned char* bscr = lds + RG_HF_OFF + __builtin_amdgcn_readfirstlane(tid >> 6) * BG_SCR;
    int pendA = -1, pendB = -1;
    const int h = unit % NHEAD, tt = (unit / NHEAD) % RG_NT, s = unit / (NHEAD * RG_NT);
    const int tok0 = tt * RG_T;
    const size_t mrow0 = (size_t)s * SEQL;
    HPB(30);
    wg_sync();
    v4u stq[2][RG_T / 16];
    if (PASS == 1) {
        const int cg = h * HDIM + 2 * lane;
        float w0[4], w1[4];
#pragma unroll
        for (int k = 0; k < 4; ++k) { w0[k] = a.conv_w[k * DRG + cg]; w1[k] = a.conv_w[k * DRG + cg + 1]; }
        const float cb0 = a.conv_b[cg], cb1 = a.conv_b[cg + 1];
        const int tb = tok0 + 16 * wave;
        unsigned raw[19];
#pragma unroll
        for (int q = 0; q < 19; ++q) { const int t = tb - 2 + q, tc = t < 0 ? 0 : (t > SEQL - 1 ? SEQL - 1 : t); raw[q] = *(const unsigned*)(a.prg + (mrow0 + tc) * DM + cg); }
#pragma unroll
        for (int q = 0; q < 19; ++q) { const int t = tb - 2 + q; if (t < 0 || t > SEQL - 1) raw[q] = 0u; }
#pragma unroll
        for (int i = 0; i < 16; ++i) {
            const float y0 = cb0 + w0[0] * bflo(raw[i]) + w0[1] * bflo(raw[i + 1]) + w0[2] * bflo(raw[i + 2]) + w0[3] * bflo(raw[i + 3]);
            const float y1 = cb1 + w1[0] * bfhi(raw[i]) + w1[1] * bfhi(raw[i + 1]) + w1[2] * bfhi(raw[i + 2]) + w1[3] * bfhi(raw[i + 3]);
            *(LAS unsigned*)(lds + (16 * wave + i) * RG_XC_STRIDE + lane * 4) = pk2(y0, y1);
        }
    } else {
        const int cg = h * HDIM + 2 * lane, tb = tok0 + 16 * wave;
        unsigned graw[16];
#pragma unroll
        for (int i = 0; i < 16; ++i) graw[i] = *(const unsigned*)(a.prg + (mrow0 + tb + i) * DM + DRG + cg);
#pragma unroll
        for (int b = 0; b < RG_T / 16; ++b) stq[0][b] = a.ab[0][((size_t)unit * (RG_T / 16) + b) * 512 + tid];
#pragma unroll
        for (int i = 0; i < 16; ++i) *(LAS unsigned*)(lds + RG_G_OFF + (16 * wave + i) * RG_XC_STRIDE + lane * 4) = graw[i];
    }
    wg_sync();
    HPE(30);
    if (PASS == 1) pendA = bg_begin<true>(pa, bg, lane, bscr);
    const int ch = h * HDIM + 16 * wave + fr;
    float hf[RG_T / 16][4];
#pragma unroll
    for (int dir = 0; dir < 2; ++dir) {
        if (dir == 1) { if (PASS == 1) { bg_end<true, 4>(pa, pendA, lane, bscr); pendB = bg_begin<true>(pa, bg, lane, bscr); }
                        else bg_end<true, 0>(pa, pendA, lane, bscr); }
        const bf16x8 (&Br)[4] = W.Br[dir], (&Bi)[4] = W.Bi[dir];
        const float ba = W.ba[dir], bx = W.bx[dir], sp = W.sp[dir];
        float carry = 0.f, ptot = 1.f;
        if (PASS == 2 && use_tab) carry = ((const LAS float*)(lds + RG_CIN_OFF))[((dir * 4 + (tt >> 4)) * 512) + tid];
        if (PASS == 2 && !use_tab) {
            const f32x2* sm = a.summ + ((size_t)dir * NSEQ + s) * RG_NT * DRG + ch;
            const int cnt = dir == 0 ? tt : RG_NT - 1 - tt;
            for (int j0 = 0; j0 < cnt; j0 += 16) {
                f32x2 pb[16];
#pragma unroll
                for (int q = 0; q < 16; ++q) { const int jj = j0 + q, j = dir == 0 ? jj : RG_NT - 1 - jj, jc = jj < cnt ? j : tt; pb[q] = sm[(size_t)jc * DRG]; if (jj >= cnt) pb[q] = (f32x2){1.f, 0.f}; }
#pragma unroll
                for (int q = 0; q < 16; ++q) carry = pb[q].x * carry + pb[q].y;
            }
        }
        if (PASS == 2) { __builtin_amdgcn_s_waitcnt(0x0F70);
                         if (dir == 0) {
#pragma unroll
                             for (int b = 0; b < RG_T / 16; ++b) stq[1][b] = a.ab[1][((size_t)unit * (RG_T / 16) + b) * 512 + tid];
                         }
                         if (dir == 0) pendA = bg_begin<true>(pa, bg, lane, bscr); else pendB = bg_begin<true>(pa, bg, lane, bscr); }
        HPB(31 + dir);
        constexpr int NB = 4;
#pragma unroll
        for (int hx = 0; hx < 2; ++hx) {
        const int b0 = (dir == 0 ? hx : 1 - hx) * NB;
        HPB(33);
        float av[NB][4], bv[NB][4];
#pragma unroll
        for (int j = 0; j < NB; ++j) {
            const int blk = b0 + j;
            typedef _Float16 h2 __attribute__((ext_vector_type(2)));
            if (PASS == 1) {
                f32x4 accR = (f32x4){0.f, 0.f, 0.f, 0.f}, accI = (f32x4){0.f, 0.f, 0.f, 0.f};
#pragma unroll
                for (int kk = 0; kk < 4; ++kk) {
                    const bf16x8 af = *(const LAS bf16x8*)(lds + (16 * blk + fr) * RG_XC_STRIDE + (32 * kk + 8 * fq) * 2);
                    accR = __builtin_amdgcn_mfma_f32_16x16x32_bf16(af, Br[kk], accR, 0, 0, 0);
                    accI = __builtin_amdgcn_mfma_f32_16x16x32_bf16(af, Bi[kk], accI, 0, 0, 0);
                }
                unsigned pk[4];
#pragma unroll
                for (int e = 0; e < 4; ++e) {
                    const float r = sigmoidf_(accR[e] + ba), ig = sigmoidf_(accI[e] + bx);
                    const float log_a = -8.0f * r * sp;
                    const float a0 = fexp(log_a);
                    const float x2 = 2.0f * log_a;
                    const float em = -x2 * (1.0f + x2 * (0.5f + x2 * (0.16666667f + x2 * (0.041666668f + x2 * (0.0083333338f + x2 * 0.0013888889f)))));
                    const float em2 = x2 < -0.25f ? (1.0f - a0 * a0) : em;
                    const float mult = __builtin_amdgcn_sqrtf(fmaxf(em2, 0.f));
                    const float xcv = bf2f(*(const LAS unsigned short*)(lds + (16 * blk + 4 * fq + e) * RG_XC_STRIDE + (16 * wave + fr) * 2));
                    const h2 p = (h2){(_Float16)log_a, (_Float16)(mult * ig * xcv)};
                    pk[e] = __builtin_bit_cast(unsigned, p);
                    av[j][e] = fexp((float)p.x); bv[j][e] = (float)p.y;
                }
                a.ab[dir][((size_t)unit * (RG_T / 16) + blk) * 512 + tid] = (v4u){pk[0], pk[1], pk[2], pk[3]};
            } else {
                const v4u w = stq[dir][blk]; const unsigned ww[4] = {w.x, w.y, w.z, w.w};
#pragma unroll
                for (int e = 0; e < 4; ++e) { const h2 p = __builtin_bit_cast(h2, ww[e]); av[j][e] = fexp((float)p.x); bv[j][e] = (float)p.y; }
            }
            if (j & 1) __builtin_amdgcn_sched_barrier(0);
        }
        HPE(33); HPB(34);
        float Ai[NB], Bi_[NB], At[NB], Bt[NB];
#pragma unroll
        for (int j = 0; j < NB; ++j) {
            float A = 1.f, B = 0.f;
            if (dir == 0) {
#pragma unroll
                for (int e = 0; e < 4; ++e) { B = av[j][e] * B + bv[j][e]; A *= av[j][e]; }
                float Ap = __shfl_up(A, 16), Bp = __shfl_up(B, 16);
                if (fq >= 1) { B = A * Bp + B; A = Ap * A; }
                Ap = __shfl_up(A, 32); Bp = __shfl_up(B, 32);
                if (fq >= 2) { B = A * Bp + B; A = Ap * A; }
                At[j] = __shfl(A, 48 + fr); Bt[j] = __shfl(B, 48 + fr);
            } else {
#pragma unroll
                for (int e = 3; e >= 0; --e) { B = av[j][e] * B + bv[j][e]; A *= av[j][e]; }
                float Ap = __shfl_down(A, 16), Bp = __shfl_down(B, 16);
                if (fq <= 2) { B = A * Bp + B; A = Ap * A; }
                Ap = __shfl_down(A, 32); Bp = __shfl_down(B, 32);
                if (fq <= 1) { B = A * Bp + B; A = Ap * A; }
                At[j] = __shfl(A, fr); Bt[j] = __shfl(B, fr);
            }
            Ai[j] = A; Bi_[j] = B;
        }
        __builtin_amdgcn_sched_barrier(0);
        float cin[NB];
#pragma unroll
        for (int q = 0; q < NB; ++q) { const int j = dir == 0 ? q : NB - 1 - q; cin[j] = carry; carry = At[j] * carry + Bt[j]; if (PASS == 1) ptot *= At[j]; }
        if (PASS == 2) {
#pragma unroll
            for (int j = 0; j < NB; ++j) {
                const int blk = b0 + j;
                const float hend = Ai[j] * cin[j] + Bi_[j];
                if (dir == 0) {
                    const float hprev = __shfl_up(hend, 16);
                    float hh = fq == 0 ? cin[j] : hprev;
#pragma unroll
                    for (int e = 0; e < 4; ++e) { hh = av[j][e] * hh + bv[j][e]; hf[blk][e] = hh; }
                } else {
                    const float hprev = __shfl_down(hend, 16);
                    float hh = fq == 3 ? cin[j] : hprev, hb[4];
#pragma unroll
                    for (int e = 3; e >= 0; --e) { hh = av[j][e] * hh + bv[j][e]; hb[e] = hh; }
#pragma unroll
                    for (int e = 0; e < 4; ++e) {
                        const size_t m = mrow0 + tok0 + 16 * blk + 4 * fq + e;
                        const float g = bf2f(*(const LAS unsigned short*)(lds + RG_G_OFF + (16 * blk + 4 * fq + e) * RG_XC_STRIDE + (16 * wave + fr) * 2));
                        a.rgy[m * DRG + ch] = (bf16)f2bf((hf[blk][e] + hb[e]) * gelu_tanh(g));
                    }
                }
            }
        }
        HPE(34);
        }
        HPE(31 + dir);
        if (PASS == 1 && fq == 0) a.summ[(((size_t)dir * NSEQ + s) * RG_NT + tt) * DRG + ch] = (f32x2){ptot, carry};
    }
    if (PASS == 1) bg_end<true, 4>(pa, pendB, lane, bscr); else bg_end<true, 16>(pa, pendB, lane, bscr);
}
__device__ __forceinline__ void mixnorm_rg_row(const bf16* rgy, const float* g_rg, bf16* mix, int m, int lane) {
    v4u r[4]; float s = 0.f;
#pragma unroll
    for (int j = 0; j < 4; ++j) { r[j] = *(const v4u*)(rgy + (size_t)m * DRG + (j * 64 + lane) * 8);
        const float a0 = bflo(r[j].x), a1 = bfhi(r[j].x), a2 = bflo(r[j].y), a3 = bfhi(r[j].y), a4 = bflo(r[j].z), a5 = bfhi(r[j].z), a6 = bflo(r[j].w), a7 = bfhi(r[j].w);
        s += (a0 * a0 + a1 * a1) + (a2 * a2 + a3 * a3) + (a4 * a4 + a5 * a5) + (a6 * a6 + a7 * a7); }
    const float rs = 1.0f / sqrtf(wave_sum(s) * (1.0f / DRG) + EPSN);
#pragma unroll
    for (int j = 0; j < 4; ++j) { const int c0 = (j * 64 + lane) * 8; const f32x4 g0 = *(const f32x4*)(g_rg + c0), g1 = *(const f32x4*)(g_rg + c0 + 4);
        v4u o; o.x = pk2(bflo(r[j].x) * rs * g0.x, bfhi(r[j].x) * rs * g0.y); o.y = pk2(bflo(r[j].y) * rs * g0.z, bfhi(r[j].y) * rs * g0.w);
        o.z = pk2(bflo(r[j].z) * rs * g1.x, bfhi(r[j].z) * rs * g1.y); o.w = pk2(bflo(r[j].w) * rs * g1.z, bfhi(r[j].w) * rs * g1.w);
        *(v4u*)(mix + (size_t)m * LDK + c0) = o; }
}
constexpr int MN_TILE_STRIDE = 66;
constexpr int MN_LDS_BYTES = 8 * 64 * MN_TILE_STRIDE * 2 + 8 * 64 * 4 + 64 * 4;
template <int TT> __device__ __forceinline__ void mixnorm_hy_tile(const bf16* hyy, const float* g_hy, bf16* mix, LAS unsigned char* lds, int m0, int tid) {
    constexpr int NG = TT / 8, RP = 64 / NG;
    const int wave = tid >> 6, lane = tid & 63, r8 = lane >> 3, g8 = lane & 7, rr = lane / NG, gg = lane % NG;
    LAS unsigned* tl = (LAS unsigned*)(lds + wave * 64 * MN_TILE_STRIDE * 2);
    LAS float* part = (LAS float*)(lds + 8 * 64 * MN_TILE_STRIDE * 2);
    LAS float* scl = part + 8 * 64;
    wg_sync();
    float s[8];
#pragma unroll
    for (int j = 0; j < 8; ++j) s[j] = 0.f;
    const bf16* src = hyy + (size_t)(wave * 256 + rr) * NTOK + m0 + 8 * gg;
#pragma unroll 4
    for (int i = 0; i < 256 / RP; ++i) { const v4u w = *(const v4u*)(src + (size_t)RP * i * NTOK);
        const float a0 = bflo(w.x), a1 = bfhi(w.x), a2 = bflo(w.y), a3 = bfhi(w.y), a4 = bflo(w.z), a5 = bfhi(w.z), a6 = bflo(w.w), a7 = bfhi(w.w);
        s[0] += a0 * a0; s[1] += a1 * a1; s[2] += a2 * a2; s[3] += a3 * a3; s[4] += a4 * a4; s[5] += a5 * a5; s[6] += a6 * a6; s[7] += a7 * a7; }
#pragma unroll
    for (int j = 0; j < 8; ++j) {
#pragma unroll
        for (int x = NG; x < 64; x *= 2) s[j] += __shfl_xor(s[j], x); }
    if (rr == 0) {
#pragma unroll
        for (int j = 0; j < 8; ++j) part[wave * 64 + 8 * gg + j] = s[j];
    }
    wg_sync();
    if (tid < TT) { float t = 0.f;
#pragma unroll
        for (int w = 0; w < 8; ++w) t += part[w * 64 + tid];
        scl[tid] = 1.0f / sqrtf(t * (1.0f / DHY) + EPSN); }
    wg_sync();
    for (int cb = wave; cb < DHY / 64; cb += 8) {
        v4u in[64 / RP];
#pragma unroll
        for (int i = 0; i < 64 / RP; ++i) in[i] = *(const v4u*)(hyy + (size_t)(cb * 64 + RP * i + rr) * NTOK + m0 + 8 * gg);
        const f32x4 gA = *(const f32x4*)(g_hy + cb * 64 + 8 * g8), gB = *(const f32x4*)(g_hy + cb * 64 + 8 * g8 + 4);
#pragma unroll
        for (int i = 0; i < 64 / RP; ++i) { LAS unsigned* w = tl + (RP * i + rr) * 33 + 4 * gg; w[0] = in[i].x; w[1] = in[i].y; w[2] = in[i].z; w[3] = in[i].w; }
        asm volatile("s_waitcnt lgkmcnt(0)" ::: "memory");
        const LAS unsigned short* th = (const LAS unsigned short*)tl;
#pragma unroll
        for (int q = 0; q < TT / 8; ++q) {
            const int tk = 8 * q + r8;
            const float sc = scl[tk];
            float v[8];
#pragma unroll
            for (int e2 = 0; e2 < 8; ++e2) v[e2] = bf2f(th[(8 * g8 + e2) * MN_TILE_STRIDE + tk]) * sc;
            v4u o; o.x = pk2(v[0] * gA.x, v[1] * gA.y); o.y = pk2(v[2] * gA.z, v[3] * gA.w); o.z = pk2(v[4] * gB.x, v[5] * gB.y); o.w = pk2(v[6] * gB.z, v[7] * gB.w);
            *(v4u*)(mix + (size_t)(m0 + tk) * LDK + DRG + cb * 64 + 8 * g8) = o;
        }
        asm volatile("s_waitcnt lgkmcnt(0)" ::: "memory");
    }
}
__device__ __forceinline__ void rowpass1(const float* xr, const bf16* yr, const float* g_post, const float* g_pre, float* outr, bf16* xnr, int lane) {
    float v[64]; float s = 0.f;
#pragma unroll
    for (int j = 0; j < 8; ++j) { const v4u r = *(const v4u*)(yr + (j * 64 + lane) * 8);
        v[8 * j + 0] = bflo(r.x); v[8 * j + 1] = bfhi(r.x); v[8 * j + 2] = bflo(r.y); v[8 * j + 3] = bfhi(r.y); v[8 * j + 4] = bflo(r.z); v[8 * j + 5] = bfhi(r.z); v[8 * j + 6] = bflo(r.w); v[8 * j + 7] = bfhi(r.w);
#pragma unroll
        for (int e = 0; e < 8; ++e) s += v[8 * j + e] * v[8 * j + e]; }
    const float rs = 1.0f / sqrtf(wave_sum(s) * (1.0f / DM) + EPSN);
    float s2 = 0.f;
#pragma unroll
    for (int j = 0; j < 8; ++j) { const int c0 = (j * 64 + lane) * 8;
        const f32x4 x0 = *(const f32x4*)(xr + c0), x1 = *(const f32x4*)(xr + c0 + 4), g0 = *(const f32x4*)(g_post + c0), g1 = *(const f32x4*)(g_post + c0 + 4);
        f32x4 o0, o1;
        o0.x = x0.x + v[8 * j + 0] * rs * g0.x; o0.y = x0.y + v[8 * j + 1] * rs * g0.y; o0.z = x0.z + v[8 * j + 2] * rs * g0.z; o0.w = x0.w + v[8 * j + 3] * rs * g0.w;
        o1.x = x1.x + v[8 * j + 4] * rs * g1.x; o1.y = x1.y + v[8 * j + 5] * rs * g1.y; o1.z = x1.z + v[8 * j + 6] * rs * g1.z; o1.w = x1.w + v[8 * j + 7] * rs * g1.w;
        { v4u ob; ob.x = pk2(o0.x, o0.y); ob.y = pk2(o0.z, o0.w); ob.z = pk2(o1.x, o1.y); ob.w = pk2(o1.z, o1.w); *(v4u*)((bf16*)outr + DM + c0) = ob; }
        v[8 * j + 0] = o0.x; v[8 * j + 1] = o0.y; v[8 * j + 2] = o0.z; v[8 * j + 3] = o0.w; v[8 * j + 4] = o1.x; v[8 * j + 5] = o1.y; v[8 * j + 6] = o1.z; v[8 * j + 7] = o1.w;
        s2 += (o0.x * o0.x + o0.y * o0.y) + (o0.z * o0.z + o0.w * o0.w) + (o1.x * o1.x + o1.y * o1.y) + (o1.z * o1.z + o1.w * o1.w); }
    const float rs2 = 1.0f / sqrtf(wave_sum(s2) * (1.0f / DM) + EPSN);
#pragma unroll
    for (int j = 0; j < 8; ++j) { const int c0 = (j * 64 + lane) * 8; const f32x4 g0 = *(const f32x4*)(g_pre + c0), g1 = *(const f32x4*)(g_pre + c0 + 4);
        v4u o; o.x = pk2(v[8 * j + 0] * rs2 * g0.x, v[8 * j + 1] * rs2 * g0.y); o.y = pk2(v[8 * j + 2] * rs2 * g0.z, v[8 * j + 3] * rs2 * g0.w);
        o.z = pk2(v[8 * j + 4] * rs2 * g1.x, v[8 * j + 5] * rs2 * g1.y); o.w = pk2(v[8 * j + 6] * rs2 * g1.z, v[8 * j + 7] * rs2 * g1.w);
        *(v4u*)(xnr + c0) = o; }
}
__device__ __forceinline__ void rowpass2(const bf16* fr_, const float* g, float* outr, int lane) {
    float v[64]; float s = 0.f;
#pragma unroll
    for (int j = 0; j < 8; ++j) { const v4u r = *(const v4u*)(fr_ + (j * 64 + lane) * 8);
        v[8 * j + 0] = bflo(r.x); v[8 * j + 1] = bfhi(r.x); v[8 * j + 2] = bflo(r.y); v[8 * j + 3] = bfhi(r.y); v[8 * j + 4] = bflo(r.z); v[8 * j + 5] = bfhi(r.z); v[8 * j + 6] = bflo(r.w); v[8 * j + 7] = bfhi(r.w);
#pragma unroll
        for (int e = 0; e < 8; ++e) s += v[8 * j + e] * v[8 * j + e]; }
    const float rs = 1.0f / sqrtf(wave_sum(s) * (1.0f / DM) + EPSN);
    v4u xb[8];
#pragma unroll
    for (int j = 0; j < 8; ++j) xb[j] = *(const v4u*)((const bf16*)outr + DM + (j * 64 + lane) * 8);
    asm volatile("s_waitcnt vmcnt(0)" ::: "memory");
#pragma unroll
    for (int j = 0; j < 8; ++j) { const int c0 = (j * 64 + lane) * 8;
        const f32x4 g0 = *(const f32x4*)(g + c0), g1 = *(const f32x4*)(g + c0 + 4);
        f32x4 o0, o1;
        o0.x = bflo(xb[j].x) + v[8 * j + 0] * rs * g0.x; o0.y = bfhi(xb[j].x) + v[8 * j + 1] * rs * g0.y; o0.z = bflo(xb[j].y) + v[8 * j + 2] * rs * g0.z; o0.w = bfhi(xb[j].y) + v[8 * j + 3] * rs * g0.w;
        o1.x = bflo(xb[j].z) + v[8 * j + 4] * rs * g1.x; o1.y = bfhi(xb[j].z) + v[8 * j + 5] * rs * g1.y; o1.z = bflo(xb[j].w) + v[8 * j + 6] * rs * g1.z; o1.w = bfhi(xb[j].w) + v[8 * j + 7] * rs * g1.w;
        *(f32x4*)(outr + c0) = o0; *(f32x4*)(outr + c0 + 4) = o1; }
}
constexpr int SIDE_G_ROWS = 8, SIDE_U_ROWS = 4;
__device__ __forceinline__ float dpp_prev(float x, float xprevblk) {
    const int old = __builtin_amdgcn_update_dpp(0, __builtin_bit_cast(int, xprevblk), 0x121  , 0xf, 0xf, false);
    return __builtin_bit_cast(float, __builtin_amdgcn_update_dpp(old, __builtin_bit_cast(int, x), 0x111  , 0xf, 0xf, false));
}
__device__ __forceinline__ float dpp_next(float x, float xnextblk) {
    const int old = __builtin_amdgcn_update_dpp(0, __builtin_bit_cast(int, xnextblk), 0x12F  , 0xf, 0xf, false);
    return __builtin_bit_cast(float, __builtin_amdgcn_update_dpp(old, __builtin_bit_cast(int, x), 0x101  , 0xf, 0xf, false));
}
struct EpiGate {
    static constexpr bool PERM = true, AFTER_DRAIN = false, AROWPERM = true;
    bf16* H; const float* cw; const float* cb; float* sideG; float* sideU;
    __device__ __forceinline__ void operator()(const pg8::f32x4 (&acc)[2][2][4][2], const pg8::Unit& u, int wr, int wc, int fr, int fq) const {
        const int hc0 = u.pn * 128 + wc * 32 + 8 * fq;
        f32x4 w0[2], w1[2], w2[2], bb[2];
#pragma unroll
        for (int n = 0; n < 2; ++n) { w0[n] = *(const f32x4*)(cw + hc0 + 4 * n); w1[n] = *(const f32x4*)(cw + DFF + hc0 + 4 * n); w2[n] = *(const f32x4*)(cw + 2 * DFF + hc0 + 4 * n); bb[n] = *(const f32x4*)(cb + hc0 + 4 * n); }
        const size_t row0 = (size_t)u.pm * 256 + wr * 128 + fr;
        const f32x4 zero4 = (f32x4){0.f, 0.f, 0.f, 0.f};
#pragma unroll
        for (int blk = 0; blk < 8; ++blk) {
            const int ai = blk >> 2, m = blk & 3;
            float r[8];
#pragma unroll
            for (int n = 0; n < 2; ++n) {
                const f32x4 x = acc[ai][0][m][n];
                const f32x4 xp = blk > 0 ? acc[(blk - 1) >> 2][0][(blk - 1) & 3][n] : zero4;
                const f32x4 xn = blk < 7 ? acc[(blk + 1) >> 2][0][(blk + 1) & 3][n] : zero4;
                const f32x4 uu = acc[ai][1][m][n];
#pragma unroll
                for (int j = 0; j < 4; ++j) {
                    const float pre = bb[n][j] + w0[n][j] * dpp_prev(x[j], xp[j]) + w1[n][j] * x[j] + w2[n][j] * dpp_next(x[j], xn[j]);
                    r[4 * n + j] = gelu_tanh(pre) * uu[j];
                }
            }
            v4u o; o.x = pk2(r[0], r[1]); o.y = pk2(r[2], r[3]); o.z = pk2(r[4], r[5]); o.w = pk2(r[6], r[7]);
            *(v4u*)(H + (row0 + 16 * blk) * DFF + hc0) = o;
        }
        float* sg = sideG + ((size_t)u.pm * SIDE_G_ROWS + 4 * wr) * DFF + hc0;
        float* su = sideU + ((size_t)u.pm * SIDE_U_ROWS + 2 * wr) * DFF + hc0;
        if (fr < 2) { *(f32x4*)(sg + (size_t)fr * DFF) = acc[0][0][0][0]; *(f32x4*)(sg + (size_t)fr * DFF + 4) = acc[0][0][0][1]; }
        if (fr >= 14) { *(f32x4*)(sg + (size_t)(fr - 12) * DFF) = acc[1][0][3][0]; *(f32x4*)(sg + (size_t)(fr - 12) * DFF + 4) = acc[1][0][3][1]; }
        if (fr == 0) { *(f32x4*)su = acc[0][1][0][0]; *(f32x4*)(su + 4) = acc[0][1][0][1]; }
        if (fr == 15) { *(f32x4*)(su + DFF) = acc[1][1][3][0]; *(f32x4*)(su + DFF + 4) = acc[1][1][3][1]; }
    }
};
__device__ __forceinline__ void gate_fixup(const float* sideG, const float* sideU, const float* cw, const float* cb, bf16* H, int gtid, int nthreads) {
    constexpr int C4 = DFF / 4, NT = NTOK / 256;
    for (int idx = gtid; idx < NT * 4 * C4; idx += nthreads) {
        const int c = (idx % C4) * 4, k = (idx / C4) & 3, pm = idx / (4 * C4);
        const float* g = sideG + (size_t)pm * SIDE_G_ROWS * DFF + c;
        f32x4 prev, cur, next; int row;
        const f32x4 z = (f32x4){0.f, 0.f, 0.f, 0.f};
        if (k == 0) { row = 0; prev = (pm % 32 == 0) ? z : *(const f32x4*)(g - (size_t)SIDE_G_ROWS * DFF + 7 * (size_t)DFF); cur = *(const f32x4*)g; next = *(const f32x4*)(g + DFF); }
        else if (k == 1) { row = 127; prev = *(const f32x4*)(g + 2 * (size_t)DFF); cur = *(const f32x4*)(g + 3 * (size_t)DFF); next = *(const f32x4*)(g + 4 * (size_t)DFF); }
        else if (k == 2) { row = 128; prev = *(const f32x4*)(g + 3 * (size_t)DFF); cur = *(const f32x4*)(g + 4 * (size_t)DFF); next = *(const f32x4*)(g + 5 * (size_t)DFF); }
        else { row = 255; prev = *(const f32x4*)(g + 6 * (size_t)DFF); cur = *(const f32x4*)(g + 7 * (size_t)DFF); next = (pm % 32 == 31) ? z : *(const f32x4*)(g + (size_t)SIDE_G_ROWS * DFF); }
        const f32x4 uu = *(const f32x4*)(sideU + ((size_t)pm * SIDE_U_ROWS + k) * DFF + c);
        const f32x4 w0 = *(const f32x4*)(cw + c), w1 = *(const f32x4*)(cw + DFF + c), w2 = *(const f32x4*)(cw + 2 * DFF + c), b = *(const f32x4*)(cb + c);
        float r[4];
#pragma unroll
        for (int j = 0; j < 4; ++j) r[j] = gelu_tanh(b[j] + w0[j] * prev[j] + w1[j] * cur[j] + w2[j] * next[j]) * uu[j];
        v2u o; o.x = pk2(r[0], r[1]); o.y = pk2(r[2], r[3]);
        *(v2u*)(H + ((size_t)pm * 256 + row) * DFF + c) = o;
    }
}
constexpr int LDS_PHASE_BYTES = 143360;
constexpr int LDSCTL_OFF = LDS_PHASE_BYTES, LDS_BYTES = 147456;
constexpr int CW_BAR = 4096;
constexpr size_t CTL_ZERO_BYTES = 64 * 1024;
static_assert(HY_LDS_BYTES <= LDS_PHASE_BYTES && RG_LDS_BYTES <= LDS_PHASE_BYTES && MN_LDS_BYTES <= LDS_PHASE_BYTES && pg8::STAGE_BYTES <= LDS_PHASE_BYTES, "LDS map");
static_assert((CW_BAR + XCD_BAR_WORDS) * 4 <= (int)CTL_ZERO_BYTES, "control words inside the memset region");

#ifndef PROBE_MASK
#define PROBE_MASK 0ull
#endif
#define PROBE_AMP 4ull
#define PB(bit) do { if ((PROBE_MASK >> (bit)) & 1ull) { if (blockIdx.x == PROBE_BLK && threadIdx.x == 0) probe_t0 = __builtin_amdgcn_s_memrealtime(); } } while (0)
#define PE(bit) do { if ((PROBE_MASK >> (bit)) & 1ull) { if (blockIdx.x == PROBE_BLK && threadIdx.x == 0) probe_acc += __builtin_amdgcn_s_memrealtime() - probe_t0; } } while (0)
struct TailStealOrder : pg8::StaticOrder {
    unsigned* head; volatile LAS unsigned* slot; int full;
    __device__ __forceinline__ bool next(int i, pg8::Unit& u) const {
        if (i < full) return pg8::StaticOrder::next(i, u);
        if (i > full) return false;
        if (threadIdx.x == 0) *slot = __hip_atomic_fetch_add(head, 1u, __ATOMIC_RELAXED, __HIP_MEMORY_SCOPE_AGENT);
        asm volatile("s_waitcnt lgkmcnt(0)" ::: "memory"); __builtin_amdgcn_s_barrier(); asm volatile("" ::: "memory");
        pg8::StaticOrder t = *this; t.c = (int)*slot;
        return t.c < G && t.next(full, u);
    }
};
struct XcdQueueOrder : pg8::StaticOrder {
    unsigned* ctr; volatile LAS unsigned* slot; int rs;
    __device__ __forceinline__ bool next(int i, pg8::Unit& u) const {
        if (i < rs) return pg8::StaticOrder::next(i, u);
        if (threadIdx.x == 0) {
            const int x = c % pg8::NXCD, q = nwg / pg8::NXCD, r = nwg % pg8::NXCD;
            unsigned cur = slot[1]; int code = -1;
            while (cur < (unsigned)pg8::NXCD) { const int y = (x + (int)cur) % pg8::NXCD, len = q + (y < r ? 1 : 0);
                const int off = rs * (G / pg8::NXCD) + (int)__hip_atomic_fetch_add(ctr + y * 32, 1u, __ATOMIC_RELAXED, __HIP_MEMORY_SCOPE_AGENT);
                if (off < len) { code = off * pg8::NXCD + y; break; }
                ++cur; }
            slot[1] = cur; slot[0] = (unsigned)code;
        }
        asm volatile("s_waitcnt lgkmcnt(0)" ::: "memory"); __builtin_amdgcn_s_barrier(); asm volatile("" ::: "memory");
        const int code = (int)slot[0];
        if (code < 0) return false;
        pg8::StaticOrder t = *this; t.c = code % G; return t.next(code / G, u);
    }
};
struct MkArgs { const float* in[32]; float* out; unsigned char* ws; };
__device__ __forceinline__ pg8::Gemm dgemm(const bf16* A, const bf16* Bt, int M, int N, int K, int lda, int ldb) { pg8::Gemm g; g.A = A; g.Bt = Bt; g.M = M; g.N = N; g.K = K; g.lda = lda; g.ldb = ldb; return g; }
__device__ __forceinline__ pg8::EpiBf16<0> depi(bf16* O, int ldc) { pg8::EpiBf16<0> e; e.O = O; e.ldc = ldc; e.bias = nullptr; e.split_cols = 0; e.split_stride = 0; e.scale0 = 1.f; return e; }

__device__ __forceinline__ void gate_seq(const bf16* gu, const float* cw, const float* cb, bf16* h, int gtid, int nthreads) {
    constexpr int CG = DFF / 8;
    for (int idx = gtid; idx < SEQL * CG; idx += nthreads) {
        const int m = idx / CG, c0 = (idx % CG) * 8;
        const v4u z = (v4u){0u, 0u, 0u, 0u};
        const v4u gm = m > 0 ? *(const v4u*)(gu + (size_t)(m - 1) * 2 * DFF + c0) : z;
        const v4u g0 = *(const v4u*)(gu + (size_t)m * 2 * DFF + c0);
        const v4u gp = m < SEQL - 1 ? *(const v4u*)(gu + (size_t)(m + 1) * 2 * DFF + c0) : z;
        const v4u uu = *(const v4u*)(gu + (size_t)m * 2 * DFF + DFF + c0);
        float r[8];
#pragma unroll
        for (int e = 0; e < 8; ++e) {
            const unsigned wm = e < 2 ? gm.x : e < 4 ? gm.y : e < 6 ? gm.z : gm.w, w0 = e < 2 ? g0.x : e < 4 ? g0.y : e < 6 ? g0.z : g0.w, wp = e < 2 ? gp.x : e < 4 ? gp.y : e < 6 ? gp.z : gp.w, wu = e < 2 ? uu.x : e < 4 ? uu.y : e < 6 ? uu.z : uu.w;
            const float a = (e & 1) ? bfhi(wm) : bflo(wm), b = (e & 1) ? bfhi(w0) : bflo(w0), c = (e & 1) ? bfhi(wp) : bflo(wp), u = (e & 1) ? bfhi(wu) : bflo(wu);
            const float pre = cb[c0 + e] + cw[c0 + e] * a + cw[DFF + c0 + e] * b + cw[2 * DFF + c0 + e] * c;
            r[e] = gelu_tanh(pre) * u;
        }
        v4u o; o.x = pk2(r[0], r[1]); o.y = pk2(r[2], r[3]); o.z = pk2(r[4], r[5]); o.w = pk2(r[6], r[7]);
        *(v4u*)(h + (size_t)m * DFF + c0) = o;
    }
}

#if defined(__HIP_DEVICE_COMPILE__)
#define MK_NOPK __attribute__((target("no-packed-fp32-ops")))
#else
#define MK_NOPK
#endif
__global__ void __launch_bounds__(512, 2) MK_NOPK mk_fwd(MkArgs args) {
    extern __shared__ __attribute__((aligned(16))) unsigned char lds_raw[];
    LAS unsigned char* lds = (LAS unsigned char*)lds_raw;
    const int tid = threadIdx.x, lane = tid & 63, wave = __builtin_amdgcn_readfirstlane(tid >> 6);
    const int G = gridDim.x, bx = blockIdx.x;
    unsigned char* ws = args.ws;
    const float* const* in = args.in;
    volatile LAS unsigned* MISC = (volatile LAS unsigned*)(lds + LDSCTL_OFF);
    for (int u = tid; u < (LDS_BYTES - LDSCTL_OFF) / 4; u += 512) ((LAS unsigned*)(lds + LDSCTL_OFF))[u] = 0u;
    wg_sync();
    unsigned long long probe_t0 = 0ull, probe_acc = 0ull;
#if (PROBE_MASK >> 50) & 1
    if (blockIdx.x == PROBE_BLK && threadIdx.x == 0) g_probe_epi = 0ull;
#endif
    XcdBarrier bar = xcd_barrier_post((unsigned*)(ws + WS_CTL) + CW_BAR, MISC + 8);

    bf16* XN = (bf16*)(ws + WS_XN); bf16* WIN = (bf16*)(ws + WS_WIN);
    PB(0);
    ProArgs pa;
    {
        pa.xp = in[0]; pa.xs = in[1]; pa.g_premix = in[2]; pa.w_in = in[3]; pa.w_out = in[24]; pa.w_ffi = in[27]; pa.w_ffo = in[30]; pa.rg_a_w = in[6]; pa.rg_x_w = in[8];
        pa.hy_w1 = in[13]; pa.hy_b1 = in[14]; pa.hy_w2 = in[15]; pa.hy_b2 = in[16]; pa.hy_w3 = in[17]; pa.hy_b3 = in[18]; pa.hy_freq = in[20]; pa.ws = ws;
        p0_prologue<true>(pa, lds, bx * 8 + wave, G * 8, wave, lane, 4 * (RG_UNITS / G));
    }
    PE(0);
    PB(40); PB(20); xcd_barrier(bar); PE(20); PE(40);
    PB(1);
    {
        XcdQueueOrder S; S.init(NTOK, 2 * DRG, G, bx); S.ctr = (unsigned*)(ws + WS_CTL) + 8192 + 0 * 256; S.slot = MISC + 24; S.rs = S.nwg / G - 2; if (tid == 0) MISC[25] = 0u;
        pg8::gemm_phase<pg8::EpiBf16<0>, XcdQueueOrder, true, true>(lds, dgemm(XN, WIN, NTOK, 2 * DRG, DM, LDK, LDK), S, depi((bf16*)(ws + WS_PRG), 2 * DRG));
    }
    {
        XcdQueueOrder S; S.init(3 * DHY, NTOK, G, bx); S.ctr = (unsigned*)(ws + WS_CTL) + 8192 + 1 * 256; S.slot = MISC + 24; S.rs = S.nwg / G - 3; if (tid == 0) MISC[25] = 0u;
        pg8::gemm_phase<pg8::EpiBf16<0>, XcdQueueOrder, true, true>(lds, dgemm(WIN + (size_t)2 * DRG * LDK, XN, 3 * DHY, NTOK, DM, LDK, LDK), S, depi((bf16*)(ws + WS_PHY), NTOK));
    }
    PB(21); { int tq = tid; asm volatile("" : "+v"(tq)); filter_gemm((const bf16*)(ws + WS_H3), in[19], (_Float16*)(ws + WS_KF), bx, G, tq); } PE(21);
    PE(1);
    PB(41); PB(20); xcd_barrier(bar); PE(20); PE(41);
    RgArgs ra; ra.prg = (const bf16*)(ws + WS_PRG); ra.conv_w = in[4]; ra.conv_b = in[5]; ra.rgw = (const bf16*)(ws + WS_RGW); ra.a_b = in[7]; ra.x_b = in[9]; ra.lam = in[10];
    ra.summ = (f32x2*)(ws + WS_SUMM); ra.rgy = (bf16*)(ws + WS_RGY); ra.ab[0] = (v4u*)(ws + WS_XN); ra.ab[1] = (v4u*)args.out;
    {
        HyArgs a; a.phy = (const bf16*)(ws + WS_PHY); a.conv_w = in[11]; a.conv_b = in[12]; a.hy_bias = in[21]; a.kf = (const _Float16*)(ws + WS_KF); a.tw = (const f32x2*)(ws + WS_TW);
        a.zk = (f32x2*)(ws + WS_ZK); a.hyy = (bf16*)(ws + WS_HYY);
        PB(2);
        for (int cp = bx; cp < DHY / 2; cp += G) hyena_unit(a, lds, cp, bx, tid, probe_t0, probe_acc);
        PE(2);
    }
    PB(3);
    BgConv bg; { const int gw = bx * 8 + wave, ngw = G * 8, tot = TR_I_OUT + TR_I_FI  ; bg.it = TR_I_IN + gw; bg.step = ngw; bg.nleft = gw < tot ? (tot - gw + ngw - 1) / ngw : 0; const int slots = 4 * (RG_UNITS / G); if (bg.nleft > slots) bg.nleft = slots; }
    { RgW rw; const bool same_head = (G % NHEAD) == 0; if (same_head) rg_load_w(ra, bx % NHEAD, tid, rw);
      for (int u = bx; u < RG_UNITS; u += G) { if (!same_head) rg_load_w(ra, u % NHEAD, tid, rw); rg_unit<1>(ra, lds, u, tid, rw, pa, bg, false, probe_t0, probe_acc); } }
    PE(3);
    PB(42); PB(20); xcd_barrier(bar); PE(20); PE(42);
    PB(4);
    { RgW rw; const bool same_head = (G % NHEAD) == 0; (void)same_head;
      const bool tab = (G == 256);
      for (int u = bx; u < RG_UNITS; u += G) { if (tab && ((u / NHEAD) % RG_NT) < 16) rg_carry_table(ra, lds, bx % NHEAD, bx / NHEAD, u / (NHEAD * RG_NT), tid);
        rg_unit<2>(ra, lds, u, tid, rw, pa, bg, tab, probe_t0, probe_acc); }
      { LAS unsigned char* bscr = lds + RG_HF_OFF + wave * BG_SCR;
        while (bg.nleft > 0) { const int it = bg_begin<true>(pa, bg, lane, bscr); bg_end<true, 0>(pa, it, lane, bscr); } } }
    {
        constexpr int NT64 = NTOK / 64; const int whole = (NT64 / G) * G;
        for (int t = bx; t < whole; t += G) mixnorm_hy_tile<64>((const bf16*)(ws + WS_HYY), in[23], (bf16*)(ws + WS_MIX), lds, t * 64, tid);
        for (int t = bx; t < 2 * (NT64 - whole); t += G) mixnorm_hy_tile<32>((const bf16*)(ws + WS_HYY), in[23], (bf16*)(ws + WS_MIX), lds, whole * 64 + t * 32, tid);
    }
    PE(4);
    PB(43); PB(20); xcd_barrier(bar); PE(20); PE(43);
    PB(5);
    for (int m = bx * 8 + wave; m < NTOK; m += G * 8) mixnorm_rg_row((const bf16*)(ws + WS_RGY), in[22], (bf16*)(ws + WS_MIX), m, lane);
    PE(5);
    PB(44); PB(20); xcd_barrier(bar); PE(20); PE(44);
    PB(6);
    {
        XcdQueueOrder S; S.init(NTOK, DM, G, bx); S.ctr = (unsigned*)(ws + WS_CTL) + 8192 + 2 * 256; S.slot = MISC + 24; S.rs = S.nwg / G - 2; if (tid == 0) MISC[25] = 0u;
        pg8::gemm_phase<pg8::EpiBf16<0>, XcdQueueOrder, true, true>(lds, dgemm((bf16*)(ws + WS_MIX), (bf16*)(ws + WS_WOUT), NTOK, DM, DM, LDK, LDK), S, depi((bf16*)(ws + WS_Y), DM));
    }
    PE(6);
    PB(45); PB(20); xcd_barrier(bar); PE(20); PE(45);
    PB(7);
    for (int m = bx * 8 + wave; m < NTOK; m += G * 8) rowpass1(xrow_ptr(in[0], in[1], m), (const bf16*)(ws + WS_Y) + (size_t)m * DM, in[25], in[26], args.out + (size_t)m * DM, XN + (size_t)m * LDK, lane);
    PE(7);
    PB(46); PB(20); xcd_barrier(bar); PE(20); PE(46);
    PB(8);
    unsigned long long clk0_ = 0ull; if (((PROBE_MASK >> 51) & 1ull) && blockIdx.x == PROBE_BLK && threadIdx.x == 0) clk0_ = __builtin_amdgcn_s_memtime();
    bf16* HB = (bf16*)(ws + WS_H);
    {
        XcdQueueOrder S; S.init(NTOK, 2 * DFF, G, bx); S.ctr = (unsigned*)(ws + WS_CTL) + 8192 + 3 * 256; S.slot = MISC + 24; S.rs = S.nwg / G - 4; if (tid == 0) MISC[25] = 0u;
        EpiGate E; E.H = HB; E.cw = in[28]; E.cb = in[29]; E.sideG = (float*)(ws + WS_SIDEG); E.sideU = (float*)(ws + WS_SIDEU);
        pg8::gemm_phase<EpiGate, XcdQueueOrder, true, true>(lds, dgemm(XN, (bf16*)(ws + WS_WFI), NTOK, 2 * DFF, DM, LDK, LDK), S, E);
        { unsigned* cctr = (unsigned*)(ws + WS_CTL) + 2112; constexpr int FO0 = TR_I_IN + TR_I_OUT + TR_I_FI, NGRP = TR_I_FO / 64; static_assert(TR_I_FO % 64 == 0, "w_ffn_out item groups");
          for (;;) {
              wg_sync();
              if (tid == 0) MISC[24] = __hip_atomic_fetch_add(cctr, 1u, __ATOMIC_RELAXED, __HIP_MEMORY_SCOPE_AGENT);
              wg_sync();
              const int g = (int)MISC[24]; if (g >= NGRP) break;
              p0_transposes<true>(pa, (LAS float*)(lds + wave * 16384), lane, wave, 8, FO0 + g * 64, FO0 + g * 64 + 64);
          } }
    }
    PE(8);
    if (((PROBE_MASK >> 51) & 1ull) && blockIdx.x == PROBE_BLK && threadIdx.x == 0) probe_acc += (__builtin_amdgcn_s_memtime() - clk0_) >> 8;
    PB(47); PB(20); xcd_barrier(bar); PE(20); PE(47);
    PB(9);
    { int tq = tid; asm volatile("" : "+v"(tq)); gate_fixup((const float*)(ws + WS_SIDEG), (const float*)(ws + WS_SIDEU), in[28], in[29], HB, bx * 512 + tq, G * 512); }
    PE(9);
    PB(48); PB(20); xcd_barrier(bar); PE(20); PE(48);
    PB(10);
    {
        XcdQueueOrder S; S.init(NTOK, DM, G, bx); S.ctr = (unsigned*)(ws + WS_CTL) + 8192 + 4 * 256; S.slot = MISC + 24; S.rs = S.nwg / G - 2; if (tid == 0) MISC[25] = 0u;
        pg8::gemm_phase<pg8::EpiBf16<0>, XcdQueueOrder, true, true>(lds, dgemm(HB, (bf16*)(ws + WS_WFO), NTOK, DM, DFF, DFF, DFF), S, depi((bf16*)(ws + WS_F), DM));
    }
    PE(10);
    PB(49); PB(20); xcd_barrier(bar); PE(20); PE(49);
    PB(11);
    for (int m = bx * 8 + wave; m < NTOK; m += G * 8) rowpass2((const bf16*)(ws + WS_F) + (size_t)m * DM, in[31], args.out + (size_t)m * DM, lane);
    PE(11);
#if (PROBE_MASK >> 50) & 1
    if (blockIdx.x == PROBE_BLK && threadIdx.x == 0) probe_acc += g_probe_epi;
#endif
    if (PROBE_MASK != 0ull && blockIdx.x == PROBE_BLK && threadIdx.x == 0) { const unsigned long long t0 = __builtin_amdgcn_s_memrealtime(); while (__builtin_amdgcn_s_memrealtime() - t0 < probe_acc * PROBE_AMP) __builtin_amdgcn_s_sleep(8); }
}

extern "C" void kernel_launch(void* const* d_in, const int* in_sizes, int n_in, void* d_out, int out_size, void* d_ws, size_t ws_size, hipStream_t stream) {
    static int grid = 0;
    if (grid == 0) {
        grid = -1;
        if (n_in != 32 || out_size != NTOK * DM || ws_size < WS_END) { fprintf(stderr, "kernel_launch: unexpected sizes n_in %d out %d ws %zu (need %zu)\n", n_in, out_size, ws_size, (size_t)WS_END); return; }
        int dev = 0, cus = 0, per_cu = 0;
        if (hipGetDevice(&dev) != hipSuccess || hipDeviceGetAttribute(&cus, hipDeviceAttributeMultiprocessorCount, dev) != hipSuccess) return;
        if (hipFuncSetAttribute((const void*)mk_fwd, hipFuncAttributeMaxDynamicSharedMemorySize, LDS_BYTES) != hipSuccess) { fprintf(stderr, "kernel_launch: hipFuncSetAttribute failed\n"); return; }
        if (hipOccupancyMaxActiveBlocksPerMultiprocessor(&per_cu, (const void*)mk_fwd, 512, LDS_BYTES) != hipSuccess || per_cu < 1) { fprintf(stderr, "kernel_launch: occupancy query says %d blocks per CU\n", per_cu); (void)hipGetLastError(); return; }
        grid = cus;
    }
    if (grid < 0) return;
    if (hipMemsetAsync((char*)d_ws + WS_CTL, 0, CTL_ZERO_BYTES, stream) != hipSuccess) return;
    MkArgs a; memset(&a, 0, sizeof a);
    for (int i = 0; i < 32; ++i) a.in[i] = (const float*)d_in[i];
    a.out = (float*)d_out; a.ws = (unsigned char*)d_ws;
    hipLaunchKernelGGL(mk_fwd, dim3(grid), dim3(512), LDS_BYTES, stream, a);
}
```

```cpp
#include <hip/hip_runtime.h>
#include <cstdio>
#include <cstdint>
#ifndef PROBE_BLK
#define PROBE_BLK 0
#endif
#ifndef PROBE_MASK
#define PROBE_MASK 0ull
#endif
#if (PROBE_MASK >> 50) & 1
__device__ unsigned long long g_probe_epi;
#define PG8_PROBE_B() unsigned long long pg8_t0_ = 0; if (blockIdx.x == PROBE_BLK && threadIdx.x == 0) pg8_t0_ = __builtin_amdgcn_s_memrealtime()
#define PG8_PROBE_E() if (blockIdx.x == PROBE_BLK && threadIdx.x == 0) g_probe_epi += __builtin_amdgcn_s_memrealtime() - pg8_t0_
#else
#define PG8_PROBE_B()
#define PG8_PROBE_E()
#endif
#include <cstring>
namespace pg8 {
#define PG8_LAS __attribute__((address_space(3)))
typedef unsigned short bf16_t;
typedef short bf16x8 __attribute__((ext_vector_type(8)));
typedef float f32x4 __attribute__((ext_vector_type(4)));
typedef unsigned u32x4 __attribute__((ext_vector_type(4)));
constexpr int BM = 256, BK = 64, HALF = 128, HTB = HALF * BK * 2  , STAGE_BYTES = 8 * HTB, NXCD = 8, WGM = 8;

__host__ __device__ __forceinline__ int lds_byte(int r, int c) { const int st = (r >> 4) * 2 + (c >> 5), rr = r & 15, cc = c & 31, ob = rr * 64 + cc * 2; return st * 1024 + (ob ^ (((ob >> 9) & 1) << 5)); }
__host__ __device__ __forceinline__ void stage_rc(int b, int& R, int& C) { const int st = b / 1024, sb = b % 1024, swz = sb ^ (((sb >> 9) & 1) << 5); R = (st >> 1) * 16 + swz / 64; C = (st & 1) * 32 + (swz % 64) / 2; }
__host__ __device__ __forceinline__ int perm32(int rho) { const int n = rho >> 4, i = rho & 15; return 8 * (i >> 2) + 4 * n + (i & 3); }

struct Unit { int pm, pn; };
struct Gemm { const bf16_t* A; const bf16_t* Bt; int M, N, K, lda, ldb; };

struct StaticOrder {
    int nM, nN, nwg, G, c;
    __host__ __device__ __forceinline__ void init(int M, int N, int G_, int c_) { nM = M / BM; nN = N / BM; nwg = nM * nN; G = G_; c = c_; }
    __host__ __device__ __forceinline__ bool next(int i, Unit& u) const {
        const long L = (long)i * G + c; if (L >= nwg) return false;
        int wgid = (int)L; { const int q = nwg / NXCD, r = nwg % NXCD, xcd = wgid % NXCD, off = wgid / NXCD; wgid = (xcd < r ? xcd * (q + 1) : r * (q + 1) + (xcd - r) * q) + off; }
        const int nig = WGM * nN, gid = wgid / nig, fm = gid * WGM, gsz = (nM - fm) < WGM ? (nM - fm) : WGM;
        u.pm = fm + ((wgid % nig) % gsz); u.pn = (wgid % nig) / gsz; return true;
    }
    __device__ __forceinline__ void a_ready(const Unit&, int) const {}
    __device__ __forceinline__ void done(const Unit&) const {}
};

__device__ __forceinline__ unsigned cvt_pk_bf16(float lo, float hi) { unsigned r; asm volatile("v_cvt_pk_bf16_f32 %0, %1, %2" : "=v"(r) : "v"(lo), "v"(hi)); return r; }
typedef float f32x2 __attribute__((ext_vector_type(2)));
__device__ __forceinline__ f32x2 gelu_pk(f32x2 v) {
    const f32x2 av = __builtin_elementwise_abs(v), d = av * 0.2316418882f + 1.0f;
    f32x2 t; t.x = __builtin_amdgcn_rcpf(d.x); t.y = __builtin_amdgcn_rcpf(d.y);
    f32x2 q = t * 0.5307027145f + (-0.7265760135f); q = q * t + 0.7107068705f; q = q * t + (-0.142248368f); q = q * t + 0.127414796f; q = q * t;
    const f32x2 s = (v * v) * (-0.72134752044f);
    f32x2 e; e.x = __builtin_amdgcn_exp2f(s.x); e.y = __builtin_amdgcn_exp2f(s.y);
    const f32x2 m = v * (q * e), r = v - m;
    f32x2 o; o.x = v.x < 0.f ? m.x : r.x; o.y = v.y < 0.f ? m.y : r.y; return o;
}

template <int ACT  > struct EpiBf16 {
    static constexpr bool PERM = true, AFTER_DRAIN = false, AROWPERM = false; static_assert(ACT == 0 || ACT == 1, "EpiBf16: ACT is 0 (none) or 1 (gelu_pk)");
    bf16_t* O; int ldc; const float* bias; int split_cols; size_t split_stride; float scale0;
    __device__ __forceinline__ void operator()(const f32x4 (&acc)[2][2][4][2], const Unit& u, int wr, int wc, int fr, int fq) const {
        const int row0 = u.pm * BM + wr * 64 + fr; int colt = u.pn * BM; bf16_t* base = O;
        float sc = 1.f; if (split_cols) { const int t = colt / split_cols; base += (size_t)t * split_stride; colt -= t * split_cols; if (t == 0) sc = scale0; }
        const int col0 = colt + wc * 32 + 8 * fq, bcol0 = u.pn * BM + wc * 32 + 8 * fq;
        f32x4 bv[2][2];
#pragma unroll
        for (int bj = 0; bj < 2; ++bj)
#pragma unroll
            for (int n = 0; n < 2; ++n) bv[bj][n] = bias ? *(const f32x4*)(bias + bcol0 + bj * HALF + 4 * n) : (f32x4){0.f, 0.f, 0.f, 0.f};
#pragma unroll
        for (int ai = 0; ai < 2; ++ai)
#pragma unroll
            for (int m = 0; m < 4; ++m) { bf16_t* rowp = base + (size_t)(row0 + ai * HALF + m * 16) * ldc + col0;
#pragma unroll
                for (int bj = 0; bj < 2; ++bj) { f32x4 v0 = acc[ai][bj][m][0] + bv[bj][0], v1 = acc[ai][bj][m][1] + bv[bj][1];
                    if (ACT == 1) { f32x2 a = gelu_pk((f32x2){v0[0], v0[1]}), b = gelu_pk((f32x2){v0[2], v0[3]}), c = gelu_pk((f32x2){v1[0], v1[1]}), d = gelu_pk((f32x2){v1[2], v1[3]});
                        v0 = (f32x4){a.x, a.y, b.x, b.y}; v1 = (f32x4){c.x, c.y, d.x, d.y}; }
                    v0 = v0 * sc; v1 = v1 * sc; u32x4 w; w.x = cvt_pk_bf16(v0[0], v0[1]); w.y = cvt_pk_bf16(v0[2], v0[3]); w.z = cvt_pk_bf16(v1[0], v1[1]); w.w = cvt_pk_bf16(v1[2], v1[3]);
                    *(u32x4*)(rowp + bj * HALF) = w; } }
    }
};
template <class Epi, class Sched, bool ALIGN_EPI = false, bool SP2 = false>
__device__ __forceinline__ void gemm_phase(PG8_LAS unsigned char* lds, const Gemm g, const Sched& S, const Epi& E) {
    int tid_ = threadIdx.x; asm volatile("" : "+v"(tid_));
    const int tid = tid_, wid = __builtin_amdgcn_readfirstlane(tid >> 6), lane = tid & 63, wr = wid >> 2, wc = wid & 3, fr = lane & 15, fq = lane >> 4;
    const int K = g.K, nt = K / BK;
    unsigned voffA[2], voffB[2];
#pragma unroll
    for (int i = 0; i < 2; ++i) { int R, C; stage_rc(tid * 16 + i * 8192, R, C); const int Rb = Epi::PERM ? ((R & ~31) + perm32(R & 31)) : R; const int Ra = Epi::AROWPERM ? (128 * (R >> 6) + (R & 63)) : R;
        voffA[i] = (unsigned)(Ra * g.lda + C) * 2u; voffB[i] = (unsigned)(Rb * g.ldb + C) * 2u; }
    const size_t kstep = (size_t)(BK * 2);
    const size_t hstep = (size_t)HALF * g.ldb * 2;
    const size_t hstepA = (size_t)(Epi::AROWPERM ? 64 : HALF) * g.lda * 2;
    const size_t tstep = 2 * hstep, tstepA = (size_t)BM * g.lda * 2;
    const unsigned ldsw = (unsigned)wid * 1024u;
    const int aoff = lds_byte(wr * 64 + fr, fq * 8), boff = lds_byte(wc * 32 + fr, fq * 8);
#define PG8_SA(b, h) (((b) * 2 + (h)) * HTB)
#define PG8_SB(b, h) ((4 + (b) * 2 + (h)) * HTB)
#define PG8_STAGE(bufoff, gbase, voff) do { _Pragma("unroll") for (int _i = 0; _i < 2; ++_i) \
        __builtin_amdgcn_global_load_lds((const unsigned*)((const char*)(gbase) + (voff)[_i]), (PG8_LAS unsigned*)(lds + (bufoff) + ldsw + _i * 8192), 16, 0, 0); } while (0)
#define PG8_LDA(dst, b, h) do { _Pragma("unroll") for (int m = 0; m < 4; ++m) _Pragma("unroll") for (int k = 0; k < 2; ++k) dst[m][k] = *(const PG8_LAS bf16x8*)(lds + PG8_SA(b, h) + aoff + m * 2048 + k * 1024); } while (0)
#define PG8_LDB(dst, b, h) do { _Pragma("unroll") for (int n = 0; n < 2; ++n) _Pragma("unroll") for (int k = 0; k < 2; ++k) dst[n][k] = *(const PG8_LAS bf16x8*)(lds + PG8_SB(b, h) + boff + n * 2048 + k * 1024); } while (0)
#define PG8_MMA(ai, bj, At, Bt) do { __builtin_amdgcn_s_setprio(1); _Pragma("unroll") for (int m = 0; m < 4; ++m) _Pragma("unroll") for (int n = 0; n < 2; ++n) _Pragma("unroll") for (int k = 0; k < 2; ++k) \
        acc[ai][bj][m][n] = __builtin_amdgcn_mfma_f32_16x16x32_bf16(Bt[n][k], At[m][k], acc[ai][bj][m][n], 0, 0, 0); __builtin_amdgcn_s_setprio(0); } while (0)
#define PG8_WAIT_V(n) asm volatile("s_waitcnt vmcnt(" #n ")" ::: "memory")
#define PG8_WAIT_L(n) asm volatile("s_waitcnt lgkmcnt(" #n ")" ::: "memory")
#define PG8_BAR __builtin_amdgcn_s_barrier()
#define PG8_SCHED __builtin_amdgcn_sched_barrier(0)
    Unit cur, nxt; int ui = 0;
    if (!S.next(0, cur)) return;
    f32x4 acc[2][2][4][2];
#pragma unroll
    for (int a = 0; a < 2; ++a)
#pragma unroll
        for (int b = 0; b < 2; ++b)
#pragma unroll
            for (int m = 0; m < 4; ++m)
#pragma unroll
                for (int n = 0; n < 2; ++n) acc[a][b][m][n] = (f32x4){0.f, 0.f, 0.f, 0.f};
    bf16x8 At[4][2], B0[2][2], B1[2][2];
    const char* cA = (const char*)g.A + (size_t)cur.pm * tstepA; const char* cB = (const char*)g.Bt + (size_t)cur.pn * tstep;
    S.a_ready(cur, 0);
    if constexpr (SP2) {
        PG8_STAGE(PG8_SB(0, 0), cB, voffB); PG8_STAGE(PG8_SB(0, 1), cB + hstep, voffB); PG8_STAGE(PG8_SA(0, 0), cA, voffA); PG8_STAGE(PG8_SA(0, 1), cA + hstepA, voffA);
        if (wr == 1) PG8_BAR;
        PG8_WAIT_V(2); PG8_BAR;
        PG8_STAGE(PG8_SB(1, 0), cB + kstep, voffB); PG8_STAGE(PG8_SA(1, 0), cA + kstep, voffA); PG8_STAGE(PG8_SB(1, 1), cB + hstep + kstep, voffB);
        PG8_WAIT_V(6); PG8_BAR;
    } else {
        PG8_STAGE(PG8_SB(0, 0), cB, voffB); PG8_STAGE(PG8_SA(0, 0), cA, voffA); PG8_STAGE(PG8_SB(0, 1), cB + hstep, voffB); PG8_STAGE(PG8_SA(0, 1), cA + hstepA, voffA);
        if (wr == 1) PG8_BAR;
        PG8_WAIT_V(4); PG8_BAR;
        PG8_STAGE(PG8_SB(1, 0), cB + kstep, voffB); PG8_STAGE(PG8_SA(1, 0), cA + kstep, voffA); PG8_STAGE(PG8_SB(1, 1), cB + hstep + kstep, voffB);
        PG8_WAIT_V(6); PG8_BAR;
    }
    for (;;) {
        const bool has_next = S.next(ui + 1, nxt);
        const char* nA = has_next ? (const char*)g.A + (size_t)nxt.pm * tstepA : cA; const char* nB = has_next ? (const char*)g.Bt + (size_t)nxt.pn * tstep : cB;
        for (int t = 0; t < nt; t += 2) {
            const bool last = (t == nt - 2);
            const char* a1 = cA + (size_t)(t + 1) * kstep;
            const char* a2 = last ? nA : cA + (size_t)(t + 2) * kstep; const char* b2 = last ? nB : cB + (size_t)(t + 2) * kstep;
            const char* a3 = a2 + kstep; const char* b3 = b2 + kstep;
            if (last && has_next) S.a_ready(nxt, ui + 1);
            if constexpr (SP2) {
            PG8_LDB(B0, 0, 0); PG8_LDB(B1, 0, 1); PG8_SCHED; PG8_LDA(At, 0, 0); PG8_STAGE(PG8_SA(1, 1), a1 + hstepA, voffA);
            PG8_WAIT_V(8); PG8_WAIT_L(0); PG8_BAR; PG8_MMA(0, 0, At, B0); PG8_MMA(0, 1, At, B1); PG8_BAR; PG8_SCHED;
            PG8_LDA(At, 0, 1); PG8_STAGE(PG8_SB(0, 0), b2, voffB); PG8_STAGE(PG8_SB(0, 1), b2 + hstep, voffB); PG8_STAGE(PG8_SA(0, 0), a2, voffA);
            PG8_WAIT_V(8); PG8_WAIT_L(0); PG8_BAR; PG8_MMA(1, 0, At, B0); PG8_MMA(1, 1, At, B1); PG8_BAR; PG8_SCHED;
            PG8_LDB(B0, 1, 0); PG8_LDB(B1, 1, 1); PG8_SCHED; PG8_LDA(At, 1, 0); PG8_STAGE(PG8_SA(0, 1), a2 + hstepA, voffA);
            PG8_WAIT_V(8); PG8_WAIT_L(0); PG8_BAR; PG8_MMA(0, 0, At, B0); PG8_MMA(0, 1, At, B1); PG8_BAR; PG8_SCHED;
            PG8_LDA(At, 1, 1); PG8_STAGE(PG8_SB(1, 0), b3, voffB); PG8_STAGE(PG8_SB(1, 1), b3 + hstep, voffB); PG8_STAGE(PG8_SA(1, 0), a3, voffA);
            PG8_WAIT_V(8); PG8_WAIT_L(0); PG8_BAR; PG8_MMA(1, 0, At, B0); PG8_MMA(1, 1, At, B1); PG8_BAR; PG8_SCHED;
            } else {
            PG8_LDB(B0, 0, 0); PG8_SCHED; PG8_LDA(At, 0, 0); PG8_STAGE(PG8_SA(1, 1), a1 + hstepA, voffA);
            PG8_WAIT_L(8); PG8_BAR; PG8_WAIT_L(0); PG8_MMA(0, 0, At, B0); PG8_BAR; PG8_SCHED;
            PG8_LDB(B1, 0, 1); PG8_STAGE(PG8_SB(0, 0), b2, voffB);
            PG8_BAR; PG8_WAIT_L(0); PG8_MMA(0, 1, At, B1); PG8_BAR;
            PG8_LDA(At, 0, 1); PG8_STAGE(PG8_SA(0, 0), a2, voffA);
            PG8_BAR; PG8_WAIT_L(0); PG8_MMA(1, 0, At, B0); PG8_BAR; PG8_SCHED;
            PG8_STAGE(PG8_SB(0, 1), b2 + hstep, voffB);
            PG8_WAIT_V(6); PG8_BAR; PG8_MMA(1, 1, At, B1); PG8_BAR;
            PG8_LDB(B0, 1, 0); PG8_SCHED; PG8_LDA(At, 1, 0); PG8_STAGE(PG8_SA(0, 1), a2 + hstepA, voffA);
            PG8_WAIT_L(8); PG8_BAR; PG8_WAIT_L(0); PG8_MMA(0, 0, At, B0); PG8_BAR; PG8_SCHED;
            PG8_LDB(B1, 1, 1); PG8_STAGE(PG8_SB(1, 0), b3, voffB);
            PG8_BAR; PG8_WAIT_L(0); PG8_MMA(0, 1, At, B1); PG8_BAR;
            PG8_LDA(At, 1, 1); PG8_STAGE(PG8_SA(1, 0), a3, voffA);
            PG8_BAR; PG8_WAIT_L(0); PG8_MMA(1, 0, At, B0); PG8_BAR; PG8_SCHED;
            PG8_STAGE(PG8_SB(1, 1), b3 + hstep, voffB);
            PG8_WAIT_V(6); PG8_BAR; PG8_MMA(1, 1, At, B1); PG8_BAR;
            }
        }
        if constexpr (ALIGN_EPI) { if (wr == 0) PG8_BAR; }
        PG8_PROBE_B(); if constexpr (!Epi::AFTER_DRAIN) { E(acc, cur, wr, wc, fr, fq); S.done(cur); } PG8_PROBE_E();
        if (!has_next) break;
#pragma unroll
        for (int a = 0; a < 2; ++a)
#pragma unroll
            for (int b = 0; b < 2; ++b)
#pragma unroll
                for (int m = 0; m < 4; ++m)
#pragma unroll
                    for (int n = 0; n < 2; ++n) acc[a][b][m][n] = (f32x4){0.f, 0.f, 0.f, 0.f};
        cur = nxt; cA = nA; cB = nB; ++ui;
        if constexpr (ALIGN_EPI) { if (wr == 1) PG8_BAR; }
    }
    PG8_WAIT_V(0);
    if constexpr (!ALIGN_EPI) { if (wr == 0) PG8_BAR; }
    PG8_BAR;
    if constexpr (Epi::AFTER_DRAIN) { E.fused(acc, cur, wr, wc, fr, fq, lds, wid, lane); S.done(cur); }
#undef PG8_SA
#undef PG8_SB
#undef PG8_STAGE
#undef PG8_LDA
#undef PG8_LDB
#undef PG8_MMA
#undef PG8_WAIT_V
#undef PG8_WAIT_L
#undef PG8_BAR
#undef PG8_SCHED
}
}
constexpr int SEQL = 8192, NSEQ = 3, NTOK = NSEQ * SEQL;
constexpr int DM = 4096, DRG = 2048, DHY = 2048, NIN = 10240, DFF = 11008;
constexpr int NHEAD = 16, HDIM = 128;
constexpr float EPSN = 1e-6f;
constexpr int FFT_N = 16384;
constexpr int LDK = DM;

#define GAS __attribute__((address_space(1)))
#define LAS __attribute__((address_space(3)))
typedef unsigned short bf16;
typedef unsigned v4u __attribute__((ext_vector_type(4)));
typedef unsigned v2u __attribute__((ext_vector_type(2)));
typedef float f32x4 __attribute__((ext_vector_type(4)));
typedef float f32x2 __attribute__((ext_vector_type(2)));
typedef short bf16x8 __attribute__((ext_vector_type(8)));

__device__ __forceinline__ void wg_sync() { __builtin_amdgcn_fence(__ATOMIC_RELEASE, "workgroup"); __builtin_amdgcn_s_barrier(); __builtin_amdgcn_fence(__ATOMIC_ACQUIRE, "workgroup"); }
__device__ __forceinline__ void lds_sync() { asm volatile("s_waitcnt lgkmcnt(0)" ::: "memory"); __builtin_amdgcn_s_barrier(); asm volatile("" ::: "memory"); }
__device__ __forceinline__ unsigned f2bf(float f) { unsigned u = __builtin_bit_cast(unsigned, f); return (u + 0x7fffu + ((u >> 16) & 1u)) >> 16; }
__device__ __forceinline__ unsigned pk2(float lo, float hi) { return f2bf(lo) | (f2bf(hi) << 16); }
__device__ __forceinline__ float bf2f(unsigned b) { return __builtin_bit_cast(float, b << 16); }
__device__ __forceinline__ float bflo(unsigned w) { return __builtin_bit_cast(float, w << 16); }
__device__ __forceinline__ float bfhi(unsigned w) { return __builtin_bit_cast(float, w & 0xffff0000u); }
__device__ __forceinline__ float wave_sum(float v) {
#pragma unroll
    for (int o = 1; o < 64; o <<= 1) v += __shfl_xor(v, o);
    return v;
}
__device__ __forceinline__ float frcp(float x) { return __builtin_amdgcn_rcpf(x); }
__device__ __forceinline__ float fexp(float x) { return __builtin_amdgcn_exp2f(x * 1.4426950408889634f); }
__device__ __forceinline__ float sigmoidf_(float x) { return frcp(1.0f + fexp(-x)); }
__device__ __forceinline__ float gelu_tanh(float x) { const float u = 1.5957691216057308f * (x + 0.044715f * x * x * x); return x * frcp(1.0f + fexp(-u)); }

constexpr size_t MiB = 1u << 20;
constexpr size_t WS_CTL = 0;
constexpr size_t WS_TW = 1 * MiB;
constexpr size_t WS_H3 = 2 * MiB;
constexpr size_t WS_RGW = 4 * MiB;
constexpr size_t WS_SUMM = 6 * MiB;
constexpr size_t WS_WIN = 16 * MiB;
constexpr size_t WS_WOUT = 98 * MiB;
constexpr size_t WS_WFI = 131 * MiB;
constexpr size_t WS_WFO = 306 * MiB;
constexpr size_t WS_XN = 392 * MiB;
constexpr size_t WS_PRG = 588 * MiB;
constexpr size_t WS_PHY = 780 * MiB;
constexpr size_t WS_HYY = 1068 * MiB;
constexpr size_t WS_RGY = 1164 * MiB;
constexpr size_t WS_ZK = WS_WIN;
constexpr size_t WS_KF = 1164 * MiB;
constexpr size_t WS_H = WS_PHY;
constexpr size_t WS_SIDEG = 1296 * MiB;
constexpr size_t WS_SIDEU = 1329 * MiB;
constexpr size_t WS_END = 1346 * MiB;
static_assert(WS_WIN + (size_t)NIN * LDK * 2 <= WS_WOUT && WS_WOUT + (size_t)DM * LDK * 2 <= WS_WFI && WS_WFI + (size_t)2 * DFF * LDK * 2 <= WS_WFO && WS_WFO + (size_t)DM * DFF * 2 <= WS_XN &&
              WS_XN + (size_t)NTOK * LDK * 2 <= WS_PRG && WS_PRG + (size_t)NTOK * DM * 2 <= WS_PHY && WS_PHY + (size_t)3 * DHY * NTOK * 2 <= WS_HYY && WS_PHY + (size_t)NTOK * LDK * 2 <= WS_HYY &&
              WS_HYY + (size_t)DHY * NTOK * 2 <= WS_RGY && WS_RGY + (size_t)NTOK * DRG * 2 <= WS_SIDEG && WS_ZK + (size_t)256 * 2 * 8256 * 16 <= WS_WOUT && WS_KF + (size_t)8192 * 8192 * 2 <= WS_SIDEG && WS_H + (size_t)NTOK * DFF * 2 <= WS_SIDEG &&
              WS_SIDEG + (size_t)96 * 8 * DFF * 4 <= WS_SIDEU && WS_SIDEU + (size_t)96 * 4 * DFF * 4 <= WS_END, "d_ws map");
constexpr size_t WS_MIX = WS_PHY;
constexpr size_t WS_Y = WS_PRG;
constexpr size_t WS_F = WS_PRG;
#define XB_TMO      128
#define XB_XCNT(j)  (256  + 64 * (j))
#define XB_XSUB(j)  (1280 + 64 * (j))
#define XB_XGEN(j)  (2304 + 64 * (j))
#define XB_TOP      3328
#define XB_TOPGEN   3392
#define XCD_BAR_WORDS 3456
#define XB_SPIN_CAP (1u << 18)

__device__ __forceinline__ unsigned xb_ld(unsigned* p)              { return __hip_atomic_load(p, __ATOMIC_RELAXED, __HIP_MEMORY_SCOPE_AGENT); }
__device__ __forceinline__ unsigned xb_add(unsigned* p, unsigned v) { return __hip_atomic_fetch_add(p, v, __ATOMIC_RELAXED, __HIP_MEMORY_SCOPE_AGENT); }
__device__ __forceinline__ unsigned xb_xcc_id() { return (unsigned)__builtin_amdgcn_s_getreg((3 << 11) | 20) & 0xFu; }
#define XB_SPIN(cond, bar) do { unsigned _sp = 0; while (cond) { __builtin_amdgcn_s_sleep(1); \
    if ((++_sp & 255u) == 0u) { if (xb_ld(&(bar)[XB_TMO])) break; if (_sp > XB_SPIN_CAP) { atomicAdd(&(bar)[XB_TMO], 1u); break; } } } } while (0)

struct XcdBarrier {
    unsigned* bar; unsigned x;
    volatile LAS unsigned* st;
};

__device__ __forceinline__ XcdBarrier xcd_barrier_post(unsigned* bar, volatile LAS unsigned* st) {
    XcdBarrier b; b.bar = bar; b.x = xb_xcc_id(); b.st = st;
    if (threadIdx.x == 0) (void)xb_add(&bar[XB_XCNT(b.x)], 1u);
    return b;
}
__device__ __forceinline__ void xcd_barrier_complete(unsigned* bar, unsigned x, unsigned& nloc, unsigned& nx) {
    const unsigned G = gridDim.x * gridDim.y * gridDim.z;
    unsigned sum, cnt, mine, sp = 0u;
    for (;;) {
        sum = 0u; cnt = 0u; mine = 0u;
#pragma unroll
        for (unsigned j = 0; j < 16; ++j) { const unsigned c = xb_ld(&bar[XB_XCNT(j)]); sum += c; cnt += (c > 0u) ? 1u : 0u; mine = (j == x) ? c : mine; }
        if (sum == G) break;
        __builtin_amdgcn_s_sleep(1);
        if ((++sp & 255u) == 0u) { if (xb_ld(&bar[XB_TMO])) break; if (sp > XB_SPIN_CAP) { atomicAdd(&bar[XB_TMO], 1u); break; } }
    }
    nloc = mine > 0u ? mine : 1u; nx = cnt > 0u ? cnt : 1u;
}

__device__ __forceinline__ void xcd_barrier(const XcdBarrier& b) {
    asm volatile("s_waitcnt vmcnt(0)" ::: "memory");
    wg_sync();
    if (threadIdx.x == 0) {
        unsigned* bar = b.bar;
        __builtin_amdgcn_s_waitcnt(0);
        unsigned nloc = b.st[0], nx = b.st[1];
        if (nloc == 0u) { xcd_barrier_complete(bar, b.x, nloc, nx); b.st[0] = nloc; b.st[1] = nx; }
        const unsigned old = xb_add(&bar[XB_XSUB(b.x)], 1u);
        const unsigned gen = old / nloc;
        if (old + 1u == (gen + 1u) * nloc) {
            __builtin_amdgcn_fence(__ATOMIC_RELEASE, "agent");
            asm volatile("s_waitcnt vmcnt(0)" ::: "memory");
            const unsigned og = xb_add(&bar[XB_TOP], 1u);
            const unsigned tg = og / nx;
            if (og + 1u == (tg + 1u) * nx) xb_add(&bar[XB_TOPGEN], 1u);
            else XB_SPIN(xb_ld(&bar[XB_TOPGEN]) == tg, bar);
            __builtin_amdgcn_fence(__ATOMIC_ACQUIRE, "agent");
            xb_add(&bar[XB_XGEN(b.x)], 1u);
            asm volatile("s_waitcnt vmcnt(0)" ::: "memory");
        } else {
            XB_SPIN(xb_ld(&bar[XB_XGEN(b.x)]) == gen, bar);
            __builtin_amdgcn_fence(__ATOMIC_ACQUIRE, "agent");
            asm volatile("s_waitcnt vmcnt(0)" ::: "memory");
        }
    }
    wg_sync();
}
struct TrItem { const float* W; bf16* WT; int K, N, k0, n0, drow0, ldt; };
__device__ __forceinline__ void tr_load(const TrItem& t, int lane, f32x4 (&v)[8]) {
    const float* p = t.W + (size_t)(t.k0 + (lane >> 3)) * t.N + t.n0 + (lane & 7) * 4;
#pragma unroll
    for (int ii = 0; ii < 8; ++ii) v[ii] = __builtin_nontemporal_load((const f32x4*)(p + (size_t)8 * ii * t.N));
}
__device__ __forceinline__ void tr_store(const TrItem& t, int lane, const f32x4 (&v)[8], LAS float* scr) {
    LAS float* w = scr + (lane >> 3) * 33 + (lane & 7) * 4;
#pragma unroll
    for (int ii = 0; ii < 8; ++ii) { w[ii * 8 * 33 + 0] = v[ii].x; w[ii * 8 * 33 + 1] = v[ii].y; w[ii * 8 * 33 + 2] = v[ii].z; w[ii * 8 * 33 + 3] = v[ii].w; }
    asm volatile("s_waitcnt lgkmcnt(0)" ::: "memory");
    const int c = lane & 7;
#pragma unroll
    for (int j = 0; j < 4; ++j) { const int n = (lane >> 3) + 8 * j; const LAS float* s = scr + (8 * c) * 33 + n;
        v4u o; o.x = pk2(s[0 * 33], s[1 * 33]); o.y = pk2(s[2 * 33], s[3 * 33]); o.z = pk2(s[4 * 33], s[5 * 33]); o.w = pk2(s[6 * 33], s[7 * 33]);
        *(v4u*)(t.WT + (size_t)(t.drow0 + n) * t.ldt + t.k0 + 8 * c) = o; }
    asm volatile("s_waitcnt lgkmcnt(0)" ::: "memory");
}
template <bool INTER> __device__ __forceinline__ int ffi_drow(int n) {
    if (!INTER) return n;
    const int up = n >= DFF ? 1 : 0, c = n - up * DFF; return (c >> 7) * 256 + up * 128 + (c & 127);
}
struct ProArgs {
    const float *xp, *xs, *g_premix;
    const float *w_in, *w_out, *w_ffi, *w_ffo;
    const float *rg_a_w, *rg_x_w;
    const float *hy_w1, *hy_b1, *hy_w2, *hy_b2, *hy_w3, *hy_b3, *hy_freq;
    unsigned char* ws;
};
__device__ __forceinline__ const float* xrow_ptr(const float* xp, const float* xs, int m) { return m < SEQL ? xp + (size_t)m * DM : xs + (size_t)(m - SEQL) * DM; }

constexpr int TR_I_IN = (DM / 64) * (NIN / 32), TR_I_OUT = (DM / 64) * (DM / 32), TR_I_FI = (DM / 64) * (2 * DFF / 32), TR_I_FO = (DFF / 64) * (DM / 32);
template <bool INTER> __device__ __forceinline__ TrItem tr_decode(const ProArgs& a, int it) {
    bf16* WIN = (bf16*)(a.ws + WS_WIN); bf16* WOUT = (bf16*)(a.ws + WS_WOUT); bf16* WFI = (bf16*)(a.ws + WS_WFI); bf16* WFO = (bf16*)(a.ws + WS_WFO);
    TrItem t; int r = it;
    if (r < TR_I_IN) { const int nb = NIN / 32, kb = r / nb, n0 = (r % nb) * 32; t.W = a.w_in; t.WT = WIN; t.K = DM; t.N = NIN; t.k0 = kb * 64; t.n0 = n0; t.drow0 = n0; t.ldt = LDK; return t; } r -= TR_I_IN;
    if (r < TR_I_OUT) { const int nb = DM / 32, kb = r / nb, n0 = (r % nb) * 32; t.W = a.w_out; t.WT = WOUT; t.K = DM; t.N = DM; t.k0 = kb * 64; t.n0 = n0; t.drow0 = n0; t.ldt = LDK; return t; } r -= TR_I_OUT;
    if (r < TR_I_FI) { const int nb = 2 * DFF / 32, kb = r / nb, n0 = (r % nb) * 32; t.W = a.w_ffi; t.WT = WFI; t.K = DM; t.N = 2 * DFF; t.k0 = kb * 64; t.n0 = n0; t.drow0 = ffi_drow<INTER>(n0); t.ldt = LDK; return t; } r -= TR_I_FI;
    { const int nb = DM / 32, kb = r / nb, n0 = (r % nb) * 32; t.W = a.w_ffo; t.WT = WFO; t.K = DFF; t.N = DM; t.k0 = kb * 64; t.n0 = n0; t.drow0 = n0; t.ldt = DFF; return t; }
}
template <bool INTER> __device__ __forceinline__ void p0_transposes(const ProArgs& a, LAS float* scr, int lane, int gw, int NGW, int it0, int it1) {
    {
        int it = it0 + gw; TrItem cur; f32x4 vc[8], vn[8];
        if (it < it1) { cur = tr_decode<INTER>(a, it); tr_load(cur, lane, vc); }
        while (it < it1) {
            const int nx = it + NGW; TrItem nxt = cur;
            if (nx < it1) { nxt = tr_decode<INTER>(a, nx); tr_load(nxt, lane, vn); }
            tr_store(cur, lane, vc, scr);
            cur = nxt; it = nx;
#pragma unroll
            for (int ii = 0; ii < 8; ++ii) vc[ii] = vn[ii];
        }
    }
}
constexpr int BG_GRP = 1056, BG_SCR = 8 * BG_GRP;
struct BgConv { int it, nleft, step; };
__device__ __forceinline__ void bg_issue(const TrItem& t, int lane, LAS unsigned char* scr) {
    const float* p = t.W + (size_t)(t.k0 + (lane >> 3)) * t.N + t.n0 + (lane & 7) * 4;
#pragma unroll
    for (int ii = 0; ii < 8; ++ii) __builtin_amdgcn_global_load_lds((const unsigned*)(p + (size_t)8 * ii * t.N), (LAS unsigned*)(scr + ii * BG_GRP), 16, 0, 0);
}
template <int NY> __device__ __forceinline__ void bg_finish(const TrItem& t, int lane, const LAS unsigned char* scr) {
    static_assert(NY >= 0 && NY < 64, "vmcnt is a 6-bit counter");
    __builtin_amdgcn_s_waitcnt((NY & 15) | (7 << 4) | (15 << 8) | ((NY >> 4) << 14));
    asm volatile("" ::: "memory");
    const int c = lane & 7; const LAS float* s0 = (const LAS float*)scr + c * (BG_GRP / 4) + (lane >> 3);
#pragma unroll
    for (int j = 0; j < 4; ++j) { const LAS float* s = s0 + 8 * j; const int n = (lane >> 3) + 8 * j;
        v4u o; o.x = pk2(s[0], s[32]); o.y = pk2(s[64], s[96]); o.z = pk2(s[128], s[160]); o.w = pk2(s[192], s[224]);
        *(v4u*)(t.WT + (size_t)(t.drow0 + n) * t.ldt + t.k0 + 8 * c) = o; }
    asm volatile("s_waitcnt lgkmcnt(0)" ::: "memory");
}
template <bool INTER> __device__ __forceinline__ int bg_begin(const ProArgs& a, BgConv& bg, int lane, LAS unsigned char* scr) {
    if (bg.nleft <= 0) return -1;
    const int it = bg.it; bg.it += bg.step; --bg.nleft; bg_issue(tr_decode<INTER>(a, it), lane, scr); return it;
}
template <bool INTER, int NY> __device__ __forceinline__ void bg_end(const ProArgs& a, int it, int lane, LAS unsigned char* scr) {
    __builtin_amdgcn_s_waitcnt((NY & 15) | (7 << 4) | (15 << 8) | ((NY >> 4) << 14));
    if (it >= 0) bg_finish<NY>(tr_decode<INTER>(a, it), lane, scr); }
template <bool INTER> __device__ __forceinline__ void p0_prologue(const ProArgs& a, LAS unsigned char* lds, int gw, int NGW, int wave, int lane, int bg_slots) {
    bf16* WIN = (bf16*)(a.ws + WS_WIN); bf16* WOUT = (bf16*)(a.ws + WS_WOUT); bf16* WFI = (bf16*)(a.ws + WS_WFI); bf16* WFO = (bf16*)(a.ws + WS_WFO);
    LAS float* scr = (LAS float*)(lds + wave * 16384);
    p0_transposes<INTER>(a, scr, lane, gw, NGW, 0, TR_I_IN);
    { const long first = (long)TR_I_IN + (long)bg_slots * NGW, tot = TR_I_IN + TR_I_OUT + TR_I_FI; if (first < tot) p0_transposes<INTER>(a, scr, lane, gw, NGW, (int)first, (int)tot); }
    bf16* XN = (bf16*)(a.ws + WS_XN);
    for (int m = gw; m < NTOK; m += NGW) {
        const float* xr = xrow_ptr(a.xp, a.xs, m);
        f32x4 v[16]; float s = 0.f;
#pragma unroll
        for (int j = 0; j < 8; ++j) { const f32x4* p = (const f32x4*)(xr + (j * 64 + lane) * 8); v[2 * j] = p[0]; v[2 * j + 1] = p[1];
            s += (v[2 * j].x * v[2 * j].x + v[2 * j].y * v[2 * j].y) + (v[2 * j].z * v[2 * j].z + v[2 * j].w * v[2 * j].w);
            s += (v[2 * j + 1].x * v[2 * j + 1].x + v[2 * j + 1].y * v[2 * j + 1].y) + (v[2 * j + 1].z * v[2 * j + 1].z + v[2 * j + 1].w * v[2 * j + 1].w); }
        const float rs = 1.0f / sqrtf(wave_sum(s) * (1.0f / DM) + EPSN);
#pragma unroll
        for (int j = 0; j < 8; ++j) { const int c0 = (j * 64 + lane) * 8; const f32x4 g0 = *(const f32x4*)(a.g_premix + c0), g1 = *(const f32x4*)(a.g_premix + c0 + 4);
            const f32x4 a0 = v[2 * j] * rs * g0, a1 = v[2 * j + 1] * rs * g1;
            v4u o; o.x = pk2(a0.x, a0.y); o.y = pk2(a0.z, a0.w); o.z = pk2(a1.x, a1.y); o.w = pk2(a1.z, a1.w);
            *(v4u*)(XN + (size_t)m * LDK + c0) = o; }
    }
    bf16* RGW = (bf16*)(a.ws + WS_RGW);
    for (int base = gw * 64 + lane; base < 2 * 2 * NHEAD * HDIM * HDIM; base += NGW * 64 * 8) {
        float v[8];
#pragma unroll
        for (int q = 0; q < 8; ++q) { const int idx = base + q * NGW * 64; v[q] = 0.f;
            if (idx < 2 * 2 * NHEAD * HDIM * HDIM) { const int gate = (idx >> 18) & 1, dir = idx >> 19; const float* W = gate ? a.rg_x_w : a.rg_a_w; v[q] = W[(size_t)dir * (NHEAD * HDIM * HDIM) + (idx & (NHEAD * HDIM * HDIM - 1))]; } }
#pragma unroll
        for (int q = 0; q < 8; ++q) { const int idx = base + q * NGW * 64;
            if (idx < 2 * 2 * NHEAD * HDIM * HDIM) { const int j = idx & 127, i = (idx >> 7) & 127, hg = idx >> 14; RGW[((size_t)hg * HDIM + j) * HDIM + i] = (bf16)f2bf(v[q]); } }
    }
    f32x2* TW = (f32x2*)(a.ws + WS_TW);
    for (int k = gw * 64 + lane; k < FFT_N; k += NGW * 64) { float sn, cs; sincospif((float)k * (1.0f / 8192.0f), &sn, &cs); TW[k] = (f32x2){cs, -sn}; }
    bf16* H3H = (bf16*)(a.ws + WS_H3); bf16* H3L = H3H + SEQL * 64;
    const float fr = a.hy_freq[lane], b1 = a.hy_b1[lane], b2 = a.hy_b2[lane], b3 = a.hy_b3[lane];
    for (int n0 = gw; n0 < SEQL; n0 += 4 * NGW) {
        float zv[4], acc[4], h[4];
#pragma unroll
        for (int p = 0; p < 4; ++p) { const int nn = n0 + p * NGW, n = nn < SEQL ? nn : n0;
            zv[p] = 0.f;
            if (lane == 0) zv[p] = (float)n * (1.0f / (float)(SEQL - 1));
            else if (lane < 33) { const int k = (lane - 1) & 15; const float band = 1e-4f + (float)k * ((15.0f - 1e-4f) / 15.0f);
                const float ang = (6.283185307179586f / (float)SEQL) * (float)n * band; zv[p] = lane < 17 ? cosf(ang) : -sinf(ang); }
            acc[p] = b1; }
        for (int e = 0; e < 33; ++e) { const float w = a.hy_w1[e * 64 + lane];
#pragma unroll
            for (int p = 0; p < 4; ++p) acc[p] += __shfl(zv[p], e) * w; }
#pragma unroll
        for (int p = 0; p < 4; ++p) { h[p] = sinf(fr * acc[p]); acc[p] = b2; }
        for (int e = 0; e < 64; ++e) { const float w = a.hy_w2[e * 64 + lane];
#pragma unroll
            for (int p = 0; p < 4; ++p) acc[p] += __shfl(h[p], e) * w; }
#pragma unroll
        for (int p = 0; p < 4; ++p) { h[p] = sinf(fr * acc[p]); acc[p] = b3; }
        for (int e = 0; e < 64; ++e) { const float w = a.hy_w3[e * 64 + lane];
#pragma unroll
            for (int p = 0; p < 4; ++p) acc[p] += __shfl(h[p], e) * w; }
#pragma unroll
        for (int p = 0; p < 4; ++p) { const int n = n0 + p * NGW; const float hv = sinf(fr * acc[p]);
            if (n < SEQL) { const unsigned hi = f2bf(hv); H3H[n * 64 + lane] = (bf16)hi; H3L[n * 64 + lane] = (bf16)f2bf(hv - bf2f(hi)); } }
    }
}
constexpr int FFT_LDS_BYTES = (FFT_N + FFT_N / 32) * 8;
constexpr int HY_W4_OFF = FFT_LDS_BYTES;
constexpr int HY_PRM_OFF = FFT_LDS_BYTES + 1024;
constexpr int HY_TWT_OFF = FFT_LDS_BYTES + 1024 + 256;
constexpr int HY_LDS_BYTES = FFT_LDS_BYTES + 1024 + 256 + 4096;
__device__ __forceinline__ int PH(int i) { return i + (i >> 5); }
__device__ __forceinline__ f32x2 cmul(f32x2 a, f32x2 b) { return (f32x2){a.x * b.x - a.y * b.y, a.x * b.y + a.y * b.x}; }
__device__ __forceinline__ constexpr int bitrev_c(int r, int bits) { int o = 0; for (int i = 0; i < bits; ++i) o |= ((r >> i) & 1) << (bits - 1 - i); return o; }

__device__ __forceinline__ f32x2 mul_w32(f32x2 d, int idx) {
    constexpr float C[16] = {1.0f, 0.98078528040323043f, 0.92387953251128674f, 0.83146961230254524f, 0.70710678118654752f, 0.55557023301960218f, 0.38268343236508977f, 0.19509032201612825f,
                             0.0f, -0.19509032201612825f, -0.38268343236508977f, -0.55557023301960218f, -0.70710678118654752f, -0.83146961230254524f, -0.92387953251128674f, -0.98078528040323043f};
    constexpr float S[16] = {0.0f, 0.19509032201612825f, 0.38268343236508977f, 0.55557023301960218f, 0.70710678118654752f, 0.83146961230254524f, 0.92387953251128674f, 0.98078528040323043f,
                             1.0f, 0.98078528040323043f, 0.92387953251128674f, 0.83146961230254524f, 0.70710678118654752f, 0.55557023301960218f, 0.38268343236508977f, 0.19509032201612825f};
    if (idx == 0) return d;
    if (idx == 8) return (f32x2){d.y, -d.x};
    const float c = C[idx], s = S[idx];
    return (f32x2){d.x * c + d.y * s, d.y * c - d.x * s};
}
template <int R> __device__ __forceinline__ void dft_inreg(f32x2 (&a)[R]) {
    constexpr int LOGR = (R == 32) ? 5 : 4;
#pragma unroll
    for (int t = 0; t < LOGR; ++t) {
        const int half = R >> (t + 1);
#pragma unroll
        for (int g = 0; g < R; g += 2 * half)
#pragma unroll
            for (int i = 0; i < half; ++i) {
                const f32x2 u = a[g + i], v = a[g + i + half];
                a[g + i] = u + v;
                a[g + i + half] = mul_w32(u - v, i * (16 / half));
            }
    }
}
template <int R, int S, bool TW, bool ZPAD = false, bool HALFOUT = false, int TWMODE = 0> __device__ __forceinline__ void fft_pass(LAS f32x2* lds, const f32x2* tw, int tid) {
    static_assert(TWMODE != 1 || (S == 32 && R == 32), "the LDS twiddle table is the second pass's");
    constexpr int NB = FFT_N / R, PER = NB / 512, LOGR = (R == 32) ? 5 : 4;
    constexpr int RSTEP = NB + NB / 32;
    constexpr int WSTEP = (S == 1) ? 1 : (S + S / 32);
    f32x2 a[PER][R];
#pragma unroll
    for (int b = 0; b < PER; ++b) { const LAS f32x2* rp = lds + PH(tid + 512 * b);
#pragma unroll
        for (int k = 0; k < R; ++k) a[b][k] = (ZPAD && k >= R / 2) ? (f32x2){0.f, 0.f} : rp[k * RSTEP]; }
    lds_sync();
#pragma unroll
    for (int b = 0; b < PER; ++b) {
        const int beta = tid + 512 * b, q = beta & (S - 1), p = beta / S, base = q + R * S * p;
        dft_inreg<R>(a[b]);
        f32x2 w1 = (f32x2){1.f, 0.f}, wj = (f32x2){1.f, 0.f}, wm = (f32x2){1.f, 0.f};
        if (TW && TWMODE != 1) { w1 = tw[p * S]; wj = w1; }
        const float kc = 2.0f * w1.x;
        const LAS f32x2* tab = lds + (HY_TWT_OFF / 8) + p * 32;
        LAS f32x2* wp = lds + PH(base);
        wp[0] = a[b][0];
#pragma unroll
        for (int j = 1; j < (HALFOUT ? R / 2 : R); ++j) {
            f32x2 v = a[b][bitrev_c(j, LOGR)];
            if (TW) {
                if (TWMODE == 1) v = cmul(v, tab[j]);
                else { v = cmul(v, wj);
                    if (TWMODE == 2) { const f32x2 nx = (f32x2){kc * wj.x - wm.x, kc * wj.y - wm.y}; wm = wj; wj = nx; }
                    else wj = cmul(wj, w1); }
            }
            wp[j * WSTEP] = v;
        }
    }
    lds_sync();
}
template <bool ZPAD = false, bool HALFOUT = false> __device__ __forceinline__ void fft16k(LAS f32x2* lds, const f32x2* tw, int tid) {
    asm volatile("" : "+v"(tid));
    fft_pass<32, 1, true, ZPAD, false, 2>(lds, tw, tid);
    fft_pass<32, 32, true, false, false, 1>(lds, tw, tid);
    fft_pass<16, 1024, false, false, HALFOUT>(lds, tw, tid);
}
__device__ __forceinline__ void spec_pair(LAS f32x2* lds, const f32x2* ZK, int p) {
    const int f = p, f2 = (FFT_N - p) & (FFT_N - 1);
    const f32x2 A = ZK[f], A2 = ZK[f2], Z = lds[PH(f)], Z2 = lds[PH(f2)];
    const float kcx = 0.5f * (A.x + A2.x), kcy = 0.5f * (A.y - A2.y);
    const float dx = 0.5f * (A.x - A2.x), dy = 0.5f * (A.y + A2.y);
    const float k1x = dy, k1y = -dx;
    const float px = 0.5f * (kcx + k1x), py = 0.5f * (kcy + k1y), qx = 0.5f * (kcx - k1x), qy = 0.5f * (kcy - k1y);
    const float wx = Z.x * px - Z.y * py + (Z2.x * qx + Z2.y * qy);
    const float wy = Z.x * py + Z.y * px + (Z2.x * qy - Z2.y * qx);
    const float w2x = Z2.x * px + Z2.y * py + (Z.x * qx - Z.y * qy);
    const float w2y = Z2.y * px - Z2.x * py - (Z.x * qy + Z.y * qx);
    lds[PH(f)] = (f32x2){wx, -wy}; lds[PH(f2)] = (f32x2){w2x, -w2y};
}
__device__ __forceinline__ void spec_mul(LAS f32x2* lds, const f32x2* ZK, int tid) {
    asm volatile("" : "+v"(tid));
#pragma unroll 8
    for (int i = 0; i < 16; ++i) spec_pair(lds, ZK, tid + 512 * i);
    if (tid == 0) spec_pair(lds, ZK, 8192);
    lds_sync();
}
constexpr int PQ_STRIDE = 8256;
__device__ __forceinline__ f32x4 spec_pq(f32x2 A, f32x2 A2) {
    const float kcx = 0.5f * (A.x + A2.x), kcy = 0.5f * (A.y - A2.y), dx = 0.5f * (A.x - A2.x), dy = 0.5f * (A.y + A2.y), k1x = dy, k1y = -dx;
    return (f32x4){0.5f * (kcx + k1x), 0.5f * (kcy + k1y), 0.5f * (kcx - k1x), 0.5f * (kcy - k1y)};
}
__device__ __forceinline__ void spec_pair_pq(LAS f32x2* lds, f32x4 pq, int p) {
    const int f = p, f2 = (FFT_N - p) & (FFT_N - 1);
    const f32x2 Z = lds[PH(f)], Z2 = lds[PH(f2)];
    const float px = pq.x, py = pq.y, qx = pq.z, qy = pq.w;
    const float wx = Z.x * px - Z.y * py + (Z2.x * qx + Z2.y * qy);
    const float wy = Z.x * py + Z.y * px + (Z2.x * qy - Z2.y * qx);
    const float w2x = Z2.x * px + Z2.y * py + (Z.x * qx - Z.y * qy);
    const float w2y = Z2.y * px - Z2.x * py - (Z.x * qy + Z.y * qx);
    lds[PH(f)] = (f32x2){wx, -wy}; lds[PH(f2)] = (f32x2){w2x, -w2y};
}
__device__ __forceinline__ void spec_prefetch(const f32x4* PQ, int tid, f32x4 (&A)[8]) {
#pragma unroll
    for (int i = 0; i < 8; ++i) A[i] = PQ[tid + 512 * i];
}
__device__ __forceinline__ void spec_mul_pre(LAS f32x2* lds, const f32x4* PQ, int tid, const f32x4 (&A)[8]) {
    asm volatile("" : "+v"(tid));
    f32x4 B[8];
#pragma unroll
    for (int i = 0; i < 8; ++i) B[i] = PQ[tid + 512 * (i + 8)];
#pragma unroll
    for (int i = 0; i < 8; ++i) spec_pair_pq(lds, A[i], tid + 512 * i);
#pragma unroll
    for (int i = 0; i < 8; ++i) spec_pair_pq(lds, B[i], tid + 512 * (i + 8));
    if (tid == 0) spec_pair_pq(lds, PQ[8192], 8192);
    lds_sync();
}
typedef _Float16 f16x4 __attribute__((ext_vector_type(4)));
__device__ __forceinline__ void filter_gemm(const bf16* h3h, const float* w4, _Float16* KF, int wgi, int nwg, int tid) {
    const int lane = tid & 63, wv = tid >> 6, fr = lane & 15, fq = lane >> 4;
    constexpr float MIN_DECAY = -3.0701134573253945f, MAX_DECAY = -15.350567286626973f;
    for (int cb = wgi; cb < 8192 / 32; cb += nwg) {
        bf16x8 Bh[2][2], Bl[2][2]; float adl[2];
#pragma unroll
        for (int ct = 0; ct < 2; ++ct) {
            const int col = 32 * cb + 16 * ct + fr;
            adl[ct] = fabsf(MIN_DECAY + (float)(col & (DHY - 1)) * ((MAX_DECAY - MIN_DECAY) / (float)(DHY - 1))) * (1.0f / (float)(SEQL - 1));
#pragma unroll
            for (int kk = 0; kk < 2; ++kk)
#pragma unroll
                for (int i = 0; i < 8; ++i) { const float w = w4[(size_t)(32 * kk + 8 * fq + i) * 8192 + col]; const unsigned hi = f2bf(w); Bh[ct][kk][i] = (short)hi; Bl[ct][kk][i] = (short)f2bf(w - bf2f(hi)); }
        }
        const bf16* apw = h3h + (size_t)(wv * 1024 + fr) * 64 + 8 * fq;
        _Float16* kout = KF + (size_t)(32 * cb + fr) * SEQL + wv * 1024 + 4 * fq;
        bf16x8 fa[4][4], fb[4][4];
        auto loadg = [&](bf16x8 (&f)[4][4], int g) {
#pragma unroll
            for (int q = 0; q < 4; ++q) { const bf16* ap = apw + (size_t)(g * 4 + q) * 16 * 64;
                f[q][0] = *(const bf16x8*)ap; f[q][1] = *(const bf16x8*)(ap + 32); f[q][2] = *(const bf16x8*)(ap + SEQL * 64); f[q][3] = *(const bf16x8*)(ap + SEQL * 64 + 32); }
        };
        auto compg = [&](const bf16x8 (&f)[4][4], int g) {
#pragma unroll
            for (int q = 0; q < 4; ++q) {
                const int blk = g * 4 + q, n0 = wv * 1024 + blk * 16 + 4 * fq;
#pragma unroll
                for (int ct = 0; ct < 2; ++ct) {
                    f32x4 acc = (f32x4){0.f, 0.f, 0.f, 0.f};
                    acc = __builtin_amdgcn_mfma_f32_16x16x32_bf16(f[q][2], Bh[ct][0], acc, 0, 0, 0); acc = __builtin_amdgcn_mfma_f32_16x16x32_bf16(f[q][3], Bh[ct][1], acc, 0, 0, 0);
                    acc = __builtin_amdgcn_mfma_f32_16x16x32_bf16(f[q][0], Bl[ct][0], acc, 0, 0, 0); acc = __builtin_amdgcn_mfma_f32_16x16x32_bf16(f[q][1], Bl[ct][1], acc, 0, 0, 0);
                    acc = __builtin_amdgcn_mfma_f32_16x16x32_bf16(f[q][0], Bh[ct][0], acc, 0, 0, 0); acc = __builtin_amdgcn_mfma_f32_16x16x32_bf16(f[q][1], Bh[ct][1], acc, 0, 0, 0);
                    f16x4 o;
#pragma unroll
                    for (int e = 0; e < 4; ++e) o[e] = (_Float16)(acc[e] * fexp(-(float)(n0 + e) * adl[ct]));
                    *(f16x4*)(kout + (size_t)16 * ct * SEQL + blk * 16) = o;
                }
            }
        };
        loadg(fa, 0);
#pragma unroll 1
        for (int gg = 0; gg < 8; ++gg) {
            loadg(fb, 2 * gg + 1); compg(fa, 2 * gg);
            loadg(fa, 2 * gg + 2 < 16 ? 2 * gg + 2 : 15); compg(fb, 2 * gg + 1);
        }
    }
}
struct HyArgs {
    const bf16* phy;
    const float *conv_w, *conv_b;
    const float* hy_bias;
    const _Float16* kf;
    const f32x2* tw;
    f32x2* zk;
    bf16* hyy;
};
__device__ __forceinline__ void load_conv3_16(const bf16* row, int t0, float w0, float w1, float w2, float bias, float (&out)[16]) {
    const v4u r0 = *(const v4u*)(row + t0), r1 = *(const v4u*)(row + t0 + 8);
    float u[18];
    u[0] = t0 > 0 ? bf2f(row[t0 - 1]) : 0.f;
    u[17] = (t0 + 16 < SEQL) ? bf2f(row[t0 + 16]) : 0.f;
    u[1] = bflo(r0.x); u[2] = bfhi(r0.x); u[3] = bflo(r0.y); u[4] = bfhi(r0.y); u[5] = bflo(r0.z); u[6] = bfhi(r0.z); u[7] = bflo(r0.w); u[8] = bfhi(r0.w);
    u[9] = bflo(r1.x); u[10] = bfhi(r1.x); u[11] = bflo(r1.y); u[12] = bfhi(r1.y); u[13] = bflo(r1.z); u[14] = bfhi(r1.z); u[15] = bflo(r1.w); u[16] = bfhi(r1.w);
#pragma unroll
    for (int e = 0; e < 16; ++e) out[e] = bias + w0 * u[e] + w1 * u[e + 1] + w2 * u[e + 2];
}
struct Raw16 { v4u a, b; unsigned lo, hi; };
__device__ __forceinline__ Raw16 load_raw16(const bf16* row, int t0) {
    Raw16 r; r.a = *(const v4u*)(row + t0); r.b = *(const v4u*)(row + t0 + 8);
    r.lo = t0 > 0 ? (unsigned)row[t0 - 1] : 0u; r.hi = (t0 + 16 < SEQL) ? (unsigned)row[t0 + 16] : 0u; return r;
}
__device__ __forceinline__ void conv3_raw16(const Raw16& r, float w0, float w1, float w2, float bias, float (&out)[16]) {
    float u[18];
    u[0] = bf2f(r.lo); u[17] = bf2f(r.hi);
    u[1] = bflo(r.a.x); u[2] = bfhi(r.a.x); u[3] = bflo(r.a.y); u[4] = bfhi(r.a.y); u[5] = bflo(r.a.z); u[6] = bfhi(r.a.z); u[7] = bflo(r.a.w); u[8] = bfhi(r.a.w);
    u[9] = bflo(r.b.x); u[10] = bfhi(r.b.x); u[11] = bflo(r.b.y); u[12] = bfhi(r.b.y); u[13] = bflo(r.b.z); u[14] = bfhi(r.b.z); u[15] = bflo(r.b.w); u[16] = bfhi(r.b.w);
#pragma unroll
    for (int e = 0; e < 16; ++e) out[e] = bias + w0 * u[e] + w1 * u[e + 1] + w2 * u[e + 2];
}
__device__ __forceinline__ void store16_bf16(bf16* dst, const float (&v)[16]) {
    v4u o0, o1; o0.x = pk2(v[0], v[1]); o0.y = pk2(v[2], v[3]); o0.z = pk2(v[4], v[5]); o0.w = pk2(v[6], v[7]);
    o1.x = pk2(v[8], v[9]); o1.y = pk2(v[10], v[11]); o1.z = pk2(v[12], v[13]); o1.w = pk2(v[14], v[15]);
    *(v4u*)dst = o0; *(v4u*)(dst + 8) = o1;
}
#ifndef PROBE_MASK
#define PROBE_MASK 0ull
#endif
#define HPB(bit) do { if ((PROBE_MASK >> (bit)) & 1ull) { if (blockIdx.x == PROBE_BLK && threadIdx.x == 0) pt0 = __builtin_amdgcn_s_memrealtime(); } } while (0)
#define HPE(bit) do { if ((PROBE_MASK >> (bit)) & 1ull) { if (blockIdx.x == PROBE_BLK && threadIdx.x == 0) pacc += __builtin_amdgcn_s_memrealtime() - pt0; } } while (0)
__device__ __forceinline__ void hyena_unit(const HyArgs& a, LAS unsigned char* ldsb_, int cp, int wgslot, int tid, unsigned long long& pt0, unsigned long long& pacc) {
    unsigned lzero; asm volatile("v_mov_b32 %0, 0" : "=v"(lzero));
    LAS unsigned char* ldsb = ldsb_ + lzero;
    LAS f32x2* lds = (LAS f32x2*)ldsb;
    const int c0 = 2 * cp, c1 = c0 + 1;
    f32x4* pqw = (f32x4*)a.zk + (size_t)wgslot * 2 * PQ_STRIDE;
    constexpr float MIN_DECAY = -3.0701134573253945f, MAX_DECAY = -15.350567286626973f;
    const float ad0 = fabsf(MIN_DECAY + (float)c0 * ((MAX_DECAY - MIN_DECAY) / (float)(DHY - 1)));
    const float ad1 = fabsf(MIN_DECAY + (float)c1 * ((MAX_DECAY - MIN_DECAY) / (float)(DHY - 1)));
    LAS float* prm = (LAS float*)(ldsb + HY_PRM_OFF);
    wg_sync();
    ((LAS f32x2*)(ldsb + HY_TWT_OFF))[tid] = a.tw[32 * (tid >> 5) * (tid & 31)];
    if (tid < 24) { const int k = tid & 3, sc = tid >> 2, st = sc >> 1, chn = st * DHY + c0 + (sc & 1); prm[tid] = k < 3 ? a.conv_w[k * 6144 + chn] : a.conv_b[chn]; }
    if (tid >= 32 && tid < 36) { const int j = tid - 32; prm[tid] = a.hy_bias[(j >> 1) * DHY + c0 + (j & 1)]; }
    HPB(12);
#pragma unroll 1
    for (int o = 0; o < 2; ++o) {
        int tq = tid; asm volatile("" : "+v"(tq)); const int t0 = 16 * tq;
        wg_sync();
        {
            const _Float16* kr = a.kf + (size_t)(o * 4096 + c0) * SEQL + t0;
            const v4u f0a = *(const v4u*)kr, f0b = *(const v4u*)(kr + 8), f1a = *(const v4u*)(kr + SEQL), f1b = *(const v4u*)(kr + SEQL + 8);
            const v4u b0a = *(const v4u*)(kr + (size_t)2048 * SEQL), b0b = *(const v4u*)(kr + (size_t)2048 * SEQL + 8), b1a = *(const v4u*)(kr + (size_t)2049 * SEQL), b1b = *(const v4u*)(kr + (size_t)2049 * SEQL + 8);
            typedef _Float16 h2 __attribute__((ext_vector_type(2)));
            const unsigned F0[8] = {f0a.x, f0a.y, f0a.z, f0a.w, f0b.x, f0b.y, f0b.z, f0b.w}, F1[8] = {f1a.x, f1a.y, f1a.z, f1a.w, f1b.x, f1b.y, f1b.z, f1b.w};
            const unsigned B0[8] = {b0a.x, b0a.y, b0a.z, b0a.w, b0b.x, b0b.y, b0b.z, b0b.w}, B1[8] = {b1a.x, b1a.y, b1a.z, b1a.w, b1b.x, b1b.y, b1b.z, b1b.w};
            if (tq == 0) lds[PH(SEQL)] = (f32x2){0.f, 0.f};
#pragma unroll
            for (int e2 = 0; e2 < 8; ++e2) {
                const h2 x0 = __builtin_bit_cast(h2, F0[e2]), x1 = __builtin_bit_cast(h2, F1[e2]), y0 = __builtin_bit_cast(h2, B0[e2]), y1 = __builtin_bit_cast(h2, B1[e2]);
                const int n = t0 + 2 * e2;
                lds[PH(n)] = (f32x2){(float)x0.x, (float)x1.x}; lds[PH(n + 1)] = (f32x2){(float)x0.y, (float)x1.y};
                if (n >= 1) lds[PH(FFT_N - n)] = (f32x2){(float)y0.x, (float)y1.x};
                lds[PH(FFT_N - n - 1)] = (f32x2){(float)y0.y, (float)y1.y};
            }
        }
        wg_sync();
        fft16k(lds, a.tw, tid);
#pragma unroll 4
        for (int i = 0; i < 16; ++i) { const int p = tq + 512 * i; pqw[(size_t)o * PQ_STRIDE + p] = spec_pq(lds[PH(p)], lds[PH((FFT_N - p) & (FFT_N - 1))]); }
        if (tq == 0) pqw[(size_t)o * PQ_STRIDE + 8192] = spec_pq(lds[PH(8192)], lds[PH(8192)]);
    }
    HPE(12);
    const float inv_n = 1.0f / (float)FFT_N;
    asm volatile("s_waitcnt vmcnt(0)" ::: "memory");
    wg_sync();
#pragma unroll 1
    for (int s = 0; s < NSEQ; ++s) {
        const size_t m0 = (size_t)s * SEQL;
        int tq = tid; asm volatile("" : "+v"(tq)); const int t0 = 16 * tq;
        const Raw16 rv0 = load_raw16(a.phy + (size_t)(0 * DHY + c0) * NTOK + m0, t0), rv1 = load_raw16(a.phy + (size_t)(0 * DHY + c1) * NTOK + m0, t0);
        {
            float v0[16], v1[16];
            conv3_raw16(rv0, prm[0], prm[1], prm[2], prm[3], v0); conv3_raw16(rv1, prm[4], prm[5], prm[6], prm[7], v1);
            wg_sync();
#pragma unroll
            for (int e = 0; e < 16; ++e) { lds[PH(t0 + e)] = (f32x2){v0[e], v1[e]}; }
        }
        wg_sync();
        { f32x4 zA[8]; spec_prefetch(pqw, tid, zA);
        HPB(13); fft16k<true, false>(lds, a.tw, tid); HPE(13);
        HPB(14); spec_mul_pre(lds, pqw, tid, zA); HPE(14); }
        const Raw16 rx0 = load_raw16(a.phy + (size_t)(1 * DHY + c0) * NTOK + m0, t0), rx1 = load_raw16(a.phy + (size_t)(1 * DHY + c1) * NTOK + m0, t0);
        HPB(15); fft16k<false, true>(lds, a.tw, tid); HPE(15);
        float z0[16], z1[16];
        {
            float x0[16], x1[16];
            conv3_raw16(rv0, prm[0], prm[1], prm[2], prm[3], x0); conv3_raw16(rv1, prm[4], prm[5], prm[6], prm[7], x1);
#pragma unroll
            for (int e = 0; e < 16; ++e) { const f32x2 r = lds[PH(t0 + e)]; z0[e] = r.x * inv_n + prm[32] * x0[e]; z1[e] = -r.y * inv_n + prm[33] * x1[e]; }
            conv3_raw16(rx0, prm[8], prm[9], prm[10], prm[11], x0); conv3_raw16(rx1, prm[12], prm[13], prm[14], prm[15], x1);
#pragma unroll
            for (int e = 0; e < 16; ++e) { z0[e] *= x0[e]; z1[e] *= x1[e]; }
        }
#pragma unroll
        for (int e = 0; e < 16; ++e) { lds[PH(t0 + e)] = (f32x2){z0[e], z1[e]}; }
        wg_sync();
        { f32x4 zA[8]; spec_prefetch(pqw + PQ_STRIDE, tid, zA);
        HPB(13); fft16k<true, false>(lds, a.tw, tid); HPE(13);
        HPB(14); spec_mul_pre(lds, pqw + PQ_STRIDE, tid, zA); HPE(14); }
        const Raw16 ry0 = load_raw16(a.phy + (size_t)(2 * DHY + c0) * NTOK + m0, t0), ry1 = load_raw16(a.phy + (size_t)(2 * DHY + c1) * NTOK + m0, t0);
        HPB(15); fft16k<false, true>(lds, a.tw, tid); HPE(15);
        {
            float x0[16], x1[16];
            conv3_raw16(ry0, prm[16], prm[17], prm[18], prm[19], x0); conv3_raw16(ry1, prm[20], prm[21], prm[22], prm[23], x1);
#pragma unroll
            for (int e = 0; e < 16; ++e) { const f32x2 r = lds[PH(t0 + e)];
                x0[e] = x0[e] * (r.x * inv_n + prm[34] * z0[e]); x1[e] = x1[e] * (-r.y * inv_n + prm[35] * z1[e]); }
            store16_bf16(a.hyy + (size_t)c0 * NTOK + m0 + t0, x0);
            store16_bf16(a.hyy + (size_t)c1 * NTOK + m0 + t0, x1);
        }
    }
}
constexpr int RG_T = 128, RG_NT = SEQL / RG_T;
constexpr int RG_XC_STRIDE = 272;
constexpr int RG_G_OFF = RG_T * RG_XC_STRIDE;
constexpr int RG_HF_OFF = 2 * RG_T * RG_XC_STRIDE;
constexpr int RG_LDS_BYTES = RG_HF_OFF + 8 * BG_SCR;
constexpr int RG_UNITS = NSEQ * RG_NT * NHEAD;
struct RgArgs {
    const bf16* prg;
    const float *conv_w, *conv_b;
    const bf16* rgw;
    const float *a_b, *x_b;
    const float* lam;
    f32x2* summ;
    bf16* rgy;
    v4u* ab[2];
};
struct RgW { bf16x8 Br[2][4], Bi[2][4]; float ba[2], bx[2], sp[2]; };
__device__ __forceinline__ void rg_load_w(const RgArgs& a, int h, int tid, RgW& w) {
    const int wave = tid >> 6, lane = tid & 63, fr = lane & 15, fq = lane >> 4, ch = h * HDIM + 16 * wave + fr;
#pragma unroll
    for (int dir = 0; dir < 2; ++dir) {
#pragma unroll
        for (int kk = 0; kk < 4; ++kk) {
            w.Br[dir][kk] = *(const bf16x8*)(a.rgw + ((((size_t)dir * 2 + 0) * NHEAD + h) * HDIM + 16 * wave + fr) * HDIM + 32 * kk + 8 * fq);
            w.Bi[dir][kk] = *(const bf16x8*)(a.rgw + ((((size_t)dir * 2 + 1) * NHEAD + h) * HDIM + 16 * wave + fr) * HDIM + 32 * kk + 8 * fq);
        }
        w.ba[dir] = a.a_b[dir * DRG + ch]; w.bx[dir] = a.x_b[dir * DRG + ch];
        w.sp[dir] = log1pf(expf(-a.lam[dir * DRG + ch]));
    }
}
constexpr int RG_CIN_OFF = 0;
static_assert(8 * 512 * 4 <= RG_T * RG_XC_STRIDE, "RG carry table inside the xc tile");
__device__ __forceinline__ void rg_carry_table(const RgArgs& a, LAS unsigned char* lds, int h, int tt0, int s, int tid) {
    const int wave = tid >> 6, lane = tid & 63, fr = lane & 15, ch = h * HDIM + 16 * wave + fr;
    LAS float* tab = (LAS float*)(lds + RG_CIN_OFF) + tid;
#pragma unroll 1
    for (int dir = 0; dir < 2; ++dir) {
        const f32x2* sm = a.summ + ((size_t)dir * NSEQ + s) * RG_NT * DRG + ch;
        float carry = 0.f;
#pragma unroll 1
        for (int j0 = 0; j0 < RG_NT; j0 += 32) {
            f32x2 pb[32];
#pragma unroll
            for (int q = 0; q < 32; ++q) { const int jj = j0 + q, j = dir == 0 ? jj : RG_NT - 1 - jj; pb[q] = sm[(size_t)j * DRG]; }
#pragma unroll
            for (int q = 0; q < 32; ++q) { const int jj = j0 + q, j = dir == 0 ? jj : RG_NT - 1 - jj, d = j - tt0;
                if (d >= 0 && (d & 15) == 0) tab[(dir * 4 + (d >> 4)) * 512] = carry;
                carry = pb[q].x * carry + pb[q].y; }
        }
    }
}
template <int PASS> __device__ __forceinline__ void rg_unit(const RgArgs& a, LAS unsigned char* lds, int unit, int tid, const RgW& W, const ProArgs& pa, BgConv& bg, bool use_tab, unsigned long long& pt0, unsigned long long& pacc) {
    const int wave = tid >> 6, lane = tid & 63, fr = lane & 15, fq = lane >> 4;
    LAS unsigned char* bscr = lds + RG_HF_OFF + __builtin_amdgcn_readfirstlane(tid >> 6) * BG_SCR;
    int pendA = -1, pendB = -1;
    const int h = unit % NHEAD, tt = (unit / NHEAD) % RG_NT, s = unit / (NHEAD * RG_NT);
    const int tok0 = tt * RG_T;
    const size_t mrow0 = (size_t)s * SEQL;
    HPB(30);
    wg_sync();
    v4u stq[2][RG_T / 16];
    if (PASS == 1) {
        const int cg = h * HDIM + 2 * lane;
        float w0[4], w1[4];
#pragma unroll
        for (int k = 0; k < 4; ++k) { w0[k] = a.conv_w[k * DRG + cg]; w1[k] = a.conv_w[k * DRG + cg + 1]; }
        const float cb0 = a.conv_b[cg], cb1 = a.conv_b[cg + 1];
        const int tb = tok0 + 16 * wave;
        unsigned raw[19];
#pragma unroll
        for (int q = 0; q < 19; ++q) { const int t = tb - 2 + q, tc = t < 0 ? 0 : (t > SEQL - 1 ? SEQL - 1 : t); raw[q] = *(const unsigned*)(a.prg + (mrow0 + tc) * DM + cg); }
#pragma unroll
        for (int q = 0; q < 19; ++q) { const int t = tb - 2 + q; if (t < 0 || t > SEQL - 1) raw[q] = 0u; }
#pragma unroll
        for (int i = 0; i < 16; ++i) {
            const float y0 = cb0 + w0[0] * bflo(raw[i]) + w0[1] * bflo(raw[i + 1]) + w0[2] * bflo(raw[i + 2]) + w0[3] * bflo(raw[i + 3]);
            const float y1 = cb1 + w1[0] * bfhi(raw[i]) + w1[1] * bfhi(raw[i + 1]) + w1[2] * bfhi(raw[i + 2]) + w1[3] * bfhi(raw[i + 3]);
            *(LAS unsigned*)(lds + (16 * wave + i) * RG_XC_STRIDE + lane * 4) = pk2(y0, y1);
        }
    } else {
        const int cg = h * HDIM + 2 * lane, tb = tok0 + 16 * wave;
        unsigned graw[16];
#pragma unroll
        for (int i = 0; i < 16; ++i) graw[i] = *(const unsigned*)(a.prg + (mrow0 + tb + i) * DM + DRG + cg);
#pragma unroll
        for (int b = 0; b < RG_T / 16; ++b) stq[0][b] = a.ab[0][((size_t)unit * (RG_T / 16) + b) * 512 + tid];
#pragma unroll
        for (int i = 0; i < 16; ++i) *(LAS unsigned*)(lds + RG_G_OFF + (16 * wave + i) * RG_XC_STRIDE + lane * 4) = graw[i];
    }
    wg_sync();
    HPE(30);
    if (PASS == 1) pendA = bg_begin<true>(pa, bg, lane, bscr);
    const int ch = h * HDIM + 16 * wave + fr;
    float hf[RG_T / 16][4];
#pragma unroll
    for (int dir = 0; dir < 2; ++dir) {
        if (dir == 1) { if (PASS == 1) { bg_end<true, 4>(pa, pendA, lane, bscr); pendB = bg_begin<true>(pa, bg, lane, bscr); }
                        else bg_end<true, 0>(pa, pendA, lane, bscr); }
        const bf16x8 (&Br)[4] = W.Br[dir], (&Bi)[4] = W.Bi[dir];
        const float ba = W.ba[dir], bx = W.bx[dir], sp = W.sp[dir];
        float carry = 0.f, ptot = 1.f;
        if (PASS == 2 && use_tab) carry = ((const LAS float*)(lds + RG_CIN_OFF))[((dir * 4 + (tt >> 4)) * 512) + tid];
        if (PASS == 2 && !use_tab) {
            const f32x2* sm = a.summ + ((size_t)dir * NSEQ + s) * RG_NT * DRG + ch;
            const int cnt = dir == 0 ? tt : RG_NT - 1 - tt;
            for (int j0 = 0; j0 < cnt; j0 += 16) {
                f32x2 pb[16];
#pragma unroll
                for (int q = 0; q < 16; ++q) { const int jj = j0 + q, j = dir == 0 ? jj : RG_NT - 1 - jj, jc = jj < cnt ? j : tt; pb[q] = sm[(size_t)jc * DRG]; if (jj >= cnt) pb[q] = (f32x2){1.f, 0.f}; }
#pragma unroll
                for (int q = 0; q < 16; ++q) carry = pb[q].x * carry + pb[q].y;
            }
        }
        if (PASS == 2) { __builtin_amdgcn_s_waitcnt(0x0F70);
                         if (dir == 0) {
#pragma unroll
                             for (int b = 0; b < RG_T / 16; ++b) stq[1][b] = a.ab[1][((size_t)unit * (RG_T / 16) + b) * 512 + tid];
                         }
                         if (dir == 0) pendA = bg_begin<true>(pa, bg, lane, bscr); else pendB = bg_begin<true>(pa, bg, lane, bscr); }
        HPB(31 + dir);
        constexpr int NB = 4;
#pragma unroll
        for (int hx = 0; hx < 2; ++hx) {
        const int b0 = (dir == 0 ? hx : 1 - hx) * NB;
        HPB(33);
        float av[NB][4], bv[NB][4];
#pragma unroll
        for (int j = 0; j < NB; ++j) {
            const int blk = b0 + j;
            typedef _Float16 h2 __attribute__((ext_vector_type(2)));
            if (PASS == 1) {
                f32x4 accR = (f32x4){0.f, 0.f, 0.f, 0.f}, accI = (f32x4){0.f, 0.f, 0.f, 0.f};
#pragma unroll
                for (int kk = 0; kk < 4; ++kk) {
                    const bf16x8 af = *(const LAS bf16x8*)(lds + (16 * blk + fr) * RG_XC_STRIDE + (32 * kk + 8 * fq) * 2);
                    accR = __builtin_amdgcn_mfma_f32_16x16x32_bf16(af, Br[kk], accR, 0, 0, 0);
                    accI = __builtin_amdgcn_mfma_f32_16x16x32_bf16(af, Bi[kk], accI, 0, 0, 0);
                }
                unsigned pk[4];
#pragma unroll
                for (int e = 0; e < 4; ++e) {
                    const float r = sigmoidf_(accR[e] + ba), ig = sigmoidf_(accI[e] + bx);
                    const float log_a = -8.0f * r * sp;
                    const float a0 = fexp(log_a);
                    const float x2 = 2.0f * log_a;
                    const float em = -x2 * (1.0f + x2 * (0.5f + x2 * (0.16666667f + x2 * (0.041666668f + x2 * (0.0083333338f + x2 * 0.0013888889f)))));
                    const float em2 = x2 < -0.25f ? (1.0f - a0 * a0) : em;
                    const float mult = __builtin_amdgcn_sqrtf(fmaxf(em2, 0.f));
                    const float xcv = bf2f(*(const LAS unsigned short*)(lds + (16 * blk + 4 * fq + e) * RG_XC_STRIDE + (16 * wave + fr) * 2));
                    const h2 p = (h2){(_Float16)log_a, (_Float16)(mult * ig * xcv)};
                    pk[e] = __builtin_bit_cast(unsigned, p);
                    av[j][e] = fexp((float)p.x); bv[j][e] = (float)p.y;
                }
                a.ab[dir][((size_t)unit * (RG_T / 16) + blk) * 512 + tid] = (v4u){pk[0], pk[1], pk[2], pk[3]};
            } else {
                const v4u w = stq[dir][blk]; const unsigned ww[4] = {w.x, w.y, w.z, w.w};
#pragma unroll
                for (int e = 0; e < 4; ++e) { const h2 p = __builtin_bit_cast(h2, ww[e]); av[j][e] = fexp((float)p.x); bv[j][e] = (float)p.y; }
            }
            if (j & 1) __builtin_amdgcn_sched_barrier(0);
        }
        HPE(33); HPB(34);
        float Ai[NB], Bi_[NB], At[NB], Bt[NB];
#pragma unroll
        for (int j = 0; j < NB; ++j) {
            float A = 1.f, B = 0.f;
            if (dir == 0) {
#pragma unroll
                for (int e = 0; e < 4; ++e) { B = av[j][e] * B + bv[j][e]; A *= av[j][e]; }
                float Ap = __shfl_up(A, 16), Bp = __shfl_up(B, 16);
                if (fq >= 1) { B = A * Bp + B; A = Ap * A; }
                Ap = __shfl_up(A, 32); Bp = __shfl_up(B, 32);
                if (fq >= 2) { B = A * Bp + B; A = Ap * A; }
                At[j] = __shfl(A, 48 + fr); Bt[j] = __shfl(B, 48 + fr);
            } else {
#pragma unroll
                for (int e = 3; e >= 0; --e) { B = av[j][e] * B + bv[j][e]; A *= av[j][e]; }
                float Ap = __shfl_down(A, 16), Bp = __shfl_down(B, 16);
                if (fq <= 2) { B = A * Bp + B; A = Ap * A; }
                Ap = __shfl_down(A, 32); Bp = __shfl_down(B, 32);
                if (fq <= 1) { B = A * Bp + B; A = Ap * A; }
                At[j] = __shfl(A, fr); Bt[j] = __shfl(B, fr);
            }
            Ai[j] = A; Bi_[j] = B;
        }
        __builtin_amdgcn_sched_barrier(0);
        float cin[NB];
#pragma unroll
        for (int q = 0; q < NB; ++q) { const int j = dir == 0 ? q : NB - 1 - q; cin[j] = carry; carry = At[j] * carry + Bt[j]; if (PASS == 1) ptot *= At[j]; }
        if (PASS == 2) {
#pragma unroll
            for (int j = 0; j < NB; ++j) {
                const int blk = b0 + j;
                const float hend = Ai[j] * cin[j] + Bi_[j];
                if (dir == 0) {
                    const float hprev = __shfl_up(hend, 16);
                    float hh = fq == 0 ? cin[j] : hprev;
#pragma unroll
                    for (int e = 0; e < 4; ++e) { hh = av[j][e] * hh + bv[j][e]; hf[blk][e] = hh; }
                } else {
                    const float hprev = __shfl_down(hend, 16);
                    float hh = fq == 3 ? cin[j] : hprev, hb[4];
#pragma unroll
                    for (int e = 3; e >= 0; --e) { hh = av[j][e] * hh + bv[j][e]; hb[e] = hh; }
#pragma unroll
                    for (int e = 0; e < 4; ++e) {
                        const size_t m = mrow0 + tok0 + 16 * blk + 4 * fq + e;
                        const float g = bf2f(*(const LAS unsigned short*)(lds + RG_G_OFF + (16 * blk + 4 * fq + e) * RG_XC_STRIDE + (16 * wave + fr) * 2));
                        a.rgy[m * DRG + ch] = (bf16)f2bf((hf[blk][e] + hb[e]) * gelu_tanh(g));
                    }
                }
            }
        }
        HPE(34);
        }
        HPE(31 + dir);
        if (PASS == 1 && fq == 0) a.summ[(((size_t)dir * NSEQ + s) * RG_NT + tt) * DRG + ch] = (f32x2){ptot, carry};
    }
    if (PASS == 1) bg_end<true, 4>(pa, pendB, lane, bscr); else bg_end<true, 16>(pa, pendB, lane, bscr);
}
__device__ __forceinline__ void mixnorm_rg_row(const bf16* rgy, const float* g_rg, bf16* mix, int m, int lane) {
    v4u r[4]; float s = 0.f;
#pragma unroll
    for (int j = 0; j < 4; ++j) { r[j] = *(const v4u*)(rgy + (size_t)m * DRG + (j * 64 + lane) * 8);
        const float a0 = bflo(r[j].x), a1 = bfhi(r[j].x), a2 = bflo(r[j].y), a3 = bfhi(r[j].y), a4 = bflo(r[j].z), a5 = bfhi(r[j].z), a6 = bflo(r[j].w), a7 = bfhi(r[j].w);
        s += (a0 * a0 + a1 * a1) + (a2 * a2 + a3 * a3) + (a4 * a4 + a5 * a5) + (a6 * a6 + a7 * a7); }
    const float rs = 1.0f / sqrtf(wave_sum(s) * (1.0f / DRG) + EPSN);
#pragma unroll
    for (int j = 0; j < 4; ++j) { const int c0 = (j * 64 + lane) * 8; const f32x4 g0 = *(const f32x4*)(g_rg + c0), g1 = *(const f32x4*)(g_rg + c0 + 4);
        v4u o; o.x = pk2(bflo(r[j].x) * rs * g0.x, bfhi(r[j].x) * rs * g0.y); o.y = pk2(bflo(r[j].y) * rs * g0.z, bfhi(r[j].y) * rs * g0.w);
        o.z = pk2(bflo(r[j].z) * rs * g1.x, bfhi(r[j].z) * rs * g1.y); o.w = pk2(bflo(r[j].w) * rs * g1.z, bfhi(r[j].w) * rs * g1.w);
        *(v4u*)(mix + (size_t)m * LDK + c0) = o; }
}
constexpr int MN_TILE_STRIDE = 66;
constexpr int MN_LDS_BYTES = 8 * 64 * MN_TILE_STRIDE * 2 + 8 * 64 * 4 + 64 * 4;
template <int TT> __device__ __forceinline__ void mixnorm_hy_tile(const bf16* hyy, const float* g_hy, bf16* mix, LAS unsigned char* lds, int m0, int tid) {
    constexpr int NG = TT / 8, RP = 64 / NG;
    const int wave = tid >> 6, lane = tid & 63, r8 = lane >> 3, g8 = lane & 7, rr = lane / NG, gg = lane % NG;
    LAS unsigned* tl = (LAS unsigned*)(lds + wave * 64 * MN_TILE_STRIDE * 2);
    LAS float* part = (LAS float*)(lds + 8 * 64 * MN_TILE_STRIDE * 2);
    LAS float* scl = part + 8 * 64;
    wg_sync();
    float s[8];
#pragma unroll
    for (int j = 0; j < 8; ++j) s[j] = 0.f;
    const bf16* src = hyy + (size_t)(wave * 256 + rr) * NTOK + m0 + 8 * gg;
#pragma unroll 4
    for (int i = 0; i < 256 / RP; ++i) { const v4u w = *(const v4u*)(src + (size_t)RP * i * NTOK);
        const float a0 = bflo(w.x), a1 = bfhi(w.x), a2 = bflo(w.y), a3 = bfhi(w.y), a4 = bflo(w.z), a5 = bfhi(w.z), a6 = bflo(w.w), a7 = bfhi(w.w);
        s[0] += a0 * a0; s[1] += a1 * a1; s[2] += a2 * a2; s[3] += a3 * a3; s[4] += a4 * a4; s[5] += a5 * a5; s[6] += a6 * a6; s[7] += a7 * a7; }
#pragma unroll
    for (int j = 0; j < 8; ++j) {
#pragma unroll
        for (int x = NG; x < 64; x *= 2) s[j] += __shfl_xor(s[j], x); }
    if (rr == 0) {
#pragma unroll
        for (int j = 0; j < 8; ++j) part[wave * 64 + 8 * gg + j] = s[j];
    }
    wg_sync();
    if (tid < TT) { float t = 0.f;
#pragma unroll
        for (int w = 0; w < 8; ++w) t += part[w * 64 + tid];
        scl[tid] = 1.0f / sqrtf(t * (1.0f / DHY) + EPSN); }
    wg_sync();
    for (int cb = wave; cb < DHY / 64; cb += 8) {
        v4u in[64 / RP];
#pragma unroll
        for (int i = 0; i < 64 / RP; ++i) in[i] = *(const v4u*)(hyy + (size_t)(cb * 64 + RP * i + rr) * NTOK + m0 + 8 * gg);
        const f32x4 gA = *(const f32x4*)(g_hy + cb * 64 + 8 * g8), gB = *(const f32x4*)(g_hy + cb * 64 + 8 * g8 + 4);
#pragma unroll
        for (int i = 0; i < 64 / RP; ++i) { LAS unsigned* w = tl + (RP * i + rr) * 33 + 4 * gg; w[0] = in[i].x; w[1] = in[i].y; w[2] = in[i].z; w[3] = in[i].w; }
        asm volatile("s_waitcnt lgkmcnt(0)" ::: "memory");
        const LAS unsigned short* th = (const LAS unsigned short*)tl;
#pragma unroll
        for (int q = 0; q < TT / 8; ++q) {
            const int tk = 8 * q + r8;
            const float sc = scl[tk];
            float v[8];
#pragma unroll
            for (int e2 = 0; e2 < 8; ++e2) v[e2] = bf2f(th[(8 * g8 + e2) * MN_TILE_STRIDE + tk]) * sc;
            v4u o; o.x = pk2(v[0] * gA.x, v[1] * gA.y); o.y = pk2(v[2] * gA.z, v[3] * gA.w); o.z = pk2(v[4] * gB.x, v[5] * gB.y); o.w = pk2(v[6] * gB.z, v[7] * gB.w);
            *(v4u*)(mix + (size_t)(m0 + tk) * LDK + DRG + cb * 64 + 8 * g8) = o;
        }
        asm volatile("s_waitcnt lgkmcnt(0)" ::: "memory");
    }
}
__device__ __forceinline__ void rowpass1(const float* xr, const bf16* yr, const float* g_post, const float* g_pre, float* outr, bf16* xnr, int lane) {
    float v[64]; float s = 0.f;
#pragma unroll
    for (int j = 0; j < 8; ++j) { const v4u r = *(const v4u*)(yr + (j * 64 + lane) * 8);
        v[8 * j + 0] = bflo(r.x); v[8 * j + 1] = bfhi(r.x); v[8 * j + 2] = bflo(r.y); v[8 * j + 3] = bfhi(r.y); v[8 * j + 4] = bflo(r.z); v[8 * j + 5] = bfhi(r.z); v[8 * j + 6] = bflo(r.w); v[8 * j + 7] = bfhi(r.w);
#pragma unroll
        for (int e = 0; e < 8; ++e) s += v[8 * j + e] * v[8 * j + e]; }
    const float rs = 1.0f / sqrtf(wave_sum(s) * (1.0f / DM) + EPSN);
    float s2 = 0.f;
#pragma unroll
    for (int j = 0; j < 8; ++j) { const int c0 = (j * 64 + lane) * 8;
        const f32x4 x0 = *(const f32x4*)(xr + c0), x1 = *(const f32x4*)(xr + c0 + 4), g0 = *(const f32x4*)(g_post + c0), g1 = *(const f32x4*)(g_post + c0 + 4);
        f32x4 o0, o1;
        o0.x = x0.x + v[8 * j + 0] * rs * g0.x; o0.y = x0.y + v[8 * j + 1] * rs * g0.y; o0.z = x0.z + v[8 * j + 2] * rs * g0.z; o0.w = x0.w + v[8 * j + 3] * rs * g0.w;
        o1.x = x1.x + v[8 * j + 4] * rs * g1.x; o1.y = x1.y + v[8 * j + 5] * rs * g1.y; o1.z = x1.z + v[8 * j + 6] * rs * g1.z; o1.w = x1.w + v[8 * j + 7] * rs * g1.w;
        { v4u ob; ob.x = pk2(o0.x, o0.y); ob.y = pk2(o0.z, o0.w); ob.z = pk2(o1.x, o1.y); ob.w = pk2(o1.z, o1.w); *(v4u*)((bf16*)outr + DM + c0) = ob; }
        v[8 * j + 0] = o0.x; v[8 * j + 1] = o0.y; v[8 * j + 2] = o0.z; v[8 * j + 3] = o0.w; v[8 * j + 4] = o1.x; v[8 * j + 5] = o1.y; v[8 * j + 6] = o1.z; v[8 * j + 7] = o1.w;
        s2 += (o0.x * o0.x + o0.y * o0.y) + (o0.z * o0.z + o0.w * o0.w) + (o1.x * o1.x + o1.y * o1.y) + (o1.z * o1.z + o1.w * o1.w); }
    const float rs2 = 1.0f / sqrtf(wave_sum(s2) * (1.0f / DM) + EPSN);
#pragma unroll
    for (int j = 0; j < 8; ++j) { const int c0 = (j * 64 + lane) * 8; const f32x4 g0 = *(const f32x4*)(g_pre + c0), g1 = *(const f32x4*)(g_pre + c0 + 4);
        v4u o; o.x = pk2(v[8 * j + 0] * rs2 * g0.x, v[8 * j + 1] * rs2 * g0.y); o.y = pk2(v[8 * j + 2] * rs2 * g0.z, v[8 * j + 3] * rs2 * g0.w);
        o.z = pk2(v[8 * j + 4] * rs2 * g1.x, v[8 * j + 5] * rs2 * g1.y); o.w = pk2(v[8 * j + 6] * rs2 * g1.z, v[8 * j + 7] * rs2 * g1.w);
        *(v4u*)(xnr + c0) = o; }
}
__device__ __forceinline__ void rowpass2(const bf16* fr_, const float* g, float* outr, int lane) {
    float v[64]; float s = 0.f;
#pragma unroll
    for (int j = 0; j < 8; ++j) { const v4u r = *(const v4u*)(fr_ + (j * 64 + lane) * 8);
        v[8 * j + 0] = bflo(r.x); v[8 * j + 1] = bfhi(r.x); v[8 * j + 2] = bflo(r.y); v[8 * j + 3] = bfhi(r.y); v[8 * j + 4] = bflo(r.z); v[8 * j + 5] = bfhi(r.z); v[8 * j + 6] = bflo(r.w); v[8 * j + 7] = bfhi(r.w);
#pragma unroll
        for (int e = 0; e < 8; ++e) s += v[8 * j + e] * v[8 * j + e]; }
    const float rs = 1.0f / sqrtf(wave_sum(s) * (1.0f / DM) + EPSN);
    v4u xb[8];
#pragma unroll
    for (int j = 0; j < 8; ++j) xb[j] = *(const v4u*)((const bf16*)outr + DM + (j * 64 + lane) * 8);
    asm volatile("s_waitcnt vmcnt(0)" ::: "memory");
#pragma unroll
    for (int j = 0; j < 8; ++j) { const int c0 = (j * 64 + lane) * 8;
        const f32x4 g0 = *(const f32x4*)(g + c0), g1 = *(const f32x4*)(g + c0 + 4);
        f32x4 o0, o1;
        o0.x = bflo(xb[j].x) + v[8 * j + 0] * rs * g0.x; o0.y = bfhi(xb[j].x) + v[8 * j + 1] * rs * g0.y; o0.z = bflo(xb[j].y) + v[8 * j + 2] * rs * g0.z; o0.w = bfhi(xb[j].y) + v[8 * j + 3] * rs * g0.w;
        o1.x = bflo(xb[j].z) + v[8 * j + 4] * rs * g1.x; o1.y = bfhi(xb[j].z) + v[8 * j + 5] * rs * g1.y; o1.z = bflo(xb[j].w) + v[8 * j + 6] * rs * g1.z; o1.w = bfhi(xb[j].w) + v[8 * j + 7] * rs * g1.w;
        *(f32x4*)(outr + c0) = o0; *(f32x4*)(outr + c0 + 4) = o1; }
}
constexpr int SIDE_G_ROWS = 8, SIDE_U_ROWS = 4;
__device__ __forceinline__ float dpp_prev(float x, float xprevblk) {
    const int old = __builtin_amdgcn_update_dpp(0, __builtin_bit_cast(int, xprevblk), 0x121  , 0xf, 0xf, false);
    return __builtin_bit_cast(float, __builtin_amdgcn_update_dpp(old, __builtin_bit_cast(int, x), 0x111  , 0xf, 0xf, false));
}
__device__ __forceinline__ float dpp_next(float x, float xnextblk) {
    const int old = __builtin_amdgcn_update_dpp(0, __builtin_bit_cast(int, xnextblk), 0x12F  , 0xf, 0xf, false);
    return __builtin_bit_cast(float, __builtin_amdgcn_update_dpp(old, __builtin_bit_cast(int, x), 0x101  , 0xf, 0xf, false));
}
struct EpiGate {
    static constexpr bool PERM = true, AFTER_DRAIN = false, AROWPERM = true;
    bf16* H; const float* cw; const float* cb; float* sideG; float* sideU;
    __device__ __forceinline__ void operator()(const pg8::f32x4 (&acc)[2][2][4][2], const pg8::Unit& u, int wr, int wc, int fr, int fq) const {
        const int hc0 = u.pn * 128 + wc * 32 + 8 * fq;
        f32x4 w0[2], w1[2], w2[2], bb[2];
#pragma unroll
        for (int n = 0; n < 2; ++n) { w0[n] = *(const f32x4*)(cw + hc0 + 4 * n); w1[n] = *(const f32x4*)(cw + DFF + hc0 + 4 * n); w2[n] = *(const f32x4*)(cw + 2 * DFF + hc0 + 4 * n); bb[n] = *(const f32x4*)(cb + hc0 + 4 * n); }
        const size_t row0 = (size_t)u.pm * 256 + wr * 128 + fr;
        const f32x4 zero4 = (f32x4){0.f, 0.f, 0.f, 0.f};
#pragma unroll
        for (int blk = 0; blk < 8; ++blk) {
            const int ai = blk >> 2, m = blk & 3;
            float r[8];
#pragma unroll
            for (int n = 0; n < 2; ++n) {
                const f32x4 x = acc[ai][0][m][n];
                const f32x4 xp = blk > 0 ? acc[(blk - 1) >> 2][0][(blk - 1) & 3][n] : zero4;
                const f32x4 xn = blk < 7 ? acc[(blk + 1) >> 2][0][(blk + 1) & 3][n] : zero4;
                const f32x4 uu = acc[ai][1][m][n];
#pragma unroll
                for (int j = 0; j < 4; ++j) {
                    const float pre = bb[n][j] + w0[n][j] * dpp_prev(x[j], xp[j]) + w1[n][j] * x[j] + w2[n][j] * dpp_next(x[j], xn[j]);
                    r[4 * n + j] = gelu_tanh(pre) * uu[j];
                }
            }
            v4u o; o.x = pk2(r[0], r[1]); o.y = pk2(r[2], r[3]); o.z = pk2(r[4], r[5]); o.w = pk2(r[6], r[7]);
            *(v4u*)(H + (row0 + 16 * blk) * DFF + hc0) = o;
        }
        float* sg = sideG + ((size_t)u.pm * SIDE_G_ROWS + 4 * wr) * DFF + hc0;
        float* su = sideU + ((size_t)u.pm * SIDE_U_ROWS + 2 * wr) * DFF + hc0;
        if (fr < 2) { *(f32x4*)(sg + (size_t)fr * DFF) = acc[0][0][0][0]; *(f32x4*)(sg + (size_t)fr * DFF + 4) = acc[0][0][0][1]; }
        if (fr >= 14) { *(f32x4*)(sg + (size_t)(fr - 12) * DFF) = acc[1][0][3][0]; *(f32x4*)(sg + (size_t)(fr - 12) * DFF + 4) = acc[1][0][3][1]; }
        if (fr == 0) { *(f32x4*)su = acc[0][1][0][0]; *(f32x4*)(su + 4) = acc[0][1][0][1]; }
        if (fr == 15) { *(f32x4*)(su + DFF) = acc[1][1][3][0]; *(f32x4*)(su + DFF + 4) = acc[1][1][3][1]; }
    }
};
__device__ __forceinline__ void gate_fixup(const float* sideG, const float* sideU, const float* cw, const float* cb, bf16* H, int gtid, int nthreads) {
    constexpr int C4 = DFF / 4, NT = NTOK / 256;
    for (int idx = gtid; idx < NT * 4 * C4; idx += nthreads) {
        const int c = (idx % C4) * 4, k = (idx / C4) & 3, pm = idx / (4 * C4);
        const float* g = sideG + (size_t)pm * SIDE_G_ROWS * DFF + c;
        f32x4 prev, cur, next; int row;
        const f32x4 z = (f32x4){0.f, 0.f, 0.f, 0.f};
        if (k == 0) { row = 0; prev = (pm % 32 == 0) ? z : *(const f32x4*)(g - (size_t)SIDE_G_ROWS * DFF + 7 * (size_t)DFF); cur = *(const f32x4*)g; next = *(const f32x4*)(g + DFF); }
        else if (k == 1) { row = 127; prev = *(const f32x4*)(g + 2 * (size_t)DFF); cur = *(const f32x4*)(g + 3 * (size_t)DFF); next = *(const f32x4*)(g + 4 * (size_t)DFF); }
        else if (k == 2) { row = 128; prev = *(const f32x4*)(g + 3 * (size_t)DFF); cur = *(const f32x4*)(g + 4 * (size_t)DFF); next = *(const f32x4*)(g + 5 * (size_t)DFF); }
        else { row = 255; prev = *(const f32x4*)(g + 6 * (size_t)DFF); cur = *(const f32x4*)(g + 7 * (size_t)DFF); next = (pm % 32 == 31) ? z : *(const f32x4*)(g + (size_t)SIDE_G_ROWS * DFF); }
        const f32x4 uu = *(const f32x4*)(sideU + ((size_t)pm * SIDE_U_ROWS + k) * DFF + c);
        const f32x4 w0 = *(const f32x4*)(cw + c), w1 = *(const f32x4*)(cw + DFF + c), w2 = *(const f32x4*)(cw + 2 * DFF + c), b = *(const f32x4*)(cb + c);
        float r[4];
#pragma unroll
        for (int j = 0; j < 4; ++j) r[j] = gelu_tanh(b[j] + w0[j] * prev[j] + w1[j] * cur[j] + w2[j] * next[j]) * uu[j];
        v2u o; o.x = pk2(r[0], r[1]); o.y = pk2(r[2], r[3]);
        *(v2u*)(H + ((size_t)pm * 256 + row) * DFF + c) = o;
    }
}
constexpr int LDS_PHASE_BYTES = 143360;
constexpr int LDSCTL_OFF = LDS_PHASE_BYTES, LDS_BYTES = 147456;
constexpr int CW_BAR = 4096;
constexpr size_t CTL_ZERO_BYTES = 64 * 1024;
static_assert(HY_LDS_BYTES <= LDS_PHASE_BYTES && RG_LDS_BYTES <= LDS_PHASE_BYTES && MN_LDS_BYTES <= LDS_PHASE_BYTES && pg8::STAGE_BYTES <= LDS_PHASE_BYTES, "LDS map");
static_assert((CW_BAR + XCD_BAR_WORDS) * 4 <= (int)CTL_ZERO_BYTES, "control words inside the memset region");

#ifndef PROBE_MASK
#define PROBE_MASK 0ull
#endif
#define PROBE_AMP 4ull
#define PB(bit) do { if ((PROBE_MASK >> (bit)) & 1ull) { if (blockIdx.x == PROBE_BLK && threadIdx.x == 0) probe_t0 = __builtin_amdgcn_s_memrealtime(); } } while (0)
#define PE(bit) do { if ((PROBE_MASK >> (bit)) & 1ull) { if (blockIdx.x == PROBE_BLK && threadIdx.x == 0) probe_acc += __builtin_amdgcn_s_memrealtime() - probe_t0; } } while (0)
struct TailStealOrder : pg8::StaticOrder {
    unsigned* head; volatile LAS unsigned* slot; int full;
    __device__ __forceinline__ bool next(int i, pg8::Unit& u) const {
        if (i < full) return pg8::StaticOrder::next(i, u);
        if (i > full) return false;
        if (threadIdx.x == 0) *slot = __hip_atomic_fetch_add(head, 1u, __ATOMIC_RELAXED, __HIP_MEMORY_SCOPE_AGENT);
        asm volatile("s_waitcnt lgkmcnt(0)" ::: "memory"); __builtin_amdgcn_s_barrier(); asm volatile("" ::: "memory");
        pg8::StaticOrder t = *this; t.c = (int)*slot;
        return t.c < G && t.next(full, u);
    }
};
struct XcdQueueOrder : pg8::StaticOrder {
    unsigned* ctr; volatile LAS unsigned* slot; int rs;
    __device__ __forceinline__ bool next(int i, pg8::Unit& u) const {
        if (i < rs) return pg8::StaticOrder::next(i, u);
        if (threadIdx.x == 0) {
            const int x = c % pg8::NXCD, q = nwg / pg8::NXCD, r = nwg % pg8::NXCD, base = rs * (G / pg8::NXCD);
            unsigned cur = slot[1]; int code = -1;
            if (cur < (unsigned)pg8::NXCD) {
                { const int y = (x + (int)cur) % pg8::NXCD, len = q + (y < r ? 1 : 0);
                  const int off = base + (int)__hip_atomic_fetch_add(ctr + y * 32, 1u, __ATOMIC_RELAXED, __HIP_MEMORY_SCOPE_AGENT);
                  if (off < len) code = off * pg8::NXCD + y; else ++cur; }
                if (code < 0 && cur < (unsigned)pg8::NXCD) {
                    unsigned cv[pg8::NXCD];
#pragma unroll
                    for (int k = 0; k < pg8::NXCD; ++k) cv[k] = __hip_atomic_load(ctr + ((x + k) % pg8::NXCD) * 32, __ATOMIC_RELAXED, __HIP_MEMORY_SCOPE_AGENT);
#pragma unroll
                    for (int k = 0; k < pg8::NXCD; ++k) {
                        if (code < 0 && (unsigned)k >= cur) { const int y = (x + k) % pg8::NXCD, len = q + (y < r ? 1 : 0);
                            cur = (unsigned)k;
                            if (base + (int)cv[k] < len) { const int off = base + (int)__hip_atomic_fetch_add(ctr + y * 32, 1u, __ATOMIC_RELAXED, __HIP_MEMORY_SCOPE_AGENT); if (off < len) code = off * pg8::NXCD + y; }
                            if (code < 0) cur = (unsigned)k + 1u; }
                    }
                }
            }
            slot[1] = cur; slot[0] = (unsigned)code;
        }
        asm volatile("s_waitcnt lgkmcnt(0)" ::: "memory"); __builtin_amdgcn_s_barrier(); asm volatile("" ::: "memory");
        const int code = (int)slot[0];
        if (code < 0) return false;
        pg8::StaticOrder t = *this; t.c = code % G; return t.next(code / G, u);
    }
};
struct MkArgs { const float* in[32]; float* out; unsigned char* ws; };
__device__ __forceinline__ pg8::Gemm dgemm(const bf16* A, const bf16* Bt, int M, int N, int K, int lda, int ldb) { pg8::Gemm g; g.A = A; g.Bt = Bt; g.M = M; g.N = N; g.K = K; g.lda = lda; g.ldb = ldb; return g; }
__device__ __forceinline__ pg8::EpiBf16<0> depi(bf16* O, int ldc) { pg8::EpiBf16<0> e; e.O = O; e.ldc = ldc; e.bias = nullptr; e.split_cols = 0; e.split_stride = 0; e.scale0 = 1.f; return e; }

__device__ __forceinline__ void gate_seq(const bf16* gu, const float* cw, const float* cb, bf16* h, int gtid, int nthreads) {
    constexpr int CG = DFF / 8;
    for (int idx = gtid; idx < SEQL * CG; idx += nthreads) {
        const int m = idx / CG, c0 = (idx % CG) * 8;
        const v4u z = (v4u){0u, 0u, 0u, 0u};
        const v4u gm = m > 0 ? *(const v4u*)(gu + (size_t)(m - 1) * 2 * DFF + c0) : z;
        const v4u g0 = *(const v4u*)(gu + (size_t)m * 2 * DFF + c0);
        const v4u gp = m < SEQL - 1 ? *(const v4u*)(gu + (size_t)(m + 1) * 2 * DFF + c0) : z;
        const v4u uu = *(const v4u*)(gu + (size_t)m * 2 * DFF + DFF + c0);
        float r[8];
#pragma unroll
        for (int e = 0; e < 8; ++e) {
            const unsigned wm = e < 2 ? gm.x : e < 4 ? gm.y : e < 6 ? gm.z : gm.w, w0 = e < 2 ? g0.x : e < 4 ? g0.y : e < 6 ? g0.z : g0.w, wp = e < 2 ? gp.x : e < 4 ? gp.y : e < 6 ? gp.z : gp.w, wu = e < 2 ? uu.x : e < 4 ? uu.y : e < 6 ? uu.z : uu.w;
            const float a = (e & 1) ? bfhi(wm) : bflo(wm), b = (e & 1) ? bfhi(w0) : bflo(w0), c = (e & 1) ? bfhi(wp) : bflo(wp), u = (e & 1) ? bfhi(wu) : bflo(wu);
            const float pre = cb[c0 + e] + cw[c0 + e] * a + cw[DFF + c0 + e] * b + cw[2 * DFF + c0 + e] * c;
            r[e] = gelu_tanh(pre) * u;
        }
        v4u o; o.x = pk2(r[0], r[1]); o.y = pk2(r[2], r[3]); o.z = pk2(r[4], r[5]); o.w = pk2(r[6], r[7]);
        *(v4u*)(h + (size_t)m * DFF + c0) = o;
    }
}

#if defined(__HIP_DEVICE_COMPILE__)
#define MK_NOPK __attribute__((target("no-packed-fp32-ops")))
#else
#define MK_NOPK
#endif
__global__ void __launch_bounds__(512, 2) MK_NOPK mk_fwd(MkArgs args) {
    extern __shared__ __attribute__((aligned(16))) unsigned char lds_raw[];
    LAS unsigned char* lds = (LAS unsigned char*)lds_raw;
    const int tid = threadIdx.x, lane = tid & 63, wave = __builtin_amdgcn_readfirstlane(tid >> 6);
    const int G = gridDim.x, bx = blockIdx.x;
    unsigned char* ws = args.ws;
    const float* const* in = args.in;
    volatile LAS unsigned* MISC = (volatile LAS unsigned*)(lds + LDSCTL_OFF);
    for (int u = tid; u < (LDS_BYTES - LDSCTL_OFF) / 4; u += 512) ((LAS unsigned*)(lds + LDSCTL_OFF))[u] = 0u;
    wg_sync();
    unsigned long long probe_t0 = 0ull, probe_acc = 0ull;
#if (PROBE_MASK >> 50) & 1
    if (blockIdx.x == PROBE_BLK && threadIdx.x == 0) g_probe_epi = 0ull;
#endif
    XcdBarrier bar = xcd_barrier_post((unsigned*)(ws + WS_CTL) + CW_BAR, MISC + 8);

    bf16* XN = (bf16*)(ws + WS_XN); bf16* WIN = (bf16*)(ws + WS_WIN);
    PB(0);
    ProArgs pa;
    {
        pa.xp = in[0]; pa.xs = in[1]; pa.g_premix = in[2]; pa.w_in = in[3]; pa.w_out = in[24]; pa.w_ffi = in[27]; pa.w_ffo = in[30]; pa.rg_a_w = in[6]; pa.rg_x_w = in[8];
        pa.hy_w1 = in[13]; pa.hy_b1 = in[14]; pa.hy_w2 = in[15]; pa.hy_b2 = in[16]; pa.hy_w3 = in[17]; pa.hy_b3 = in[18]; pa.hy_freq = in[20]; pa.ws = ws;
        p0_prologue<true>(pa, lds, bx * 8 + wave, G * 8, wave, lane, 4 * (RG_UNITS / G));
    }
    PE(0);
    PB(40); PB(20); xcd_barrier(bar); PE(20); PE(40);
    PB(1);
    {
        XcdQueueOrder S; S.init(NTOK, 2 * DRG, G, bx); S.ctr = (unsigned*)(ws + WS_CTL) + 8192 + 0 * 256; S.slot = MISC + 24; S.rs = S.nwg / G - 2; if (tid == 0) MISC[25] = 0u;
        pg8::gemm_phase<pg8::EpiBf16<0>, XcdQueueOrder, true, true>(lds, dgemm(XN, WIN, NTOK, 2 * DRG, DM, LDK, LDK), S, depi((bf16*)(ws + WS_PRG), 2 * DRG));
    }
    {
        XcdQueueOrder S; S.init(3 * DHY, NTOK, G, bx); S.ctr = (unsigned*)(ws + WS_CTL) + 8192 + 1 * 256; S.slot = MISC + 24; S.rs = S.nwg / G - 3; if (tid == 0) MISC[25] = 0u;
        pg8::gemm_phase<pg8::EpiBf16<0>, XcdQueueOrder, true, true>(lds, dgemm(WIN + (size_t)2 * DRG * LDK, XN, 3 * DHY, NTOK, DM, LDK, LDK), S, depi((bf16*)(ws + WS_PHY), NTOK));
    }
    PB(21); { int tq = tid; asm volatile("" : "+v"(tq)); filter_gemm((const bf16*)(ws + WS_H3), in[19], (_Float16*)(ws + WS_KF), bx, G, tq); } PE(21);
    PE(1);
    PB(41); PB(20); xcd_barrier(bar); PE(20); PE(41);
    RgArgs ra; ra.prg = (const bf16*)(ws + WS_PRG); ra.conv_w = in[4]; ra.conv_b = in[5]; ra.rgw = (const bf16*)(ws + WS_RGW); ra.a_b = in[7]; ra.x_b = in[9]; ra.lam = in[10];
    ra.summ = (f32x2*)(ws + WS_SUMM); ra.rgy = (bf16*)(ws + WS_RGY); ra.ab[0] = (v4u*)(ws + WS_XN); ra.ab[1] = (v4u*)args.out;
    {
        HyArgs a; a.phy = (const bf16*)(ws + WS_PHY); a.conv_w = in[11]; a.conv_b = in[12]; a.hy_bias = in[21]; a.kf = (const _Float16*)(ws + WS_KF); a.tw = (const f32x2*)(ws + WS_TW);
        a.zk = (f32x2*)(ws + WS_ZK); a.hyy = (bf16*)(ws + WS_HYY);
        PB(2);
        for (int cp = bx; cp < DHY / 2; cp += G) hyena_unit(a, lds, cp, bx, tid, probe_t0, probe_acc);
        PE(2);
    }
    PB(3);
    BgConv bg; { const int gw = bx * 8 + wave, ngw = G * 8, tot = TR_I_OUT + TR_I_FI  ; bg.it = TR_I_IN + gw; bg.step = ngw; bg.nleft = gw < tot ? (tot - gw + ngw - 1) / ngw : 0; const int slots = 4 * (RG_UNITS / G); if (bg.nleft > slots) bg.nleft = slots; }
    { RgW rw; const bool same_head = (G % NHEAD) == 0; if (same_head) rg_load_w(ra, bx % NHEAD, tid, rw);
      for (int u = bx; u < RG_UNITS; u += G) { if (!same_head) rg_load_w(ra, u % NHEAD, tid, rw); rg_unit<1>(ra, lds, u, tid, rw, pa, bg, false, probe_t0, probe_acc); } }
    PE(3);
    PB(42); PB(20); xcd_barrier(bar); PE(20); PE(42);
    PB(4);
    { RgW rw; const bool same_head = (G % NHEAD) == 0; (void)same_head;
      const bool tab = (G == 256);
      for (int u = bx; u < RG_UNITS; u += G) { if (tab && ((u / NHEAD) % RG_NT) < 16) rg_carry_table(ra, lds, bx % NHEAD, bx / NHEAD, u / (NHEAD * RG_NT), tid);
        rg_unit<2>(ra, lds, u, tid, rw, pa, bg, tab, probe_t0, probe_acc); }
      { LAS unsigned char* bscr = lds + RG_HF_OFF + wave * BG_SCR;
        while (bg.nleft > 0) { const int it = bg_begin<true>(pa, bg, lane, bscr); bg_end<true, 0>(pa, it, lane, bscr); } } }
    {
        constexpr int NT64 = NTOK / 64; const int whole = (NT64 / G) * G;
        for (int t = bx; t < whole; t += G) mixnorm_hy_tile<64>((const bf16*)(ws + WS_HYY), in[23], (bf16*)(ws + WS_MIX), lds, t * 64, tid);
        for (int t = bx; t < 2 * (NT64 - whole); t += G) mixnorm_hy_tile<32>((const bf16*)(ws + WS_HYY), in[23], (bf16*)(ws + WS_MIX), lds, whole * 64 + t * 32, tid);
    }
    PE(4);
    PB(43); PB(20); xcd_barrier(bar); PE(20); PE(43);
    PB(5);
    for (int m = bx * 8 + wave; m < NTOK; m += G * 8) mixnorm_rg_row((const bf16*)(ws + WS_RGY), in[22], (bf16*)(ws + WS_MIX), m, lane);
    PE(5);
    PB(44); PB(20); xcd_barrier(bar); PE(20); PE(44);
    PB(6);
    {
        pg8::StaticOrder S; S.init(NTOK, DM, G, bx);
        pg8::gemm_phase<pg8::EpiBf16<0>, pg8::StaticOrder, true, true>(lds, dgemm((bf16*)(ws + WS_MIX), (bf16*)(ws + WS_WOUT), NTOK, DM, DM, LDK, LDK), S, depi((bf16*)(ws + WS_Y), DM));
    }
    PE(6);
    PB(45); PB(20); xcd_barrier(bar); PE(20); PE(45);
    PB(7);
    for (int m = bx * 8 + wave; m < NTOK; m += G * 8) rowpass1(xrow_ptr(in[0], in[1], m), (const bf16*)(ws + WS_Y) + (size_t)m * DM, in[25], in[26], args.out + (size_t)m * DM, XN + (size_t)m * LDK, lane);
    PE(7);
    PB(46); PB(20); xcd_barrier(bar); PE(20); PE(46);
    PB(8);
    unsigned long long clk0_ = 0ull; if (((PROBE_MASK >> 51) & 1ull) && blockIdx.x == PROBE_BLK && threadIdx.x == 0) clk0_ = __builtin_amdgcn_s_memtime();
    bf16* HB = (bf16*)(ws + WS_H);
    {
        XcdQueueOrder S; S.init(NTOK, 2 * DFF, G, bx); S.ctr = (unsigned*)(ws + WS_CTL) + 8192 + 3 * 256; S.slot = MISC + 24; S.rs = S.nwg / G - 4; if (tid == 0) MISC[25] = 0u;
        EpiGate E; E.H = HB; E.cw = in[28]; E.cb = in[29]; E.sideG = (float*)(ws + WS_SIDEG); E.sideU = (float*)(ws + WS_SIDEU);
        pg8::gemm_phase<EpiGate, XcdQueueOrder, true, true>(lds, dgemm(XN, (bf16*)(ws + WS_WFI), NTOK, 2 * DFF, DM, LDK, LDK), S, E);
        { unsigned* cctr = (unsigned*)(ws + WS_CTL) + 2112; constexpr int FO0 = TR_I_IN + TR_I_OUT + TR_I_FI, NGRP = TR_I_FO / 64; static_assert(TR_I_FO % 64 == 0, "w_ffn_out item groups");
          for (;;) {
              wg_sync();
              if (tid == 0) MISC[24] = __hip_atomic_fetch_add(cctr, 1u, __ATOMIC_RELAXED, __HIP_MEMORY_SCOPE_AGENT);
              wg_sync();
              const int g = (int)MISC[24]; if (g >= NGRP) break;
              p0_transposes<true>(pa, (LAS float*)(lds + wave * 16384), lane, wave, 8, FO0 + g * 64, FO0 + g * 64 + 64);
          } }
    }
    PE(8);
    if (((PROBE_MASK >> 51) & 1ull) && blockIdx.x == PROBE_BLK && threadIdx.x == 0) probe_acc += (__builtin_amdgcn_s_memtime() - clk0_) >> 8;
    PB(47); PB(20); xcd_barrier(bar); PE(20); PE(47);
    PB(9);
    { int tq = tid; asm volatile("" : "+v"(tq)); gate_fixup((const float*)(ws + WS_SIDEG), (const float*)(ws + WS_SIDEU), in[28], in[29], HB, bx * 512 + tq, G * 512); }
    PE(9);
    PB(48); PB(20); xcd_barrier(bar); PE(20); PE(48);
    PB(10);
    {
        pg8::StaticOrder S; S.init(NTOK, DM, G, bx);
        pg8::gemm_phase<pg8::EpiBf16<0>, pg8::StaticOrder, true, true>(lds, dgemm(HB, (bf16*)(ws + WS_WFO), NTOK, DM, DFF, DFF, DFF), S, depi((bf16*)(ws + WS_F), DM));
    }
    PE(10);
    PB(49); PB(20); xcd_barrier(bar); PE(20); PE(49);
    PB(11);
    for (int m = bx * 8 + wave; m < NTOK; m += G * 8) rowpass2((const bf16*)(ws + WS_F) + (size_t)m * DM, in[31], args.out + (size_t)m * DM, lane);
    PE(11);
#if (PROBE_MASK >> 50) & 1
    if (blockIdx.x == PROBE_BLK && threadIdx.x == 0) probe_acc += g_probe_epi;
#endif
    if (PROBE_MASK != 0ull && blockIdx.x == PROBE_BLK && threadIdx.x == 0) { const unsigned long long t0 = __builtin_amdgcn_s_memrealtime(); while (__builtin_amdgcn_s_memrealtime() - t0 < probe_acc * PROBE_AMP) __builtin_amdgcn_s_sleep(8); }
}

extern "C" void kernel_launch(void* const* d_in, const int* in_sizes, int n_in, void* d_out, int out_size, void* d_ws, size_t ws_size, hipStream_t stream) {
    static int grid = 0;
    if (grid == 0) {
        grid = -1;
        if (n_in != 32 || out_size != NTOK * DM || ws_size < WS_END) { fprintf(stderr, "kernel_launch: unexpected sizes n_in %d out %d ws %zu (need %zu)\n", n_in, out_size, ws_size, (size_t)WS_END); return; }
        int dev = 0, cus = 0, per_cu = 0;
        if (hipGetDevice(&dev) != hipSuccess || hipDeviceGetAttribute(&cus, hipDeviceAttributeMultiprocessorCount, dev) != hipSuccess) return;
        if (hipFuncSetAttribute((const void*)mk_fwd, hipFuncAttributeMaxDynamicSharedMemorySize, LDS_BYTES) != hipSuccess) { fprintf(stderr, "kernel_launch: hipFuncSetAttribute failed\n"); return; }
        if (hipOccupancyMaxActiveBlocksPerMultiprocessor(&per_cu, (const void*)mk_fwd, 512, LDS_BYTES) != hipSuccess || per_cu < 1) { fprintf(stderr, "kernel_launch: occupancy query says %d blocks per CU\n", per_cu); (void)hipGetLastError(); return; }
        grid = cus;
    }
    if (grid < 0) return;
    if (hipMemsetAsync((char*)d_ws + WS_CTL, 0, CTL_ZERO_BYTES, stream) != hipSuccess) return;
    MkArgs a; memset(&a, 0, sizeof a);
    for (int i = 0; i < 32; ++i) a.in[i] = (const float*)d_in[i];
    a.out = (float*)d_out; a.ws = (unsigned char*)d_ws;
    hipLaunchKernelGGL(mk_fwd, dim3(grid), dim3(512), LDS_BYTES, stream, a);
}
```
